# Optimizing an MI355X kernel written in HIP

```python
import math
import jax, jax.numpy as jnp
from jax import lax
import numpy as np

D_MODEL = 1024
BATCH = 8
SEQ = 2048
DEPTH = 4

N_HEADS = 8
HEAD_DIM = 64
V_HEAD_DIM = 2 * HEAD_DIM
QK_WIDTH = 2 * N_HEADS * HEAD_DIM
V_WIDTH = N_HEADS * V_HEAD_DIM
CONV_WIDTH = D_MODEL
CONV_GROUPS = 8
CONV_K = 3
SPLIT_SIZES = (QK_WIDTH, QK_WIDTH, V_WIDTH, CONV_WIDTH, CONV_WIDTH, CONV_WIDTH, D_MODEL, D_MODEL)
SPLIT_IDX = (1024, 2048, 3072, 4096, 5120, 6144, 7168)
IN_WIDTH = 8192
D_FF = 2816
N_EXPERTS = 8
TOP_K = 2
D_FF_EXPERT = 3584
N_DENSE = (DEPTH + 1) // 2
N_MOE = DEPTH // 2
ROPE_THETA = 10000.0
RMS_EPS = 1e-5
Q_BLOCK = 128

kernel_name = "hybrid_diffattn_shortconv_moe_trunk"


def rmsnorm(x, g):
    xf = x.astype(jnp.float32)
    y = xf * lax.rsqrt(jnp.mean(xf * xf, axis=-1, keepdims=True) + RMS_EPS)
    return (y * g.astype(jnp.float32)).astype(x.dtype)


def rope_tables(T, dtype):
    pos = jnp.arange(T, dtype=jnp.float32)
    inv = 1.0 / (ROPE_THETA ** (jnp.arange(0, HEAD_DIM, 2, dtype=jnp.float32) / HEAD_DIM))
    ang = pos[:, None] * inv[None, :]
    ang = jnp.concatenate([ang, ang], axis=-1)
    return jnp.cos(ang).astype(dtype), jnp.sin(ang).astype(dtype)


def apply_rope(x, cos, sin):
    x1, x2 = jnp.split(x, 2, axis=-1)
    rot = jnp.concatenate([-x2, x1], axis=-1)
    return x * cos[None, :, None, :] + rot * sin[None, :, None, :]


def diff_attention(q, k, v, lam, lam_init, subln_g):
    B, T = q.shape[0], q.shape[1]
    q = q * (HEAD_DIM ** -0.5)
    neg = jnp.finfo(jnp.float32).min
    outs = []
    for i in range(T // Q_BLOCK):
        q0 = i * Q_BLOCK
        kv_len = q0 + Q_BLOCK
        q_blk = q[:, q0:kv_len]
        k_blk = k[:, :kv_len]
        v_blk = v[:, :kv_len]
        s = jnp.einsum('bqhmd,bkhmd->bhmqk', q_blk, k_blk).astype(jnp.float32)
        q_pos = q0 + jnp.arange(Q_BLOCK)
        k_pos = jnp.arange(kv_len)
        mask = k_pos[None, :] <= q_pos[:, None]
        s = jnp.where(mask[None, None, None], s, neg)
        p = jax.nn.softmax(s, axis=-1)
        p_diff = p[:, :, 0] - lam * p[:, :, 1]
        outs.append(jnp.einsum('bhqk,bkhe->bqhe', p_diff.astype(v.dtype), v_blk))
    o = jnp.concatenate(outs, axis=1)
    o = rmsnorm(o, subln_g) * (1.0 - lam_init)
    return o.reshape(B, T, V_WIDTH)


def causal_short_conv(u, w):
    T = u.shape[1]
    up = jnp.pad(u, ((0, 0), (CONV_K - 1, 0), (0, 0)))
    y = w[0] * up[:, 0:T]
    for j in range(1, CONV_K):
        y = y + w[j] * up[:, j:j + T]
    return y


def hybrid_mixer(h, w_in, conv_w, lam_q1, lam_k1, lam_q2, lam_k2, subln_g, w_out,
                 layer_idx, cos, sin):
    B, T, _ = h.shape
    proj = h @ w_in
    q, k, v, b_g, c_g, u, g_attn, g_conv = jnp.split(proj, SPLIT_IDX, axis=-1)
    q = apply_rope(q.reshape(B, T, 2 * N_HEADS, HEAD_DIM), cos, sin)
    k = apply_rope(k.reshape(B, T, 2 * N_HEADS, HEAD_DIM), cos, sin)
    q = q.reshape(B, T, N_HEADS, 2, HEAD_DIM)
    k = k.reshape(B, T, N_HEADS, 2, HEAD_DIM)
    v = v.reshape(B, T, N_HEADS, V_HEAD_DIM)
    lam_init = 0.8 - 0.6 * math.exp(-0.3 * layer_idx)
    lam = (jnp.exp(jnp.sum(lam_q1.astype(jnp.float32) * lam_k1.astype(jnp.float32)))
           - jnp.exp(jnp.sum(lam_q2.astype(jnp.float32) * lam_k2.astype(jnp.float32)))
           + lam_init)
    y_attn = diff_attention(q, k, v, lam, lam_init, subln_g)
    y_conv = b_g * causal_short_conv(c_g * u, conv_w)
    m = jax.nn.sigmoid(g_attn) * y_attn + jax.nn.sigmoid(g_conv) * y_conv
    return m @ w_out


def swiglu(h, w_gate, w_up, w_down):
    return (jax.nn.silu(h @ w_gate) * (h @ w_up)) @ w_down


def moe_swiglu(h, w_router, e_gate, e_up, e_down):
    B, T, D = h.shape
    xt = h.reshape(B * T, D)
    logits = (xt @ w_router).astype(jnp.float32)
    top_vals, top_idx = lax.top_k(logits, TOP_K)
    top_w = jax.nn.softmax(top_vals, axis=-1)
    gates = jnp.sum(jax.nn.one_hot(top_idx, N_EXPERTS, dtype=jnp.float32) * top_w[..., None],
                    axis=1).astype(h.dtype)
    y = jnp.zeros_like(xt)
    for e in range(N_EXPERTS):
        y = y + gates[:, e:e + 1] * swiglu(xt, e_gate[e], e_up[e], e_down[e])
    return y.reshape(B, T, D)


def setup_inputs(seed: int = 0) -> dict:
    key = jax.random.key(seed)
    ks = jax.random.split(key, 24)
    f32 = jnp.float32
    nrm = lambda k, shape, scale: jax.random.normal(k, shape, f32) * scale
    return {
        "x": nrm(ks[0], (BATCH, SEQ, D_MODEL), 1.0),
        "norm_mix": 1.0 + nrm(ks[1], (DEPTH, D_MODEL), 0.02),
        "w_in": nrm(ks[2], (DEPTH, D_MODEL, IN_WIDTH), D_MODEL ** -0.5),
        "conv_w": nrm(ks[3], (DEPTH, CONV_K, CONV_WIDTH), CONV_K ** -0.5),
        "lam_q1": nrm(ks[4], (DEPTH, HEAD_DIM), 0.1),
        "lam_k1": nrm(ks[5], (DEPTH, HEAD_DIM), 0.1),
        "lam_q2": nrm(ks[6], (DEPTH, HEAD_DIM), 0.1),
        "lam_k2": nrm(ks[7], (DEPTH, HEAD_DIM), 0.1),
        "subln_g": 1.0 + nrm(ks[8], (DEPTH, V_HEAD_DIM), 0.02),
        "w_out": nrm(ks[9], (DEPTH, D_MODEL, D_MODEL), D_MODEL ** -0.5),
        "norm_ffn": 1.0 + nrm(ks[10], (DEPTH, D_MODEL), 0.02),
        "ffn_w_gate": nrm(ks[11], (N_DENSE, D_MODEL, D_FF), D_MODEL ** -0.5),
        "ffn_w_up": nrm(ks[12], (N_DENSE, D_MODEL, D_FF), D_MODEL ** -0.5),
        "ffn_w_down": nrm(ks[13], (N_DENSE, D_FF, D_MODEL), D_FF ** -0.5),
        "router_w": nrm(ks[14], (N_MOE, D_MODEL, N_EXPERTS), D_MODEL ** -0.5),
        "exp_w_gate": nrm(ks[15], (N_MOE, N_EXPERTS, D_MODEL, D_FF_EXPERT), D_MODEL ** -0.5),
        "exp_w_up": nrm(ks[16], (N_MOE, N_EXPERTS, D_MODEL, D_FF_EXPERT), D_MODEL ** -0.5),
        "exp_w_down": nrm(ks[17], (N_MOE, N_EXPERTS, D_FF_EXPERT, D_MODEL), D_FF_EXPERT ** -0.5),
        "norm_final": 1.0 + nrm(ks[18], (D_MODEL,), 0.02),
    }


def reference(x, norm_mix, w_in, conv_w, lam_q1, lam_k1, lam_q2, lam_k2, subln_g, w_out,
              norm_ffn, ffn_w_gate, ffn_w_up, ffn_w_down, router_w, exp_w_gate, exp_w_up,
              exp_w_down, norm_final):
    T = x.shape[1]
    cos, sin = rope_tables(T, x.dtype)
    for l in range(DEPTH):
        h = rmsnorm(x, norm_mix[l])
        x = x + hybrid_mixer(h, w_in[l], conv_w[l], lam_q1[l], lam_k1[l], lam_q2[l], lam_k2[l],
                             subln_g[l], w_out[l], l, cos, sin)
        h = rmsnorm(x, norm_ffn[l])
        j = l // 2
        if l % 2 == 0:
            x = x + swiglu(h, ffn_w_gate[j], ffn_w_up[j], ffn_w_down[j])
        else:
            x = x + moe_swiglu(h, router_w[j], exp_w_gate[j], exp_w_up[j], exp_w_down[j])
    return rmsnorm(x, norm_final)
```

```cpp
#include <hip/hip_runtime.h>
#include <hip/hip_bf16.h>
#include <cstdio>
#include <cstdint>
#include <cmath>

#ifndef PH_MASK
#define PH_MASK 0xFFFF
#endif
#ifndef DENSE_F8_MASK
#define DENSE_F8_MASK 2
#endif
#define DENSE_F8(j) (((DENSE_F8_MASK) >> (j)) & 1)
#ifndef DENSE_DN_F8_MASK
#define DENSE_DN_F8_MASK 3
#endif
#define DENSE_DN_F8(j) (((DENSE_DN_F8_MASK) >> (j)) & 1)
static_assert((DENSE_DN_F8_MASK & DENSE_F8_MASK) == DENSE_F8_MASK, "an fp8 gate|up GEMM writes fp8 hidden activations: its down projection is fp8 too");
#ifndef INPROJ_F8_MASK
#define INPROJ_F8_MASK 12
#endif
#define INPROJ_F8(l) (((INPROJ_F8_MASK) >> (l)) & 1)
static_assert((INPROJ_F8_MASK & 1) == 0, "layer 0's in-projection reads the prologue's bf16 x");
#ifndef PROBE_DUP
#define PROBE_DUP 0
#endif
#ifndef MK_PER_PHASE
#define MK_PER_PHASE 0
#endif

constexpr int BATCH = 8, SEQ = 2048, DM = 1024, DEPTH = 4;
constexpr int M = BATCH * SEQ;
constexpr int NHEADS = 8;
constexpr int IN_W = 8192;
constexpr int DFF = 2816, DFFE = 3584, NEXP = 8;
constexpr int MSLOT = 2 * M + NEXP * 256;
constexpr float RMS_EPS = 1e-5f;

__device__ __forceinline__ int opaque_tid() { int t = threadIdx.x; asm volatile("" : "+v"(t)); return t; }
__device__ __forceinline__ int opaque_bid() { int t = blockIdx.x; asm volatile("" : "+s"(t)); return t; }
__device__ __forceinline__ int opaque_grid() { int t = gridDim.x; asm volatile("" : "+s"(t)); return t; }

typedef unsigned wt_u32x4 __attribute__((ext_vector_type(4))); typedef unsigned wt_u32x2 __attribute__((ext_vector_type(2)));
__device__ __forceinline__ void st16_wt(void* p, wt_u32x4 v) { asm volatile("global_store_dwordx4 %0, %1, off nt\n\ts_nop 1" :: "v"(p), "v"(v) : "memory"); }
__device__ __forceinline__ void st8_wt(void* p, wt_u32x2 v) { asm volatile("global_store_dwordx2 %0, %1, off nt" :: "v"(p), "v"(v) : "memory"); }

namespace pg8 {
#define PG8_LAS __attribute__((address_space(3)))
typedef unsigned short bf16_t;
typedef short bf16x8 __attribute__((ext_vector_type(8)));
typedef float f32x4 __attribute__((ext_vector_type(4)));
typedef unsigned u32x4 __attribute__((ext_vector_type(4)));
constexpr int BM = 256, BK = 64, HALF = 128, HTB = HALF * BK * 2, STAGE_BYTES = 8 * HTB, NXCD = 8, WGM = 8;

__host__ __device__ __forceinline__ int lds_byte(int r, int c) { const int st = (r >> 4) * 2 + (c >> 5), rr = r & 15, cc = c & 31, ob = rr * 64 + cc * 2; return st * 1024 + (ob ^ (((ob >> 9) & 1) << 5)); }
__host__ __device__ __forceinline__ void stage_rc(int b, int& R, int& C) { const int st = b / 1024, sb = b % 1024, swz = sb ^ (((sb >> 9) & 1) << 5); R = (st >> 1) * 16 + swz / 64; C = (st & 1) * 32 + (swz % 64) / 2; }
__host__ __device__ __forceinline__ int perm32(int rho) { const int n = rho >> 4, i = rho & 15; return 8 * (i >> 2) + 4 * n + (i & 3); }

struct Unit { int pm, pn, be, pa, ps; };
struct Gemm { const bf16_t* A; const bf16_t* Bt; int M, N, K; size_t bstride; };

struct StaticOrder {
    int nM, nN, nwg, G, c;
    __host__ __device__ void init(int M_, int N_, int G_, int c_) { nM = M_ / BM; nN = N_ / BM; nwg = nM * nN; G = G_; c = c_; }
    __host__ __device__ bool next(int i, Unit& u) const {
        const long L = (long)i * G + c; if (L >= nwg) return false;
        int wgid = (int)L; { const int q = nwg / NXCD, r = nwg % NXCD, xcd = wgid % NXCD, off = wgid / NXCD; wgid = (xcd < r ? xcd * (q + 1) : r * (q + 1) + (xcd - r) * q) + off; }
        const int nig = WGM * nN, gid = wgid / nig, fm = gid * WGM, gsz = (nM - fm) < WGM ? (nM - fm) : WGM;
        u.pm = fm + ((wgid % nig) % gsz); u.pn = (wgid % nig) / gsz; u.be = 0; u.pa = u.pm; u.ps = u.pm; return true;
    }
    __device__ __forceinline__ void a_ready(const Unit&) const {}
    __device__ __forceinline__ void done(const Unit&) const {}
};
struct GroupedOrder {
    int nM, nN, nwg, G, c; const PG8_LAS int* tab; bool sparseA;
    __device__ void init(int nM_, int N_, int G_, int c_, const PG8_LAS int* tab_, bool sparseA_) { nM = nM_; nN = N_ / BM; nwg = nM * nN; G = G_; c = c_; tab = tab_; sparseA = sparseA_; }
    __device__ bool next(int i, Unit& u) const {
        const long L = (long)i * G + c; if (L >= nwg) return false;
        int wgid = (int)L; { const int q = nwg / NXCD, r = nwg % NXCD, xcd = wgid % NXCD, off = wgid / NXCD; wgid = (xcd < r ? xcd * (q + 1) : r * (q + 1) + (xcd - r) * q) + off; }
        const int nig = WGM * nN, gid = wgid / nig, fm = gid * WGM, gsz = (nM - fm) < WGM ? (nM - fm) : WGM;
        u.pm = fm + ((wgid % nig) % gsz); u.pn = (wgid % nig) / gsz;
        const int ent = __builtin_amdgcn_readfirstlane(tab[u.pm]); u.be = ent >> 16; u.ps = ent & 0xffff; u.pa = sparseA ? u.ps : u.pm; return true;
    }
    __device__ __forceinline__ void a_ready(const Unit&) const {}
    __device__ __forceinline__ void done(const Unit&) const {}
};

constexpr int RSC_OFF = 131072 + 8192;
__device__ __forceinline__ unsigned cvt_pk_bf16(float lo, float hi) { unsigned r; asm volatile("v_cvt_pk_bf16_f32 %0, %1, %2" : "=v"(r) : "v"(lo), "v"(hi)); return r; }
__device__ __forceinline__ u32x4 pack8(const f32x4 a, const f32x4 b) { u32x4 w; w.x = cvt_pk_bf16(a[0], a[1]); w.y = cvt_pk_bf16(a[2], a[3]); w.z = cvt_pk_bf16(b[0], b[1]); w.w = cvt_pk_bf16(b[2], b[3]); return w; }
__device__ __forceinline__ float rstd_of(const float* ss4) { const f32x4 p = *(const f32x4*)ss4; return __builtin_amdgcn_rsqf(((p[0] + p[1]) + (p[2] + p[3])) * (1.0f / 1024.0f) + RMS_EPS); }

struct EpiProj {
    static constexpr bool PERM = true, AFTER_DRAIN = false, NEEDS_ALIGN = false;
    bf16_t* P; const float* ss; const float* ropeC; const float* ropeS; float qscale; float ascale = 1.0f;
    mutable int pmc = -1;
    __device__ __forceinline__ PG8_LAS float* rsc_lds() const { extern __shared__ __attribute__((aligned(16))) unsigned char lds_all[]; return (PG8_LAS float*)((PG8_LAS unsigned char*)lds_all + RSC_OFF) + opaque_tid(); }
    __device__ __forceinline__ void refresh(const Unit& u, int wr, int fr) const {
        if (u.pm != pmc) { pmc = u.pm; const int row0 = u.pm * BM + wr * 64 + fr; f32x4 t_[8]; PG8_LAS float* rc = rsc_lds();
#pragma unroll
            for (int i = 0; i < 8; ++i) t_[i] = *(const f32x4*)(ss + 4 * (size_t)(row0 + (i >> 2) * HALF + (i & 3) * 16));
#pragma unroll
            for (int i = 0; i < 8; ++i) rc[i * 512] = __builtin_amdgcn_rsqf(((t_[i][0] + t_[i][1]) + (t_[i][2] + t_[i][3])) * (1.0f / 1024.0f) + RMS_EPS) * ascale;
            asm volatile("s_waitcnt lgkmcnt(0)" ::: "memory"); }
    }
    __device__ __forceinline__ void half(const f32x4 (&acc)[2][2][4][2], const Unit& u, int ai, int wr, int wc, int fr, int fq) const {
        asm volatile("" : "+v"(fr), "+v"(fq));
        refresh(u, wr, fr);
        float rsc[4]; { const PG8_LAS float* rc = rsc_lds();
#pragma unroll
            for (int m = 0; m < 4; ++m) rsc[m] = rc[(ai * 4 + m) * 512]; }
        const int t = u.pn >> 2, ct = u.pn & 3;
        bf16_t* base = P + (size_t)t * ((size_t)M * 1024);
        const int row0 = u.pm * BM + wr * 64 + fr;
        if (t < 2) {
            const float sc = (t == 0) ? qscale : 1.0f;
            int fqo = fq; asm volatile("" : "+v"(fqo));
            const int hcol = ct * 256 + wc * 64 + 8 * fq;
#pragma unroll
            for (int m = 0; m < 4; ++m) {
                const int row = row0 + ai * HALF + m * 16; const float rs = rsc[m] * sc; const int pos = row & (SEQ - 1);
                const f32x4 c0 = *(const f32x4*)(ropeC + pos * 32 + 8 * fqo), c1 = *(const f32x4*)(ropeC + pos * 32 + 8 * fqo + 4);
                const f32x4 s0 = *(const f32x4*)(ropeS + pos * 32 + 8 * fqo), s1 = *(const f32x4*)(ropeS + pos * 32 + 8 * fqo + 4);
                const f32x4 l0 = acc[ai][0][m][0] * rs, l1 = acc[ai][0][m][1] * rs, h0 = acc[ai][1][m][0] * rs, h1 = acc[ai][1][m][1] * rs;
                const f32x4 ol0 = l0 * c0 - h0 * s0, ol1 = l1 * c1 - h1 * s1, oh0 = h0 * c0 + l0 * s0, oh1 = h1 * c1 + l1 * s1;
                bf16_t* rowp = base + (size_t)row * 1024 + hcol;
                st16_wt(rowp, pack8(ol0, ol1)); st16_wt(rowp + 32, pack8(oh0, oh1));
                if (m & 1) asm volatile("" ::: "memory");
            }
        } else if (u.pn < 12 || u.pn >= 28) {
            bf16_t* b2 = P + (size_t)(u.pn < 12 ? 2 : 5) * ((size_t)M * 1024);
            const int col0 = ct * 256 + wc * 32 + 8 * fq;
#pragma unroll
            for (int m = 0; m < 4; ++m) {
                const int row = row0 + ai * HALF + m * 16; const float rs = rsc[m];
                bf16_t* rowp = b2 + (size_t)row * 1024 + col0;
#pragma unroll
                for (int bj = 0; bj < 2; ++bj) st16_wt(rowp + bj * HALF, pack8(acc[ai][bj][m][0] * rs, acc[ai][bj][m][1] * rs));
            }
        } else {
            const bool conv = u.pn < 20;
            bf16_t* b2 = P + (size_t)(conv ? 3 : 4) * ((size_t)M * 1024);
            const int col0 = (u.pn - (conv ? 12 : 20)) * HALF + wc * 32 + 8 * fq;
#pragma unroll
            for (int m = 0; m < 4; ++m) {
                const int row = row0 + ai * HALF + m * 16; const float rs = rsc[m];
                f32x4 o[2];
#pragma unroll
                for (int n = 0; n < 2; ++n) {
                    const f32x4 x0 = acc[ai][0][m][n] * rs, x1 = acc[ai][1][m][n] * rs;
                    if (conv) o[n] = x0 * x1;
                    else {
#pragma unroll
                        for (int i = 0; i < 4; ++i) o[n][i] = x0[i] * __builtin_amdgcn_rcpf(1.0f + __builtin_amdgcn_exp2f(x1[i] * -1.4426950408889634f)); }
                }
                st16_wt(b2 + (size_t)row * 1024 + col0, pack8(o[0], o[1]));
            }
        }
    }
    __device__ __forceinline__ void operator()(const f32x4 (&acc)[2][2][4][2], const Unit& u, int wr, int wc, int fr, int fq) const { half(acc, u, 0, wr, wc, fr, fq); half(acc, u, 1, wr, wc, fr, fq); }
};
__device__ __forceinline__ float clamp448(float v) { return __builtin_fminf(__builtin_fmaxf(v, -448.0f), 448.0f); }
template <bool F8OUT> struct EpiSwigluT {
    static constexpr bool PERM = true, AFTER_DRAIN = false, NEEDS_ALIGN = false;
    void* H; int ldh; const float* ss; float ascale;
    mutable int pmc = -1;
    __device__ __forceinline__ PG8_LAS float* rsc_lds() const { extern __shared__ __attribute__((aligned(16))) unsigned char lds_all[]; return (PG8_LAS float*)((PG8_LAS unsigned char*)lds_all + RSC_OFF) + opaque_tid(); }
    __device__ __forceinline__ void refresh(const Unit& u, int wr, int fr) const {
        if (u.pm != pmc) { pmc = u.pm; const int srow0 = u.ps * BM + wr * 64 + fr;
            f32x4 t_[8]; PG8_LAS float* rc = rsc_lds();
#pragma unroll
            for (int i = 0; i < 8; ++i) t_[i] = *(const f32x4*)(ss + 4 * (size_t)(srow0 + (i >> 2) * HALF + (i & 3) * 16));
#pragma unroll
            for (int i = 0; i < 8; ++i) rc[i * 512] = __builtin_amdgcn_rsqf(((t_[i][0] + t_[i][1]) + (t_[i][2] + t_[i][3])) * (1.0f / 1024.0f) + RMS_EPS) * ascale;
            asm volatile("s_waitcnt lgkmcnt(0)" ::: "memory"); }
    }
    __device__ __forceinline__ void half(const f32x4 (&acc)[2][2][4][2], const Unit& u, int ai, int wr, int wc, int fr, int fq) const {
        asm volatile("" : "+v"(fr), "+v"(fq));
        refresh(u, wr, fr);
        float rsc[4]; { const PG8_LAS float* rc = rsc_lds();
#pragma unroll
            for (int m = 0; m < 4; ++m) rsc[m] = rc[(ai * 4 + m) * 512]; }
        const int row0 = u.pm * BM + wr * 64 + fr, col0 = u.pn * HALF + wc * 32 + 8 * fq;
#pragma unroll
        for (int m = 0; m < 4; ++m) {
            const int row = row0 + ai * HALF + m * 16; const float rs = rsc[m];
            f32x4 o[2];
            {
                const float rse = rs * -1.4426950408889634f, rs2 = rs * rs * (F8OUT ? 8.0f : 1.0f);
                f32x4 e[2], p[2];
#pragma unroll
                for (int n = 0; n < 2; ++n) { e[n] = acc[ai][0][m][n] * rse; p[n] = (acc[ai][0][m][n] * acc[ai][1][m][n]) * rs2; }
#pragma unroll
                for (int n = 0; n < 2; ++n)
#pragma unroll
                    for (int i = 0; i < 4; ++i) e[n][i] = __builtin_amdgcn_exp2f(e[n][i]);
#pragma unroll
                for (int n = 0; n < 2; ++n) e[n] = e[n] + 1.0f;
#pragma unroll
                for (int n = 0; n < 2; ++n)
#pragma unroll
                    for (int i = 0; i < 4; ++i) e[n][i] = __builtin_amdgcn_rcpf(e[n][i]);
#pragma unroll
                for (int n = 0; n < 2; ++n) o[n] = p[n] * e[n];
            }
            if constexpr (F8OUT) {
                unsigned w0 = 0u, w1 = 0u;
                w0 = __builtin_amdgcn_cvt_pk_fp8_f32(clamp448(o[0][0]), clamp448(o[0][1]), w0, false); w0 = __builtin_amdgcn_cvt_pk_fp8_f32(clamp448(o[0][2]), clamp448(o[0][3]), w0, true);
                w1 = __builtin_amdgcn_cvt_pk_fp8_f32(clamp448(o[1][0]), clamp448(o[1][1]), w1, false); w1 = __builtin_amdgcn_cvt_pk_fp8_f32(clamp448(o[1][2]), clamp448(o[1][3]), w1, true);
                typedef unsigned u32x2 __attribute__((ext_vector_type(2)));
                *(u32x2*)((unsigned char*)H + (size_t)row * ldh + col0) = (u32x2){w0, w1};
            } else {
                st16_wt((bf16_t*)H + (size_t)row * ldh + col0, pack8(o[0], o[1]));
            }
        }
    }
    __device__ __forceinline__ void operator()(const f32x4 (&acc)[2][2][4][2], const Unit& u, int wr, int wc, int fr, int fq) const { half(acc, u, 0, wr, wc, fr, fq); half(acc, u, 1, wr, wc, fr, fq); }
};
typedef EpiSwigluT<false> EpiSwiglu;
typedef EpiSwigluT<true> EpiSwigluF8;
constexpr int EPI_TAB_OFF = 131072 + 1024;
template <bool LITE, bool F8X = false> struct EpiResidT {
    static constexpr bool PERM = true, AFTER_DRAIN = false, NEEDS_ALIGN = !LITE;
    bf16_t* xb; float* ssn; unsigned char* xq = nullptr; float ascale = 1.0f;
    __device__ __forceinline__ void operator()(const f32x4 (&acc)[2][2][4][2], const Unit& u, int wr, int wc, int fr, int fq) const {
        extern __shared__ __attribute__((aligned(16))) unsigned char lds_all[];
        PG8_LAS float* T = (PG8_LAS float*)((PG8_LAS unsigned char*)lds_all + EPI_TAB_OFF);
        const int row0 = u.pm * BM + wr * 64 + fr, col0 = u.pn * BM + wc * 32 + 8 * fq;
#pragma unroll
        for (int ai = 0; ai < 2; ++ai) {
            u32x4 xv[4][2];
#pragma unroll
            for (int m = 0; m < 4; ++m)
#pragma unroll
                for (int bj = 0; bj < 2; ++bj) xv[m][bj] = *(const u32x4*)(xb + (size_t)(row0 + ai * HALF + m * 16) * 1024 + col0 + bj * HALF);
            asm volatile("" ::: "memory");
#pragma unroll
            for (int m = 0; m < 4; ++m) {
                const int row = row0 + ai * HALF + m * 16; float sq = 0.f;
#pragma unroll
                for (int bj = 0; bj < 2; ++bj) {
                    const u32x4 w = xv[m][bj];
                    f32x4 x0 = {__uint_as_float(w.x << 16), __uint_as_float(w.x & 0xffff0000u), __uint_as_float(w.y << 16), __uint_as_float(w.y & 0xffff0000u)};
                    f32x4 x1 = {__uint_as_float(w.z << 16), __uint_as_float(w.z & 0xffff0000u), __uint_as_float(w.w << 16), __uint_as_float(w.w & 0xffff0000u)};
                    x0 += acc[ai][bj][m][0] * ascale; x1 += acc[ai][bj][m][1] * ascale;
                    st16_wt(xb + (size_t)row * 1024 + col0 + bj * HALF, pack8(x0, x1));
                    if constexpr (F8X) { unsigned w0 = 0u, w1 = 0u;
                        w0 = __builtin_amdgcn_cvt_pk_fp8_f32(clamp448(x0[0] * 8.0f), clamp448(x0[1] * 8.0f), w0, false); w0 = __builtin_amdgcn_cvt_pk_fp8_f32(clamp448(x0[2] * 8.0f), clamp448(x0[3] * 8.0f), w0, true);
                        w1 = __builtin_amdgcn_cvt_pk_fp8_f32(clamp448(x1[0] * 8.0f), clamp448(x1[1] * 8.0f), w1, false); w1 = __builtin_amdgcn_cvt_pk_fp8_f32(clamp448(x1[2] * 8.0f), clamp448(x1[3] * 8.0f), w1, true);
                        st8_wt(xq + (size_t)row * 1024 + col0 + bj * HALF, (wt_u32x2){w0, w1}); }
                    if constexpr (!LITE) sq += (x0[0] * x0[0] + x0[1] * x0[1]) + (x0[2] * x0[2] + x0[3] * x0[3]) + (x1[0] * x1[0] + x1[1] * x1[1]) + (x1[2] * x1[2] + x1[3] * x1[3]);
                }
                if constexpr (!LITE) { sq += __shfl_xor(sq, 16); sq += __shfl_xor(sq, 32);
                    if (fq == 0) T[(ai * HALF + wr * 64 + m * 16 + fr) * 4 + wc] = sq; }
            }
        }
        if constexpr (!LITE) {
        asm volatile("s_waitcnt lgkmcnt(0)\n\ts_barrier" ::: "memory");
        if (wc == 0 && fq == 0) {
#pragma unroll
            for (int ai = 0; ai < 2; ++ai)
#pragma unroll
                for (int m = 0; m < 4; ++m) { const int lr = ai * HALF + wr * 64 + m * 16 + fr; const f32x4 p = *(const PG8_LAS f32x4*)(T + lr * 4);
                    ssn[(size_t)(u.pm * BM + lr) * 4 + u.pn] = (p[0] + p[1]) + (p[2] + p[3]); }
        } }
    }
};
typedef EpiResidT<false> EpiResid;
typedef EpiResidT<true> EpiResidLite;
typedef EpiResidT<false, true> EpiResidF8X;
struct EpiSlot {
    static constexpr bool PERM = true, AFTER_DRAIN = false, NEEDS_ALIGN = false;
    bf16_t* Y; const float* wslot; float ascale;
    __device__ __forceinline__ void half(const f32x4 (&acc)[2][2][4][2], const Unit& u, int ai, int wr, int wc, int fr, int fq) const {
        asm volatile("" : "+v"(fr), "+v"(fq));
        const int row0 = u.pm * BM + wr * 64 + fr, col0 = u.pn * BM + wc * 32 + 8 * fq;
        float w[4];
#pragma unroll
        for (int m = 0; m < 4; ++m) w[m] = wslot[u.ps * BM + wr * 64 + fr + ai * HALF + m * 16] * ascale;
#pragma unroll
        for (int m = 0; m < 4; ++m) {
            const int row = row0 + ai * HALF + m * 16;
#pragma unroll
            for (int bj = 0; bj < 2; ++bj) st16_wt(Y + (size_t)row * 1024 + col0 + bj * HALF, pack8(acc[ai][bj][m][0] * w[m], acc[ai][bj][m][1] * w[m]));
        }
    }
    __device__ __forceinline__ void operator()(const f32x4 (&acc)[2][2][4][2], const Unit& u, int wr, int wc, int fr, int fq) const { half(acc, u, 0, wr, wc, fr, fq); half(acc, u, 1, wr, wc, fr, fq); }
};

__device__ __forceinline__ void glds16s(unsigned voff, const void* sbase, unsigned lds_dst) { unsigned keep;
    asm volatile("s_mov_b32 %0, m0\n\ts_mov_b32 m0, %3\n\ts_nop 0\n\tglobal_load_lds_dwordx4 %1, %2\n\ts_mov_b32 m0, %0" : "=&s"(keep) : "v"(voff), "s"(sbase), "s"(lds_dst) : "memory"); }
typedef int v8i_t __attribute__((ext_vector_type(8))); typedef int v4i_t __attribute__((ext_vector_type(4)));
__device__ __forceinline__ v8i_t cat16(bf16x8 lo, bf16x8 hi) { const v4i_t a = __builtin_bit_cast(v4i_t, lo), b = __builtin_bit_cast(v4i_t, hi); return __builtin_shufflevector(a, b, 0, 1, 2, 3, 4, 5, 6, 7); }
template <class Epi, class Sched, bool ALIGN_EPI = false, bool SP2 = false, bool FP8 = false>
__device__ __forceinline__ void gemm_phase(PG8_LAS unsigned char* lds, const Gemm g, const Sched& S, const Epi& E) {
    const int tid = opaque_tid(), wid = __builtin_amdgcn_readfirstlane(tid >> 6), lane = tid & 63, wr = wid >> 2, wc = wid & 3, fr = lane & 15, fq = lane >> 4;
    const int K = FP8 ? g.K / 2 : g.K, nt = K / BK;
    unsigned voffA[2], voffB[2];
#pragma unroll
    for (int i = 0; i < 2; ++i) { int R, C; stage_rc(tid * 16 + i * 8192, R, C); const int Rb = Epi::PERM ? ((R & ~31) + perm32(R & 31)) : R;
        voffA[i] = (unsigned)(R * K + C) * 2u; voffB[i] = (unsigned)(Rb * K + C) * 2u; }
    const size_t kstep = (size_t)(BK * 2);
    const size_t hstep = (size_t)HALF * K * 2;
    const size_t tstep = 2 * hstep;
    const unsigned ldsw = (unsigned)wid * 1024u; const unsigned ldsb = (unsigned)__builtin_amdgcn_readfirstlane((int)((unsigned)(size_t)lds + ldsw));
    const int aoff = lds_byte(wr * 64 + fr, fq * 8), boff = lds_byte(wc * 32 + fr, fq * 8);
#define PG8_SA(b, h) (((b) * 2 + (h)) * HTB)
#define PG8_SB(b, h) ((4 + (b) * 2 + (h)) * HTB)
#define PG8_STAGE(bufoff, gbase, voff) do { _Pragma("unroll") for (int _i = 0; _i < 2; ++_i) \
        glds16s((voff)[_i], (const void*)(gbase), ldsb + (unsigned)((bufoff) + _i * 8192)); } while (0)
#define PG8_LDA(dst, b, h) do { _Pragma("unroll") for (int m = 0; m < 4; ++m) _Pragma("unroll") for (int k = 0; k < 2; ++k) dst[m][k] = *(const PG8_LAS bf16x8*)(lds + PG8_SA(b, h) + aoff + m * 2048 + k * 1024); } while (0)
#define PG8_LDB(dst, b, h) do { _Pragma("unroll") for (int n = 0; n < 2; ++n) _Pragma("unroll") for (int k = 0; k < 2; ++k) dst[n][k] = *(const PG8_LAS bf16x8*)(lds + PG8_SB(b, h) + boff + n * 2048 + k * 1024); } while (0)
#define PG8_MMA(ai, bj, At, Bt) do { __builtin_amdgcn_s_setprio(1); _Pragma("unroll") for (int m = 0; m < 4; ++m) _Pragma("unroll") for (int n = 0; n < 2; ++n) { \
        if constexpr (FP8) { const v8i_t bo_ = cat16(Bt[n][0], Bt[n][1]), ao_ = cat16(At[m][0], At[m][1]); \
            asm volatile("v_mfma_f32_16x16x128_f8f6f4 %0, %1, %2, %0" : "+v"(acc[ai][bj][m][n]) : "v"(bo_), "v"(ao_)); }     \
        else { _Pragma("unroll") for (int k = 0; k < 2; ++k) acc[ai][bj][m][n] = __builtin_amdgcn_mfma_f32_16x16x32_bf16(Bt[n][k], At[m][k], acc[ai][bj][m][n], 0, 0, 0); } } \
        __builtin_amdgcn_s_setprio(0); } while (0)
#define PG8_WAIT_V(n) asm volatile("s_waitcnt vmcnt(" #n ")" ::: "memory")
#define PG8_WAIT_L(n) asm volatile("s_waitcnt lgkmcnt(" #n ")" ::: "memory")
#define PG8_BAR __builtin_amdgcn_s_barrier()
#define PG8_SCHED __builtin_amdgcn_sched_barrier(0)
    Unit cur, nxt; int ui = 0;
    if (!S.next(0, cur)) return;
    f32x4 acc[2][2][4][2];
#pragma unroll
    for (int a = 0; a < 2; ++a)
#pragma unroll
        for (int b = 0; b < 2; ++b)
#pragma unroll
            for (int m = 0; m < 4; ++m)
#pragma unroll
                for (int n = 0; n < 2; ++n) { acc[a][b][m][n] = (f32x4){0.f, 0.f, 0.f, 0.f}; asm volatile("" : "+v"(acc[a][b][m][n])); }
    bf16x8 At[4][2], B0[2][2], B1[2][2];
    const char* cA = (const char*)g.A + (size_t)cur.pa * tstep; const char* cB = (const char*)g.Bt + (size_t)cur.be * g.bstride + (size_t)cur.pn * tstep;
    S.a_ready(cur);
    if constexpr (SP2) {
        PG8_STAGE(PG8_SB(0, 0), cB, voffB); PG8_STAGE(PG8_SB(0, 1), cB + hstep, voffB); PG8_STAGE(PG8_SA(0, 0), cA, voffA); PG8_STAGE(PG8_SA(0, 1), cA + hstep, voffA);
        if (wr == 1) PG8_BAR;
        PG8_WAIT_V(2); PG8_BAR;
        PG8_STAGE(PG8_SB(1, 0), cB + kstep, voffB); PG8_STAGE(PG8_SA(1, 0), cA + kstep, voffA); PG8_STAGE(PG8_SB(1, 1), cB + hstep + kstep, voffB);
        PG8_WAIT_V(6); PG8_BAR;
    } else {
        PG8_STAGE(PG8_SB(0, 0), cB, voffB); PG8_STAGE(PG8_SA(0, 0), cA, voffA); PG8_STAGE(PG8_SB(0, 1), cB + hstep, voffB); PG8_STAGE(PG8_SA(0, 1), cA + hstep, voffA);
        if (wr == 1) PG8_BAR;
        PG8_WAIT_V(4); PG8_BAR;
        PG8_STAGE(PG8_SB(1, 0), cB + kstep, voffB); PG8_STAGE(PG8_SA(1, 0), cA + kstep, voffA); PG8_STAGE(PG8_SB(1, 1), cB + hstep + kstep, voffB);
        PG8_WAIT_V(6); PG8_BAR;
    }
    for (;;) {
        const bool has_next = S.next(ui + 1, nxt);
        const char* nA = has_next ? (const char*)g.A + (size_t)nxt.pa * tstep : cA; const char* nB = has_next ? (const char*)g.Bt + (size_t)nxt.be * g.bstride + (size_t)nxt.pn * tstep : cB;
#pragma nounroll
        for (int t = 0; t < nt; t += 2) {
            const bool last = (t == nt - 2);
            const char* a1 = cA + (size_t)(t + 1) * kstep;
            const char* a2 = last ? nA : cA + (size_t)(t + 2) * kstep; const char* b2 = last ? nB : cB + (size_t)(t + 2) * kstep;
            const char* a3 = a2 + kstep; const char* b3 = b2 + kstep;
            if (last && has_next) S.a_ready(nxt);
            if constexpr (SP2) {
            PG8_LDB(B0, 0, 0); PG8_LDB(B1, 0, 1); PG8_SCHED; PG8_LDA(At, 0, 0); PG8_STAGE(PG8_SA(1, 1), a1 + hstep, voffA);
            PG8_WAIT_V(8); PG8_WAIT_L(0); PG8_BAR; PG8_MMA(0, 0, At, B0); PG8_MMA(0, 1, At, B1); PG8_BAR; PG8_SCHED;
            PG8_LDA(At, 0, 1); PG8_STAGE(PG8_SB(0, 0), b2, voffB); PG8_STAGE(PG8_SB(0, 1), b2 + hstep, voffB); PG8_STAGE(PG8_SA(0, 0), a2, voffA);
            PG8_WAIT_V(8); PG8_WAIT_L(0); PG8_BAR; PG8_MMA(1, 0, At, B0); PG8_MMA(1, 1, At, B1); PG8_BAR; PG8_SCHED;
            PG8_LDB(B0, 1, 0); PG8_LDB(B1, 1, 1); PG8_SCHED; PG8_LDA(At, 1, 0); PG8_STAGE(PG8_SA(0, 1), a2 + hstep, voffA);
            PG8_WAIT_V(8); PG8_WAIT_L(0); PG8_BAR; PG8_MMA(0, 0, At, B0); PG8_MMA(0, 1, At, B1); PG8_BAR; PG8_SCHED;
            PG8_LDA(At, 1, 1); PG8_STAGE(PG8_SB(1, 0), b3, voffB); PG8_STAGE(PG8_SB(1, 1), b3 + hstep, voffB); PG8_STAGE(PG8_SA(1, 0), a3, voffA);
            PG8_WAIT_V(8); PG8_WAIT_L(0); PG8_BAR; PG8_MMA(1, 0, At, B0); PG8_MMA(1, 1, At, B1); PG8_BAR; PG8_SCHED;
            } else {
            PG8_LDB(B0, 0, 0); PG8_SCHED; PG8_LDA(At, 0, 0); PG8_STAGE(PG8_SA(1, 1), a1 + hstep, voffA);
            PG8_WAIT_L(8); PG8_BAR; PG8_WAIT_L(0); PG8_MMA(0, 0, At, B0); PG8_BAR; PG8_SCHED;
            PG8_LDB(B1, 0, 1); PG8_STAGE(PG8_SB(0, 0), b2, voffB);
            PG8_BAR; PG8_WAIT_L(0); PG8_MMA(0, 1, At, B1); PG8_BAR;
            PG8_LDA(At, 0, 1); PG8_STAGE(PG8_SA(0, 0), a2, voffA);
            PG8_BAR; PG8_WAIT_L(0); PG8_MMA(1, 0, At, B0); PG8_BAR; PG8_SCHED;
            PG8_STAGE(PG8_SB(0, 1), b2 + hstep, voffB);
            PG8_WAIT_V(6); PG8_BAR; PG8_MMA(1, 1, At, B1); PG8_BAR;
            PG8_LDB(B0, 1, 0); PG8_SCHED; PG8_LDA(At, 1, 0); PG8_STAGE(PG8_SA(0, 1), a2 + hstep, voffA);
            PG8_WAIT_L(8); PG8_BAR; PG8_WAIT_L(0); PG8_MMA(0, 0, At, B0); PG8_BAR; PG8_SCHED;
            PG8_LDB(B1, 1, 1); PG8_STAGE(PG8_SB(1, 0), b3, voffB);
            PG8_BAR; PG8_WAIT_L(0); PG8_MMA(0, 1, At, B1); PG8_BAR;
            PG8_LDA(At, 1, 1); PG8_STAGE(PG8_SA(1, 0), a3, voffA);
            PG8_BAR; PG8_WAIT_L(0); PG8_MMA(1, 0, At, B0); PG8_BAR; PG8_SCHED;
            PG8_STAGE(PG8_SB(1, 1), b3 + hstep, voffB);
            PG8_WAIT_V(6); PG8_BAR; PG8_MMA(1, 1, At, B1); PG8_BAR;
            }
        }
        if constexpr (ALIGN_EPI) { if (wr == 0) PG8_BAR; }
        static_assert(ALIGN_EPI || !Epi::NEEDS_ALIGN, "this epilogue contains a workgroup barrier: both halves must run it together");
        if constexpr (!Epi::AFTER_DRAIN) { E(acc, cur, wr, wc, fr, fq); S.done(cur); }
        if (!has_next) break;
#pragma unroll
        for (int a = 0; a < 2; ++a)
#pragma unroll
            for (int b = 0; b < 2; ++b)
#pragma unroll
                for (int m = 0; m < 4; ++m)
#pragma unroll
                    for (int n = 0; n < 2; ++n) { acc[a][b][m][n] = (f32x4){0.f, 0.f, 0.f, 0.f}; asm volatile("" : "+v"(acc[a][b][m][n])); }
        cur = nxt; cA = nA; cB = nB; ++ui;
        if constexpr (ALIGN_EPI) { if (wr == 1) PG8_BAR; }
    }
    PG8_WAIT_V(0);
    if constexpr (!ALIGN_EPI) { if (wr == 0) PG8_BAR; }
    PG8_BAR;
#undef PG8_SA
#undef PG8_SB
#undef PG8_STAGE
#undef PG8_LDA
#undef PG8_LDB
#undef PG8_MMA
#undef PG8_WAIT_V
#undef PG8_WAIT_L
#undef PG8_BAR
#undef PG8_SCHED
}

}

#ifndef PG8_SP2
#define PG8_SP2 true
#endif
#ifndef PG8_ALIGN
#define PG8_ALIGN true
#endif

namespace attn_body {
using bf16=__hip_bfloat16;
using bf16x8=__attribute__((ext_vector_type(8)))short;
using s16x4=__attribute__((ext_vector_type(4)))short;
using f32x16=__attribute__((ext_vector_type(16)))float;
using u32x4=__attribute__((ext_vector_type(4)))unsigned;
constexpr int D=64;
constexpr int PQ=1024,PK=1024,PV=1024,PO=2048;
constexpr int NW=8,QBLK=32,QB=QBLK*NW,KVBLK=64;
__device__ __forceinline__ int crow(int r,int hi){return (r&3)+8*(r>>2)+4*hi;}
#define SBAR() __builtin_amdgcn_sched_barrier(0)
__device__ __forceinline__ void cmask(f32x16&p0,f32x16&p1,int jb,int qrel,int hi){
  const float NEG=-INFINITY; int kb=64*jb+4*hi;
  #pragma unroll
  for(int r=0;r<16;++r){int kv=kb+(r&3)+8*(r>>2); if(kv>qrel)p0[r]=NEG; if(kv+32>qrel)p1[r]=NEG;}
}
constexpr int NSLOT=3, SLOTB=8192;
constexpr int LDS_K=0, LDS_V=NSLOT*SLOTB, LDS_WS=2*NSLOT*SLOTB, LDS_OST=LDS_WS+NW*64*4, LDS_BYTES=LDS_OST+NW*4096;
constexpr float C2=0.125f*1.4426950408889634f;
__device__ __forceinline__ void glds16(const void*gsrc,unsigned lds_dst){unsigned keep;
  asm volatile("s_mov_b32 %0, m0\n\ts_mov_b32 m0, %2\n\ts_nop 0\n\tglobal_load_lds_dwordx4 %1, off\n\ts_mov_b32 m0, %0":"=&s"(keep):"v"(gsrc),"s"(lds_dst):"memory");}
__device__ __forceinline__ float max3f(float a,float b,float c){float r;asm("v_max3_f32 %0, %1, %2, %3":"=v"(r):"v"(a),"v"(b),"v"(c));return r;}
__device__ __forceinline__ float max2f(float a,float b){float r;asm("v_max_f32_e32 %0, %1, %2":"=v"(r):"v"(a),"v"(b));return r;}
__device__ __forceinline__ float fadd_s(float a,float b){float r;asm("v_add_f32_e32 %0, %1, %2":"=v"(r):"v"(a),"v"(b));return r;}
__device__ __forceinline__ float fsub_s(float a,float b){float r;asm("v_sub_f32_e32 %0, %1, %2":"=v"(r):"v"(a),"v"(b));return r;}
typedef float f32x2_t __attribute__((ext_vector_type(2))); typedef __bf16 bf16x2_t __attribute__((ext_vector_type(2)));
__device__ __forceinline__ unsigned cvtpk_s(float lo,float hi){f32x2_t v={lo,hi};bf16x2_t b=__builtin_convertvector(v,bf16x2_t);return __builtin_bit_cast(unsigned,b);}
#define WAIT_BAR(N) asm volatile("s_waitcnt vmcnt(" #N ") lgkmcnt(0)\n\ts_barrier":::"memory")

__device__ __forceinline__ void qkt(f32x16&p0,f32x16&p1,const char*Kslot,const bf16x8*qr,const f32x16&negm,int r32,int hi){
  const char*kb=Kslot+hi*1024+r32*16;
  #pragma unroll
  for(int d0=0;d0<4;++d0){
    const bf16x8 b0=*reinterpret_cast<const bf16x8*>(kb+d0*2048);
    const bf16x8 b1=*reinterpret_cast<const bf16x8*>(kb+d0*2048+512);
    if(d0==0){p0=__builtin_amdgcn_mfma_f32_32x32x16_bf16(b0,qr[0],negm,0,0,0);p1=__builtin_amdgcn_mfma_f32_32x32x16_bf16(b1,qr[0],negm,0,0,0);}
    else{p0=__builtin_amdgcn_mfma_f32_32x32x16_bf16(b0,qr[d0],p0,0,0,0);p1=__builtin_amdgcn_mfma_f32_32x32x16_bf16(b1,qr[d0],p1,0,0,0);}}
}
typedef __attribute__((address_space(3))) const char* lds_cptr;
typedef short v4i16_t __attribute__((ext_vector_type(4)));
__device__ __forceinline__ void kload8(bf16x8*kf,lds_cptr kp){
  kf[0]=*(const __attribute__((address_space(3))) bf16x8*)(kp);      kf[1]=*(const __attribute__((address_space(3))) bf16x8*)(kp+512);
  kf[2]=*(const __attribute__((address_space(3))) bf16x8*)(kp+2048); kf[3]=*(const __attribute__((address_space(3))) bf16x8*)(kp+2560);
  kf[4]=*(const __attribute__((address_space(3))) bf16x8*)(kp+4096); kf[5]=*(const __attribute__((address_space(3))) bf16x8*)(kp+4608);
  kf[6]=*(const __attribute__((address_space(3))) bf16x8*)(kp+6144); kf[7]=*(const __attribute__((address_space(3))) bf16x8*)(kp+6656);
}
__device__ __forceinline__ void kload2(bf16x8*kf,lds_cptr kp,int j){ kf[2*j]=*(const __attribute__((address_space(3))) bf16x8*)(kp+j*2048); kf[2*j+1]=*(const __attribute__((address_space(3))) bf16x8*)(kp+j*2048+512); }
__device__ __forceinline__ s16x4 vtr(lds_cptr p){ return __builtin_bit_cast(s16x4,__builtin_amdgcn_ds_read_tr16_b64_v4i16((__attribute__((address_space(3))) v4i16_t*)p)); }
__device__ __forceinline__ float rowmax(const f32x16&p0,const f32x16&p1){
  float a=max3f(p0[0],p0[1],p1[0]),b=max3f(p0[2],p0[3],p1[1]);a=max3f(a,p1[2],p1[3]);
  #pragma unroll
  for(int r=4;r<16;r+=4){a=max3f(a,p0[r],p0[r+1]);b=max3f(b,p0[r+2],p0[r+3]);a=max3f(a,p1[r],p1[r+1]);b=max3f(b,p1[r+2],p1[r+3]);}
  const float m=max2f(a,b);
  auto rr=__builtin_amdgcn_permlane32_swap(__float_as_uint(m),__float_as_uint(m),false,false);
  return max2f(__uint_as_float(rr[0]),__uint_as_float(rr[1]));
}
__device__ __forceinline__ void pv(f32x16*o,int vb,bf16x8 pa0,bf16x8 pa1,bf16x8 pa2,bf16x8 pa3){
  #pragma unroll
  for(int d0=0;d0<2;++d0){s16x4 lo[4],hi[4];
    #pragma unroll
    for(int ks=0;ks<4;++ks){
      asm volatile("ds_read_b64_tr_b16 %0,%1 offset:%c2":"=&v"(lo[ks]):"v"(vb),"i"(d0*4096+ks*1024):"memory");
      asm volatile("ds_read_b64_tr_b16 %0,%1 offset:%c2":"=&v"(hi[ks]):"v"(vb),"i"(d0*4096+ks*1024+512):"memory");}
    asm volatile("s_waitcnt lgkmcnt(0)":::"memory");SBAR();
    #define PK(k) (bf16x8){lo[k][0],lo[k][1],lo[k][2],lo[k][3],hi[k][0],hi[k][1],hi[k][2],hi[k][3]}
    o[d0]=__builtin_amdgcn_mfma_f32_32x32x16_bf16(pa0,PK(0),o[d0],0,0,0);
    o[d0]=__builtin_amdgcn_mfma_f32_32x32x16_bf16(pa1,PK(1),o[d0],0,0,0);
    o[d0]=__builtin_amdgcn_mfma_f32_32x32x16_bf16(pa2,PK(2),o[d0],0,0,0);
    o[d0]=__builtin_amdgcn_mfma_f32_32x32x16_bf16(pa3,PK(3),o[d0],0,0,0);
    #undef PK
  }
}
#ifndef ATTN_STORE16
#define ATTN_STORE16(p,v) st16_wt((void*)(p),(v))
#endif
template<int THRL> __device__ __forceinline__ void attn_unit(int qb,const bf16*Qh,const bf16*__restrict__ Kh,const bf16*__restrict__ Vh,bf16*Oh,char*shm){
  const int tid=opaque_tid(),lane=tid&63,r32=lane&31,hi=lane>>5; const int wid=__builtin_amdgcn_readfirstlane(tid>>6);
  const int q0=qb*QB;
  const bf16*Qw=Qh+(long)(q0+wid*QBLK)*PQ;
  const unsigned lds0=(unsigned)(uintptr_t)shm;
  float*wsf=(float*)(shm+LDS_WS)+wid*64;
  const bf16*ksrc=Kh+(long)lane*PK+wid*8;
  const bf16*vsrc=Vh+(long)(16*(wid&3)+(lane>>2))*PV+(wid>>2)*32+(lane&3)*8;
  const unsigned kdst=lds0+LDS_K+wid*1024, vdst=lds0+LDS_V+wid*1024;
  #define DMA_K(t,slot) glds16(ksrc+(long)(t)*KVBLK*PK,(unsigned)__builtin_amdgcn_readfirstlane(kdst+(slot)))
  #define DMA_V(t,slot) glds16(vsrc+(long)(t)*KVBLK*PV,(unsigned)__builtin_amdgcn_readfirstlane(vdst+(slot)))
  const int vb0=(int)(lds0+LDS_V)+((lane>>4)&1)*32+(lane&3)*8+(4*hi+((lane&15)>>2))*64;
  const char*Kbase=shm+LDS_K; bf16x8 kf[8];
  const lds_cptr shm3=(lds_cptr)shm; const lds_cptr kp0=shm3+LDS_K+hi*1024+r32*16; const lds_cptr vp0=shm3+LDS_V+((lane>>4)&1)*32+(lane&3)*8+(4*hi+((lane&15)>>2))*64;
  const int NT=(q0+QB)/KVBLK;
  DMA_K(0,0);DMA_V(0,0);DMA_K(1,SLOTB);
  bf16x8 qr[4];
  #pragma unroll
  for(int d0=0;d0<4;++d0)qr[d0]=*reinterpret_cast<const bf16x8*>(&Qw[(long)r32*PQ+d0*16+hi*8]);
  float mhat=0.f,l_reg=0.f;f32x16 o[2];o[0]=f32x16{};o[1]=f32x16{};f32x16 negm=f32x16{};asm volatile("":"+v"(negm));
  const int qrel=wid*QBLK+r32;
  #define CMASK(P0,P1,t) do{int jb_=(t)-(NT-4); if(jb_>=0)cmask(P0,P1,jb_,qrel,hi);}while(0)
  bool resc=false;
  #define START(P0,P1) do{ const float rm=rowmax(P0,P1); resc=false; \
    { const float dl=rm; mhat=fadd_s(mhat,dl); \
      _Pragma("unroll") for(int r=0;r<16;++r){P0[r]=fsub_s(P0[r],dl);P1[r]=fsub_s(P1[r],dl);} \
      _Pragma("unroll") for(int r=0;r<16;++r)negm[r]=-mhat; asm volatile("":"+v"(negm)); } \
    _Pragma("unroll") for(int r=0;r<16;++r)P0[r]=__builtin_amdgcn_exp2f(P0[r]); }while(0)
  #define RESC() do{ if(resc){ asm volatile("s_waitcnt lgkmcnt(0)":::"memory"); \
      _Pragma("unroll") for(int d_=0;d_<2;++d_) _Pragma("unroll") for(int r=0;r<16;++r)o[d_][r]*=wsf[crow(r,hi)]; } }while(0)
  f32x16 pA0,pA1,pB0,pB1;
  int sl_prev=0,sl_cur=0,sl_next=SLOTB;
  #define ROT() do{sl_prev=sl_cur;sl_cur=sl_next;sl_next=(sl_next==(NSLOT-1)*SLOTB)?0:sl_next+SLOTB;}while(0)
  DMA_K(2,2*SLOTB);
  WAIT_BAR(3);
  qkt(pA0,pA1,Kbase,qr,negm,r32,hi);asm volatile("s_nop 15\n\ts_nop 7":"+v"(pA0),"+v"(pA1));CMASK(pA0,pA1,0);
  START(pA0,pA1);
  _Pragma("unroll") for(int r=0;r<16;++r)pA1[r]=__builtin_amdgcn_exp2f(pA1[r]);
  WAIT_BAR(0);
  DMA_K(3,0);DMA_V(1,SLOTB);
  ROT();
  kload8(kf,kp0+sl_cur);
  WAIT_BAR(2);
  s16x4 vlo[8],vhi[8]; u32x4 pw0,pw1,pw2,pw3;
  #define PKW(P,B) cvtpk_s(P[B],P[B+1])
  #define PAF(k) __builtin_bit_cast(bf16x8,pw##k)
  #define VFR(i) (bf16x8){vlo[i][0],vlo[i][1],vlo[i][2],vlo[i][3],vhi[i][0],vhi[i][1],vhi[i][2],vhi[i][3]}
  #define PIN(x) asm volatile("":"+v"(x))
  #define MX3(a,b,c) __builtin_fmaxf(__builtin_fmaxf((a),(b)),(c))
  #define GAPA(MF,A0,A1,A2,A3,W0,W1,PW) do{ MF; sacc+=A0; sacc+=A1; sacc+=A2; sacc+=A3; PIN(sacc); W0; W1; PIN(PW); SBAR(); }while(0)
  #define EX(v) __builtin_amdgcn_exp2f(v)
  #define GAPB(MF,X,B) do{ MF; X[B]=EX(X[B]); X[B+1]=EX(X[B+1]); X[B+2]=EX(X[B+2]); X[B+3]=EX(X[B+3]); PIN(X); SBAR(); }while(0)
  #define VRD(i) do{ vlo[i]=vtr(vp_+(((i)>>2)*4096+((i)&3)*1024)); vhi[i]=vtr(vp_+(((i)>>2)*4096+((i)&3)*1024+512)); }while(0)
  #define KRD(G,j) do{ if(G){ kload2(kf,kp0+sl_next,j); SBAR(); } }while(0)
  #define STEP(C0,C1,P0,P1,t,GK,GV,GL) do{ SBAR(); \
    const lds_cptr vp_=vp0+sl_prev; \
    VRD(0); SBAR(); float sacc=(P0[0]+P0[1]); \
    GAPA(C0=__builtin_amdgcn_mfma_f32_32x32x16_bf16(kf[0],qr[0],negm,0,0,0), P0[2],P0[3],P0[4],P0[5],     pw0[0]=PKW(P0,0), pw0[1]=PKW(P0,2), pw0); \
    VRD(4); SBAR(); GAPA(C1=__builtin_amdgcn_mfma_f32_32x32x16_bf16(kf[1],qr[0],negm,0,0,0), P0[6],P0[7],P0[8],P0[9],     pw0[2]=PKW(P0,4), pw0[3]=PKW(P0,6), pw0); \
    VRD(1); SBAR(); GAPA(C0=__builtin_amdgcn_mfma_f32_32x32x16_bf16(kf[2],qr[1],C0,0,0,0),   P0[10],P0[11],P0[12],P0[13], pw1[0]=PKW(P0,8), pw1[1]=PKW(P0,10), pw1); \
    VRD(5); SBAR(); GAPA(C1=__builtin_amdgcn_mfma_f32_32x32x16_bf16(kf[3],qr[1],C1,0,0,0),   P0[14],P0[15],P1[0],P1[1],   pw1[2]=PKW(P0,12),pw1[3]=PKW(P0,14), pw1); \
    VRD(2); SBAR(); GAPA(C0=__builtin_amdgcn_mfma_f32_32x32x16_bf16(kf[4],qr[2],C0,0,0,0),   P1[2],P1[3],P1[4],P1[5],     pw2[0]=PKW(P1,0), pw2[1]=PKW(P1,2), pw2); \
    VRD(6); SBAR(); GAPA(C1=__builtin_amdgcn_mfma_f32_32x32x16_bf16(kf[5],qr[2],C1,0,0,0),   P1[6],P1[7],P1[8],P1[9],     pw2[2]=PKW(P1,4), pw2[3]=PKW(P1,6), pw2); \
    VRD(3); SBAR(); GAPA(C0=__builtin_amdgcn_mfma_f32_32x32x16_bf16(kf[6],qr[3],C0,0,0,0),   P1[10],P1[11],P1[12],P1[13], pw3[0]=PKW(P1,8), pw3[1]=PKW(P1,10), pw3); \
    VRD(7); SBAR(); GAPA(C1=__builtin_amdgcn_mfma_f32_32x32x16_bf16(kf[7],qr[3],C1,0,0,0),   P1[14],P1[15],0.f,0.f,       pw3[2]=PKW(P1,12),pw3[3]=PKW(P1,14), pw3); \
    l_reg+=sacc; \
    if(GK){DMA_K((t)+3,sl_cur);} if(GV){DMA_V((t)+1,sl_next);} \
    CMASK(C0,C1,t); \
    { float a=MX3(C0[0],C0[1],C1[0]),b=MX3(C0[2],C0[3],C1[1]); a=MX3(a,C1[2],C1[3]); \
      _Pragma("unroll") for(int r=4;r<16;r+=4){a=MX3(a,C0[r],C0[r+1]);b=MX3(b,C0[r+2],C0[r+3]);a=MX3(a,C1[r],C1[r+1]);b=MX3(b,C1[r+2],C1[r+3]);} \
      float rm=__builtin_fmaxf(a,b); { auto rr=__builtin_amdgcn_permlane32_swap(__float_as_uint(rm),__float_as_uint(rm),false,false); rm=__builtin_fmaxf(__uint_as_float(rr[0]),__uint_as_float(rr[1])); } \
      resc=false; \
      if(__builtin_expect(__any(rm>(float)THRL),0)){ const float dl=__builtin_fmaxf(rm,0.f); mhat+=dl; \
        _Pragma("unroll") for(int r=0;r<16;++r){C0[r]-=dl;C1[r]-=dl;} \
        _Pragma("unroll") for(int r=0;r<16;++r)negm[r]=-mhat; asm volatile("":"+v"(negm)); \
        const float f=__builtin_amdgcn_exp2f(-dl); l_reg*=f; if(hi==0)wsf[r32]=f; resc=true; } } \
    SBAR(); \
    GAPB(o[0]=__builtin_amdgcn_mfma_f32_32x32x16_bf16(PAF(0),VFR(0),o[0],0,0,0), C0,0); \
    GAPB(o[1]=__builtin_amdgcn_mfma_f32_32x32x16_bf16(PAF(0),VFR(4),o[1],0,0,0), C0,4); \
    KRD(GL,0); GAPB(o[0]=__builtin_amdgcn_mfma_f32_32x32x16_bf16(PAF(1),VFR(1),o[0],0,0,0), C0,8); \
    KRD(GL,1); GAPB(o[1]=__builtin_amdgcn_mfma_f32_32x32x16_bf16(PAF(1),VFR(5),o[1],0,0,0), C0,12); \
    KRD(GL,2); GAPB(o[0]=__builtin_amdgcn_mfma_f32_32x32x16_bf16(PAF(2),VFR(2),o[0],0,0,0), C1,0); \
    KRD(GL,3); GAPB(o[1]=__builtin_amdgcn_mfma_f32_32x32x16_bf16(PAF(2),VFR(6),o[1],0,0,0), C1,4); \
    GAPB(o[0]=__builtin_amdgcn_mfma_f32_32x32x16_bf16(PAF(3),VFR(3),o[0],0,0,0), C1,8); \
    GAPB(o[1]=__builtin_amdgcn_mfma_f32_32x32x16_bf16(PAF(3),VFR(7),o[1],0,0,0), C1,12); \
    }while(0)
  int t=1;
  #undef CMASK
  #define CMASK(P0,P1,t) do{}while(0)
  for(;t+5<NT;t+=2){
    STEP(pB0,pB1,pA0,pA1,t,true,true,true);     WAIT_BAR(2); RESC(); ROT();
    STEP(pA0,pA1,pB0,pB1,t+1,true,true,true);   WAIT_BAR(2); RESC(); ROT();
  }
  #undef CMASK
  #define CMASK(P0,P1,t) do{int jb_=(t)-(NT-4); if(jb_>=0)cmask(P0,P1,jb_,qrel,hi);}while(0)
  #define ENDW(tt) do{ if((tt)+3<NT){WAIT_BAR(2);} else if((tt)+2<NT){WAIT_BAR(1);} else {WAIT_BAR(0);} }while(0)
  for(;t+1<NT;t+=2){
    STEP(pB0,pB1,pA0,pA1,t,(t+3<NT),(t+1<NT),(t+1<NT));       ENDW(t);   RESC(); ROT();
    STEP(pA0,pA1,pB0,pB1,t+1,(t+4<NT),(t+2<NT),(t+2<NT));     ENDW(t+1); RESC(); ROT();
  }
  STEP(pB0,pB1,pA0,pA1,NT-1,false,false,false); RESC();
  { float sacc=pB0[0]+pB0[1]; _Pragma("unroll") for(int r=2;r<16;++r)sacc+=pB0[r]; _Pragma("unroll") for(int r=0;r<16;++r)sacc+=pB1[r]; l_reg+=sacc;
    pw0=(u32x4){PKW(pB0,0),PKW(pB0,2),PKW(pB0,4),PKW(pB0,6)};pw1=(u32x4){PKW(pB0,8),PKW(pB0,10),PKW(pB0,12),PKW(pB0,14)};pw2=(u32x4){PKW(pB1,0),PKW(pB1,2),PKW(pB1,4),PKW(pB1,6)};pw3=(u32x4){PKW(pB1,8),PKW(pB1,10),PKW(pB1,12),PKW(pB1,14)};
    SBAR(); pv(o,vb0+sl_cur,PAF(0),PAF(1),PAF(2),PAF(3)); }
  #undef PKW
  #undef PAF
  #undef VFR
  #undef PIN
  #undef MX3
  #undef GAPA
  #undef GAPB
  #undef EX
  #undef VRD
  #undef KRD
  #undef STEP
  #undef ENDW
  {auto rr=__builtin_amdgcn_permlane32_swap(__float_as_uint(l_reg),__float_as_uint(l_reg),false,false);l_reg=__uint_as_float(rr[0])+__uint_as_float(rr[1]);}
  if(hi==0)wsf[32+r32]=l_reg;asm volatile("s_waitcnt lgkmcnt(0)":::"memory");
  float rli[16];
  #pragma unroll
  for(int r=0;r<16;++r)rli[r]=__builtin_amdgcn_rcpf(wsf[32+crow(r,hi)]);
  bf16*Ow=Oh+(long)(q0+wid*QBLK)*PO;
  { bf16*stg=(bf16*)(shm+LDS_OST)+wid*2048;
    #pragma unroll
    for(int r=0;r<16;++r){const int orow=crow(r,hi);
      #pragma unroll
      for(int d0=0;d0<2;++d0)stg[orow*64+d0*32+r32]=__float2bfloat16(o[d0][r]*rli[r]);}
    asm volatile("s_waitcnt lgkmcnt(0)":::"memory");
    #pragma unroll
    for(int i=0;i<4;++i){const int row=i*8+(lane>>3),ch=lane&7; const u32x4 v=*(const u32x4*)(stg+row*64+ch*8); ATTN_STORE16(Ow+(long)row*PO+ch*8,v);} }
  asm volatile("s_waitcnt lgkmcnt(0)\n\ts_barrier":::"memory");
  #undef DMA_K
  #undef DMA_V
  #undef CMASK
  #undef START
  #undef RESC
  #undef ROT
}

constexpr int VSLOT=2*SLOTB;
constexpr int L2_K=0, L2_V=NSLOT*SLOTB, L2_WS=L2_V+NSLOT*VSLOT, L2_OST=L2_WS+NW*64*4, L2_BYTES=L2_OST+NW*4096;
__device__ __forceinline__ void pv128(f32x16*o,int vb,bf16x8 pa0,bf16x8 pa1,bf16x8 pa2,bf16x8 pa3){
  #pragma unroll
  for(int d0=0;d0<4;++d0){s16x4 lo[4],hi[4];
    #pragma unroll
    for(int ks=0;ks<4;++ks){
      asm volatile("ds_read_b64_tr_b16 %0,%1 offset:%c2":"=&v"(lo[ks]):"v"(vb),"i"(d0*4096+ks*1024):"memory");
      asm volatile("ds_read_b64_tr_b16 %0,%1 offset:%c2":"=&v"(hi[ks]):"v"(vb),"i"(d0*4096+ks*1024+512):"memory");}
    asm volatile("s_waitcnt lgkmcnt(0)":::"memory");SBAR();
    #define PK(k) (bf16x8){lo[k][0],lo[k][1],lo[k][2],lo[k][3],hi[k][0],hi[k][1],hi[k][2],hi[k][3]}
    o[d0]=__builtin_amdgcn_mfma_f32_32x32x16_bf16(pa0,PK(0),o[d0],0,0,0);
    o[d0]=__builtin_amdgcn_mfma_f32_32x32x16_bf16(pa1,PK(1),o[d0],0,0,0);
    o[d0]=__builtin_amdgcn_mfma_f32_32x32x16_bf16(pa2,PK(2),o[d0],0,0,0);
    o[d0]=__builtin_amdgcn_mfma_f32_32x32x16_bf16(pa3,PK(3),o[d0],0,0,0);
    #undef PK
  }
}
struct AttnNext { bool has; int qb; const bf16* Qh; const bf16* Kh; const bf16* Vh; };
struct AttnCarry { bool primed; int s0; bf16x8 qr[4]; };
template<int THRL,class Post> __device__ __forceinline__ void attn_unit128(int qb,const bf16*Qh,const bf16*__restrict__ Kh,const bf16*__restrict__ Vh,bf16*Oh,char*shm,const Post&post,const AttnNext&nx,AttnCarry&cy){
  const int tid=opaque_tid(),lane=tid&63,r32=lane&31,hi=lane>>5; const int wid=__builtin_amdgcn_readfirstlane(tid>>6);
  const int q0=qb*QB;
  const bf16*Qw=Qh+(long)(q0+wid*QBLK)*PQ;
  const unsigned lds0=(unsigned)(uintptr_t)shm;
  float*wsf=(float*)(shm+L2_WS)+wid*64;
  const bf16*ksrc=Kh+(long)lane*PK+wid*8;
  const bf16*vsrc=Vh+(long)(16*(wid&3)+(lane>>2))*PV+(wid>>2)*32+(lane&3)*8;
  const unsigned kdst=lds0+L2_K+wid*1024, vdst=lds0+L2_V+wid*1024;
  #define DMA_K(t,slot) glds16(ksrc+(long)(t)*KVBLK*PK,(unsigned)__builtin_amdgcn_readfirstlane(kdst+(slot)))
  #define DMA_V(t,slot) do{ glds16(vsrc+(long)(t)*KVBLK*PV,(unsigned)__builtin_amdgcn_readfirstlane(vdst+2*(slot))); glds16(vsrc+(long)(t)*KVBLK*PV+64,(unsigned)__builtin_amdgcn_readfirstlane(vdst+2*(slot)+8192)); }while(0)
  const char*Kbase=shm+L2_K; bf16x8 kf[8];
  const lds_cptr shm3=(lds_cptr)shm; const lds_cptr kp0=shm3+L2_K+hi*1024+r32*16; const lds_cptr vp0=shm3+L2_V+((lane>>4)&1)*32+(lane&3)*8+(4*hi+((lane&15)>>2))*64;
  const int NT=(q0+QB)/KVBLK;
  const bool primed=cy.primed; const int s0=primed?cy.s0:0, s1=(s0==(NSLOT-1)*SLOTB)?0:s0+SLOTB, s2=(s1==(NSLOT-1)*SLOTB)?0:s1+SLOTB;
  bf16x8 (&qr)[4]=cy.qr;
  if(!primed){
    DMA_K(0,s0);DMA_V(0,s0);DMA_K(1,s1);
    #pragma unroll
    for(int d0=0;d0<4;++d0)qr[d0]=*reinterpret_cast<const bf16x8*>(&Qw[(long)r32*PQ+d0*16+hi*8]);
  }
  float mhat=0.f,l_reg=0.f;f32x16 o[4];o[0]=f32x16{};o[1]=f32x16{};o[2]=f32x16{};o[3]=f32x16{};f32x16 negm=f32x16{};asm volatile("":"+v"(negm));
  const int qrel=wid*QBLK+r32;
  #define CMASK(P0,P1,t) do{int jb_=(t)-(NT-4); if(jb_>=0)cmask(P0,P1,jb_,qrel,hi);}while(0)
  bool resc=false;
  #define RESC() do{ if(resc){ asm volatile("s_waitcnt lgkmcnt(0)":::"memory"); \
      _Pragma("unroll") for(int d_=0;d_<4;++d_) _Pragma("unroll") for(int r=0;r<16;++r)o[d_][r]*=wsf[crow(r,hi)]; } }while(0)
  f32x16 c0,c1;
  int sl_prev=s0,sl_cur=s0,sl_next=s1;
  #define ROT() do{sl_prev=sl_cur;sl_cur=sl_next;sl_next=(sl_next==(NSLOT-1)*SLOTB)?0:sl_next+SLOTB;}while(0)
  if(!primed){
    DMA_K(2,s2);
    WAIT_BAR(3);
  }
  qkt(c0,c1,Kbase+s0,qr,negm,r32,hi);asm volatile("s_nop 15\n\ts_nop 7":"+v"(c0),"+v"(c1));CMASK(c0,c1,0);
  u32x4 pw0,pw1,pw2,pw3;
  #define PKW(P,B) cvtpk_s(P[B],P[(B)+1])
  { const float rm=rowmax(c0,c1); mhat=fadd_s(mhat,rm);
    _Pragma("unroll") for(int r=0;r<16;++r){c0[r]=fsub_s(c0[r],rm);c1[r]=fsub_s(c1[r],rm);}
    _Pragma("unroll") for(int r=0;r<16;++r)negm[r]=-mhat; asm volatile("":"+v"(negm));
    _Pragma("unroll") for(int r=0;r<16;++r){c0[r]=__builtin_amdgcn_exp2f(c0[r]);c1[r]=__builtin_amdgcn_exp2f(c1[r]);}
    float sacc=c0[0]+c0[1]; _Pragma("unroll") for(int r=2;r<16;++r)sacc+=c0[r]; _Pragma("unroll") for(int r=0;r<8;++r)sacc+=c1[r]; l_reg+=sacc;
    pw0=(u32x4){PKW(c0,0),PKW(c0,2),PKW(c0,4),PKW(c0,6)};pw1=(u32x4){PKW(c0,8),PKW(c0,10),PKW(c0,12),PKW(c0,14)};pw2=(u32x4){PKW(c1,0),PKW(c1,2),PKW(c1,4),PKW(c1,6)}; }
  WAIT_BAR(0);
  DMA_K(3,s0);DMA_V(1,s1);
  ROT();
  kload8(kf,kp0+sl_cur);
  WAIT_BAR(3);
  s16x4 vlo[8],vhi[8];
  #define PAF(k) __builtin_bit_cast(bf16x8,pw##k)
  #define VFR(i) (bf16x8){vlo[i][0],vlo[i][1],vlo[i][2],vlo[i][3],vhi[i][0],vhi[i][1],vhi[i][2],vhi[i][3]}
  #define PIN(x) asm volatile("":"+v"(x))
  #define MX3(a,b,c) __builtin_fmaxf(__builtin_fmaxf((a),(b)),(c))
  #define EX(v) __builtin_amdgcn_exp2f(v)
  #define VRDF(sl,db,ks) do{ vlo[sl]=vtr(vp_+((db)*4096+(ks)*1024)); vhi[sl]=vtr(vp_+((db)*4096+(ks)*1024+512)); }while(0)
  #define KRD(G,j) do{ if(G){ kload2(kf,kp0+sl_next,j); SBAR(); } }while(0)
  #define MFQ(C,KF,Q,CIN) C=__builtin_amdgcn_mfma_f32_32x32x16_bf16(KF,Q,CIN,0,0,0)
  #define MFO(DB,KS,SL) o[DB]=__builtin_amdgcn_mfma_f32_32x32x16_bf16(PAF(KS),VFR(SL),o[DB],0,0,0)
  #define EX2(X,B) do{ X[B]=EX(X[B]); X[(B)+1]=EX(X[(B)+1]); PIN(X); }while(0)
  #define SPK(Y,PB,PW,W) do{ sacc+=Y[PB]; sacc+=Y[(PB)+1]; PIN(sacc); PW[W]=PKW(Y,PB); PIN(PW); }while(0)
  #define STEP(t,GK,GV,GL) do{ SBAR(); \
    const lds_cptr vp_=vp0+2*sl_prev; float sacc; \
    VRDF(0,0,0); SBAR(); MFQ(c0,kf[0],qr[0],negm); sacc=(c1[8]+c1[9]); sacc+=c1[10]; sacc+=c1[11]; sacc+=c1[12]; sacc+=c1[13]; sacc+=c1[14]; sacc+=c1[15]; PIN(sacc); \
                         pw3[0]=PKW(c1,8); pw3[1]=PKW(c1,10); pw3[2]=PKW(c1,12); pw3[3]=PKW(c1,14); PIN(pw3); SBAR(); \
    VRDF(1,1,0); SBAR(); MFQ(c1,kf[1],qr[0],negm); SBAR(); \
    VRDF(2,2,0); SBAR(); MFQ(c0,kf[2],qr[1],c0); SBAR(); \
    VRDF(3,3,0); SBAR(); MFQ(c1,kf[3],qr[1],c1); SBAR(); \
    VRDF(4,0,1); SBAR(); MFQ(c0,kf[4],qr[2],c0); SBAR(); \
    VRDF(5,1,1); SBAR(); MFQ(c1,kf[5],qr[2],c1); SBAR(); \
    VRDF(6,2,1); SBAR(); MFQ(c0,kf[6],qr[3],c0); SBAR(); \
    VRDF(7,3,1); SBAR(); MFQ(c1,kf[7],qr[3],c1); SBAR(); \
    l_reg+=sacc; sacc=0.f; \
    if(GK){DMA_K((t)+3,sl_cur);} if(GV){DMA_V((t)+1,sl_next);} \
    CMASK(c0,c1,t); \
    { float a=MX3(c0[0],c0[1],c1[0]),b=MX3(c0[2],c0[3],c1[1]); a=MX3(a,c1[2],c1[3]); \
      _Pragma("unroll") for(int r=4;r<16;r+=4){a=MX3(a,c0[r],c0[r+1]);b=MX3(b,c0[r+2],c0[r+3]);a=MX3(a,c1[r],c1[r+1]);b=MX3(b,c1[r+2],c1[r+3]);} \
      float rm=__builtin_fmaxf(a,b); { auto rr=__builtin_amdgcn_permlane32_swap(__float_as_uint(rm),__float_as_uint(rm),false,false); rm=__builtin_fmaxf(__uint_as_float(rr[0]),__uint_as_float(rr[1])); } \
      resc=false; \
      if(__builtin_expect(__any(rm>(float)THRL),0)){ const float dl=__builtin_fmaxf(rm,0.f); mhat+=dl; \
        _Pragma("unroll") for(int r=0;r<16;++r){c0[r]-=dl;c1[r]-=dl;} \
        _Pragma("unroll") for(int r=0;r<16;++r)negm[r]=-mhat; asm volatile("":"+v"(negm)); \
        const float f=__builtin_amdgcn_exp2f(-dl); l_reg*=f; if(hi==0)wsf[r32]=f; resc=true; } } \
    SBAR(); \
    MFO(0,0,0); VRDF(0,0,2); EX2(c0,0);  SBAR(); \
    MFO(1,0,1); VRDF(1,1,2); EX2(c0,2);  SBAR(); \
    MFO(2,0,2); VRDF(2,2,2); EX2(c0,4);  SBAR(); \
    MFO(3,0,3); VRDF(3,3,2); EX2(c0,6);  SBAR(); \
    MFO(0,1,4); VRDF(4,0,3); EX2(c0,8);  SPK(c0,0,pw0,0); SBAR(); \
    MFO(1,1,5); VRDF(5,1,3); EX2(c0,10); SPK(c0,2,pw0,1); SBAR(); \
    MFO(2,1,6); VRDF(6,2,3); EX2(c0,12); SPK(c0,4,pw0,2); SBAR(); \
    MFO(3,1,7); VRDF(7,3,3); EX2(c0,14); SPK(c0,6,pw0,3); SBAR(); \
    KRD(GL,0); MFO(0,2,0); EX2(c1,0);  SPK(c0,8,pw1,0);  SBAR(); \
    KRD(GL,1); MFO(1,2,1); EX2(c1,2);  SPK(c0,10,pw1,1); SBAR(); \
    KRD(GL,2); MFO(2,2,2); EX2(c1,4);  SPK(c0,12,pw1,2); SBAR(); \
    KRD(GL,3); MFO(3,2,3); EX2(c1,6);  SPK(c0,14,pw1,3); SBAR(); \
    MFO(0,3,4); EX2(c1,8);  SPK(c1,0,pw2,0); SBAR(); \
    MFO(1,3,5); EX2(c1,10); SPK(c1,2,pw2,1); SBAR(); \
    MFO(2,3,6); EX2(c1,12); SPK(c1,4,pw2,2); SBAR(); \
    MFO(3,3,7); EX2(c1,14); SPK(c1,6,pw2,3); SBAR(); \
    l_reg+=sacc; \
    }while(0)
  int t=1;
  #undef CMASK
  #define CMASK(P0,P1,t) do{}while(0)
  for(;t+4<NT;++t){ STEP(t,true,true,true); WAIT_BAR(3); RESC(); ROT(); }
  #undef CMASK
  #define CMASK(P0,P1,t) do{int jb_=(t)-(NT-4); if(jb_>=0)cmask(P0,P1,jb_,qrel,hi);}while(0)
  const bool hn=nx.has;
  const long kadj=hn?(long)(nx.Kh-Kh)-(long)NT*KVBLK*PK:0L, vadj=hn?(long)(nx.Vh-Vh)-(long)NT*KVBLK*PV:0L;
  #undef DMA_K
  #undef DMA_V
  #define DMA_K(t,slot) glds16(ksrc+(long)(t)*KVBLK*PK+(((t)>=NT)?kadj:0L),(unsigned)__builtin_amdgcn_readfirstlane(kdst+(slot)))
  #define DMA_V(t,slot) do{ const bf16*vs_=vsrc+(long)(t)*KVBLK*PV+(((t)>=NT)?vadj:0L); glds16(vs_,(unsigned)__builtin_amdgcn_readfirstlane(vdst+2*(slot))); glds16(vs_+64,(unsigned)__builtin_amdgcn_readfirstlane(vdst+2*(slot)+8192)); }while(0)
  #define ENDW(tt) do{ if(hn||(tt)+3<NT){WAIT_BAR(3);} else if((tt)+2<NT){WAIT_BAR(2);} else {WAIT_BAR(0);} }while(0)
  for(;t+1<NT;++t){ STEP(t,(hn||t+3<NT),true,true); ENDW(t); RESC(); ROT(); }
  STEP(NT-1,hn,hn,false);
  if(hn){
    const bf16*QwN=nx.Qh+(long)(nx.qb*QB+wid*QBLK)*PQ;
    #pragma unroll
    for(int d0=0;d0<4;++d0)qr[d0]=*reinterpret_cast<const bf16x8*>(&QwN[(long)r32*PQ+d0*16+hi*8]);
    WAIT_BAR(7);
  }
  cy.primed=hn; cy.s0=sl_next;
  RESC();
  { float sacc=(c1[8]+c1[9]); _Pragma("unroll") for(int r=10;r<16;++r)sacc+=c1[r]; l_reg+=sacc;
    pw3=(u32x4){PKW(c1,8),PKW(c1,10),PKW(c1,12),PKW(c1,14)};
    SBAR(); pv128(o,(int)(unsigned)(uintptr_t)vp0+2*sl_cur,PAF(0),PAF(1),PAF(2),PAF(3)); }
  #undef PKW
  #undef PAF
  #undef VFR
  #undef PIN
  #undef MX3
  #undef EX
  #undef VRDF
  #undef KRD
  #undef MFQ
  #undef MFO
  #undef EX2
  #undef SPK
  #undef STEP
  #undef ENDW
  {auto rr=__builtin_amdgcn_permlane32_swap(__float_as_uint(l_reg),__float_as_uint(l_reg),false,false);l_reg=__uint_as_float(rr[0])+__uint_as_float(rr[1]);}
  if(hi==0)wsf[32+r32]=l_reg;asm volatile("s_waitcnt lgkmcnt(0)":::"memory");
  float rli[16];
  #pragma unroll
  for(int r=0;r<16;++r)rli[r]=__builtin_amdgcn_rcpf(wsf[32+crow(r,hi)]);
  if(post.on){
    asm volatile("s_waitcnt lgkmcnt(0)\n\ts_barrier":::"memory");
    const int so=__builtin_amdgcn_readfirstlane((wid<4)?(L2_OST+wid*8192):(L2_V+2*((wid<6)?sl_prev:sl_cur)+(wid&1)*8192));
    bf16*stg=(bf16*)(shm+so);
    #pragma unroll
    for(int r=0;r<16;++r){const int orow=crow(r,hi);
      #pragma unroll
      for(int d0=0;d0<4;++d0)stg[orow*128+d0*32+r32]=__float2bfloat16(o[d0][r]*rli[r]);}
    asm volatile("s_waitcnt lgkmcnt(0)":::"memory");
    post.run((lds_cptr)shm+so,q0+wid*QBLK,lane);
  } else {
  bf16*Ow=Oh+(long)(q0+wid*QBLK)*PO;
  { bf16*stg=(bf16*)(shm+L2_OST)+wid*2048;
    #pragma unroll
    for(int h2=0;h2<2;++h2){
      #pragma unroll
      for(int r=0;r<16;++r){const int orow=crow(r,hi);
        #pragma unroll
        for(int d0=0;d0<2;++d0)stg[orow*64+d0*32+r32]=__float2bfloat16(o[2*h2+d0][r]*rli[r]);}
      asm volatile("s_waitcnt lgkmcnt(0)":::"memory");
      #pragma unroll
      for(int i=0;i<4;++i){const int row=i*8+(lane>>3),ch=lane&7; const u32x4 v=*(const u32x4*)(stg+row*64+ch*8); ATTN_STORE16(Ow+(long)row*PO+h2*64+ch*8,v);}
      asm volatile("s_waitcnt lgkmcnt(0)":::"memory"); } }
  }
  asm volatile("s_waitcnt lgkmcnt(0)\n\ts_barrier":::"memory");
  #undef DMA_K
  #undef DMA_V
  #undef CMASK
  #undef RESC
  #undef ROT
}
constexpr int ATTN_LDS_BYTES=L2_BYTES;
#undef SBAR
#undef WAIT_BAR
}

constexpr int NWAVES = 8;
constexpr size_t MiB = 1u << 20;
constexpr size_t WS_CTL = 0, CTL_ZERO_BYTES = 1 * MiB;
constexpr size_t WS_ROPEC = 1 * MiB, WS_ROPES = WS_ROPEC + 256 * 1024;
constexpr size_t WS_ROUTE = 2 * MiB;
constexpr int ECAP = M, ECAP_LOG = 14;
static_assert((1 << ECAP_LOG) == ECAP, "ECAP");
constexpr size_t RT_SLOTOF = 0, RT_WSLOT = 128 * 1024, RT_SSSLOT = 1024 * 1024;
constexpr size_t WS_SS = 6 * MiB;
constexpr size_t WS_WIN = 10 * MiB;
constexpr size_t WS_WOUT = WS_WIN + 64 * MiB;
constexpr size_t WS_WGU = WS_WOUT + 8 * MiB;
constexpr size_t WS_WD = WS_WGU + 22 * MiB;
constexpr size_t WS_WEGU = WS_WD + 11 * MiB;
constexpr size_t WS_WED = WS_WEGU + 224 * MiB;
constexpr size_t WS_XB = WS_WED + 112 * MiB;
constexpr size_t WS_PROJ = WS_XB + 32 * MiB;
constexpr size_t WS_O = WS_PROJ + 256 * MiB;
constexpr size_t WS_MIX = WS_O + 64 * MiB;
constexpr size_t WS_Y = WS_MIX + 32 * MiB;
constexpr size_t WS_END = WS_Y + 68 * MiB;
static_assert((size_t)MSLOT * DFFE * 2 <= 256 * MiB && (size_t)MSLOT * 1024 * 2 <= 68 * MiB && (size_t)MSLOT * 1024 * 2 <= 96 * MiB, "overlays");
static_assert((size_t)NEXP * ECAP * 4 <= 896 * 1024 && RT_SSSLOT + (size_t)NEXP * ECAP * 16 <= 4 * MiB && (size_t)9 * M * 16 <= 4 * MiB && (size_t)NEXP * ECAP * 1024 <= 164 * MiB, "routing / ss map; sparse expert inputs overlay O | MIX | Y");
constexpr int CW_TMO = 0, CW_CODE = 1;
constexpr int CW_BAR = 4096;
constexpr int CW_GCNT = 16384;

constexpr int RING_OFF = 0, RING_BYTES = 131072;
constexpr int LDSCTL_OFF = RING_BYTES, MISC_OFF = LDSCTL_OFF + 320;
constexpr int LDS_BYTES = 163840;
static_assert(MISC_OFF + 128 <= LDS_BYTES, "LDS map");

#define GAS __attribute__((address_space(1)))
#define LAS __attribute__((address_space(3)))
typedef unsigned short bf16;
typedef unsigned v4u __attribute__((ext_vector_type(4)));
typedef unsigned v2u __attribute__((ext_vector_type(2)));
typedef float f32x4 __attribute__((ext_vector_type(4)));
typedef GAS unsigned gu32;
#define RLX_AGENT __ATOMIC_RELAXED, __HIP_MEMORY_SCOPE_AGENT
#define LDS_WAIT() asm volatile("s_waitcnt lgkmcnt(0)" ::: "memory")
#define VM_WAIT() asm volatile("s_waitcnt vmcnt(0)" ::: "memory")
__device__ __forceinline__ unsigned f2bf(float f) { unsigned u = __builtin_bit_cast(unsigned, f); return (u + 0x7fffu + ((u >> 16) & 1u)) >> 16; }
__device__ __forceinline__ unsigned pk2(float lo, float hi) { return f2bf(lo) | (f2bf(hi) << 16); }
__device__ __forceinline__ float bflo(unsigned w) { return __uint_as_float(w << 16); }
__device__ __forceinline__ float bfhi(unsigned w) { return __uint_as_float(w & 0xffff0000u); }

#define XB_TMO      128
#define XB_XCNT(j)  (256  + 64 * (j))
#define XB_XSUB(j)  (1280 + 64 * (j))
#define XB_XGEN(j)  (2304 + 64 * (j))
#define XB_TOP      3328
#define XB_TOPGEN   3392
#define XCD_BAR_WORDS 3456
#define XB_SPIN_CAP (1u << 18)
__device__ __forceinline__ unsigned xb_ld(unsigned* p)              { return __hip_atomic_load(p, __ATOMIC_RELAXED, __HIP_MEMORY_SCOPE_AGENT); }
__device__ __forceinline__ unsigned xb_add(unsigned* p, unsigned v) { return __hip_atomic_fetch_add(p, v, __ATOMIC_RELAXED, __HIP_MEMORY_SCOPE_AGENT); }
__device__ __forceinline__ unsigned xb_xcc_id() { return (unsigned)__builtin_amdgcn_s_getreg((3 << 11) | 20) & 0xFu; }
#define XB_SPIN(cond, bar) do { unsigned _sp = 0; while (cond) { __builtin_amdgcn_s_sleep(1); \
    if ((++_sp & 255u) == 0u) { if (xb_ld(&(bar)[XB_TMO])) break; if (_sp > XB_SPIN_CAP) { atomicAdd(&(bar)[XB_TMO], 1u); break; } } } } while (0)
struct XcdBarrier { unsigned* bar; unsigned x; volatile LAS unsigned* st; };
__device__ __forceinline__ XcdBarrier xcd_barrier_post(unsigned* bar, volatile LAS unsigned* st) {
    XcdBarrier b; b.bar = bar; b.x = xb_xcc_id(); b.st = st;
    if (threadIdx.x == 0) (void)xb_add(&bar[XB_XCNT(b.x)], 1u);
    return b;
}
__device__ __forceinline__ void xcd_barrier_complete(unsigned* bar, unsigned x, unsigned& nloc, unsigned& nx) {
    const unsigned G = gridDim.x * gridDim.y * gridDim.z;
    unsigned sum, cnt, mine, sp = 0u;
    for (;;) {
        sum = 0u; cnt = 0u; mine = 0u;
#pragma unroll
        for (unsigned j = 0; j < 16; ++j) { const unsigned c = xb_ld(&bar[XB_XCNT(j)]); sum += c; cnt += (c > 0u) ? 1u : 0u; mine = (j == x) ? c : mine; }
        if (sum == G) break;
        __builtin_amdgcn_s_sleep(1);
        if ((++sp & 255u) == 0u) { if (xb_ld(&bar[XB_TMO])) break; if (sp > XB_SPIN_CAP) { atomicAdd(&bar[XB_TMO], 1u); break; } }
    }
    nloc = mine > 0u ? mine : 1u; nx = cnt > 0u ? cnt : 1u;
}
__device__ __forceinline__ void xcd_barrier(const XcdBarrier& b) {
    asm volatile("s_waitcnt vmcnt(0)" ::: "memory");
    __syncthreads();
    if (threadIdx.x == 0) {
        unsigned* bar = b.bar;
        __builtin_amdgcn_s_waitcnt(0);
        unsigned nloc = b.st[0], nx = b.st[1];
        if (nloc == 0u) { xcd_barrier_complete(bar, b.x, nloc, nx); b.st[0] = nloc; b.st[1] = nx; }
        const unsigned old = xb_add(&bar[XB_XSUB(b.x)], 1u);
        const unsigned gen = old / nloc;
        if (old + 1u == (gen + 1u) * nloc) {
            __builtin_amdgcn_fence(__ATOMIC_RELEASE, "agent");
            asm volatile("s_waitcnt vmcnt(0)" ::: "memory");
            const unsigned og = xb_add(&bar[XB_TOP], 1u);
            const unsigned tg = og / nx;
            if (og + 1u == (tg + 1u) * nx) xb_add(&bar[XB_TOPGEN], 1u);
            else XB_SPIN(xb_ld(&bar[XB_TOPGEN]) == tg, bar);
            __builtin_amdgcn_fence(__ATOMIC_ACQUIRE, "agent");
            xb_add(&bar[XB_XGEN(b.x)], 1u);
            asm volatile("s_waitcnt vmcnt(0)" ::: "memory");
        } else {
            XB_SPIN(xb_ld(&bar[XB_XGEN(b.x)]) == gen, bar);
            __builtin_amdgcn_fence(__ATOMIC_ACQUIRE, "agent");
            asm volatile("s_waitcnt vmcnt(0)" ::: "memory");
        }
    }
    __syncthreads();
}

struct Args { const float* in[19]; float* out; unsigned char* ws; int ph_lo, ph_hi; };
static_assert(sizeof(Args) == 19 * 8 + 8 + 8 + 8, "Args has no padding");

typedef const __attribute__((address_space(4))) Args* kargs_t;
#define KARGS() ({ kargs_t p_ = (kargs_t)__builtin_amdgcn_kernarg_segment_ptr(); asm volatile("" : "+s"(p_)); p_; })
struct Frame {
    LAS unsigned char* lds;
    int tid, lane, wave;
    int vcu, G;
    unsigned char* ws;
    gu32* ctl;
    float* X;
};
__device__ __forceinline__ Frame make_frame(kargs_t ap) {
    extern __shared__ __attribute__((aligned(16))) unsigned char lds[];
    Frame F; F.lds = (LAS unsigned char*)lds; F.tid = opaque_tid(); F.lane = F.tid & 63; F.wave = __builtin_amdgcn_readfirstlane(F.tid >> 6);
    F.G = opaque_grid(); { const int bx = opaque_bid(); F.vcu = (F.G % 8 == 0) ? (bx % 8) * (F.G / 8) + bx / 8 : bx; }
    F.ws = ap->ws; F.ctl = (gu32*)(F.ws + WS_CTL); F.X = ap->out; return F;
}

__device__ __forceinline__ float wave_sum(float v) {
#pragma unroll
    for (int o = 1; o < 64; o <<= 1) v += __shfl_xor(v, o);
    return v;
}

template <int KIND>
__device__ __forceinline__ int rowmap(int n) {
    if (KIND == 1) {
        if (n < 2048) { const int tile = n >> 8, hh = (n >> 6) & 3, half = (n >> 5) & 1, j = n & 31; return tile * 256 + half * 128 + hh * 32 + j; }
        if (n < 3072) return n;
        if (n < 4096) { const int c = n - 3072; return (20 + (c >> 7)) * 256 + (c & 127); }
        if (n < 5120) { const int c = n - 4096; return (12 + (c >> 7)) * 256 + (c & 127); }
        if (n < 6144) { const int c = n - 5120; return (12 + (c >> 7)) * 256 + 128 + (c & 127); }
        if (n < 7168) { return 28 * 256 + (n - 6144); }
        { const int c = n - 7168; return (20 + (c >> 7)) * 256 + 128 + (c & 127); }
    }
    if (KIND == 2) return (n >> 7) * 256 + (n & 127);
    if (KIND == 3) return (n >> 7) * 256 + 128 + (n & 127);
    return n;
}
__device__ __forceinline__ void cvt_ld(const float* __restrict__ W, int N, int item, int lane, f32x4 (&v)[8]) {
    const int nblk = N >> 5, kb = item / nblk, nb = item - kb * nblk;
    const int l8 = lane & 7, kg = lane >> 3;
    const int k0 = kb * 64 + kg * 8, n0 = nb * 32 + l8 * 4;
#pragma unroll
    for (int r = 0; r < 8; ++r) v[r] = *(const GAS f32x4*)(W + (size_t)(k0 + r) * N + n0);
}
template <int KIND>
__device__ __forceinline__ void cvt_st(int K, int N, const float* __restrict__ gain, bf16* __restrict__ WT, int item, int lane, f32x4 (&v)[8]) {
    const int nblk = N >> 5, kb = item / nblk, nb = item - kb * nblk;
    const int l8 = lane & 7, kg = lane >> 3;
    const int k0 = kb * 64 + kg * 8, n0 = nb * 32 + l8 * 4;
    if (gain) {
        const f32x4 g0 = *(const GAS f32x4*)(gain + k0), g1 = *(const GAS f32x4*)(gain + k0 + 4);
#pragma unroll
        for (int r = 0; r < 4; ++r) { v[r] = v[r] * g0[r]; v[r + 4] = v[r + 4] * g1[r]; }
    }
#pragma unroll
    for (int i = 0; i < 4; ++i) {
        v4u o; o.x = pk2(v[0][i], v[1][i]); o.y = pk2(v[2][i], v[3][i]); o.z = pk2(v[4][i], v[5][i]); o.w = pk2(v[6][i], v[7][i]);
        st16_wt((void*)(WT + (size_t)rowmap<KIND>(n0 + i) * K + k0), o);
    }
}

__device__ __forceinline__ void cvt_ld_f8(const float* __restrict__ W, int N, int item, int lane, f32x4 (&v)[16]) {
    const int nblk = N >> 5, kb = item / nblk, nb = item - kb * nblk;
    const int l8 = lane & 7, kg = lane >> 3;
    const int k0 = kb * 128 + kg * 16, n0 = nb * 32 + l8 * 4;
#pragma unroll
    for (int r = 0; r < 16; ++r) v[r] = __builtin_nontemporal_load((const GAS f32x4*)(W + (size_t)(k0 + r) * N + n0));
}
template <int KIND>
__device__ __forceinline__ void cvt_st_f8(int K, int N, const float* __restrict__ gain, unsigned char* __restrict__ WT, int item, int lane, f32x4 (&v)[16]) {
    const int nblk = N >> 5, kb = item / nblk, nb = item - kb * nblk;
    const int l8 = lane & 7, kg = lane >> 3;
    const int k0 = kb * 128 + kg * 16, n0 = nb * 32 + l8 * 4;
#pragma unroll
    for (int q = 0; q < 4; ++q) { f32x4 g = {256.f, 256.f, 256.f, 256.f}; if (gain) g = *(const GAS f32x4*)(gain + k0 + 4 * q) * 256.f;
#pragma unroll
        for (int r = 0; r < 4; ++r) v[4 * q + r] = v[4 * q + r] * g[r]; }
#pragma unroll
    for (int i = 0; i < 4; ++i) {
        v4u o;
#pragma unroll
        for (int q = 0; q < 4; ++q) { unsigned w = 0u;
            w = __builtin_amdgcn_cvt_pk_fp8_f32(pg8::clamp448(v[4 * q][i]), pg8::clamp448(v[4 * q + 1][i]), w, false);
            w = __builtin_amdgcn_cvt_pk_fp8_f32(pg8::clamp448(v[4 * q + 2][i]), pg8::clamp448(v[4 * q + 3][i]), w, true); o[q] = w; }
        st16_wt((void*)(WT + (size_t)rowmap<KIND>(n0 + i) * K + k0), o);
    }
}

template <int KIND>
__device__ __forceinline__ void cvt_st_b16(int K, int N, const float* __restrict__ gain, bf16* __restrict__ WT, int item, int lane, f32x4 (&v)[16]) {
    const int nblk = N >> 5, kb = item / nblk, nb = item - kb * nblk;
    const int l8 = lane & 7, kg = lane >> 3;
    const int k0 = kb * 128 + kg * 16, n0 = nb * 32 + l8 * 4;
    if (gain) {
#pragma unroll
        for (int q = 0; q < 4; ++q) { const f32x4 g = *(const GAS f32x4*)(gain + k0 + 4 * q);
#pragma unroll
            for (int r = 0; r < 4; ++r) v[4 * q + r] = v[4 * q + r] * g[r]; } }
#pragma unroll
    for (int i = 0; i < 4; ++i) {
        v4u o0, o1; o0.x = pk2(v[0][i], v[1][i]); o0.y = pk2(v[2][i], v[3][i]); o0.z = pk2(v[4][i], v[5][i]); o0.w = pk2(v[6][i], v[7][i]);
        o1.x = pk2(v[8][i], v[9][i]); o1.y = pk2(v[10][i], v[11][i]); o1.z = pk2(v[12][i], v[13][i]); o1.w = pk2(v[14][i], v[15][i]);
        bf16* q = WT + (size_t)rowmap<KIND>(n0 + i) * K + k0;
        *(GAS v4u*)q = o0; *(GAS v4u*)(q + 8) = o1;
    }
}

template <int KIND>
__device__ __forceinline__ void cvt_run(const float* __restrict__ W, int K, int N, const float* __restrict__ gain, bf16* __restrict__ WT, int it0, int NI, int nranks, int lane) {
    constexpr int NP = 4;
    for (int it = it0; it < NI; it += NP * nranks) {
        f32x4 v[NP][8];
#pragma unroll
        for (int q = 0; q < NP; ++q) { const int ii = it + q * nranks; if (ii < NI) cvt_ld(W, N, ii, lane, v[q]); }
        asm volatile("" ::: "memory");
#pragma unroll
        for (int q = 0; q < NP; ++q) { const int ii = it + q * nranks; if (ii < NI) cvt_st<KIND>(K, N, gain, WT, ii, lane, v[q]); }
    }
}
template <int KIND>
__device__ __forceinline__ void cvt_run_f8(const float* __restrict__ W, int K, int N, const float* __restrict__ gain, unsigned char* __restrict__ WT, int it0, int NI, int nranks, int lane) {
    constexpr int NP = 2;
    for (int it = it0; it < NI; it += NP * nranks) {
        f32x4 v[NP][16];
#pragma unroll
        for (int q = 0; q < NP; ++q) { const int ii = it + q * nranks; if (ii < NI) cvt_ld_f8(W, N, ii, lane, v[q]); }
        asm volatile("" ::: "memory");
#pragma unroll
        for (int q = 0; q < NP; ++q) { const int ii = it + q * nranks; if (ii < NI) cvt_st_f8<KIND>(K, N, gain, WT, ii, lane, v[q]); }
    }
}

__device__ __forceinline__ void convert_group(kargs_t A, unsigned char* ws, int grp, int rank, int nranks, int lane) {
    constexpr int I_IN = (DM / 128) * (IN_W / 32), I_OUT = (DM / 128) * (DM / 32), I_G = (DM / 128) * (DFF / 32), I_D = (DFF / 128) * (DM / 32), I_EG = (DM / 128) * (DFFE / 32), I_ED = (DFFE / 128) * (DM / 32);
    const int in_n = (grp < 4) ? 1 : 0, d_n = (grp == 1 || grp == 2) ? 1 : 0, e_lo = (grp - 1) * 4, e_n = (grp >= 1) ? 4 : 0;
    const int c0 = in_n * I_IN, c1 = c0 + in_n * I_OUT, c2 = c1 + d_n * I_G, c3 = c2 + d_n * I_G, c4 = c3 + d_n * I_D, c5 = c4 + e_n * I_EG, c6 = c5 + e_n * I_EG, c7 = c6 + e_n * I_ED;
    const int j = grp, jd = grp - 1;
    for (int it = rank; it < c7; it += 2 * nranks) {
        f32x4 v[2][16];
#pragma unroll
        for (int q = 0; q < 2; ++q) { const int ii = it + q * nranks;
            if (ii < c7) { const float* W; int N, r;
                if (ii < c0) { W = A->in[2] + (size_t)j * DM * IN_W; N = IN_W; r = ii; }
                else if (ii < c1) { W = A->in[9] + (size_t)j * DM * DM; N = DM; r = ii - c0; }
                else if (ii < c2) { W = A->in[11] + (size_t)jd * DM * DFF; N = DFF; r = ii - c1; }
                else if (ii < c3) { W = A->in[12] + (size_t)jd * DM * DFF; N = DFF; r = ii - c2; }
                else if (ii < c4) { W = A->in[13] + (size_t)jd * DFF * DM; N = DM; r = ii - c3; }
                else if (ii < c5) { const int rr = ii - c4, jj = rr / I_EG; r = rr - jj * I_EG; W = A->in[15] + (size_t)(e_lo + jj) * DM * DFFE; N = DFFE; }
                else if (ii < c6) { const int rr = ii - c5, jj = rr / I_EG; r = rr - jj * I_EG; W = A->in[16] + (size_t)(e_lo + jj) * DM * DFFE; N = DFFE; }
                else { const int rr = ii - c6, jj = rr / I_ED; r = rr - jj * I_ED; W = A->in[17] + (size_t)(e_lo + jj) * DFFE * DM; N = DM; }
                cvt_ld_f8(W, N, r, lane, v[q]); } }
        asm volatile("" ::: "memory");
#pragma unroll
        for (int q = 0; q < 2; ++q) { const int ii = it + q * nranks;
            if (ii < c7) {
                if (ii < c0) { const int r = ii;
                    if (INPROJ_F8(j)) cvt_st_f8<1>(DM, IN_W, A->in[1] + j * DM, (unsigned char*)(ws + WS_WIN) + (size_t)j * IN_W * DM * 2, r, lane, v[q]);
                    else cvt_st_b16<1>(DM, IN_W, A->in[1] + j * DM, (bf16*)(ws + WS_WIN) + (size_t)j * IN_W * DM, r, lane, v[q]); }
                else if (ii < c1) cvt_st_b16<0>(DM, DM, nullptr, (bf16*)(ws + WS_WOUT) + (size_t)j * DM * DM, ii - c0, lane, v[q]);
                else if (ii < c2) { const int r = ii - c1;
                    if (DENSE_F8(jd)) cvt_st_f8<2>(DM, DFF, A->in[10] + (2 * jd) * DM, (unsigned char*)(ws + WS_WGU) + (size_t)jd * 2 * DFF * DM * 2, r, lane, v[q]);
                    else cvt_st_b16<2>(DM, DFF, A->in[10] + (2 * jd) * DM, (bf16*)(ws + WS_WGU) + (size_t)jd * 2 * DFF * DM, r, lane, v[q]); }
                else if (ii < c3) { const int r = ii - c2;
                    if (DENSE_F8(jd)) cvt_st_f8<3>(DM, DFF, A->in[10] + (2 * jd) * DM, (unsigned char*)(ws + WS_WGU) + (size_t)jd * 2 * DFF * DM * 2, r, lane, v[q]);
                    else cvt_st_b16<3>(DM, DFF, A->in[10] + (2 * jd) * DM, (bf16*)(ws + WS_WGU) + (size_t)jd * 2 * DFF * DM, r, lane, v[q]); }
                else if (ii < c4) { const int r = ii - c3;
                    if (DENSE_DN_F8(jd)) cvt_st_f8<0>(DFF, DM, nullptr, (unsigned char*)(ws + WS_WD) + (size_t)jd * DM * DFF * 2, r, lane, v[q]);
                    else cvt_st_b16<0>(DFF, DM, nullptr, (bf16*)(ws + WS_WD) + (size_t)jd * DM * DFF, r, lane, v[q]); }
                else if (ii < c5) { const int rr = ii - c4, jj = rr / I_EG, r = rr - jj * I_EG, je = e_lo + jj;
                    cvt_st_f8<2>(DM, DFFE, A->in[10] + (2 * (je >> 3) + 1) * DM, (unsigned char*)(ws + WS_WEGU) + (size_t)je * 2 * DFFE * DM, r, lane, v[q]); }
                else if (ii < c6) { const int rr = ii - c5, jj = rr / I_EG, r = rr - jj * I_EG, je = e_lo + jj;
                    cvt_st_f8<3>(DM, DFFE, A->in[10] + (2 * (je >> 3) + 1) * DM, (unsigned char*)(ws + WS_WEGU) + (size_t)je * 2 * DFFE * DM, r, lane, v[q]); }
                else { const int rr = ii - c6, jj = rr / I_ED, r = rr - jj * I_ED, je = e_lo + jj;
                    cvt_st_f8<0>(DFFE, DM, nullptr, (unsigned char*)(ws + WS_WED) + (size_t)je * DM * DFFE, r, lane, v[q]); } } }
    }
}
__device__ __forceinline__ void p0_prologue() {
    const kargs_t A = KARGS(); Frame F = make_frame(A);
    const int gw = F.vcu * NWAVES + F.wave, NGW = F.G * NWAVES, lane = F.lane;
    unsigned char* ws = F.ws;
    convert_group(A, ws, 0, gw, NGW, lane);
    { float* rc = (float*)(ws + WS_ROPEC); float* rs = (float*)(ws + WS_ROPES);
      for (int idx = (F.vcu * NWAVES + F.wave) * 64 + lane; idx < SEQ * 32; idx += NGW * 64) {
          const int pos = idx >> 5, i = idx & 31;
          const float inv = __builtin_amdgcn_exp2f(-(float)i * 0.4152410118609203f);
          const float ang = (float)pos * inv;
          const double rev = (double)ang * 0.15915494309189535; const float fr = (float)(rev - __builtin_rint(rev));
          rc[idx] = __builtin_amdgcn_cosf(fr); rs[idx] = __builtin_amdgcn_sinf(fr); } }
    { const float* x = A->in[0]; float* ss = (float*)(ws + WS_SS); bf16* xb = (bf16*)(ws + WS_XB);
      for (int m0 = gw * 4; m0 < M; m0 += NGW * 4) {
          f32x4 v[4][4];
#pragma unroll
          for (int r = 0; r < 4; ++r) { const GAS f32x4* xr = (const GAS f32x4*)(x + (size_t)(m0 + r) * DM) + lane;
#pragma unroll
              for (int j = 0; j < 4; ++j) v[r][j] = xr[64 * j]; }
#pragma unroll
          for (int r = 0; r < 4; ++r) { const int m = m0 + r; GAS v2u* o8 = (GAS v2u*)(xb + (size_t)m * DM) + lane; float s = 0.f;
#pragma unroll
              for (int j = 0; j < 4; ++j) { const f32x4 q = v[r][j]; s += (q.x * q.x + q.y * q.y) + (q.z * q.z + q.w * q.w); v2u w; w.x = pk2(q.x, q.y); w.y = pk2(q.z, q.w); st8_wt((void*)(o8 + 64 * j), w); }
              s = wave_sum(s); if (lane == 0) *(GAS f32x4*)(ss + 4 * (size_t)m) = (f32x4){s, 0.f, 0.f, 0.f}; } } }
}

__device__ __forceinline__ float sigmoidf_(float x) { return __builtin_amdgcn_rcpf(1.0f + __builtin_amdgcn_exp2f(x * -1.4426950408889634f)); }
__device__ __forceinline__ void unpack8(const v4u w, float (&f)[8]) { f[0] = bflo(w.x); f[1] = bfhi(w.x); f[2] = bflo(w.y); f[3] = bfhi(w.y); f[4] = bflo(w.z); f[5] = bfhi(w.z); f[6] = bflo(w.w); f[7] = bfhi(w.w); }
struct MergeCtx { float lam, one_m_li; float w0[8], w1[8], w2[8], g[8]; };
__device__ __forceinline__ void merge_setup(MergeCtx& C, kargs_t A, int l, int h, int tid) {
    const int lane = tid & 63, chunk = tid & 15;
    const float lam_init = (l == 0) ? 0.2f : (l == 1) ? 0.35550906759096934f : (l == 2) ? 0.4707130183435842f : 0.5560582041556406f;
    const float a1 = A->in[4][l * 64 + lane] * A->in[5][l * 64 + lane], a2 = A->in[6][l * 64 + lane] * A->in[7][l * 64 + lane];
    const float s1 = wave_sum(a1), s2 = wave_sum(a2);
    C.lam = __builtin_amdgcn_exp2f(s1 * 1.4426950408889634f) - __builtin_amdgcn_exp2f(s2 * 1.4426950408889634f) + lam_init; C.one_m_li = 1.0f - lam_init;
    const float* cw = A->in[3] + (size_t)l * 3 * DM + h * 128 + 8 * chunk; const float* sg = A->in[8] + l * 128 + 8 * chunk;
#pragma unroll
    for (int i = 0; i < 8; ++i) { C.w0[i] = cw[i]; C.w1[i] = cw[DM + i]; C.w2[i] = cw[2 * DM + i]; C.g[i] = sg[i] * C.one_m_li; }
}
__device__ __forceinline__ void merge_block(const MergeCtx& C, unsigned char* ws, int b, int h, int qb, int tid) {
    const bf16* P = (const bf16*)(ws + WS_PROJ); const size_t PS = (size_t)M * 1024;
    const bf16* Ob = (const bf16*)(ws + WS_O); bf16* Mx = (bf16*)(ws + WS_MIX);
    const int chunk = tid & 15, c = h * 128 + 8 * chunk, oc = h * 256 + 8 * chunk;
    for (int it0 = 0; it0 < 8; it0 += 2) {
        v4u raw[2][7];
#pragma unroll
        for (int k = 0; k < 2; ++k) {
            const int tl = qb * 256 + (it0 + k) * 32 + (tid >> 4);
            const size_t t = (size_t)b * SEQ + tl;
            const size_t tm1 = (tl >= 1) ? t - 1 : t, tm2 = (tl >= 2) ? t - 2 : t;
            raw[k][0] = *(const GAS v4u*)(Ob + t * 2048 + oc); raw[k][1] = *(const GAS v4u*)(Ob + t * 2048 + oc + 128);
            raw[k][2] = *(const GAS v4u*)(P + 4 * PS + t * 1024 + c); raw[k][3] = *(const GAS v4u*)(P + 5 * PS + t * 1024 + c);
            raw[k][4] = *(const GAS v4u*)(P + 3 * PS + t * 1024 + c); raw[k][5] = *(const GAS v4u*)(P + 3 * PS + tm1 * 1024 + c); raw[k][6] = *(const GAS v4u*)(P + 3 * PS + tm2 * 1024 + c);
        }
        asm volatile("" ::: "memory");
#pragma unroll
        for (int k = 0; k < 2; ++k) {
            const int tl = qb * 256 + (it0 + k) * 32 + (tid >> 4);
            const size_t t = (size_t)b * SEQ + tl;
            float o1[8], o2[8], bgc[8], ga[8], cu0[8], cu1[8], cu2[8];
            unpack8(raw[k][0], o1); unpack8(raw[k][1], o2); unpack8(raw[k][2], bgc); unpack8(raw[k][3], ga); unpack8(raw[k][4], cu0); unpack8(raw[k][5], cu1); unpack8(raw[k][6], cu2);
            const float k1 = (tl >= 1) ? 1.f : 0.f, k2 = (tl >= 2) ? 1.f : 0.f;
            float d[8], sq = 0.f;
#pragma unroll
            for (int i = 0; i < 8; ++i) { d[i] = o1[i] - C.lam * o2[i]; sq += d[i] * d[i]; }
            sq += __shfl_xor(sq, 1); sq += __shfl_xor(sq, 2); sq += __shfl_xor(sq, 4); sq += __shfl_xor(sq, 8);
            const float r = __builtin_amdgcn_rsqf(sq * (1.0f / 128.0f) + RMS_EPS);
            float mo[8];
#pragma unroll
            for (int i = 0; i < 8; ++i) {
                const float yc = bgc[i] * (C.w0[i] * (cu2[i] * k2) + C.w1[i] * (cu1[i] * k1) + C.w2[i] * cu0[i]);
                const float ya = d[i] * r * C.g[i];
                mo[i] = sigmoidf_(ga[i]) * ya + yc; }
            v4u w; w.x = pk2(mo[0], mo[1]); w.y = pk2(mo[2], mo[3]); w.z = pk2(mo[4], mo[5]); w.w = pk2(mo[6], mo[7]);
            st16_wt((void*)(Mx + t * 1024 + c), w);
        }
    }
}

__device__ __forceinline__ void merge_wave(const MergeCtx& C, unsigned char* ws, int b, int h, int tl0, attn_body::lds_cptr stg, int lane) {
    const bf16* P = (const bf16*)(ws + WS_PROJ); const size_t PS = (size_t)M * 1024;
    const bf16* Ob = (const bf16*)(ws + WS_O); bf16* Mx = (bf16*)(ws + WS_MIX);
    const int chunk = lane & 15, c = h * 128 + 8 * chunk, oc = h * 256 + 8 * chunk;
    for (int p0 = 0; p0 < 8; p0 += 2) {
        v4u raw[2][7];
#pragma unroll
        for (int k = 0; k < 2; ++k) {
            const int rw = (p0 + k) * 4 + (lane >> 4), tl = tl0 + rw;
            const size_t t = (size_t)b * SEQ + tl;
            const size_t tm1 = (tl >= 1) ? t - 1 : t, tm2 = (tl >= 2) ? t - 2 : t;
            raw[k][0] = *(const GAS v4u*)(Ob + t * 2048 + oc); raw[k][1] = *(const LAS v4u*)(stg + (rw * 128 + 8 * chunk) * 2);
            raw[k][2] = *(const GAS v4u*)(P + 4 * PS + t * 1024 + c); raw[k][3] = *(const GAS v4u*)(P + 5 * PS + t * 1024 + c);
            raw[k][4] = *(const GAS v4u*)(P + 3 * PS + t * 1024 + c); raw[k][5] = *(const GAS v4u*)(P + 3 * PS + tm1 * 1024 + c); raw[k][6] = *(const GAS v4u*)(P + 3 * PS + tm2 * 1024 + c);
        }
        asm volatile("" ::: "memory");
#pragma unroll
        for (int k = 0; k < 2; ++k) {
            const int rw = (p0 + k) * 4 + (lane >> 4), tl = tl0 + rw;
            const size_t t = (size_t)b * SEQ + tl;
            float o1[8], o2[8], bgc[8], ga[8], cu0[8], cu1[8], cu2[8];
            unpack8(raw[k][0], o1); unpack8(raw[k][1], o2); unpack8(raw[k][2], bgc); unpack8(raw[k][3], ga); unpack8(raw[k][4], cu0); unpack8(raw[k][5], cu1); unpack8(raw[k][6], cu2);
            const float k1 = (tl >= 1) ? 1.f : 0.f, k2 = (tl >= 2) ? 1.f : 0.f;
            float d[8], sq = 0.f;
#pragma unroll
            for (int i = 0; i < 8; ++i) { d[i] = o1[i] - C.lam * o2[i]; sq += d[i] * d[i]; }
            sq += __shfl_xor(sq, 1); sq += __shfl_xor(sq, 2); sq += __shfl_xor(sq, 4); sq += __shfl_xor(sq, 8);
            const float r = __builtin_amdgcn_rsqf(sq * (1.0f / 128.0f) + RMS_EPS);
            float mo[8];
#pragma unroll
            for (int i = 0; i < 8; ++i) {
                const float yc = bgc[i] * (C.w0[i] * (cu2[i] * k2) + C.w1[i] * (cu1[i] * k1) + C.w2[i] * cu0[i]);
                const float ya = d[i] * r * C.g[i];
                mo[i] = sigmoidf_(ga[i]) * ya + yc; }
            v4u w; w.x = pk2(mo[0], mo[1]); w.y = pk2(mo[2], mo[3]); w.z = pk2(mo[4], mo[5]); w.w = pk2(mo[6], mo[7]);
            st16_wt((void*)(Mx + t * 1024 + c), w);
        }
    }
}
struct MergePost { bool on; int l, b, h;
    __device__ __forceinline__ void run(attn_body::lds_cptr stg, int tl0, int lane) const {
        const kargs_t A = KARGS(); asm volatile("s_waitcnt vmcnt(0)" ::: "memory");
        MergeCtx MC; merge_setup(MC, A, l, h, lane); merge_wave(MC, A->ws, b, h, tl0, stg, lane); } };

constexpr int TILE_TAB_OFF = RING_BYTES + 1024 + 4096;
__device__ __forceinline__ void route_phase(int l) {
    const kargs_t A = KARGS(); Frame F = make_frame(A);
    const int lane = F.lane, tid = F.tid, j = l >> 1;
    LAS float* WrT = (LAS float*)(F.lds);
    volatile LAS int* cntl = (volatile LAS int*)(F.lds + 32768);
    volatile LAS int* gbase = cntl + 8;
    volatile LAS int* li = cntl + 16;
    volatile LAS int* lr = cntl + 16 + 128;
    volatile LAS float* lw = (volatile LAS float*)(cntl + 16 + 256);
    const float* Wr = A->in[14] + (size_t)j * DM * NEXP; const float* gn = A->in[10] + (size_t)l * DM;
    for (int idx = tid; idx < DM * NEXP; idx += NWAVES * 64) { const int k = idx >> 3, e = idx & 7; WrT[e * DM + k] = Wr[idx] * gn[k]; }
    gu32* gcnt = F.ctl + CW_GCNT + j * 8 * 64;
    int* slotof = (int*)(F.ws + WS_ROUTE + RT_SLOTOF); float* wslot = (float*)(F.ws + WS_ROUTE + RT_WSLOT); float* ssslot = (float*)(F.ws + WS_ROUTE + RT_SSSLOT);
    unsigned char* xg = (unsigned char*)(F.ws + WS_O);
    for (int blk = F.vcu; blk < M / 64; blk += F.G) {
        if (tid < 8) cntl[tid] = 0;
        __syncthreads();
        float ssq[8];
        const bf16* xbr = (const bf16*)(F.ws + WS_XB) + (size_t)(blk * 64 + F.wave * 8) * DM + 8 * lane;
        v4u cur0 = *(const GAS v4u*)xbr, cur1 = *(const GAS v4u*)(xbr + 512);
#pragma unroll
        for (int rr = 0; rr < 8; ++rr) {
            const int loc = F.wave * 8 + rr;
            v4u nx0 = cur0, nx1 = cur1;
            if (rr < 7) { nx0 = *(const GAS v4u*)(xbr + (size_t)(rr + 1) * DM); nx1 = *(const GAS v4u*)(xbr + (size_t)(rr + 1) * DM + 512); }
            float v[16]; float s = 0.f;
            { float t8[8]; unpack8(cur0, t8);
#pragma unroll
              for (int i = 0; i < 8; ++i) v[i] = t8[i];
              unpack8(cur1, t8);
#pragma unroll
              for (int i = 0; i < 8; ++i) v[8 + i] = t8[i]; }
#pragma unroll
            for (int i = 0; i < 16; ++i) s += v[i] * v[i];
            s = wave_sum(s); ssq[rr] = s; const float rstd = 1.0f / sqrtf(s * (1.0f / 1024.0f) + RMS_EPS);
            float lg[8];
#pragma unroll
            for (int e = 0; e < 8; ++e) { float a = 0.f;
#pragma unroll
                for (int q = 0; q < 2; ++q) { const f32x4 w0 = *(const LAS f32x4*)(WrT + e * DM + 512 * q + 8 * lane), w1 = *(const LAS f32x4*)(WrT + e * DM + 512 * q + 8 * lane + 4);
                    a += (v[8 * q] * w0.x + v[8 * q + 1] * w0.y) + (v[8 * q + 2] * w0.z + v[8 * q + 3] * w0.w) + (v[8 * q + 4] * w1.x + v[8 * q + 5] * w1.y) + (v[8 * q + 6] * w1.z + v[8 * q + 7] * w1.w); }
                lg[e] = wave_sum(a) * rstd; }
            int i0 = 0; float v0 = lg[0];
#pragma unroll
            for (int e = 1; e < 8; ++e) if (lg[e] > v0) { v0 = lg[e]; i0 = e; }
            int i1 = -1; float v1 = -INFINITY;
#pragma unroll
            for (int e = 0; e < 8; ++e) if (e != i0 && lg[e] > v1) { v1 = lg[e]; i1 = e; }
            if (i1 < 0) i1 = (i0 + 1) & 7;
            const float wA = 1.0f / (1.0f + __expf(v1 - v0)), wB = 1.0f - wA;
            if (lane == 0) {
                const int r0 = __hip_atomic_fetch_add((LAS int*)&cntl[i0], 1, __ATOMIC_RELAXED, __HIP_MEMORY_SCOPE_WORKGROUP);
                const int r1 = __hip_atomic_fetch_add((LAS int*)&cntl[i1], 1, __ATOMIC_RELAXED, __HIP_MEMORY_SCOPE_WORKGROUP);
                li[2 * loc] = i0; li[2 * loc + 1] = i1; lr[2 * loc] = r0; lr[2 * loc + 1] = r1; lw[2 * loc] = wA; lw[2 * loc + 1] = wB;
            }
            cur0 = nx0; cur1 = nx1;
            asm volatile("" ::: "memory");
        }
        __syncthreads();
        if (tid < 8) gbase[tid] = (int)__hip_atomic_fetch_add(gcnt + tid * 64, (unsigned)cntl[tid], RLX_AGENT);
        __syncthreads();
        v4u vs[8][2];
#pragma unroll
        for (int rr = 0; rr < 8; ++rr) { vs[rr][0] = *(const GAS v4u*)(xbr + (size_t)rr * DM); vs[rr][1] = *(const GAS v4u*)(xbr + (size_t)rr * DM + 512); }
#pragma unroll
        for (int rr = 0; rr < 8; ++rr) {
            const int loc = F.wave * 8 + rr, t = blk * 64 + loc;
            const int e0 = li[2 * loc], e1 = li[2 * loc + 1];
            const int s0 = e0 * ECAP + gbase[e0] + lr[2 * loc], s1 = e1 * ECAP + gbase[e1] + lr[2 * loc + 1];
            typedef unsigned u32x2_t __attribute__((ext_vector_type(2)));
#pragma unroll
            for (int q = 0; q < 2; ++q) { float t8[8]; unpack8(vs[rr][q], t8); u32x2_t w = {0u, 0u};
                w.x = __builtin_amdgcn_cvt_pk_fp8_f32(pg8::clamp448(t8[0] * 8.f), pg8::clamp448(t8[1] * 8.f), w.x, false); w.x = __builtin_amdgcn_cvt_pk_fp8_f32(pg8::clamp448(t8[2] * 8.f), pg8::clamp448(t8[3] * 8.f), w.x, true);
                w.y = __builtin_amdgcn_cvt_pk_fp8_f32(pg8::clamp448(t8[4] * 8.f), pg8::clamp448(t8[5] * 8.f), w.y, false); w.y = __builtin_amdgcn_cvt_pk_fp8_f32(pg8::clamp448(t8[6] * 8.f), pg8::clamp448(t8[7] * 8.f), w.y, true);
                st8_wt((void*)(xg + (size_t)s0 * DM + 512 * q + 8 * lane), w); st8_wt((void*)(xg + (size_t)s1 * DM + 512 * q + 8 * lane), w); }
            if (lane == 0) { slotof[2 * t] = s0; slotof[2 * t + 1] = s1; wslot[s0] = lw[2 * loc]; wslot[s1] = lw[2 * loc + 1];
                const f32x4 sv = {ssq[rr], 0.f, 0.f, 0.f}; *(GAS f32x4*)(ssslot + 4 * (size_t)s0) = sv; *(GAS f32x4*)(ssslot + 4 * (size_t)s1) = sv; }
        }
        __syncthreads();
    }
}
__device__ __forceinline__ void build_tiles(LAS unsigned char* lds, gu32* gcnt) {
    const int tid = opaque_tid(); LAS int* tab = (LAS int*)(lds + TILE_TAB_OFF);
    int seg = 0, ent = -1;
#pragma unroll
    for (int e = 0; e < 8; ++e) { const int nte = ((int)__hip_atomic_load(gcnt + e * 64, RLX_AGENT) + 255) >> 8;
        if (tid >= seg && tid < seg + nte) ent = (e << 16) | (e * (ECAP / 256) + (tid - seg)); seg += nte; }
    if (tid < 255 && ent >= 0) tab[tid] = ent;
    if (tid == 0) tab[255] = seg;
    __syncthreads();
}
__device__ __forceinline__ void combine_phase(int l) {
    const kargs_t A = KARGS(); Frame F = make_frame(A);
    const int lane = F.lane; const int gw = F.vcu * NWAVES + F.wave, NGW = F.G * NWAVES;
    const int* slotof = (const int*)(F.ws + WS_ROUTE + RT_SLOTOF); const bf16* Y = (const bf16*)(F.ws + WS_Y); bf16* xb = (bf16*)(F.ws + WS_XB);
    volatile LAS int* segc = (volatile LAS int*)(F.lds);
    if (F.tid == 0) { gu32* gcnt = F.ctl + CW_GCNT + (l >> 1) * 8 * 64; int s = 0; for (int e = 0; e < 8; ++e) { segc[e] = s; s += (((int)__hip_atomic_load(gcnt + e * 64, RLX_AGENT) + 255) >> 8) << 8; } }
    __syncthreads();
    float* ssn = (float*)(F.ws + WS_SS) + (size_t)(2 * l + 2) * M * 4; const bool fin = (l == DEPTH - 1);
    const float* gf = A->in[18];
    for (int t0 = gw * 4; t0 < M; t0 += NGW * 4) {
        v2u xa[4][4], ya[4][4], yb[4][4];
#pragma unroll
        for (int r = 0; r < 4; ++r) { const int t = t0 + r; const int p0 = slotof[2 * t], p1 = slotof[2 * t + 1];
            const int s0 = segc[p0 >> ECAP_LOG] + (p0 & (ECAP - 1)), s1 = segc[p1 >> ECAP_LOG] + (p1 & (ECAP - 1));
            const GAS v2u* xr = (const GAS v2u*)(xb + (size_t)t * DM) + lane;
            const GAS v2u* y0 = (const GAS v2u*)(Y + (size_t)s0 * DM) + lane; const GAS v2u* y1 = (const GAS v2u*)(Y + (size_t)s1 * DM) + lane;
#pragma unroll
            for (int q = 0; q < 4; ++q) { xa[r][q] = xr[64 * q]; ya[r][q] = y0[64 * q]; yb[r][q] = y1[64 * q]; } }
        asm volatile("" ::: "memory");
#pragma unroll
        for (int r = 0; r < 4; ++r) { const int t = t0 + r; float s = 0.f; f32x4 v[4];
#pragma unroll
            for (int q = 0; q < 4; ++q) { const v2u c = xa[r][q], a = ya[r][q], b = yb[r][q]; f32x4& x = v[q];
                x.x = bflo(c.x) + (bflo(a.x) + bflo(b.x)); x.y = bfhi(c.x) + (bfhi(a.x) + bfhi(b.x)); x.z = bflo(c.y) + (bflo(a.y) + bflo(b.y)); x.w = bfhi(c.y) + (bfhi(a.y) + bfhi(b.y));
                s += (x.x * x.x + x.y * x.y) + (x.z * x.z + x.w * x.w); }
            s = wave_sum(s);
            if (!fin) {
                GAS v2u* o8 = (GAS v2u*)(xb + (size_t)t * DM) + lane;
#pragma unroll
                for (int q = 0; q < 4; ++q) { v2u w; w.x = pk2(v[q].x, v[q].y); w.y = pk2(v[q].z, v[q].w); st8_wt((void*)(o8 + 64 * q), w); }
                if ((INPROJ_F8_MASK & 4) && INPROJ_F8(l + 1)) {
                    GAS unsigned* q8 = (GAS unsigned*)(F.ws + WS_O + (size_t)t * DM) + lane;
#pragma unroll
                    for (int q = 0; q < 4; ++q) { unsigned w = 0u;
                        w = __builtin_amdgcn_cvt_pk_fp8_f32(pg8::clamp448(v[q].x * 8.0f), pg8::clamp448(v[q].y * 8.0f), w, false);
                        w = __builtin_amdgcn_cvt_pk_fp8_f32(pg8::clamp448(v[q].z * 8.0f), pg8::clamp448(v[q].w * 8.0f), w, true); q8[64 * q] = w; } }
                if (lane == 0) *(GAS f32x4*)(ssn + 4 * (size_t)t) = (f32x4){s, 0.f, 0.f, 0.f};
            } else {
                const float rstd = 1.0f / sqrtf(s * (1.0f / 1024.0f) + RMS_EPS);
                GAS f32x4* xo = (GAS f32x4*)(F.X + (size_t)t * DM) + lane;
#pragma unroll
                for (int q = 0; q < 4; ++q) { const f32x4 gg = *((const GAS f32x4*)gf + lane + 64 * q); xo[64 * q] = v[q] * rstd * gg; }
            } }
    }
}

__device__ __forceinline__ XcdBarrier make_bar(unsigned char* ws) {
    extern __shared__ __attribute__((aligned(16))) unsigned char lds[];
    XcdBarrier b; b.bar = (unsigned*)(ws + WS_CTL) + CW_BAR; b.x = xb_xcc_id(); b.st = (volatile LAS unsigned*)((LAS unsigned char*)lds + MISC_OFF) + 8; return b;
}
__global__ void __launch_bounds__(NWAVES * 64, 2) trunk_fwd(Args args_unused) {
    extern __shared__ __attribute__((aligned(16))) unsigned char lds[];
    { const int tid = threadIdx.x;
      for (int u = tid; u < (LDS_BYTES - LDSCTL_OFF) / 4; u += NWAVES * 64) ((LAS unsigned*)((LAS unsigned char*)lds + LDSCTL_OFF))[u] = 0u;
      __syncthreads();
      if (!MK_PER_PHASE) { const kargs_t A = KARGS(); (void)xcd_barrier_post((unsigned*)(A->ws + WS_CTL) + CW_BAR, (volatile LAS unsigned*)((LAS unsigned char*)lds + MISC_OFF) + 8); } }
    int ph = 0;
#define PH_ON ({ const kargs_t Ap_ = KARGS(); ph >= Ap_->ph_lo && ph < Ap_->ph_hi; })
#define PH_END do { if (!MK_PER_PHASE && PH_ON && ph + 1 < KARGS()->ph_hi) { const kargs_t A_ = KARGS(); xcd_barrier(make_bar(A_->ws)); } ++ph; } while (0)

    for (int rep_ = 0; rep_ < (((PROBE_DUP >> 0) & 1) ? 2 : 1); ++rep_) if (((PH_MASK >> 0) & 1) && PH_ON) p0_prologue();
    PH_END;

    for (int l = 0; l < DEPTH; ++l) {
        for (int rep_ = 0; rep_ < (((PROBE_DUP >> 1) & 1) ? 2 : 1); ++rep_) if (((PH_MASK >> 1) & 1) && PH_ON) {
            const kargs_t A = KARGS(); unsigned char* ws = A->ws;
            pg8::StaticOrder S; S.init(M, IN_W, opaque_grid(), opaque_bid());
            if ((INPROJ_F8_MASK != 0) && INPROJ_F8(l)) {
                pg8::Gemm g{(const bf16*)(ws + WS_O), (const bf16*)(ws + WS_WIN + (size_t)l * IN_W * DM * 2), M, IN_W, DM, 0};
                pg8::EpiProj E{(bf16*)(ws + WS_PROJ), (const float*)(ws + WS_SS) + (size_t)(2 * l) * M * 4, (const float*)(ws + WS_ROPEC), (const float*)(ws + WS_ROPES), attn_body::C2, 1.0f / 2048.0f};
                pg8::gemm_phase<pg8::EpiProj, pg8::StaticOrder, PG8_ALIGN, PG8_SP2, true>((LAS unsigned char*)lds + RING_OFF, g, S, E);
            } else {
            pg8::Gemm g{(const bf16*)(ws + WS_XB), (const bf16*)(ws + WS_WIN) + (size_t)l * IN_W * DM, M, IN_W, DM, 0};
            pg8::EpiProj E{(bf16*)(ws + WS_PROJ), (const float*)(ws + WS_SS) + (size_t)(2 * l) * M * 4, (const float*)(ws + WS_ROPEC), (const float*)(ws + WS_ROPES), attn_body::C2};
            pg8::gemm_phase<pg8::EpiProj, pg8::StaticOrder, PG8_ALIGN, PG8_SP2>((LAS unsigned char*)lds + RING_OFF, g, S, E); }
        }
        PH_END;
        for (int rep_ = 0; rep_ < (((PROBE_DUP >> 2) & 1) ? 2 : 1); ++rep_) if (((PH_MASK >> 2) & 1) && PH_ON) {
            const kargs_t A = KARGS(); unsigned char* ws = A->ws;
            const attn_body::bf16* Qb = (const attn_body::bf16*)(ws + WS_PROJ); attn_body::bf16* Ob = (attn_body::bf16*)(ws + WS_O);
            const int G = opaque_grid(), bx = opaque_bid(), vcu = (G % 8 == 0) ? (bx % 8) * (G / 8) + bx / 8 : bx;
            attn_body::AttnCarry cy; cy.primed = false; cy.s0 = 0;
#pragma unroll
            for (int d0 = 0; d0 < 4; ++d0) cy.qr[d0] = (attn_body::bf16x8){0, 0, 0, 0, 0, 0, 0, 0};
            for (int vc = vcu; vc < 256; vc += G) {
                const int bh = vc >> 2, b = bh >> 3, h = bh & 7;
                for (int u = 0; u < 4; ++u) {
                    const int mp = u & 1, qb = (u >> 1) ? (vc & 3) : 7 - (vc & 3);
                    if (((vc >> 2) & 3) == u) {
                        const kargs_t A3 = KARGS(); const int tid3 = opaque_tid(); int grp3 = l + 1; asm volatile("" : "+s"(grp3));
                        convert_group(A3, A3->ws, grp3, vc * NWAVES + (tid3 >> 6), 256 * NWAVES, tid3 & 63);
                    }
                    const attn_body::bf16* Qh = Qb + (size_t)b * SEQ * 1024 + (2 * h + mp) * 64;
                    const attn_body::bf16* Vh = Qb + (size_t)2 * M * 1024 + (size_t)b * SEQ * 1024 + h * 128;
                    attn_body::AttnNext nx; nx.has = (u < 3); nx.qb = ((u + 1) >> 1) ? (vc & 3) : 7 - (vc & 3);
                    nx.Qh = Qb + (size_t)b * SEQ * 1024 + (2 * h + ((u + 1) & 1)) * 64; nx.Kh = nx.Qh + (size_t)M * 1024; nx.Vh = Vh;
                    const MergePost post{mp == 1, l, b, h};
                    attn_body::attn_unit128<8>(qb, Qh, Qh + (size_t)M * 1024, Vh, Ob + (size_t)b * SEQ * 2048 + h * 256 + mp * 128, (char*)lds + RING_OFF, post, nx, cy);
                }
            }
        }
        PH_END;
        for (int rep_ = 0; rep_ < (((PROBE_DUP >> 4) & 1) ? 2 : 1); ++rep_) if (((PH_MASK >> 4) & 1) && PH_ON) {
            const kargs_t A = KARGS(); unsigned char* ws = A->ws;
            pg8::Gemm g{(const bf16*)(ws + WS_MIX), (const bf16*)(ws + WS_WOUT) + (size_t)l * DM * DM, M, DM, DM, 0};
            pg8::StaticOrder S; S.init(M, DM, opaque_grid(), opaque_bid());
            if (l & 1) { pg8::EpiResidLite E{(bf16*)(ws + WS_XB), nullptr};
                pg8::gemm_phase<pg8::EpiResidLite, pg8::StaticOrder, PG8_ALIGN, PG8_SP2>((LAS unsigned char*)lds + RING_OFF, g, S, E); }
            else if (DENSE_F8(l >> 1)) { pg8::EpiResidF8X E{(bf16*)(ws + WS_XB), (float*)(ws + WS_SS) + (size_t)(2 * l + 1) * M * 4, (unsigned char*)(ws + WS_O), 1.0f};
                pg8::gemm_phase<pg8::EpiResidF8X, pg8::StaticOrder, PG8_ALIGN, PG8_SP2>((LAS unsigned char*)lds + RING_OFF, g, S, E); }
            else { pg8::EpiResid E{(bf16*)(ws + WS_XB), (float*)(ws + WS_SS) + (size_t)(2 * l + 1) * M * 4};
                pg8::gemm_phase<pg8::EpiResid, pg8::StaticOrder, PG8_ALIGN, PG8_SP2>((LAS unsigned char*)lds + RING_OFF, g, S, E); }
        }
        PH_END;
        if ((l & 1) == 0) {
            for (int rep_ = 0; rep_ < (((PROBE_DUP >> 5) & 1) ? 2 : 1); ++rep_) if (((PH_MASK >> 5) & 1) && PH_ON) {
                const kargs_t A = KARGS(); unsigned char* ws = A->ws; const int j = l >> 1;
                pg8::StaticOrder S; S.init(M, 2 * DFF, opaque_grid(), opaque_bid());
                if (DENSE_F8(j)) {
                    pg8::Gemm g{(const bf16*)(ws + WS_O), (const bf16*)(ws + WS_WGU + (size_t)j * 2 * DFF * DM * 2), M, 2 * DFF, DM, 0};
                    pg8::EpiSwigluF8 E{(void*)(ws + WS_PROJ), DFF, (const float*)(ws + WS_SS) + (size_t)(2 * l + 1) * M * 4, 1.0f / 2048.0f};
                    pg8::gemm_phase<pg8::EpiSwigluF8, pg8::StaticOrder, PG8_ALIGN, PG8_SP2, true>((LAS unsigned char*)lds + RING_OFF, g, S, E);
                } else {
                pg8::Gemm g{(const bf16*)(ws + WS_XB), (const bf16*)(ws + WS_WGU) + (size_t)j * 2 * DFF * DM, M, 2 * DFF, DM, 0};
                if (((DENSE_DN_F8_MASK & ~DENSE_F8_MASK) != 0) && DENSE_DN_F8(j)) {
                    pg8::EpiSwigluF8 E{(void*)(ws + WS_PROJ), DFF, (const float*)(ws + WS_SS) + (size_t)(2 * l + 1) * M * 4, 1.0f};
                    pg8::gemm_phase<pg8::EpiSwigluF8, pg8::StaticOrder, PG8_ALIGN, PG8_SP2>((LAS unsigned char*)lds + RING_OFF, g, S, E);
                } else {
                pg8::EpiSwiglu E{(void*)(ws + WS_PROJ), DFF, (const float*)(ws + WS_SS) + (size_t)(2 * l + 1) * M * 4, 1.0f};
                pg8::gemm_phase<pg8::EpiSwiglu, pg8::StaticOrder, PG8_ALIGN, PG8_SP2>((LAS unsigned char*)lds + RING_OFF, g, S, E); } }
            }
            PH_END;
            for (int rep_ = 0; rep_ < (((PROBE_DUP >> 6) & 1) ? 2 : 1); ++rep_) if (((PH_MASK >> 6) & 1) && PH_ON) {
                const kargs_t A = KARGS(); unsigned char* ws = A->ws; const int j = l >> 1;
                pg8::StaticOrder S; S.init(M, DM, opaque_grid(), opaque_bid());
                constexpr bool C_F8_X = ((DENSE_DN_F8_MASK & 1) && (INPROJ_F8_MASK & 2)) || ((DENSE_DN_F8_MASK & 2) && (INPROJ_F8_MASK & 8));
                constexpr bool C_F8_N = ((DENSE_DN_F8_MASK & 1) && !(INPROJ_F8_MASK & 2)) || ((DENSE_DN_F8_MASK & 2) && !(INPROJ_F8_MASK & 8));
                constexpr bool C_BF_X = (!(DENSE_DN_F8_MASK & 1) && (INPROJ_F8_MASK & 2)) || (!(DENSE_DN_F8_MASK & 2) && (INPROJ_F8_MASK & 8));
                const bool f8x = INPROJ_F8(l + 1);
                if (C_F8_X && DENSE_DN_F8(j) && f8x) {
                    pg8::Gemm g{(const bf16*)(ws + WS_PROJ), (const bf16*)(ws + WS_WD + (size_t)j * DM * DFF * 2), M, DM, DFF, 0};
                    pg8::EpiResidF8X E{(bf16*)(ws + WS_XB), (float*)(ws + WS_SS) + (size_t)(2 * l + 2) * M * 4, (unsigned char*)(ws + WS_O), 1.0f / 2048.0f};
                    pg8::gemm_phase<pg8::EpiResidF8X, pg8::StaticOrder, PG8_ALIGN, PG8_SP2, true>((LAS unsigned char*)lds + RING_OFF, g, S, E);
                } else if (C_F8_N && DENSE_DN_F8(j)) {
                    pg8::Gemm g{(const bf16*)(ws + WS_PROJ), (const bf16*)(ws + WS_WD + (size_t)j * DM * DFF * 2), M, DM, DFF, 0};
                    pg8::EpiResid E{(bf16*)(ws + WS_XB), (float*)(ws + WS_SS) + (size_t)(2 * l + 2) * M * 4, nullptr, 1.0f / 2048.0f};
                    pg8::gemm_phase<pg8::EpiResid, pg8::StaticOrder, PG8_ALIGN, PG8_SP2, true>((LAS unsigned char*)lds + RING_OFF, g, S, E);
                } else if (C_BF_X && f8x) {
                    pg8::Gemm g{(const bf16*)(ws + WS_PROJ), (const bf16*)(ws + WS_WD) + (size_t)j * DM * DFF, M, DM, DFF, 0};
                    pg8::EpiResidF8X E{(bf16*)(ws + WS_XB), (float*)(ws + WS_SS) + (size_t)(2 * l + 2) * M * 4, (unsigned char*)(ws + WS_O), 1.0f};
                    pg8::gemm_phase<pg8::EpiResidF8X, pg8::StaticOrder, PG8_ALIGN, PG8_SP2>((LAS unsigned char*)lds + RING_OFF, g, S, E);
                } else {
                pg8::Gemm g{(const bf16*)(ws + WS_PROJ), (const bf16*)(ws + WS_WD) + (size_t)j * DM * DFF, M, DM, DFF, 0};
                pg8::EpiResid E{(bf16*)(ws + WS_XB), (float*)(ws + WS_SS) + (size_t)(2 * l + 2) * M * 4};
                pg8::gemm_phase<pg8::EpiResid, pg8::StaticOrder, PG8_ALIGN, PG8_SP2>((LAS unsigned char*)lds + RING_OFF, g, S, E); }
            }
            PH_END;
        } else {
            for (int rep_ = 0; rep_ < (((PROBE_DUP >> 7) & 1) ? 2 : 1); ++rep_) if (((PH_MASK >> 7) & 1) && PH_ON) route_phase(l);
            PH_END;
            for (int rep_ = 0; rep_ < (((PROBE_DUP >> 9) & 1) ? 2 : 1); ++rep_) if (((PH_MASK >> 9) & 1) && PH_ON) {
                const kargs_t A = KARGS(); unsigned char* ws = A->ws; const int j = l >> 1;
                build_tiles((LAS unsigned char*)lds, (gu32*)(ws + WS_CTL) + CW_GCNT + j * 8 * 64);
                const LAS int* tab = (const LAS int*)((LAS unsigned char*)lds + TILE_TAB_OFF);
                const int ntl = __builtin_amdgcn_readfirstlane(tab[255]);
                pg8::Gemm g{(const bf16*)(ws + WS_O), (const bf16*)(ws + WS_WEGU + (size_t)j * 8 * 2 * DFFE * DM), NEXP * ECAP, 2 * DFFE, DM, (size_t)2 * DFFE * DM};
                pg8::GroupedOrder S; S.init(ntl, 2 * DFFE, opaque_grid(), opaque_bid(), tab, true);
                pg8::EpiSwigluF8 E{(void*)(ws + WS_PROJ), DFFE, (const float*)(ws + WS_ROUTE + RT_SSSLOT), 1.0f / 2048.0f};
                pg8::gemm_phase<pg8::EpiSwigluF8, pg8::GroupedOrder, PG8_ALIGN, PG8_SP2, true>((LAS unsigned char*)lds + RING_OFF, g, S, E);
            }
            PH_END;
            for (int rep_ = 0; rep_ < (((PROBE_DUP >> 10) & 1) ? 2 : 1); ++rep_) if (((PH_MASK >> 10) & 1) && PH_ON) {
                const kargs_t A = KARGS(); unsigned char* ws = A->ws; const int j = l >> 1;
                build_tiles((LAS unsigned char*)lds, (gu32*)(ws + WS_CTL) + CW_GCNT + j * 8 * 64);
                const LAS int* tab = (const LAS int*)((LAS unsigned char*)lds + TILE_TAB_OFF);
                const int ntl = __builtin_amdgcn_readfirstlane(tab[255]);
                pg8::Gemm g{(const bf16*)(ws + WS_PROJ), (const bf16*)(ws + WS_WED + (size_t)j * 8 * DM * DFFE), MSLOT, DM, DFFE, (size_t)DM * DFFE};
                pg8::GroupedOrder S; S.init(ntl, DM, opaque_grid(), opaque_bid(), tab, false);
                pg8::EpiSlot E{(bf16*)(ws + WS_Y), (const float*)(ws + WS_ROUTE + RT_WSLOT), 1.0f / 2048.0f};
                pg8::gemm_phase<pg8::EpiSlot, pg8::GroupedOrder, PG8_ALIGN, PG8_SP2, true>((LAS unsigned char*)lds + RING_OFF, g, S, E);
            }
            PH_END;
            for (int rep_ = 0; rep_ < (((PROBE_DUP >> 11) & 1) ? 2 : 1); ++rep_) if (((PH_MASK >> 11) & 1) && PH_ON) combine_phase(l);
            PH_END;
        }
    }
#undef PH_ON
#undef PH_END
}

constexpr int N_PHASES = 1 + 2 * 5 + 2 * 7;

extern "C" void kernel_launch(void* const* d_in, const int* in_sizes, int n_in, void* d_out, int out_size, void* d_ws, size_t ws_size, hipStream_t stream) {
    static int grid = 0;
    if (grid == 0) {
        if (n_in != 19 || in_sizes[0] != M * DM || out_size != M * DM || ws_size < WS_END) { fprintf(stderr, "kernel_launch: unexpected shapes / workspace (n_in %d, in0 %d, out %d, ws %zu < %zu); nothing launched\n", n_in, n_in > 0 ? in_sizes[0] : -1, out_size, ws_size, (size_t)WS_END); grid = -1; return; }
        int dev = 0, cus = 0, per_cu = 0;
        if (hipGetDevice(&dev) != hipSuccess || hipDeviceGetAttribute(&cus, hipDeviceAttributeMultiprocessorCount, dev) != hipSuccess) { grid = -1; return; }
        if (hipFuncSetAttribute((const void*)trunk_fwd, hipFuncAttributeMaxDynamicSharedMemorySize, LDS_BYTES) != hipSuccess) { fprintf(stderr, "kernel_launch: hipFuncSetAttribute failed\n"); grid = -1; return; }
        if (hipOccupancyMaxActiveBlocksPerMultiprocessor(&per_cu, (const void*)trunk_fwd, NWAVES * 64, LDS_BYTES) != hipSuccess || per_cu < 1)
            fprintf(stderr, "kernel_launch: note: occupancy query reports %d workgroups per CU\n", per_cu);
        (void)hipGetLastError();
        grid = cus;
        if (grid > 256) grid = 256;
    }
    if (grid < 0) return;
    if (hipMemsetAsync((char*)d_ws + WS_CTL, 0, CTL_ZERO_BYTES, stream) != hipSuccess) return;
    Args a{};
    for (int i = 0; i < 19; ++i) a.in[i] = (const float*)d_in[i];
    a.out = (float*)d_out; a.ws = (unsigned char*)d_ws;
#if MK_PER_PHASE
    for (int p = 0; p < N_PHASES; ++p) { a.ph_lo = p; a.ph_hi = p + 1; hipLaunchKernelGGL(trunk_fwd, dim3(grid), dim3(NWAVES * 64), LDS_BYTES, stream, a); }
#else
    a.ph_lo = 0; a.ph_hi = N_PHASES;
    hipLaunchKernelGGL(trunk_fwd, dim3(grid), dim3(NWAVES * 64), LDS_BYTES, stream, a);
#endif
}
```

```cpp
#include <hip/hip_runtime.h>
#include <hip/hip_bf16.h>
#include <cstdio>
#include <cstdint>
#include <cmath>

#ifndef PH_MASK
#define PH_MASK 0xFFFF
#endif
#ifndef DENSE_F8_MASK
#define DENSE_F8_MASK 2
#endif
#define DENSE_F8(j) (((DENSE_F8_MASK) >> (j)) & 1)
#ifndef DENSE_DN_F8_MASK
#define DENSE_DN_F8_MASK 3
#endif
#define DENSE_DN_F8(j) (((DENSE_DN_F8_MASK) >> (j)) & 1)
static_assert((DENSE_DN_F8_MASK & DENSE_F8_MASK) == DENSE_F8_MASK, "an fp8 gate|up GEMM writes fp8 hidden activations: its down projection is fp8 too");
#ifndef INPROJ_F8_MASK
#define INPROJ_F8_MASK 12
#endif
#define INPROJ_F8(l) (((INPROJ_F8_MASK) >> (l)) & 1)
static_assert((INPROJ_F8_MASK & 1) == 0, "layer 0's in-projection reads the prologue's bf16 x");
#ifndef STAGGER_INPROJ
#define STAGGER_INPROJ 2
#endif
#ifndef PROBE_DUP
#define PROBE_DUP 0
#endif
#ifndef MK_PER_PHASE
#define MK_PER_PHASE 0
#endif

constexpr int BATCH = 8, SEQ = 2048, DM = 1024, DEPTH = 4;
constexpr int M = BATCH * SEQ;
constexpr int NHEADS = 8;
constexpr int IN_W = 8192;
constexpr int DFF = 2816, DFFE = 3584, NEXP = 8;
constexpr int MSLOT = 2 * M + NEXP * 256;
constexpr float RMS_EPS = 1e-5f;

__device__ __forceinline__ int opaque_tid() { int t = threadIdx.x; asm volatile("" : "+v"(t)); return t; }
__device__ __forceinline__ int opaque_bid() { int t = blockIdx.x; asm volatile("" : "+s"(t)); return t; }
__device__ __forceinline__ int opaque_grid() { int t = gridDim.x; asm volatile("" : "+s"(t)); return t; }

typedef unsigned wt_u32x4 __attribute__((ext_vector_type(4))); typedef unsigned wt_u32x2 __attribute__((ext_vector_type(2)));
__device__ __forceinline__ void st16_wt(void* p, wt_u32x4 v) { asm volatile("global_store_dwordx4 %0, %1, off sc1\n\ts_nop 1" :: "v"(p), "v"(v) : "memory"); }
__device__ __forceinline__ void st8_wt(void* p, wt_u32x2 v) { asm volatile("global_store_dwordx2 %0, %1, off sc1" :: "v"(p), "v"(v) : "memory"); }

namespace pg8 {
#define PG8_LAS __attribute__((address_space(3)))
typedef unsigned short bf16_t;
typedef short bf16x8 __attribute__((ext_vector_type(8)));
typedef float f32x4 __attribute__((ext_vector_type(4)));
typedef unsigned u32x4 __attribute__((ext_vector_type(4)));
constexpr int BM = 256, BK = 64, HALF = 128, HTB = HALF * BK * 2, STAGE_BYTES = 8 * HTB, NXCD = 8, WGM = 8;

__host__ __device__ __forceinline__ int lds_byte(int r, int c) { const int st = (r >> 4) * 2 + (c >> 5), rr = r & 15, cc = c & 31, ob = rr * 64 + cc * 2; return st * 1024 + (ob ^ (((ob >> 9) & 1) << 5)); }
__host__ __device__ __forceinline__ void stage_rc(int b, int& R, int& C) { const int st = b / 1024, sb = b % 1024, swz = sb ^ (((sb >> 9) & 1) << 5); R = (st >> 1) * 16 + swz / 64; C = (st & 1) * 32 + (swz % 64) / 2; }
__host__ __device__ __forceinline__ int perm32(int rho) { const int n = rho >> 4, i = rho & 15; return 8 * (i >> 2) + 4 * n + (i & 3); }

struct Unit { int pm, pn, be, pa, ps; };
struct Gemm { const bf16_t* A; const bf16_t* Bt; int M, N, K; size_t bstride; };

struct StaticOrder {
    int nM, nN, nwg, G, c;
    __host__ __device__ void init(int M_, int N_, int G_, int c_) { nM = M_ / BM; nN = N_ / BM; nwg = nM * nN; G = G_; c = c_; }
    __host__ __device__ bool next(int i, Unit& u) const {
        const long L = (long)i * G + c; if (L >= nwg) return false;
        int wgid = (int)L; { const int q = nwg / NXCD, r = nwg % NXCD, xcd = wgid % NXCD, off = wgid / NXCD; wgid = (xcd < r ? xcd * (q + 1) : r * (q + 1) + (xcd - r) * q) + off; }
        const int nig = WGM * nN, gid = wgid / nig, fm = gid * WGM, gsz = (nM - fm) < WGM ? (nM - fm) : WGM;
        u.pm = fm + ((wgid % nig) % gsz); u.pn = (wgid % nig) / gsz; u.be = 0; u.pa = u.pm; u.ps = u.pm; return true;
    }
    __device__ __forceinline__ void a_ready(const Unit&) const {}
    __device__ __forceinline__ void done(const Unit&) const {}
};
struct GroupedOrder {
    int nM, nN, nwg, G, c; const PG8_LAS int* tab; bool sparseA;
    __device__ void init(int nM_, int N_, int G_, int c_, const PG8_LAS int* tab_, bool sparseA_) { nM = nM_; nN = N_ / BM; nwg = nM * nN; G = G_; c = c_; tab = tab_; sparseA = sparseA_; }
    __device__ bool next(int i, Unit& u) const {
        const long L = (long)i * G + c; if (L >= nwg) return false;
        int wgid = (int)L; { const int q = nwg / NXCD, r = nwg % NXCD, xcd = wgid % NXCD, off = wgid / NXCD; wgid = (xcd < r ? xcd * (q + 1) : r * (q + 1) + (xcd - r) * q) + off; }
        const int nig = WGM * nN, gid = wgid / nig, fm = gid * WGM, gsz = (nM - fm) < WGM ? (nM - fm) : WGM;
        u.pm = fm + ((wgid % nig) % gsz); u.pn = (wgid % nig) / gsz;
        const int ent = __builtin_amdgcn_readfirstlane(tab[u.pm]); u.be = ent >> 16; u.ps = ent & 0xffff; u.pa = sparseA ? u.ps : u.pm; return true;
    }
    __device__ __forceinline__ void a_ready(const Unit&) const {}
    __device__ __forceinline__ void done(const Unit&) const {}
};

constexpr int RSC_OFF = 131072 + 8192;
__device__ __forceinline__ unsigned cvt_pk_bf16(float lo, float hi) { unsigned r; asm volatile("v_cvt_pk_bf16_f32 %0, %1, %2" : "=v"(r) : "v"(lo), "v"(hi)); return r; }
__device__ __forceinline__ u32x4 pack8(const f32x4 a, const f32x4 b) { u32x4 w; w.x = cvt_pk_bf16(a[0], a[1]); w.y = cvt_pk_bf16(a[2], a[3]); w.z = cvt_pk_bf16(b[0], b[1]); w.w = cvt_pk_bf16(b[2], b[3]); return w; }
__device__ __forceinline__ float rstd_of(const float* ss4) { const f32x4 p = *(const f32x4*)ss4; return __builtin_amdgcn_rsqf(((p[0] + p[1]) + (p[2] + p[3])) * (1.0f / 1024.0f) + RMS_EPS); }

struct EpiProj {
    static constexpr bool PERM = true, AFTER_DRAIN = false, NEEDS_ALIGN = false;
    bf16_t* P; const float* ss; const float* ropeC; const float* ropeS; float qscale; float ascale = 1.0f;
    mutable int pmc = -1;
    __device__ __forceinline__ PG8_LAS float* rsc_lds() const { extern __shared__ __attribute__((aligned(16))) unsigned char lds_all[]; return (PG8_LAS float*)((PG8_LAS unsigned char*)lds_all + RSC_OFF) + opaque_tid(); }
    __device__ __forceinline__ void refresh(const Unit& u, int wr, int fr) const {
        if (u.pm != pmc) { pmc = u.pm; const int row0 = u.pm * BM + wr * 64 + fr; f32x4 t_[8]; PG8_LAS float* rc = rsc_lds();
#pragma unroll
            for (int i = 0; i < 8; ++i) t_[i] = *(const f32x4*)(ss + 4 * (size_t)(row0 + (i >> 2) * HALF + (i & 3) * 16));
#pragma unroll
            for (int i = 0; i < 8; ++i) rc[i * 512] = __builtin_amdgcn_rsqf(((t_[i][0] + t_[i][1]) + (t_[i][2] + t_[i][3])) * (1.0f / 1024.0f) + RMS_EPS) * ascale;
            asm volatile("s_waitcnt lgkmcnt(0)" ::: "memory"); }
    }
    __device__ __forceinline__ void half(const f32x4 (&acc)[2][2][4][2], const Unit& u, int ai, int wr, int wc, int fr, int fq) const {
        asm volatile("" : "+v"(fr), "+v"(fq));
        refresh(u, wr, fr);
        float rsc[4]; { const PG8_LAS float* rc = rsc_lds();
#pragma unroll
            for (int m = 0; m < 4; ++m) rsc[m] = rc[(ai * 4 + m) * 512]; }
        const int t = u.pn >> 2, ct = u.pn & 3;
        bf16_t* base = P + (size_t)t * ((size_t)M * 1024);
        const int row0 = u.pm * BM + wr * 64 + fr;
        if (t < 2) {
            const float sc = (t == 0) ? qscale : 1.0f;
            int fqo = fq; asm volatile("" : "+v"(fqo));
            const int hcol = ct * 256 + wc * 64 + 8 * fq;
#pragma unroll
            for (int m = 0; m < 4; ++m) {
                const int row = row0 + ai * HALF + m * 16; const float rs = rsc[m] * sc; const int pos = row & (SEQ - 1);
                const f32x4 c0 = *(const f32x4*)(ropeC + pos * 32 + 8 * fqo), c1 = *(const f32x4*)(ropeC + pos * 32 + 8 * fqo + 4);
                const f32x4 s0 = *(const f32x4*)(ropeS + pos * 32 + 8 * fqo), s1 = *(const f32x4*)(ropeS + pos * 32 + 8 * fqo + 4);
                const f32x4 l0 = acc[ai][0][m][0] * rs, l1 = acc[ai][0][m][1] * rs, h0 = acc[ai][1][m][0] * rs, h1 = acc[ai][1][m][1] * rs;
                const f32x4 ol0 = l0 * c0 - h0 * s0, ol1 = l1 * c1 - h1 * s1, oh0 = h0 * c0 + l0 * s0, oh1 = h1 * c1 + l1 * s1;
                bf16_t* rowp = base + (size_t)row * 1024 + hcol;
                st16_wt(rowp, pack8(ol0, ol1)); st16_wt(rowp + 32, pack8(oh0, oh1));
                if (m & 1) asm volatile("" ::: "memory");
            }
        } else if (u.pn < 12 || u.pn >= 28) {
            bf16_t* b2 = P + (size_t)(u.pn < 12 ? 2 : 5) * ((size_t)M * 1024);
            const int col0 = ct * 256 + wc * 32 + 8 * fq;
#pragma unroll
            for (int m = 0; m < 4; ++m) {
                const int row = row0 + ai * HALF + m * 16; const float rs = rsc[m];
                bf16_t* rowp = b2 + (size_t)row * 1024 + col0;
#pragma unroll
                for (int bj = 0; bj < 2; ++bj) st16_wt(rowp + bj * HALF, pack8(acc[ai][bj][m][0] * rs, acc[ai][bj][m][1] * rs));
            }
        } else {
            const bool conv = u.pn < 20;
            bf16_t* b2 = P + (size_t)(conv ? 3 : 4) * ((size_t)M * 1024);
            const int col0 = (u.pn - (conv ? 12 : 20)) * HALF + wc * 32 + 8 * fq;
#pragma unroll
            for (int m = 0; m < 4; ++m) {
                const int row = row0 + ai * HALF + m * 16; const float rs = rsc[m];
                f32x4 o[2];
#pragma unroll
                for (int n = 0; n < 2; ++n) {
                    const f32x4 x0 = acc[ai][0][m][n] * rs, x1 = acc[ai][1][m][n] * rs;
                    if (conv) o[n] = x0 * x1;
                    else {
#pragma unroll
                        for (int i = 0; i < 4; ++i) o[n][i] = x0[i] * __builtin_amdgcn_rcpf(1.0f + __builtin_amdgcn_exp2f(x1[i] * -1.4426950408889634f)); }
                }
                st16_wt(b2 + (size_t)row * 1024 + col0, pack8(o[0], o[1]));
            }
        }
    }
    __device__ __forceinline__ void operator()(const f32x4 (&acc)[2][2][4][2], const Unit& u, int wr, int wc, int fr, int fq) const { half(acc, u, 0, wr, wc, fr, fq); half(acc, u, 1, wr, wc, fr, fq); }
};
__device__ __forceinline__ float clamp448(float v) { return __builtin_fminf(__builtin_fmaxf(v, -448.0f), 448.0f); }
template <bool F8OUT> struct EpiSwigluT {
    static constexpr bool PERM = true, AFTER_DRAIN = false, NEEDS_ALIGN = false;
    void* H; int ldh; const float* ss; float ascale;
    mutable int pmc = -1;
    __device__ __forceinline__ PG8_LAS float* rsc_lds() const { extern __shared__ __attribute__((aligned(16))) unsigned char lds_all[]; return (PG8_LAS float*)((PG8_LAS unsigned char*)lds_all + RSC_OFF) + opaque_tid(); }
    __device__ __forceinline__ void refresh(const Unit& u, int wr, int fr) const {
        if (u.pm != pmc) { pmc = u.pm; const int srow0 = u.ps * BM + wr * 64 + fr;
            f32x4 t_[8]; PG8_LAS float* rc = rsc_lds();
#pragma unroll
            for (int i = 0; i < 8; ++i) t_[i] = *(const f32x4*)(ss + 4 * (size_t)(srow0 + (i >> 2) * HALF + (i & 3) * 16));
#pragma unroll
            for (int i = 0; i < 8; ++i) rc[i * 512] = __builtin_amdgcn_rsqf(((t_[i][0] + t_[i][1]) + (t_[i][2] + t_[i][3])) * (1.0f / 1024.0f) + RMS_EPS) * ascale;
            asm volatile("s_waitcnt lgkmcnt(0)" ::: "memory"); }
    }
    __device__ __forceinline__ void half(const f32x4 (&acc)[2][2][4][2], const Unit& u, int ai, int wr, int wc, int fr, int fq) const {
        asm volatile("" : "+v"(fr), "+v"(fq));
        refresh(u, wr, fr);
        float rsc[4]; { const PG8_LAS float* rc = rsc_lds();
#pragma unroll
            for (int m = 0; m < 4; ++m) rsc[m] = rc[(ai * 4 + m) * 512]; }
        const int row0 = u.pm * BM + wr * 64 + fr, col0 = u.pn * HALF + wc * 32 + 8 * fq;
#pragma unroll
        for (int m = 0; m < 4; ++m) {
            const int row = row0 + ai * HALF + m * 16; const float rs = rsc[m];
            f32x4 o[2];
            {
                const float rse = rs * -1.4426950408889634f, rs2 = rs * rs * (F8OUT ? 8.0f : 1.0f);
                f32x4 e[2], p[2];
#pragma unroll
                for (int n = 0; n < 2; ++n) { e[n] = acc[ai][0][m][n] * rse; p[n] = (acc[ai][0][m][n] * acc[ai][1][m][n]) * rs2; }
#pragma unroll
                for (int n = 0; n < 2; ++n)
#pragma unroll
                    for (int i = 0; i < 4; ++i) e[n][i] = __builtin_amdgcn_exp2f(e[n][i]);
#pragma unroll
                for (int n = 0; n < 2; ++n) e[n] = e[n] + 1.0f;
#pragma unroll
                for (int n = 0; n < 2; ++n)
#pragma unroll
                    for (int i = 0; i < 4; ++i) e[n][i] = __builtin_amdgcn_rcpf(e[n][i]);
#pragma unroll
                for (int n = 0; n < 2; ++n) o[n] = p[n] * e[n];
            }
            if constexpr (F8OUT) {
                unsigned w0 = 0u, w1 = 0u;
                w0 = __builtin_amdgcn_cvt_pk_fp8_f32(clamp448(o[0][0]), clamp448(o[0][1]), w0, false); w0 = __builtin_amdgcn_cvt_pk_fp8_f32(clamp448(o[0][2]), clamp448(o[0][3]), w0, true);
                w1 = __builtin_amdgcn_cvt_pk_fp8_f32(clamp448(o[1][0]), clamp448(o[1][1]), w1, false); w1 = __builtin_amdgcn_cvt_pk_fp8_f32(clamp448(o[1][2]), clamp448(o[1][3]), w1, true);
                typedef unsigned u32x2 __attribute__((ext_vector_type(2)));
                *(u32x2*)((unsigned char*)H + (size_t)row * ldh + col0) = (u32x2){w0, w1};
            } else {
                st16_wt((bf16_t*)H + (size_t)row * ldh + col0, pack8(o[0], o[1]));
            }
        }
    }
    __device__ __forceinline__ void operator()(const f32x4 (&acc)[2][2][4][2], const Unit& u, int wr, int wc, int fr, int fq) const { half(acc, u, 0, wr, wc, fr, fq); half(acc, u, 1, wr, wc, fr, fq); }
};
typedef EpiSwigluT<false> EpiSwiglu;
typedef EpiSwigluT<true> EpiSwigluF8;
constexpr int EPI_TAB_OFF = 131072 + 1024;
template <bool LITE, bool F8X = false> struct EpiResidT {
    static constexpr bool PERM = true, AFTER_DRAIN = false, NEEDS_ALIGN = !LITE;
    bf16_t* xb; float* ssn; unsigned char* xq = nullptr; float ascale = 1.0f;
    __device__ __forceinline__ void operator()(const f32x4 (&acc)[2][2][4][2], const Unit& u, int wr, int wc, int fr, int fq) const {
        extern __shared__ __attribute__((aligned(16))) unsigned char lds_all[];
        PG8_LAS float* T = (PG8_LAS float*)((PG8_LAS unsigned char*)lds_all + EPI_TAB_OFF);
        const int row0 = u.pm * BM + wr * 64 + fr, col0 = u.pn * BM + wc * 32 + 8 * fq;
#pragma unroll
        for (int ai = 0; ai < 2; ++ai) {
            u32x4 xv[4][2];
#pragma unroll
            for (int m = 0; m < 4; ++m)
#pragma unroll
                for (int bj = 0; bj < 2; ++bj) xv[m][bj] = *(const u32x4*)(xb + (size_t)(row0 + ai * HALF + m * 16) * 1024 + col0 + bj * HALF);
            asm volatile("" ::: "memory");
#pragma unroll
            for (int m = 0; m < 4; ++m) {
                const int row = row0 + ai * HALF + m * 16; float sq = 0.f;
#pragma unroll
                for (int bj = 0; bj < 2; ++bj) {
                    const u32x4 w = xv[m][bj];
                    f32x4 x0 = {__uint_as_float(w.x << 16), __uint_as_float(w.x & 0xffff0000u), __uint_as_float(w.y << 16), __uint_as_float(w.y & 0xffff0000u)};
                    f32x4 x1 = {__uint_as_float(w.z << 16), __uint_as_float(w.z & 0xffff0000u), __uint_as_float(w.w << 16), __uint_as_float(w.w & 0xffff0000u)};
                    x0 += acc[ai][bj][m][0] * ascale; x1 += acc[ai][bj][m][1] * ascale;
                    st16_wt(xb + (size_t)row * 1024 + col0 + bj * HALF, pack8(x0, x1));
                    if constexpr (F8X) { unsigned w0 = 0u, w1 = 0u;
                        w0 = __builtin_amdgcn_cvt_pk_fp8_f32(clamp448(x0[0] * 8.0f), clamp448(x0[1] * 8.0f), w0, false); w0 = __builtin_amdgcn_cvt_pk_fp8_f32(clamp448(x0[2] * 8.0f), clamp448(x0[3] * 8.0f), w0, true);
                        w1 = __builtin_amdgcn_cvt_pk_fp8_f32(clamp448(x1[0] * 8.0f), clamp448(x1[1] * 8.0f), w1, false); w1 = __builtin_amdgcn_cvt_pk_fp8_f32(clamp448(x1[2] * 8.0f), clamp448(x1[3] * 8.0f), w1, true);
                        st8_wt(xq + (size_t)row * 1024 + col0 + bj * HALF, (wt_u32x2){w0, w1}); }
                    if constexpr (!LITE) sq += (x0[0] * x0[0] + x0[1] * x0[1]) + (x0[2] * x0[2] + x0[3] * x0[3]) + (x1[0] * x1[0] + x1[1] * x1[1]) + (x1[2] * x1[2] + x1[3] * x1[3]);
                }
                if constexpr (!LITE) { sq += __shfl_xor(sq, 16); sq += __shfl_xor(sq, 32);
                    if (fq == 0) T[(ai * HALF + wr * 64 + m * 16 + fr) * 4 + wc] = sq; }
            }
        }
        if constexpr (!LITE) {
        asm volatile("s_waitcnt lgkmcnt(0)\n\ts_barrier" ::: "memory");
        if (wc == 0 && fq == 0) {
#pragma unroll
            for (int ai = 0; ai < 2; ++ai)
#pragma unroll
                for (int m = 0; m < 4; ++m) { const int lr = ai * HALF + wr * 64 + m * 16 + fr; const f32x4 p = *(const PG8_LAS f32x4*)(T + lr * 4);
                    ssn[(size_t)(u.pm * BM + lr) * 4 + u.pn] = (p[0] + p[1]) + (p[2] + p[3]); }
        } }
    }
};
typedef EpiResidT<false> EpiResid;
typedef EpiResidT<true> EpiResidLite;
typedef EpiResidT<false, true> EpiResidF8X;
struct EpiSlot {
    static constexpr bool PERM = true, AFTER_DRAIN = false, NEEDS_ALIGN = false;
    bf16_t* Y; const float* wslot; float ascale;
    __device__ __forceinline__ void half(const f32x4 (&acc)[2][2][4][2], const Unit& u, int ai, int wr, int wc, int fr, int fq) const {
        asm volatile("" : "+v"(fr), "+v"(fq));
        const int row0 = u.pm * BM + wr * 64 + fr, col0 = u.pn * BM + wc * 32 + 8 * fq;
        float w[4];
#pragma unroll
        for (int m = 0; m < 4; ++m) w[m] = wslot[u.ps * BM + wr * 64 + fr + ai * HALF + m * 16] * ascale;
#pragma unroll
        for (int m = 0; m < 4; ++m) {
            const int row = row0 + ai * HALF + m * 16;
#pragma unroll
            for (int bj = 0; bj < 2; ++bj) st16_wt(Y + (size_t)row * 1024 + col0 + bj * HALF, pack8(acc[ai][bj][m][0] * w[m], acc[ai][bj][m][1] * w[m]));
        }
    }
    __device__ __forceinline__ void operator()(const f32x4 (&acc)[2][2][4][2], const Unit& u, int wr, int wc, int fr, int fq) const { half(acc, u, 0, wr, wc, fr, fq); half(acc, u, 1, wr, wc, fr, fq); }
};

__device__ __forceinline__ void glds16s(unsigned voff, const void* sbase, unsigned lds_dst) { unsigned keep;
    asm volatile("s_mov_b32 %0, m0\n\ts_mov_b32 m0, %3\n\ts_nop 0\n\tglobal_load_lds_dwordx4 %1, %2\n\ts_mov_b32 m0, %0" : "=&s"(keep) : "v"(voff), "s"(sbase), "s"(lds_dst) : "memory"); }
typedef int v8i_t __attribute__((ext_vector_type(8))); typedef int v4i_t __attribute__((ext_vector_type(4)));
__device__ __forceinline__ v8i_t cat16(bf16x8 lo, bf16x8 hi) { const v4i_t a = __builtin_bit_cast(v4i_t, lo), b = __builtin_bit_cast(v4i_t, hi); return __builtin_shufflevector(a, b, 0, 1, 2, 3, 4, 5, 6, 7); }
template <class Epi, class Sched, bool ALIGN_EPI = false, bool SP2 = false, bool FP8 = false>
__device__ __forceinline__ void gemm_phase(PG8_LAS unsigned char* lds, const Gemm g, const Sched& S, const Epi& E) {
    const int tid = opaque_tid(), wid = __builtin_amdgcn_readfirstlane(tid >> 6), lane = tid & 63, wr = wid >> 2, wc = wid & 3, fr = lane & 15, fq = lane >> 4;
    const int K = FP8 ? g.K / 2 : g.K, nt = K / BK;
    unsigned voffA[2], voffB[2];
#pragma unroll
    for (int i = 0; i < 2; ++i) { int R, C; stage_rc(tid * 16 + i * 8192, R, C); const int Rb = Epi::PERM ? ((R & ~31) + perm32(R & 31)) : R;
        voffA[i] = (unsigned)(R * K + C) * 2u; voffB[i] = (unsigned)(Rb * K + C) * 2u; }
    const size_t kstep = (size_t)(BK * 2);
    const size_t hstep = (size_t)HALF * K * 2;
    const size_t tstep = 2 * hstep;
    const unsigned ldsw = (unsigned)wid * 1024u; const unsigned ldsb = (unsigned)__builtin_amdgcn_readfirstlane((int)((unsigned)(size_t)lds + ldsw));
    const int aoff = lds_byte(wr * 64 + fr, fq * 8), boff = lds_byte(wc * 32 + fr, fq * 8);
#define PG8_SA(b, h) (((b) * 2 + (h)) * HTB)
#define PG8_SB(b, h) ((4 + (b) * 2 + (h)) * HTB)
#define PG8_STAGE(bufoff, gbase, voff) do { _Pragma("unroll") for (int _i = 0; _i < 2; ++_i) \
        glds16s((voff)[_i], (const void*)(gbase), ldsb + (unsigned)((bufoff) + _i * 8192)); } while (0)
#define PG8_LDA(dst, b, h) do { _Pragma("unroll") for (int m = 0; m < 4; ++m) _Pragma("unroll") for (int k = 0; k < 2; ++k) dst[m][k] = *(const PG8_LAS bf16x8*)(lds + PG8_SA(b, h) + aoff + m * 2048 + k * 1024); } while (0)
#define PG8_LDB(dst, b, h) do { _Pragma("unroll") for (int n = 0; n < 2; ++n) _Pragma("unroll") for (int k = 0; k < 2; ++k) dst[n][k] = *(const PG8_LAS bf16x8*)(lds + PG8_SB(b, h) + boff + n * 2048 + k * 1024); } while (0)
#define PG8_MMA(ai, bj, At, Bt) do { __builtin_amdgcn_s_setprio(1); _Pragma("unroll") for (int m = 0; m < 4; ++m) _Pragma("unroll") for (int n = 0; n < 2; ++n) { \
        if constexpr (FP8) { const v8i_t bo_ = cat16(Bt[n][0], Bt[n][1]), ao_ = cat16(At[m][0], At[m][1]); \
            asm volatile("v_mfma_f32_16x16x128_f8f6f4 %0, %1, %2, %0" : "+v"(acc[ai][bj][m][n]) : "v"(bo_), "v"(ao_)); }     \
        else { _Pragma("unroll") for (int k = 0; k < 2; ++k) acc[ai][bj][m][n] = __builtin_amdgcn_mfma_f32_16x16x32_bf16(Bt[n][k], At[m][k], acc[ai][bj][m][n], 0, 0, 0); } } \
        __builtin_amdgcn_s_setprio(0); } while (0)
#define PG8_WAIT_V(n) asm volatile("s_waitcnt vmcnt(" #n ")" ::: "memory")
#define PG8_WAIT_L(n) asm volatile("s_waitcnt lgkmcnt(" #n ")" ::: "memory")
#define PG8_BAR __builtin_amdgcn_s_barrier()
#define PG8_SCHED __builtin_amdgcn_sched_barrier(0)
    Unit cur, nxt; int ui = 0;
    if (!S.next(0, cur)) return;
    f32x4 acc[2][2][4][2];
#pragma unroll
    for (int a = 0; a < 2; ++a)
#pragma unroll
        for (int b = 0; b < 2; ++b)
#pragma unroll
            for (int m = 0; m < 4; ++m)
#pragma unroll
                for (int n = 0; n < 2; ++n) { acc[a][b][m][n] = (f32x4){0.f, 0.f, 0.f, 0.f}; asm volatile("" : "+v"(acc[a][b][m][n])); }
    bf16x8 At[4][2], B0[2][2], B1[2][2];
    const char* cA = (const char*)g.A + (size_t)cur.pa * tstep; const char* cB = (const char*)g.Bt + (size_t)cur.be * g.bstride + (size_t)cur.pn * tstep;
    S.a_ready(cur);
    if constexpr (SP2) {
        PG8_STAGE(PG8_SB(0, 0), cB, voffB); PG8_STAGE(PG8_SB(0, 1), cB + hstep, voffB); PG8_STAGE(PG8_SA(0, 0), cA, voffA); PG8_STAGE(PG8_SA(0, 1), cA + hstep, voffA);
        if (wr == 1) PG8_BAR;
        PG8_WAIT_V(2); PG8_BAR;
        PG8_STAGE(PG8_SB(1, 0), cB + kstep, voffB); PG8_STAGE(PG8_SA(1, 0), cA + kstep, voffA); PG8_STAGE(PG8_SB(1, 1), cB + hstep + kstep, voffB);
        PG8_WAIT_V(6); PG8_BAR;
    } else {
        PG8_STAGE(PG8_SB(0, 0), cB, voffB); PG8_STAGE(PG8_SA(0, 0), cA, voffA); PG8_STAGE(PG8_SB(0, 1), cB + hstep, voffB); PG8_STAGE(PG8_SA(0, 1), cA + hstep, voffA);
        if (wr == 1) PG8_BAR;
        PG8_WAIT_V(4); PG8_BAR;
        PG8_STAGE(PG8_SB(1, 0), cB + kstep, voffB); PG8_STAGE(PG8_SA(1, 0), cA + kstep, voffA); PG8_STAGE(PG8_SB(1, 1), cB + hstep + kstep, voffB);
        PG8_WAIT_V(6); PG8_BAR;
    }
    for (;;) {
        const bool has_next = S.next(ui + 1, nxt);
        const char* nA = has_next ? (const char*)g.A + (size_t)nxt.pa * tstep : cA; const char* nB = has_next ? (const char*)g.Bt + (size_t)nxt.be * g.bstride + (size_t)nxt.pn * tstep : cB;
#pragma nounroll
        for (int t = 0; t < nt; t += 2) {
            const bool last = (t == nt - 2);
            const char* a1 = cA + (size_t)(t + 1) * kstep;
            const char* a2 = last ? nA : cA + (size_t)(t + 2) * kstep; const char* b2 = last ? nB : cB + (size_t)(t + 2) * kstep;
            const char* a3 = a2 + kstep; const char* b3 = b2 + kstep;
            if (last && has_next) S.a_ready(nxt);
            if constexpr (SP2) {
            PG8_LDB(B0, 0, 0); PG8_LDB(B1, 0, 1); PG8_SCHED; PG8_LDA(At, 0, 0); PG8_STAGE(PG8_SA(1, 1), a1 + hstep, voffA);
            PG8_WAIT_V(8); PG8_WAIT_L(0); PG8_BAR; PG8_MMA(0, 0, At, B0); PG8_MMA(0, 1, At, B1); PG8_BAR; PG8_SCHED;
            PG8_LDA(At, 0, 1); PG8_STAGE(PG8_SB(0, 0), b2, voffB); PG8_STAGE(PG8_SB(0, 1), b2 + hstep, voffB); PG8_STAGE(PG8_SA(0, 0), a2, voffA);
            PG8_WAIT_V(8); PG8_WAIT_L(0); PG8_BAR; PG8_MMA(1, 0, At, B0); PG8_MMA(1, 1, At, B1); PG8_BAR; PG8_SCHED;
            PG8_LDB(B0, 1, 0); PG8_LDB(B1, 1, 1); PG8_SCHED; PG8_LDA(At, 1, 0); PG8_STAGE(PG8_SA(0, 1), a2 + hstep, voffA);
            PG8_WAIT_V(8); PG8_WAIT_L(0); PG8_BAR; PG8_MMA(0, 0, At, B0); PG8_MMA(0, 1, At, B1); PG8_BAR; PG8_SCHED;
            PG8_LDA(At, 1, 1); PG8_STAGE(PG8_SB(1, 0), b3, voffB); PG8_STAGE(PG8_SB(1, 1), b3 + hstep, voffB); PG8_STAGE(PG8_SA(1, 0), a3, voffA);
            PG8_WAIT_V(8); PG8_WAIT_L(0); PG8_BAR; PG8_MMA(1, 0, At, B0); PG8_MMA(1, 1, At, B1); PG8_BAR; PG8_SCHED;
            } else {
            PG8_LDB(B0, 0, 0); PG8_SCHED; PG8_LDA(At, 0, 0); PG8_STAGE(PG8_SA(1, 1), a1 + hstep, voffA);
            PG8_WAIT_L(8); PG8_BAR; PG8_WAIT_L(0); PG8_MMA(0, 0, At, B0); PG8_BAR; PG8_SCHED;
            PG8_LDB(B1, 0, 1); PG8_STAGE(PG8_SB(0, 0), b2, voffB);
            PG8_BAR; PG8_WAIT_L(0); PG8_MMA(0, 1, At, B1); PG8_BAR;
            PG8_LDA(At, 0, 1); PG8_STAGE(PG8_SA(0, 0), a2, voffA);
            PG8_BAR; PG8_WAIT_L(0); PG8_MMA(1, 0, At, B0); PG8_BAR; PG8_SCHED;
            PG8_STAGE(PG8_SB(0, 1), b2 + hstep, voffB);
            PG8_WAIT_V(6); PG8_BAR; PG8_MMA(1, 1, At, B1); PG8_BAR;
            PG8_LDB(B0, 1, 0); PG8_SCHED; PG8_LDA(At, 1, 0); PG8_STAGE(PG8_SA(0, 1), a2 + hstep, voffA);
            PG8_WAIT_L(8); PG8_BAR; PG8_WAIT_L(0); PG8_MMA(0, 0, At, B0); PG8_BAR; PG8_SCHED;
            PG8_LDB(B1, 1, 1); PG8_STAGE(PG8_SB(1, 0), b3, voffB);
            PG8_BAR; PG8_WAIT_L(0); PG8_MMA(0, 1, At, B1); PG8_BAR;
            PG8_LDA(At, 1, 1); PG8_STAGE(PG8_SA(1, 0), a3, voffA);
            PG8_BAR; PG8_WAIT_L(0); PG8_MMA(1, 0, At, B0); PG8_BAR; PG8_SCHED;
            PG8_STAGE(PG8_SB(1, 1), b3 + hstep, voffB);
            PG8_WAIT_V(6); PG8_BAR; PG8_MMA(1, 1, At, B1); PG8_BAR;
            }
        }
        if constexpr (ALIGN_EPI) { if (wr == 0) PG8_BAR; }
        static_assert(ALIGN_EPI || !Epi::NEEDS_ALIGN, "this epilogue contains a workgroup barrier: both halves must run it together");
        if constexpr (!Epi::AFTER_DRAIN) { E(acc, cur, wr, wc, fr, fq); S.done(cur); }
        if (!has_next) break;
#pragma unroll
        for (int a = 0; a < 2; ++a)
#pragma unroll
            for (int b = 0; b < 2; ++b)
#pragma unroll
                for (int m = 0; m < 4; ++m)
#pragma unroll
                    for (int n = 0; n < 2; ++n) { acc[a][b][m][n] = (f32x4){0.f, 0.f, 0.f, 0.f}; asm volatile("" : "+v"(acc[a][b][m][n])); }
        cur = nxt; cA = nA; cB = nB; ++ui;
        if constexpr (ALIGN_EPI) { if (wr == 1) PG8_BAR; }
    }
    PG8_WAIT_V(0);
    if constexpr (!ALIGN_EPI) { if (wr == 0) PG8_BAR; }
    PG8_BAR;
#undef PG8_SA
#undef PG8_SB
#undef PG8_STAGE
#undef PG8_LDA
#undef PG8_LDB
#undef PG8_MMA
#undef PG8_WAIT_V
#undef PG8_WAIT_L
#undef PG8_BAR
#undef PG8_SCHED
}

}

#ifndef PG8_SP2
#define PG8_SP2 true
#endif
#ifndef PG8_ALIGN
#define PG8_ALIGN true
#endif

namespace attn_body {
using bf16=__hip_bfloat16;
using bf16x8=__attribute__((ext_vector_type(8)))short;
using s16x4=__attribute__((ext_vector_type(4)))short;
using f32x16=__attribute__((ext_vector_type(16)))float;
using u32x4=__attribute__((ext_vector_type(4)))unsigned;
constexpr int D=64;
constexpr int PQ=1024,PK=1024,PV=1024,PO=2048;
constexpr int NW=8,QBLK=32,QB=QBLK*NW,KVBLK=64;
__device__ __forceinline__ int crow(int r,int hi){return (r&3)+8*(r>>2)+4*hi;}
#define SBAR() __builtin_amdgcn_sched_barrier(0)
__device__ __forceinline__ void cmask(f32x16&p0,f32x16&p1,int jb,int qrel,int hi){
  const float NEG=-INFINITY; int kb=64*jb+4*hi;
  #pragma unroll
  for(int r=0;r<16;++r){int kv=kb+(r&3)+8*(r>>2); if(kv>qrel)p0[r]=NEG; if(kv+32>qrel)p1[r]=NEG;}
}
constexpr int NSLOT=3, SLOTB=8192;
constexpr int LDS_K=0, LDS_V=NSLOT*SLOTB, LDS_WS=2*NSLOT*SLOTB, LDS_OST=LDS_WS+NW*64*4, LDS_BYTES=LDS_OST+NW*4096;
constexpr float C2=0.125f*1.4426950408889634f;
__device__ __forceinline__ void glds16(const void*gsrc,unsigned lds_dst){unsigned keep;
  asm volatile("s_mov_b32 %0, m0\n\ts_mov_b32 m0, %2\n\ts_nop 0\n\tglobal_load_lds_dwordx4 %1, off\n\ts_mov_b32 m0, %0":"=&s"(keep):"v"(gsrc),"s"(lds_dst):"memory");}
__device__ __forceinline__ float max3f(float a,float b,float c){float r;asm("v_max3_f32 %0, %1, %2, %3":"=v"(r):"v"(a),"v"(b),"v"(c));return r;}
__device__ __forceinline__ float max2f(float a,float b){float r;asm("v_max_f32_e32 %0, %1, %2":"=v"(r):"v"(a),"v"(b));return r;}
__device__ __forceinline__ float fadd_s(float a,float b){float r;asm("v_add_f32_e32 %0, %1, %2":"=v"(r):"v"(a),"v"(b));return r;}
__device__ __forceinline__ float fsub_s(float a,float b){float r;asm("v_sub_f32_e32 %0, %1, %2":"=v"(r):"v"(a),"v"(b));return r;}
typedef float f32x2_t __attribute__((ext_vector_type(2))); typedef __bf16 bf16x2_t __attribute__((ext_vector_type(2)));
__device__ __forceinline__ unsigned cvtpk_s(float lo,float hi){f32x2_t v={lo,hi};bf16x2_t b=__builtin_convertvector(v,bf16x2_t);return __builtin_bit_cast(unsigned,b);}
#define WAIT_BAR(N) asm volatile("s_waitcnt vmcnt(" #N ") lgkmcnt(0)\n\ts_barrier":::"memory")

__device__ __forceinline__ void qkt(f32x16&p0,f32x16&p1,const char*Kslot,const bf16x8*qr,const f32x16&negm,int r32,int hi){
  const char*kb=Kslot+hi*1024+r32*16;
  #pragma unroll
  for(int d0=0;d0<4;++d0){
    const bf16x8 b0=*reinterpret_cast<const bf16x8*>(kb+d0*2048);
    const bf16x8 b1=*reinterpret_cast<const bf16x8*>(kb+d0*2048+512);
    if(d0==0){p0=__builtin_amdgcn_mfma_f32_32x32x16_bf16(b0,qr[0],negm,0,0,0);p1=__builtin_amdgcn_mfma_f32_32x32x16_bf16(b1,qr[0],negm,0,0,0);}
    else{p0=__builtin_amdgcn_mfma_f32_32x32x16_bf16(b0,qr[d0],p0,0,0,0);p1=__builtin_amdgcn_mfma_f32_32x32x16_bf16(b1,qr[d0],p1,0,0,0);}}
}
typedef __attribute__((address_space(3))) const char* lds_cptr;
typedef short v4i16_t __attribute__((ext_vector_type(4)));
__device__ __forceinline__ void kload8(bf16x8*kf,lds_cptr kp){
  kf[0]=*(const __attribute__((address_space(3))) bf16x8*)(kp);      kf[1]=*(const __attribute__((address_space(3))) bf16x8*)(kp+512);
  kf[2]=*(const __attribute__((address_space(3))) bf16x8*)(kp+2048); kf[3]=*(const __attribute__((address_space(3))) bf16x8*)(kp+2560);
  kf[4]=*(const __attribute__((address_space(3))) bf16x8*)(kp+4096); kf[5]=*(const __attribute__((address_space(3))) bf16x8*)(kp+4608);
  kf[6]=*(const __attribute__((address_space(3))) bf16x8*)(kp+6144); kf[7]=*(const __attribute__((address_space(3))) bf16x8*)(kp+6656);
}
__device__ __forceinline__ void kload2(bf16x8*kf,lds_cptr kp,int j){ kf[2*j]=*(const __attribute__((address_space(3))) bf16x8*)(kp+j*2048); kf[2*j+1]=*(const __attribute__((address_space(3))) bf16x8*)(kp+j*2048+512); }
__device__ __forceinline__ s16x4 vtr(lds_cptr p){ return __builtin_bit_cast(s16x4,__builtin_amdgcn_ds_read_tr16_b64_v4i16((__attribute__((address_space(3))) v4i16_t*)p)); }
__device__ __forceinline__ float rowmax(const f32x16&p0,const f32x16&p1){
  float a=max3f(p0[0],p0[1],p1[0]),b=max3f(p0[2],p0[3],p1[1]);a=max3f(a,p1[2],p1[3]);
  #pragma unroll
  for(int r=4;r<16;r+=4){a=max3f(a,p0[r],p0[r+1]);b=max3f(b,p0[r+2],p0[r+3]);a=max3f(a,p1[r],p1[r+1]);b=max3f(b,p1[r+2],p1[r+3]);}
  const float m=max2f(a,b);
  auto rr=__builtin_amdgcn_permlane32_swap(__float_as_uint(m),__float_as_uint(m),false,false);
  return max2f(__uint_as_float(rr[0]),__uint_as_float(rr[1]));
}
__device__ __forceinline__ void pv(f32x16*o,int vb,bf16x8 pa0,bf16x8 pa1,bf16x8 pa2,bf16x8 pa3){
  #pragma unroll
  for(int d0=0;d0<2;++d0){s16x4 lo[4],hi[4];
    #pragma unroll
    for(int ks=0;ks<4;++ks){
      asm volatile("ds_read_b64_tr_b16 %0,%1 offset:%c2":"=&v"(lo[ks]):"v"(vb),"i"(d0*4096+ks*1024):"memory");
      asm volatile("ds_read_b64_tr_b16 %0,%1 offset:%c2":"=&v"(hi[ks]):"v"(vb),"i"(d0*4096+ks*1024+512):"memory");}
    asm volatile("s_waitcnt lgkmcnt(0)":::"memory");SBAR();
    #define PK(k) (bf16x8){lo[k][0],lo[k][1],lo[k][2],lo[k][3],hi[k][0],hi[k][1],hi[k][2],hi[k][3]}
    o[d0]=__builtin_amdgcn_mfma_f32_32x32x16_bf16(pa0,PK(0),o[d0],0,0,0);
    o[d0]=__builtin_amdgcn_mfma_f32_32x32x16_bf16(pa1,PK(1),o[d0],0,0,0);
    o[d0]=__builtin_amdgcn_mfma_f32_32x32x16_bf16(pa2,PK(2),o[d0],0,0,0);
    o[d0]=__builtin_amdgcn_mfma_f32_32x32x16_bf16(pa3,PK(3),o[d0],0,0,0);
    #undef PK
  }
}
#ifndef ATTN_STORE16
#define ATTN_STORE16(p,v) st16_wt((void*)(p),(v))
#endif
template<int THRL> __device__ __forceinline__ void attn_unit(int qb,const bf16*Qh,const bf16*__restrict__ Kh,const bf16*__restrict__ Vh,bf16*Oh,char*shm){
  const int tid=opaque_tid(),lane=tid&63,r32=lane&31,hi=lane>>5; const int wid=__builtin_amdgcn_readfirstlane(tid>>6);
  const int q0=qb*QB;
  const bf16*Qw=Qh+(long)(q0+wid*QBLK)*PQ;
  const unsigned lds0=(unsigned)(uintptr_t)shm;
  float*wsf=(float*)(shm+LDS_WS)+wid*64;
  const bf16*ksrc=Kh+(long)lane*PK+wid*8;
  const bf16*vsrc=Vh+(long)(16*(wid&3)+(lane>>2))*PV+(wid>>2)*32+(lane&3)*8;
  const unsigned kdst=lds0+LDS_K+wid*1024, vdst=lds0+LDS_V+wid*1024;
  #define DMA_K(t,slot) glds16(ksrc+(long)(t)*KVBLK*PK,(unsigned)__builtin_amdgcn_readfirstlane(kdst+(slot)))
  #define DMA_V(t,slot) glds16(vsrc+(long)(t)*KVBLK*PV,(unsigned)__builtin_amdgcn_readfirstlane(vdst+(slot)))
  const int vb0=(int)(lds0+LDS_V)+((lane>>4)&1)*32+(lane&3)*8+(4*hi+((lane&15)>>2))*64;
  const char*Kbase=shm+LDS_K; bf16x8 kf[8];
  const lds_cptr shm3=(lds_cptr)shm; const lds_cptr kp0=shm3+LDS_K+hi*1024+r32*16; const lds_cptr vp0=shm3+LDS_V+((lane>>4)&1)*32+(lane&3)*8+(4*hi+((lane&15)>>2))*64;
  const int NT=(q0+QB)/KVBLK;
  DMA_K(0,0);DMA_V(0,0);DMA_K(1,SLOTB);
  bf16x8 qr[4];
  #pragma unroll
  for(int d0=0;d0<4;++d0)qr[d0]=*reinterpret_cast<const bf16x8*>(&Qw[(long)r32*PQ+d0*16+hi*8]);
  float mhat=0.f,l_reg=0.f;f32x16 o[2];o[0]=f32x16{};o[1]=f32x16{};f32x16 negm=f32x16{};asm volatile("":"+v"(negm));
  const int qrel=wid*QBLK+r32;
  #define CMASK(P0,P1,t) do{int jb_=(t)-(NT-4); if(jb_>=0)cmask(P0,P1,jb_,qrel,hi);}while(0)
  bool resc=false;
  #define START(P0,P1) do{ const float rm=rowmax(P0,P1); resc=false; \
    { const float dl=rm; mhat=fadd_s(mhat,dl); \
      _Pragma("unroll") for(int r=0;r<16;++r){P0[r]=fsub_s(P0[r],dl);P1[r]=fsub_s(P1[r],dl);} \
      _Pragma("unroll") for(int r=0;r<16;++r)negm[r]=-mhat; asm volatile("":"+v"(negm)); } \
    _Pragma("unroll") for(int r=0;r<16;++r)P0[r]=__builtin_amdgcn_exp2f(P0[r]); }while(0)
  #define RESC() do{ if(resc){ asm volatile("s_waitcnt lgkmcnt(0)":::"memory"); \
      _Pragma("unroll") for(int d_=0;d_<2;++d_) _Pragma("unroll") for(int r=0;r<16;++r)o[d_][r]*=wsf[crow(r,hi)]; } }while(0)
  f32x16 pA0,pA1,pB0,pB1;
  int sl_prev=0,sl_cur=0,sl_next=SLOTB;
  #define ROT() do{sl_prev=sl_cur;sl_cur=sl_next;sl_next=(sl_next==(NSLOT-1)*SLOTB)?0:sl_next+SLOTB;}while(0)
  DMA_K(2,2*SLOTB);
  WAIT_BAR(3);
  qkt(pA0,pA1,Kbase,qr,negm,r32,hi);asm volatile("s_nop 15\n\ts_nop 7":"+v"(pA0),"+v"(pA1));CMASK(pA0,pA1,0);
  START(pA0,pA1);
  _Pragma("unroll") for(int r=0;r<16;++r)pA1[r]=__builtin_amdgcn_exp2f(pA1[r]);
  WAIT_BAR(0);
  DMA_K(3,0);DMA_V(1,SLOTB);
  ROT();
  kload8(kf,kp0+sl_cur);
  WAIT_BAR(2);
  s16x4 vlo[8],vhi[8]; u32x4 pw0,pw1,pw2,pw3;
  #define PKW(P,B) cvtpk_s(P[B],P[B+1])
  #define PAF(k) __builtin_bit_cast(bf16x8,pw##k)
  #define VFR(i) (bf16x8){vlo[i][0],vlo[i][1],vlo[i][2],vlo[i][3],vhi[i][0],vhi[i][1],vhi[i][2],vhi[i][3]}
  #define PIN(x) asm volatile("":"+v"(x))
  #define MX3(a,b,c) __builtin_fmaxf(__builtin_fmaxf((a),(b)),(c))
  #define GAPA(MF,A0,A1,A2,A3,W0,W1,PW) do{ MF; sacc+=A0; sacc+=A1; sacc+=A2; sacc+=A3; PIN(sacc); W0; W1; PIN(PW); SBAR(); }while(0)
  #define EX(v) __builtin_amdgcn_exp2f(v)
  #define GAPB(MF,X,B) do{ MF; X[B]=EX(X[B]); X[B+1]=EX(X[B+1]); X[B+2]=EX(X[B+2]); X[B+3]=EX(X[B+3]); PIN(X); SBAR(); }while(0)
  #define VRD(i) do{ vlo[i]=vtr(vp_+(((i)>>2)*4096+((i)&3)*1024)); vhi[i]=vtr(vp_+(((i)>>2)*4096+((i)&3)*1024+512)); }while(0)
  #define KRD(G,j) do{ if(G){ kload2(kf,kp0+sl_next,j); SBAR(); } }while(0)
  #define STEP(C0,C1,P0,P1,t,GK,GV,GL) do{ SBAR(); \
    const lds_cptr vp_=vp0+sl_prev; \
    VRD(0); SBAR(); float sacc=(P0[0]+P0[1]); \
    GAPA(C0=__builtin_amdgcn_mfma_f32_32x32x16_bf16(kf[0],qr[0],negm,0,0,0), P0[2],P0[3],P0[4],P0[5],     pw0[0]=PKW(P0,0), pw0[1]=PKW(P0,2), pw0); \
    VRD(4); SBAR(); GAPA(C1=__builtin_amdgcn_mfma_f32_32x32x16_bf16(kf[1],qr[0],negm,0,0,0), P0[6],P0[7],P0[8],P0[9],     pw0[2]=PKW(P0,4), pw0[3]=PKW(P0,6), pw0); \
    VRD(1); SBAR(); GAPA(C0=__builtin_amdgcn_mfma_f32_32x32x16_bf16(kf[2],qr[1],C0,0,0,0),   P0[10],P0[11],P0[12],P0[13], pw1[0]=PKW(P0,8), pw1[1]=PKW(P0,10), pw1); \
    VRD(5); SBAR(); GAPA(C1=__builtin_amdgcn_mfma_f32_32x32x16_bf16(kf[3],qr[1],C1,0,0,0),   P0[14],P0[15],P1[0],P1[1],   pw1[2]=PKW(P0,12),pw1[3]=PKW(P0,14), pw1); \
    VRD(2); SBAR(); GAPA(C0=__builtin_amdgcn_mfma_f32_32x32x16_bf16(kf[4],qr[2],C0,0,0,0),   P1[2],P1[3],P1[4],P1[5],     pw2[0]=PKW(P1,0), pw2[1]=PKW(P1,2), pw2); \
    VRD(6); SBAR(); GAPA(C1=__builtin_amdgcn_mfma_f32_32x32x16_bf16(kf[5],qr[2],C1,0,0,0),   P1[6],P1[7],P1[8],P1[9],     pw2[2]=PKW(P1,4), pw2[3]=PKW(P1,6), pw2); \
    VRD(3); SBAR(); GAPA(C0=__builtin_amdgcn_mfma_f32_32x32x16_bf16(kf[6],qr[3],C0,0,0,0),   P1[10],P1[11],P1[12],P1[13], pw3[0]=PKW(P1,8), pw3[1]=PKW(P1,10), pw3); \
    VRD(7); SBAR(); GAPA(C1=__builtin_amdgcn_mfma_f32_32x32x16_bf16(kf[7],qr[3],C1,0,0,0),   P1[14],P1[15],0.f,0.f,       pw3[2]=PKW(P1,12),pw3[3]=PKW(P1,14), pw3); \
    l_reg+=sacc; \
    if(GK){DMA_K((t)+3,sl_cur);} if(GV){DMA_V((t)+1,sl_next);} \
    CMASK(C0,C1,t); \
    { float a=MX3(C0[0],C0[1],C1[0]),b=MX3(C0[2],C0[3],C1[1]); a=MX3(a,C1[2],C1[3]); \
      _Pragma("unroll") for(int r=4;r<16;r+=4){a=MX3(a,C0[r],C0[r+1]);b=MX3(b,C0[r+2],C0[r+3]);a=MX3(a,C1[r],C1[r+1]);b=MX3(b,C1[r+2],C1[r+3]);} \
      float rm=__builtin_fmaxf(a,b); { auto rr=__builtin_amdgcn_permlane32_swap(__float_as_uint(rm),__float_as_uint(rm),false,false); rm=__builtin_fmaxf(__uint_as_float(rr[0]),__uint_as_float(rr[1])); } \
      resc=false; \
      if(__builtin_expect(__any(rm>(float)THRL),0)){ const float dl=__builtin_fmaxf(rm,0.f); mhat+=dl; \
        _Pragma("unroll") for(int r=0;r<16;++r){C0[r]-=dl;C1[r]-=dl;} \
        _Pragma("unroll") for(int r=0;r<16;++r)negm[r]=-mhat; asm volatile("":"+v"(negm)); \
        const float f=__builtin_amdgcn_exp2f(-dl); l_reg*=f; if(hi==0)wsf[r32]=f; resc=true; } } \
    SBAR(); \
    GAPB(o[0]=__builtin_amdgcn_mfma_f32_32x32x16_bf16(PAF(0),VFR(0),o[0],0,0,0), C0,0); \
    GAPB(o[1]=__builtin_amdgcn_mfma_f32_32x32x16_bf16(PAF(0),VFR(4),o[1],0,0,0), C0,4); \
    KRD(GL,0); GAPB(o[0]=__builtin_amdgcn_mfma_f32_32x32x16_bf16(PAF(1),VFR(1),o[0],0,0,0), C0,8); \
    KRD(GL,1); GAPB(o[1]=__builtin_amdgcn_mfma_f32_32x32x16_bf16(PAF(1),VFR(5),o[1],0,0,0), C0,12); \
    KRD(GL,2); GAPB(o[0]=__builtin_amdgcn_mfma_f32_32x32x16_bf16(PAF(2),VFR(2),o[0],0,0,0), C1,0); \
    KRD(GL,3); GAPB(o[1]=__builtin_amdgcn_mfma_f32_32x32x16_bf16(PAF(2),VFR(6),o[1],0,0,0), C1,4); \
    GAPB(o[0]=__builtin_amdgcn_mfma_f32_32x32x16_bf16(PAF(3),VFR(3),o[0],0,0,0), C1,8); \
    GAPB(o[1]=__builtin_amdgcn_mfma_f32_32x32x16_bf16(PAF(3),VFR(7),o[1],0,0,0), C1,12); \
    }while(0)
  int t=1;
  #undef CMASK
  #define CMASK(P0,P1,t) do{}while(0)
  for(;t+5<NT;t+=2){
    STEP(pB0,pB1,pA0,pA1,t,true,true,true);     WAIT_BAR(2); RESC(); ROT();
    STEP(pA0,pA1,pB0,pB1,t+1,true,true,true);   WAIT_BAR(2); RESC(); ROT();
  }
  #undef CMASK
  #define CMASK(P0,P1,t) do{int jb_=(t)-(NT-4); if(jb_>=0)cmask(P0,P1,jb_,qrel,hi);}while(0)
  #define ENDW(tt) do{ if((tt)+3<NT){WAIT_BAR(2);} else if((tt)+2<NT){WAIT_BAR(1);} else {WAIT_BAR(0);} }while(0)
  for(;t+1<NT;t+=2){
    STEP(pB0,pB1,pA0,pA1,t,(t+3<NT),(t+1<NT),(t+1<NT));       ENDW(t);   RESC(); ROT();
    STEP(pA0,pA1,pB0,pB1,t+1,(t+4<NT),(t+2<NT),(t+2<NT));     ENDW(t+1); RESC(); ROT();
  }
  STEP(pB0,pB1,pA0,pA1,NT-1,false,false,false); RESC();
  { float sacc=pB0[0]+pB0[1]; _Pragma("unroll") for(int r=2;r<16;++r)sacc+=pB0[r]; _Pragma("unroll") for(int r=0;r<16;++r)sacc+=pB1[r]; l_reg+=sacc;
    pw0=(u32x4){PKW(pB0,0),PKW(pB0,2),PKW(pB0,4),PKW(pB0,6)};pw1=(u32x4){PKW(pB0,8),PKW(pB0,10),PKW(pB0,12),PKW(pB0,14)};pw2=(u32x4){PKW(pB1,0),PKW(pB1,2),PKW(pB1,4),PKW(pB1,6)};pw3=(u32x4){PKW(pB1,8),PKW(pB1,10),PKW(pB1,12),PKW(pB1,14)};
    SBAR(); pv(o,vb0+sl_cur,PAF(0),PAF(1),PAF(2),PAF(3)); }
  #undef PKW
  #undef PAF
  #undef VFR
  #undef PIN
  #undef MX3
  #undef GAPA
  #undef GAPB
  #undef EX
  #undef VRD
  #undef KRD
  #undef STEP
  #undef ENDW
  {auto rr=__builtin_amdgcn_permlane32_swap(__float_as_uint(l_reg),__float_as_uint(l_reg),false,false);l_reg=__uint_as_float(rr[0])+__uint_as_float(rr[1]);}
  if(hi==0)wsf[32+r32]=l_reg;asm volatile("s_waitcnt lgkmcnt(0)":::"memory");
  float rli[16];
  #pragma unroll
  for(int r=0;r<16;++r)rli[r]=__builtin_amdgcn_rcpf(wsf[32+crow(r,hi)]);
  bf16*Ow=Oh+(long)(q0+wid*QBLK)*PO;
  { bf16*stg=(bf16*)(shm+LDS_OST)+wid*2048;
    #pragma unroll
    for(int r=0;r<16;++r){const int orow=crow(r,hi);
      #pragma unroll
      for(int d0=0;d0<2;++d0)stg[orow*64+d0*32+r32]=__float2bfloat16(o[d0][r]*rli[r]);}
    asm volatile("s_waitcnt lgkmcnt(0)":::"memory");
    #pragma unroll
    for(int i=0;i<4;++i){const int row=i*8+(lane>>3),ch=lane&7; const u32x4 v=*(const u32x4*)(stg+row*64+ch*8); ATTN_STORE16(Ow+(long)row*PO+ch*8,v);} }
  asm volatile("s_waitcnt lgkmcnt(0)\n\ts_barrier":::"memory");
  #undef DMA_K
  #undef DMA_V
  #undef CMASK
  #undef START
  #undef RESC
  #undef ROT
}

constexpr int VSLOT=2*SLOTB;
constexpr int L2_K=0, L2_V=NSLOT*SLOTB, L2_WS=L2_V+NSLOT*VSLOT, L2_OST=L2_WS+NW*64*4, L2_BYTES=L2_OST+NW*4096;
__device__ __forceinline__ void pv128(f32x16*o,int vb,bf16x8 pa0,bf16x8 pa1,bf16x8 pa2,bf16x8 pa3){
  #pragma unroll
  for(int d0=0;d0<4;++d0){s16x4 lo[4],hi[4];
    #pragma unroll
    for(int ks=0;ks<4;++ks){
      asm volatile("ds_read_b64_tr_b16 %0,%1 offset:%c2":"=&v"(lo[ks]):"v"(vb),"i"(d0*4096+ks*1024):"memory");
      asm volatile("ds_read_b64_tr_b16 %0,%1 offset:%c2":"=&v"(hi[ks]):"v"(vb),"i"(d0*4096+ks*1024+512):"memory");}
    asm volatile("s_waitcnt lgkmcnt(0)":::"memory");SBAR();
    #define PK(k) (bf16x8){lo[k][0],lo[k][1],lo[k][2],lo[k][3],hi[k][0],hi[k][1],hi[k][2],hi[k][3]}
    o[d0]=__builtin_amdgcn_mfma_f32_32x32x16_bf16(pa0,PK(0),o[d0],0,0,0);
    o[d0]=__builtin_amdgcn_mfma_f32_32x32x16_bf16(pa1,PK(1),o[d0],0,0,0);
    o[d0]=__builtin_amdgcn_mfma_f32_32x32x16_bf16(pa2,PK(2),o[d0],0,0,0);
    o[d0]=__builtin_amdgcn_mfma_f32_32x32x16_bf16(pa3,PK(3),o[d0],0,0,0);
    #undef PK
  }
}
struct AttnNext { bool has; int qb; const bf16* Qh; const bf16* Kh; const bf16* Vh; };
struct AttnCarry { bool primed; int s0; bf16x8 qr[4]; };
template<int THRL,class Post> __device__ __forceinline__ void attn_unit128(int qb,const bf16*Qh,const bf16*__restrict__ Kh,const bf16*__restrict__ Vh,bf16*Oh,char*shm,const Post&post,const AttnNext&nx,AttnCarry&cy){
  const int tid=opaque_tid(),lane=tid&63,r32=lane&31,hi=lane>>5; const int wid=__builtin_amdgcn_readfirstlane(tid>>6);
  const int q0=qb*QB;
  const bf16*Qw=Qh+(long)(q0+wid*QBLK)*PQ;
  const unsigned lds0=(unsigned)(uintptr_t)shm;
  float*wsf=(float*)(shm+L2_WS)+wid*64;
  const bf16*ksrc=Kh+(long)lane*PK+wid*8;
  const bf16*vsrc=Vh+(long)(16*(wid&3)+(lane>>2))*PV+(wid>>2)*32+(lane&3)*8;
  const unsigned kdst=lds0+L2_K+wid*1024, vdst=lds0+L2_V+wid*1024;
  #define DMA_K(t,slot) glds16(ksrc+(long)(t)*KVBLK*PK,(unsigned)__builtin_amdgcn_readfirstlane(kdst+(slot)))
  #define DMA_V(t,slot) do{ glds16(vsrc+(long)(t)*KVBLK*PV,(unsigned)__builtin_amdgcn_readfirstlane(vdst+2*(slot))); glds16(vsrc+(long)(t)*KVBLK*PV+64,(unsigned)__builtin_amdgcn_readfirstlane(vdst+2*(slot)+8192)); }while(0)
  const char*Kbase=shm+L2_K; bf16x8 kf[8];
  const lds_cptr shm3=(lds_cptr)shm; const lds_cptr kp0=shm3+L2_K+hi*1024+r32*16; const lds_cptr vp0=shm3+L2_V+((lane>>4)&1)*32+(lane&3)*8+(4*hi+((lane&15)>>2))*64;
  const int NT=(q0+QB)/KVBLK;
  const bool primed=cy.primed; const int s0=primed?cy.s0:0, s1=(s0==(NSLOT-1)*SLOTB)?0:s0+SLOTB, s2=(s1==(NSLOT-1)*SLOTB)?0:s1+SLOTB;
  bf16x8 (&qr)[4]=cy.qr;
  if(!primed){
    DMA_K(0,s0);DMA_V(0,s0);DMA_K(1,s1);
    #pragma unroll
    for(int d0=0;d0<4;++d0)qr[d0]=*reinterpret_cast<const bf16x8*>(&Qw[(long)r32*PQ+d0*16+hi*8]);
  }
  float mhat=0.f,l_reg=0.f;f32x16 o[4];o[0]=f32x16{};o[1]=f32x16{};o[2]=f32x16{};o[3]=f32x16{};f32x16 negm=f32x16{};asm volatile("":"+v"(negm));
  const int qrel=wid*QBLK+r32;
  #define CMASK(P0,P1,t) do{int jb_=(t)-(NT-4); if(jb_>=0)cmask(P0,P1,jb_,qrel,hi);}while(0)
  bool resc=false;
  #define RESC() do{ if(resc){ asm volatile("s_waitcnt lgkmcnt(0)":::"memory"); \
      _Pragma("unroll") for(int d_=0;d_<4;++d_) _Pragma("unroll") for(int r=0;r<16;++r)o[d_][r]*=wsf[crow(r,hi)]; } }while(0)
  f32x16 c0,c1;
  int sl_prev=s0,sl_cur=s0,sl_next=s1;
  #define ROT() do{sl_prev=sl_cur;sl_cur=sl_next;sl_next=(sl_next==(NSLOT-1)*SLOTB)?0:sl_next+SLOTB;}while(0)
  if(!primed){
    DMA_K(2,s2);
    WAIT_BAR(3);
  }
  qkt(c0,c1,Kbase+s0,qr,negm,r32,hi);asm volatile("s_nop 15\n\ts_nop 7":"+v"(c0),"+v"(c1));CMASK(c0,c1,0);
  u32x4 pw0,pw1,pw2,pw3;
  #define PKW(P,B) cvtpk_s(P[B],P[(B)+1])
  { const float rm=rowmax(c0,c1); mhat=fadd_s(mhat,rm);
    _Pragma("unroll") for(int r=0;r<16;++r){c0[r]=fsub_s(c0[r],rm);c1[r]=fsub_s(c1[r],rm);}
    _Pragma("unroll") for(int r=0;r<16;++r)negm[r]=-mhat; asm volatile("":"+v"(negm));
    _Pragma("unroll") for(int r=0;r<16;++r){c0[r]=__builtin_amdgcn_exp2f(c0[r]);c1[r]=__builtin_amdgcn_exp2f(c1[r]);}
    float sacc=c0[0]+c0[1]; _Pragma("unroll") for(int r=2;r<16;++r)sacc+=c0[r]; _Pragma("unroll") for(int r=0;r<8;++r)sacc+=c1[r]; l_reg+=sacc;
    pw0=(u32x4){PKW(c0,0),PKW(c0,2),PKW(c0,4),PKW(c0,6)};pw1=(u32x4){PKW(c0,8),PKW(c0,10),PKW(c0,12),PKW(c0,14)};pw2=(u32x4){PKW(c1,0),PKW(c1,2),PKW(c1,4),PKW(c1,6)}; }
  WAIT_BAR(0);
  DMA_K(3,s0);DMA_V(1,s1);
  ROT();
  kload8(kf,kp0+sl_cur);
  WAIT_BAR(3);
  s16x4 vlo[8],vhi[8];
  #define PAF(k) __builtin_bit_cast(bf16x8,pw##k)
  #define VFR(i) (bf16x8){vlo[i][0],vlo[i][1],vlo[i][2],vlo[i][3],vhi[i][0],vhi[i][1],vhi[i][2],vhi[i][3]}
  #define PIN(x) asm volatile("":"+v"(x))
  #define MX3(a,b,c) __builtin_fmaxf(__builtin_fmaxf((a),(b)),(c))
  #define EX(v) __builtin_amdgcn_exp2f(v)
  #define VRDF(sl,db,ks) do{ vlo[sl]=vtr(vp_+((db)*4096+(ks)*1024)); vhi[sl]=vtr(vp_+((db)*4096+(ks)*1024+512)); }while(0)
  #define KRD(G,j) do{ if(G){ kload2(kf,kp0+sl_next,j); SBAR(); } }while(0)
  #define MFQ(C,KF,Q,CIN) C=__builtin_amdgcn_mfma_f32_32x32x16_bf16(KF,Q,CIN,0,0,0)
  #define MFO(DB,KS,SL) o[DB]=__builtin_amdgcn_mfma_f32_32x32x16_bf16(PAF(KS),VFR(SL),o[DB],0,0,0)
  #define EX2(X,B) do{ X[B]=EX(X[B]); X[(B)+1]=EX(X[(B)+1]); PIN(X); }while(0)
  #define SPK(Y,PB,PW,W) do{ sacc+=Y[PB]; sacc+=Y[(PB)+1]; PIN(sacc); PW[W]=PKW(Y,PB); PIN(PW); }while(0)
  #define STEP(t,GK,GV,GL) do{ SBAR(); \
    const lds_cptr vp_=vp0+2*sl_prev; float sacc; \
    VRDF(0,0,0); SBAR(); MFQ(c0,kf[0],qr[0],negm); sacc=(c1[8]+c1[9]); sacc+=c1[10]; sacc+=c1[11]; sacc+=c1[12]; sacc+=c1[13]; sacc+=c1[14]; sacc+=c1[15]; PIN(sacc); \
                         pw3[0]=PKW(c1,8); pw3[1]=PKW(c1,10); pw3[2]=PKW(c1,12); pw3[3]=PKW(c1,14); PIN(pw3); SBAR(); \
    VRDF(1,1,0); SBAR(); MFQ(c1,kf[1],qr[0],negm); SBAR(); \
    VRDF(2,2,0); SBAR(); MFQ(c0,kf[2],qr[1],c0); SBAR(); \
    VRDF(3,3,0); SBAR(); MFQ(c1,kf[3],qr[1],c1); SBAR(); \
    VRDF(4,0,1); SBAR(); MFQ(c0,kf[4],qr[2],c0); SBAR(); \
    VRDF(5,1,1); SBAR(); MFQ(c1,kf[5],qr[2],c1); SBAR(); \
    VRDF(6,2,1); SBAR(); MFQ(c0,kf[6],qr[3],c0); SBAR(); \
    VRDF(7,3,1); SBAR(); MFQ(c1,kf[7],qr[3],c1); SBAR(); \
    l_reg+=sacc; sacc=0.f; \
    if(GK){DMA_K((t)+3,sl_cur);} if(GV){DMA_V((t)+1,sl_next);} \
    CMASK(c0,c1,t); \
    { float a=MX3(c0[0],c0[1],c1[0]),b=MX3(c0[2],c0[3],c1[1]); a=MX3(a,c1[2],c1[3]); \
      _Pragma("unroll") for(int r=4;r<16;r+=4){a=MX3(a,c0[r],c0[r+1]);b=MX3(b,c0[r+2],c0[r+3]);a=MX3(a,c1[r],c1[r+1]);b=MX3(b,c1[r+2],c1[r+3]);} \
      float rm=__builtin_fmaxf(a,b); { auto rr=__builtin_amdgcn_permlane32_swap(__float_as_uint(rm),__float_as_uint(rm),false,false); rm=__builtin_fmaxf(__uint_as_float(rr[0]),__uint_as_float(rr[1])); } \
      resc=false; \
      if(__builtin_expect(__any(rm>(float)THRL),0)){ const float dl=__builtin_fmaxf(rm,0.f); mhat+=dl; \
        _Pragma("unroll") for(int r=0;r<16;++r){c0[r]-=dl;c1[r]-=dl;} \
        _Pragma("unroll") for(int r=0;r<16;++r)negm[r]=-mhat; asm volatile("":"+v"(negm)); \
        const float f=__builtin_amdgcn_exp2f(-dl); l_reg*=f; if(hi==0)wsf[r32]=f; resc=true; } } \
    SBAR(); \
    MFO(0,0,0); VRDF(0,0,2); EX2(c0,0);  SBAR(); \
    MFO(1,0,1); VRDF(1,1,2); EX2(c0,2);  SBAR(); \
    MFO(2,0,2); VRDF(2,2,2); EX2(c0,4);  SBAR(); \
    MFO(3,0,3); VRDF(3,3,2); EX2(c0,6);  SBAR(); \
    MFO(0,1,4); VRDF(4,0,3); EX2(c0,8);  SPK(c0,0,pw0,0); SBAR(); \
    MFO(1,1,5); VRDF(5,1,3); EX2(c0,10); SPK(c0,2,pw0,1); SBAR(); \
    MFO(2,1,6); VRDF(6,2,3); EX2(c0,12); SPK(c0,4,pw0,2); SBAR(); \
    MFO(3,1,7); VRDF(7,3,3); EX2(c0,14); SPK(c0,6,pw0,3); SBAR(); \
    KRD(GL,0); MFO(0,2,0); EX2(c1,0);  SPK(c0,8,pw1,0);  SBAR(); \
    KRD(GL,1); MFO(1,2,1); EX2(c1,2);  SPK(c0,10,pw1,1); SBAR(); \
    KRD(GL,2); MFO(2,2,2); EX2(c1,4);  SPK(c0,12,pw1,2); SBAR(); \
    KRD(GL,3); MFO(3,2,3); EX2(c1,6);  SPK(c0,14,pw1,3); SBAR(); \
    MFO(0,3,4); EX2(c1,8);  SPK(c1,0,pw2,0); SBAR(); \
    MFO(1,3,5); EX2(c1,10); SPK(c1,2,pw2,1); SBAR(); \
    MFO(2,3,6); EX2(c1,12); SPK(c1,4,pw2,2); SBAR(); \
    MFO(3,3,7); EX2(c1,14); SPK(c1,6,pw2,3); SBAR(); \
    l_reg+=sacc; \
    }while(0)
  int t=1;
  #undef CMASK
  #define CMASK(P0,P1,t) do{}while(0)
  for(;t+4<NT;++t){ STEP(t,true,true,true); WAIT_BAR(3); RESC(); ROT(); }
  #undef CMASK
  #define CMASK(P0,P1,t) do{int jb_=(t)-(NT-4); if(jb_>=0)cmask(P0,P1,jb_,qrel,hi);}while(0)
  const bool hn=nx.has;
  const long kadj=hn?(long)(nx.Kh-Kh)-(long)NT*KVBLK*PK:0L, vadj=hn?(long)(nx.Vh-Vh)-(long)NT*KVBLK*PV:0L;
  #undef DMA_K
  #undef DMA_V
  #define DMA_K(t,slot) glds16(ksrc+(long)(t)*KVBLK*PK+(((t)>=NT)?kadj:0L),(unsigned)__builtin_amdgcn_readfirstlane(kdst+(slot)))
  #define DMA_V(t,slot) do{ const bf16*vs_=vsrc+(long)(t)*KVBLK*PV+(((t)>=NT)?vadj:0L); glds16(vs_,(unsigned)__builtin_amdgcn_readfirstlane(vdst+2*(slot))); glds16(vs_+64,(unsigned)__builtin_amdgcn_readfirstlane(vdst+2*(slot)+8192)); }while(0)
  #define ENDW(tt) do{ if(hn||(tt)+3<NT){WAIT_BAR(3);} else if((tt)+2<NT){WAIT_BAR(2);} else {WAIT_BAR(0);} }while(0)
  for(;t+1<NT;++t){ STEP(t,(hn||t+3<NT),true,true); ENDW(t); RESC(); ROT(); }
  STEP(NT-1,hn,hn,false);
  if(hn){
    const bf16*QwN=nx.Qh+(long)(nx.qb*QB+wid*QBLK)*PQ;
    #pragma unroll
    for(int d0=0;d0<4;++d0)qr[d0]=*reinterpret_cast<const bf16x8*>(&QwN[(long)r32*PQ+d0*16+hi*8]);
    WAIT_BAR(7);
  }
  cy.primed=hn; cy.s0=sl_next;
  RESC();
  { float sacc=(c1[8]+c1[9]); _Pragma("unroll") for(int r=10;r<16;++r)sacc+=c1[r]; l_reg+=sacc;
    pw3=(u32x4){PKW(c1,8),PKW(c1,10),PKW(c1,12),PKW(c1,14)};
    SBAR(); pv128(o,(int)(unsigned)(uintptr_t)vp0+2*sl_cur,PAF(0),PAF(1),PAF(2),PAF(3)); }
  #undef PKW
  #undef PAF
  #undef VFR
  #undef PIN
  #undef MX3
  #undef EX
  #undef VRDF
  #undef KRD
  #undef MFQ
  #undef MFO
  #undef EX2
  #undef SPK
  #undef STEP
  #undef ENDW
  {auto rr=__builtin_amdgcn_permlane32_swap(__float_as_uint(l_reg),__float_as_uint(l_reg),false,false);l_reg=__uint_as_float(rr[0])+__uint_as_float(rr[1]);}
  if(hi==0)wsf[32+r32]=l_reg;asm volatile("s_waitcnt lgkmcnt(0)":::"memory");
  float rli[16];
  #pragma unroll
  for(int r=0;r<16;++r)rli[r]=__builtin_amdgcn_rcpf(wsf[32+crow(r,hi)]);
  if(post.on){
    asm volatile("s_waitcnt lgkmcnt(0)\n\ts_barrier":::"memory");
    const int so=__builtin_amdgcn_readfirstlane((wid<4)?(L2_OST+wid*8192):(L2_V+2*((wid<6)?sl_prev:sl_cur)+(wid&1)*8192));
    bf16*stg=(bf16*)(shm+so);
    #pragma unroll
    for(int r=0;r<16;++r){const int orow=crow(r,hi);
      #pragma unroll
      for(int d0=0;d0<4;++d0)stg[orow*128+d0*32+r32]=__float2bfloat16(o[d0][r]*rli[r]);}
    asm volatile("s_waitcnt lgkmcnt(0)":::"memory");
    post.run((lds_cptr)shm+so,q0+wid*QBLK,lane);
  } else {
  bf16*Ow=Oh+(long)(q0+wid*QBLK)*PO;
  { bf16*stg=(bf16*)(shm+L2_OST)+wid*2048;
    #pragma unroll
    for(int h2=0;h2<2;++h2){
      #pragma unroll
      for(int r=0;r<16;++r){const int orow=crow(r,hi);
        #pragma unroll
        for(int d0=0;d0<2;++d0)stg[orow*64+d0*32+r32]=__float2bfloat16(o[2*h2+d0][r]*rli[r]);}
      asm volatile("s_waitcnt lgkmcnt(0)":::"memory");
      #pragma unroll
      for(int i=0;i<4;++i){const int row=i*8+(lane>>3),ch=lane&7; const u32x4 v=*(const u32x4*)(stg+row*64+ch*8); ATTN_STORE16(Ow+(long)row*PO+h2*64+ch*8,v);}
      asm volatile("s_waitcnt lgkmcnt(0)":::"memory"); } }
  }
  asm volatile("s_waitcnt lgkmcnt(0)\n\ts_barrier":::"memory");
  #undef DMA_K
  #undef DMA_V
  #undef CMASK
  #undef RESC
  #undef ROT
}
constexpr int ATTN_LDS_BYTES=L2_BYTES;
#undef SBAR
#undef WAIT_BAR
}

constexpr int NWAVES = 8;
constexpr size_t MiB = 1u << 20;
constexpr size_t WS_CTL = 0, CTL_ZERO_BYTES = 1 * MiB;
constexpr size_t WS_ROPEC = 1 * MiB, WS_ROPES = WS_ROPEC + 256 * 1024;
constexpr size_t WS_ROUTE = 2 * MiB;
constexpr int ECAP = M, ECAP_LOG = 14;
static_assert((1 << ECAP_LOG) == ECAP, "ECAP");
constexpr size_t RT_SLOTOF = 0, RT_WSLOT = 128 * 1024, RT_SSSLOT = 1024 * 1024;
constexpr size_t WS_SS = 6 * MiB;
constexpr size_t WS_WIN = 10 * MiB;
constexpr size_t WS_WOUT = WS_WIN + 64 * MiB;
constexpr size_t WS_WGU = WS_WOUT + 8 * MiB;
constexpr size_t WS_WD = WS_WGU + 22 * MiB;
constexpr size_t WS_WEGU = WS_WD + 11 * MiB;
constexpr size_t WS_WED = WS_WEGU + 224 * MiB;
constexpr size_t WS_XB = WS_WED + 112 * MiB;
constexpr size_t WS_PROJ = WS_XB + 32 * MiB;
constexpr size_t WS_O = WS_PROJ + 256 * MiB;
constexpr size_t WS_MIX = WS_O + 64 * MiB;
constexpr size_t WS_Y = WS_MIX + 32 * MiB;
constexpr size_t WS_END = WS_Y + 68 * MiB;
static_assert((size_t)MSLOT * DFFE * 2 <= 256 * MiB && (size_t)MSLOT * 1024 * 2 <= 68 * MiB && (size_t)MSLOT * 1024 * 2 <= 96 * MiB, "overlays");
static_assert((size_t)NEXP * ECAP * 4 <= 896 * 1024 && RT_SSSLOT + (size_t)NEXP * ECAP * 16 <= 4 * MiB && (size_t)9 * M * 16 <= 4 * MiB && (size_t)NEXP * ECAP * 1024 <= 164 * MiB, "routing / ss map; sparse expert inputs overlay O | MIX | Y");
constexpr int CW_TMO = 0, CW_CODE = 1;
constexpr int CW_BAR = 4096;
constexpr int CW_GCNT = 16384;

constexpr int RING_OFF = 0, RING_BYTES = 131072;
constexpr int LDSCTL_OFF = RING_BYTES, MISC_OFF = LDSCTL_OFF + 320;
constexpr int LDS_BYTES = 163840;
static_assert(MISC_OFF + 128 <= LDS_BYTES, "LDS map");

#define GAS __attribute__((address_space(1)))
#define LAS __attribute__((address_space(3)))
typedef unsigned short bf16;
typedef unsigned v4u __attribute__((ext_vector_type(4)));
typedef unsigned v2u __attribute__((ext_vector_type(2)));
typedef float f32x4 __attribute__((ext_vector_type(4)));
typedef GAS unsigned gu32;
#define RLX_AGENT __ATOMIC_RELAXED, __HIP_MEMORY_SCOPE_AGENT
#define LDS_WAIT() asm volatile("s_waitcnt lgkmcnt(0)" ::: "memory")
#define VM_WAIT() asm volatile("s_waitcnt vmcnt(0)" ::: "memory")
__device__ __forceinline__ unsigned f2bf(float f) { unsigned u = __builtin_bit_cast(unsigned, f); return (u + 0x7fffu + ((u >> 16) & 1u)) >> 16; }
__device__ __forceinline__ unsigned pk2(float lo, float hi) { return f2bf(lo) | (f2bf(hi) << 16); }
__device__ __forceinline__ float bflo(unsigned w) { return __uint_as_float(w << 16); }
__device__ __forceinline__ float bfhi(unsigned w) { return __uint_as_float(w & 0xffff0000u); }

#define XB_TMO      128
#define XB_XCNT(j)  (256  + 64 * (j))
#define XB_XSUB(j)  (1280 + 64 * (j))
#define XB_XGEN(j)  (2304 + 64 * (j))
#define XB_TOP      3328
#define XB_TOPGEN   3392
#define XCD_BAR_WORDS 3456
#define XB_SPIN_CAP (1u << 18)
__device__ __forceinline__ unsigned xb_ld(unsigned* p)              { return __hip_atomic_load(p, __ATOMIC_RELAXED, __HIP_MEMORY_SCOPE_AGENT); }
__device__ __forceinline__ unsigned xb_add(unsigned* p, unsigned v) { return __hip_atomic_fetch_add(p, v, __ATOMIC_RELAXED, __HIP_MEMORY_SCOPE_AGENT); }
__device__ __forceinline__ unsigned xb_xcc_id() { return (unsigned)__builtin_amdgcn_s_getreg((3 << 11) | 20) & 0xFu; }
#define XB_SPIN(cond, bar) do { unsigned _sp = 0; while (cond) { __builtin_amdgcn_s_sleep(1); \
    if ((++_sp & 255u) == 0u) { if (xb_ld(&(bar)[XB_TMO])) break; if (_sp > XB_SPIN_CAP) { atomicAdd(&(bar)[XB_TMO], 1u); break; } } } } while (0)
struct XcdBarrier { unsigned* bar; unsigned x; volatile LAS unsigned* st; };
__device__ __forceinline__ XcdBarrier xcd_barrier_post(unsigned* bar, volatile LAS unsigned* st) {
    XcdBarrier b; b.bar = bar; b.x = xb_xcc_id(); b.st = st;
    if (threadIdx.x == 0) (void)xb_add(&bar[XB_XCNT(b.x)], 1u);
    return b;
}
__device__ __forceinline__ void xcd_barrier_complete(unsigned* bar, unsigned x, unsigned& nloc, unsigned& nx) {
    const unsigned G = gridDim.x * gridDim.y * gridDim.z;
    unsigned sum, cnt, mine, sp = 0u;
    for (;;) {
        sum = 0u; cnt = 0u; mine = 0u;
#pragma unroll
        for (unsigned j = 0; j < 16; ++j) { const unsigned c = xb_ld(&bar[XB_XCNT(j)]); sum += c; cnt += (c > 0u) ? 1u : 0u; mine = (j == x) ? c : mine; }
        if (sum == G) break;
        __builtin_amdgcn_s_sleep(1);
        if ((++sp & 255u) == 0u) { if (xb_ld(&bar[XB_TMO])) break; if (sp > XB_SPIN_CAP) { atomicAdd(&bar[XB_TMO], 1u); break; } }
    }
    nloc = mine > 0u ? mine : 1u; nx = cnt > 0u ? cnt : 1u;
}
__device__ __forceinline__ void xcd_barrier(const XcdBarrier& b) {
    asm volatile("s_waitcnt vmcnt(0)" ::: "memory");
    __syncthreads();
    if (threadIdx.x == 0) {
        unsigned* bar = b.bar;
        __builtin_amdgcn_s_waitcnt(0);
        unsigned nloc = b.st[0], nx = b.st[1];
        if (nloc == 0u) { xcd_barrier_complete(bar, b.x, nloc, nx); b.st[0] = nloc; b.st[1] = nx; }
        const unsigned old = xb_add(&bar[XB_XSUB(b.x)], 1u);
        const unsigned gen = old / nloc;
        if (old + 1u == (gen + 1u) * nloc) {
            __builtin_amdgcn_fence(__ATOMIC_RELEASE, "agent");
            asm volatile("s_waitcnt vmcnt(0)" ::: "memory");
            const unsigned og = xb_add(&bar[XB_TOP], 1u);
            const unsigned tg = og / nx;
            if (og + 1u == (tg + 1u) * nx) xb_add(&bar[XB_TOPGEN], 1u);
            else XB_SPIN(xb_ld(&bar[XB_TOPGEN]) == tg, bar);
            __builtin_amdgcn_fence(__ATOMIC_ACQUIRE, "agent");
            xb_add(&bar[XB_XGEN(b.x)], 1u);
            asm volatile("s_waitcnt vmcnt(0)" ::: "memory");
        } else {
            XB_SPIN(xb_ld(&bar[XB_XGEN(b.x)]) == gen, bar);
            __builtin_amdgcn_fence(__ATOMIC_ACQUIRE, "agent");
            asm volatile("s_waitcnt vmcnt(0)" ::: "memory");
        }
    }
    __syncthreads();
}

struct Args { const float* in[19]; float* out; unsigned char* ws; int ph_lo, ph_hi; };
static_assert(sizeof(Args) == 19 * 8 + 8 + 8 + 8, "Args has no padding");

typedef const __attribute__((address_space(4))) Args* kargs_t;
#define KARGS() ({ kargs_t p_ = (kargs_t)__builtin_amdgcn_kernarg_segment_ptr(); asm volatile("" : "+s"(p_)); p_; })
struct Frame {
    LAS unsigned char* lds;
    int tid, lane, wave;
    int vcu, G;
    unsigned char* ws;
    gu32* ctl;
    float* X;
};
__device__ __forceinline__ Frame make_frame(kargs_t ap) {
    extern __shared__ __attribute__((aligned(16))) unsigned char lds[];
    Frame F; F.lds = (LAS unsigned char*)lds; F.tid = opaque_tid(); F.lane = F.tid & 63; F.wave = __builtin_amdgcn_readfirstlane(F.tid >> 6);
    F.G = opaque_grid(); { const int bx = opaque_bid(); F.vcu = (F.G % 8 == 0) ? (bx % 8) * (F.G / 8) + bx / 8 : bx; }
    F.ws = ap->ws; F.ctl = (gu32*)(F.ws + WS_CTL); F.X = ap->out; return F;
}

__device__ __forceinline__ float wave_sum(float v) {
#pragma unroll
    for (int o = 1; o < 64; o <<= 1) v += __shfl_xor(v, o);
    return v;
}

template <int KIND>
__device__ __forceinline__ int rowmap(int n) {
    if (KIND == 1) {
        if (n < 2048) { const int tile = n >> 8, hh = (n >> 6) & 3, half = (n >> 5) & 1, j = n & 31; return tile * 256 + half * 128 + hh * 32 + j; }
        if (n < 3072) return n;
        if (n < 4096) { const int c = n - 3072; return (20 + (c >> 7)) * 256 + (c & 127); }
        if (n < 5120) { const int c = n - 4096; return (12 + (c >> 7)) * 256 + (c & 127); }
        if (n < 6144) { const int c = n - 5120; return (12 + (c >> 7)) * 256 + 128 + (c & 127); }
        if (n < 7168) { return 28 * 256 + (n - 6144); }
        { const int c = n - 7168; return (20 + (c >> 7)) * 256 + 128 + (c & 127); }
    }
    if (KIND == 2) return (n >> 7) * 256 + (n & 127);
    if (KIND == 3) return (n >> 7) * 256 + 128 + (n & 127);
    return n;
}
__device__ __forceinline__ void cvt_ld(const float* __restrict__ W, int N, int item, int lane, f32x4 (&v)[8]) {
    const int nblk = N >> 5, kb = item / nblk, nb = item - kb * nblk;
    const int l8 = lane & 7, kg = lane >> 3;
    const int k0 = kb * 64 + kg * 8, n0 = nb * 32 + l8 * 4;
#pragma unroll
    for (int r = 0; r < 8; ++r) v[r] = *(const GAS f32x4*)(W + (size_t)(k0 + r) * N + n0);
}
template <int KIND>
__device__ __forceinline__ void cvt_st(int K, int N, const float* __restrict__ gain, bf16* __restrict__ WT, int item, int lane, f32x4 (&v)[8]) {
    const int nblk = N >> 5, kb = item / nblk, nb = item - kb * nblk;
    const int l8 = lane & 7, kg = lane >> 3;
    const int k0 = kb * 64 + kg * 8, n0 = nb * 32 + l8 * 4;
    if (gain) {
        const f32x4 g0 = *(const GAS f32x4*)(gain + k0), g1 = *(const GAS f32x4*)(gain + k0 + 4);
#pragma unroll
        for (int r = 0; r < 4; ++r) { v[r] = v[r] * g0[r]; v[r + 4] = v[r + 4] * g1[r]; }
    }
#pragma unroll
    for (int i = 0; i < 4; ++i) {
        v4u o; o.x = pk2(v[0][i], v[1][i]); o.y = pk2(v[2][i], v[3][i]); o.z = pk2(v[4][i], v[5][i]); o.w = pk2(v[6][i], v[7][i]);
        st16_wt((void*)(WT + (size_t)rowmap<KIND>(n0 + i) * K + k0), o);
    }
}

__device__ __forceinline__ void cvt_ld_f8(const float* __restrict__ W, int N, int item, int lane, f32x4 (&v)[16]) {
    const int nblk = N >> 5, kb = item / nblk, nb = item - kb * nblk;
    const int l8 = lane & 7, kg = lane >> 3;
    const int k0 = kb * 128 + kg * 16, n0 = nb * 32 + l8 * 4;
#pragma unroll
    for (int r = 0; r < 16; ++r) v[r] = __builtin_nontemporal_load((const GAS f32x4*)(W + (size_t)(k0 + r) * N + n0));
}
template <int KIND>
__device__ __forceinline__ void cvt_st_f8(int K, int N, const float* __restrict__ gain, unsigned char* __restrict__ WT, int item, int lane, f32x4 (&v)[16]) {
    const int nblk = N >> 5, kb = item / nblk, nb = item - kb * nblk;
    const int l8 = lane & 7, kg = lane >> 3;
    const int k0 = kb * 128 + kg * 16, n0 = nb * 32 + l8 * 4;
#pragma unroll
    for (int q = 0; q < 4; ++q) { f32x4 g = {256.f, 256.f, 256.f, 256.f}; if (gain) g = *(const GAS f32x4*)(gain + k0 + 4 * q) * 256.f;
#pragma unroll
        for (int r = 0; r < 4; ++r) v[4 * q + r] = v[4 * q + r] * g[r]; }
#pragma unroll
    for (int i = 0; i < 4; ++i) {
        v4u o;
#pragma unroll
        for (int q = 0; q < 4; ++q) { unsigned w = 0u;
            w = __builtin_amdgcn_cvt_pk_fp8_f32(pg8::clamp448(v[4 * q][i]), pg8::clamp448(v[4 * q + 1][i]), w, false);
            w = __builtin_amdgcn_cvt_pk_fp8_f32(pg8::clamp448(v[4 * q + 2][i]), pg8::clamp448(v[4 * q + 3][i]), w, true); o[q] = w; }
        st16_wt((void*)(WT + (size_t)rowmap<KIND>(n0 + i) * K + k0), o);
    }
}

template <int KIND>
__device__ __forceinline__ void cvt_st_b16(int K, int N, const float* __restrict__ gain, bf16* __restrict__ WT, int item, int lane, f32x4 (&v)[16]) {
    const int nblk = N >> 5, kb = item / nblk, nb = item - kb * nblk;
    const int l8 = lane & 7, kg = lane >> 3;
    const int k0 = kb * 128 + kg * 16, n0 = nb * 32 + l8 * 4;
    if (gain) {
#pragma unroll
        for (int q = 0; q < 4; ++q) { const f32x4 g = *(const GAS f32x4*)(gain + k0 + 4 * q);
#pragma unroll
            for (int r = 0; r < 4; ++r) v[4 * q + r] = v[4 * q + r] * g[r]; } }
#pragma unroll
    for (int i = 0; i < 4; ++i) {
        v4u o0, o1; o0.x = pk2(v[0][i], v[1][i]); o0.y = pk2(v[2][i], v[3][i]); o0.z = pk2(v[4][i], v[5][i]); o0.w = pk2(v[6][i], v[7][i]);
        o1.x = pk2(v[8][i], v[9][i]); o1.y = pk2(v[10][i], v[11][i]); o1.z = pk2(v[12][i], v[13][i]); o1.w = pk2(v[14][i], v[15][i]);
        bf16* q = WT + (size_t)rowmap<KIND>(n0 + i) * K + k0;
        *(GAS v4u*)q = o0; *(GAS v4u*)(q + 8) = o1;
    }
}

template <int KIND>
__device__ __forceinline__ void cvt_run(const float* __restrict__ W, int K, int N, const float* __restrict__ gain, bf16* __restrict__ WT, int it0, int NI, int nranks, int lane) {
    constexpr int NP = 4;
    for (int it = it0; it < NI; it += NP * nranks) {
        f32x4 v[NP][8];
#pragma unroll
        for (int q = 0; q < NP; ++q) { const int ii = it + q * nranks; if (ii < NI) cvt_ld(W, N, ii, lane, v[q]); }
        asm volatile("" ::: "memory");
#pragma unroll
        for (int q = 0; q < NP; ++q) { const int ii = it + q * nranks; if (ii < NI) cvt_st<KIND>(K, N, gain, WT, ii, lane, v[q]); }
    }
}
template <int KIND>
__device__ __forceinline__ void cvt_run_f8(const float* __restrict__ W, int K, int N, const float* __restrict__ gain, unsigned char* __restrict__ WT, int it0, int NI, int nranks, int lane) {
    constexpr int NP = 2;
    for (int it = it0; it < NI; it += NP * nranks) {
        f32x4 v[NP][16];
#pragma unroll
        for (int q = 0; q < NP; ++q) { const int ii = it + q * nranks; if (ii < NI) cvt_ld_f8(W, N, ii, lane, v[q]); }
        asm volatile("" ::: "memory");
#pragma unroll
        for (int q = 0; q < NP; ++q) { const int ii = it + q * nranks; if (ii < NI) cvt_st_f8<KIND>(K, N, gain, WT, ii, lane, v[q]); }
    }
}

__device__ __forceinline__ void convert_group(kargs_t A, unsigned char* ws, int grp, int rank, int nranks, int lane) {
    constexpr int I_IN = (DM / 128) * (IN_W / 32), I_OUT = (DM / 128) * (DM / 32), I_G = (DM / 128) * (DFF / 32), I_D = (DFF / 128) * (DM / 32), I_EG = (DM / 128) * (DFFE / 32), I_ED = (DFFE / 128) * (DM / 32);
    const int in_n = (grp < 4) ? 1 : 0, d_n = (grp == 1 || grp == 2) ? 1 : 0, e_lo = (grp - 1) * 4, e_n = (grp >= 1) ? 4 : 0;
    const int c0 = in_n * I_IN, c1 = c0 + in_n * I_OUT, c2 = c1 + d_n * I_G, c3 = c2 + d_n * I_G, c4 = c3 + d_n * I_D, c5 = c4 + e_n * I_EG, c6 = c5 + e_n * I_EG, c7 = c6 + e_n * I_ED;
    const int j = grp, jd = grp - 1;
    for (int it = rank; it < c7; it += 2 * nranks) {
        f32x4 v[2][16];
#pragma unroll
        for (int q = 0; q < 2; ++q) { const int ii = it + q * nranks;
            if (ii < c7) { const float* W; int N, r;
                if (ii < c0) { W = A->in[2] + (size_t)j * DM * IN_W; N = IN_W; r = ii; }
                else if (ii < c1) { W = A->in[9] + (size_t)j * DM * DM; N = DM; r = ii - c0; }
                else if (ii < c2) { W = A->in[11] + (size_t)jd * DM * DFF; N = DFF; r = ii - c1; }
                else if (ii < c3) { W = A->in[12] + (size_t)jd * DM * DFF; N = DFF; r = ii - c2; }
                else if (ii < c4) { W = A->in[13] + (size_t)jd * DFF * DM; N = DM; r = ii - c3; }
                else if (ii < c5) { const int rr = ii - c4, jj = rr / I_EG; r = rr - jj * I_EG; W = A->in[15] + (size_t)(e_lo + jj) * DM * DFFE; N = DFFE; }
                else if (ii < c6) { const int rr = ii - c5, jj = rr / I_EG; r = rr - jj * I_EG; W = A->in[16] + (size_t)(e_lo + jj) * DM * DFFE; N = DFFE; }
                else { const int rr = ii - c6, jj = rr / I_ED; r = rr - jj * I_ED; W = A->in[17] + (size_t)(e_lo + jj) * DFFE * DM; N = DM; }
                cvt_ld_f8(W, N, r, lane, v[q]); } }
        asm volatile("" ::: "memory");
#pragma unroll
        for (int q = 0; q < 2; ++q) { const int ii = it + q * nranks;
            if (ii < c7) {
                if (ii < c0) { const int r = ii;
                    if (INPROJ_F8(j)) cvt_st_f8<1>(DM, IN_W, A->in[1] + j * DM, (unsigned char*)(ws + WS_WIN) + (size_t)j * IN_W * DM * 2, r, lane, v[q]);
                    else cvt_st_b16<1>(DM, IN_W, A->in[1] + j * DM, (bf16*)(ws + WS_WIN) + (size_t)j * IN_W * DM, r, lane, v[q]); }
                else if (ii < c1) cvt_st_b16<0>(DM, DM, nullptr, (bf16*)(ws + WS_WOUT) + (size_t)j * DM * DM, ii - c0, lane, v[q]);
                else if (ii < c2) { const int r = ii - c1;
                    if (DENSE_F8(jd)) cvt_st_f8<2>(DM, DFF, A->in[10] + (2 * jd) * DM, (unsigned char*)(ws + WS_WGU) + (size_t)jd * 2 * DFF * DM * 2, r, lane, v[q]);
                    else cvt_st_b16<2>(DM, DFF, A->in[10] + (2 * jd) * DM, (bf16*)(ws + WS_WGU) + (size_t)jd * 2 * DFF * DM, r, lane, v[q]); }
                else if (ii < c3) { const int r = ii - c2;
                    if (DENSE_F8(jd)) cvt_st_f8<3>(DM, DFF, A->in[10] + (2 * jd) * DM, (unsigned char*)(ws + WS_WGU) + (size_t)jd * 2 * DFF * DM * 2, r, lane, v[q]);
                    else cvt_st_b16<3>(DM, DFF, A->in[10] + (2 * jd) * DM, (bf16*)(ws + WS_WGU) + (size_t)jd * 2 * DFF * DM, r, lane, v[q]); }
                else if (ii < c4) { const int r = ii - c3;
                    if (DENSE_DN_F8(jd)) cvt_st_f8<0>(DFF, DM, nullptr, (unsigned char*)(ws + WS_WD) + (size_t)jd * DM * DFF * 2, r, lane, v[q]);
                    else cvt_st_b16<0>(DFF, DM, nullptr, (bf16*)(ws + WS_WD) + (size_t)jd * DM * DFF, r, lane, v[q]); }
                else if (ii < c5) { const int rr = ii - c4, jj = rr / I_EG, r = rr - jj * I_EG, je = e_lo + jj;
                    cvt_st_f8<2>(DM, DFFE, A->in[10] + (2 * (je >> 3) + 1) * DM, (unsigned char*)(ws + WS_WEGU) + (size_t)je * 2 * DFFE * DM, r, lane, v[q]); }
                else if (ii < c6) { const int rr = ii - c5, jj = rr / I_EG, r = rr - jj * I_EG, je = e_lo + jj;
                    cvt_st_f8<3>(DM, DFFE, A->in[10] + (2 * (je >> 3) + 1) * DM, (unsigned char*)(ws + WS_WEGU) + (size_t)je * 2 * DFFE * DM, r, lane, v[q]); }
                else { const int rr = ii - c6, jj = rr / I_ED, r = rr - jj * I_ED, je = e_lo + jj;
                    cvt_st_f8<0>(DFFE, DM, nullptr, (unsigned char*)(ws + WS_WED) + (size_t)je * DM * DFFE, r, lane, v[q]); } } }
    }
}
__device__ __forceinline__ void p0_prologue() {
    const kargs_t A = KARGS(); Frame F = make_frame(A);
    const int gw = F.vcu * NWAVES + F.wave, NGW = F.G * NWAVES, lane = F.lane;
    unsigned char* ws = F.ws;
    convert_group(A, ws, 0, gw, NGW, lane);
    { float* rc = (float*)(ws + WS_ROPEC); float* rs = (float*)(ws + WS_ROPES);
      for (int idx = (F.vcu * NWAVES + F.wave) * 64 + lane; idx < SEQ * 32; idx += NGW * 64) {
          const int pos = idx >> 5, i = idx & 31;
          const float inv = __builtin_amdgcn_exp2f(-(float)i * 0.4152410118609203f);
          const float ang = (float)pos * inv;
          const double rev = (double)ang * 0.15915494309189535; const float fr = (float)(rev - __builtin_rint(rev));
          rc[idx] = __builtin_amdgcn_cosf(fr); rs[idx] = __builtin_amdgcn_sinf(fr); } }
    { const float* x = A->in[0]; float* ss = (float*)(ws + WS_SS); bf16* xb = (bf16*)(ws + WS_XB);
      for (int m0 = gw * 4; m0 < M; m0 += NGW * 4) {
          f32x4 v[4][4];
#pragma unroll
          for (int r = 0; r < 4; ++r) { const GAS f32x4* xr = (const GAS f32x4*)(x + (size_t)(m0 + r) * DM) + lane;
#pragma unroll
              for (int j = 0; j < 4; ++j) v[r][j] = xr[64 * j]; }
#pragma unroll
          for (int r = 0; r < 4; ++r) { const int m = m0 + r; GAS v2u* o8 = (GAS v2u*)(xb + (size_t)m * DM) + lane; float s = 0.f;
#pragma unroll
              for (int j = 0; j < 4; ++j) { const f32x4 q = v[r][j]; s += (q.x * q.x + q.y * q.y) + (q.z * q.z + q.w * q.w); v2u w; w.x = pk2(q.x, q.y); w.y = pk2(q.z, q.w); st8_wt((void*)(o8 + 64 * j), w); }
              s = wave_sum(s); if (lane == 0) *(GAS f32x4*)(ss + 4 * (size_t)m) = (f32x4){s, 0.f, 0.f, 0.f}; } } }
}

__device__ __forceinline__ float sigmoidf_(float x) { return __builtin_amdgcn_rcpf(1.0f + __builtin_amdgcn_exp2f(x * -1.4426950408889634f)); }
__device__ __forceinline__ void unpack8(const v4u w, float (&f)[8]) { f[0] = bflo(w.x); f[1] = bfhi(w.x); f[2] = bflo(w.y); f[3] = bfhi(w.y); f[4] = bflo(w.z); f[5] = bfhi(w.z); f[6] = bflo(w.w); f[7] = bfhi(w.w); }
struct MergeCtx { float lam, one_m_li; float w0[8], w1[8], w2[8], g[8]; };
__device__ __forceinline__ void merge_setup(MergeCtx& C, kargs_t A, int l, int h, int tid) {
    const int lane = tid & 63, chunk = tid & 15;
    const float lam_init = (l == 0) ? 0.2f : (l == 1) ? 0.35550906759096934f : (l == 2) ? 0.4707130183435842f : 0.5560582041556406f;
    const float a1 = A->in[4][l * 64 + lane] * A->in[5][l * 64 + lane], a2 = A->in[6][l * 64 + lane] * A->in[7][l * 64 + lane];
    const float s1 = wave_sum(a1), s2 = wave_sum(a2);
    C.lam = __builtin_amdgcn_exp2f(s1 * 1.4426950408889634f) - __builtin_amdgcn_exp2f(s2 * 1.4426950408889634f) + lam_init; C.one_m_li = 1.0f - lam_init;
    const float* cw = A->in[3] + (size_t)l * 3 * DM + h * 128 + 8 * chunk; const float* sg = A->in[8] + l * 128 + 8 * chunk;
#pragma unroll
    for (int i = 0; i < 8; ++i) { C.w0[i] = cw[i]; C.w1[i] = cw[DM + i]; C.w2[i] = cw[2 * DM + i]; C.g[i] = sg[i] * C.one_m_li; }
}
__device__ __forceinline__ void merge_block(const MergeCtx& C, unsigned char* ws, int b, int h, int qb, int tid) {
    const bf16* P = (const bf16*)(ws + WS_PROJ); const size_t PS = (size_t)M * 1024;
    const bf16* Ob = (const bf16*)(ws + WS_O); bf16* Mx = (bf16*)(ws + WS_MIX);
    const int chunk = tid & 15, c = h * 128 + 8 * chunk, oc = h * 256 + 8 * chunk;
    for (int it0 = 0; it0 < 8; it0 += 2) {
        v4u raw[2][7];
#pragma unroll
        for (int k = 0; k < 2; ++k) {
            const int tl = qb * 256 + (it0 + k) * 32 + (tid >> 4);
            const size_t t = (size_t)b * SEQ + tl;
            const size_t tm1 = (tl >= 1) ? t - 1 : t, tm2 = (tl >= 2) ? t - 2 : t;
            raw[k][0] = *(const GAS v4u*)(Ob + t * 2048 + oc); raw[k][1] = *(const GAS v4u*)(Ob + t * 2048 + oc + 128);
            raw[k][2] = *(const GAS v4u*)(P + 4 * PS + t * 1024 + c); raw[k][3] = *(const GAS v4u*)(P + 5 * PS + t * 1024 + c);
            raw[k][4] = *(const GAS v4u*)(P + 3 * PS + t * 1024 + c); raw[k][5] = *(const GAS v4u*)(P + 3 * PS + tm1 * 1024 + c); raw[k][6] = *(const GAS v4u*)(P + 3 * PS + tm2 * 1024 + c);
        }
        asm volatile("" ::: "memory");
#pragma unroll
        for (int k = 0; k < 2; ++k) {
            const int tl = qb * 256 + (it0 + k) * 32 + (tid >> 4);
            const size_t t = (size_t)b * SEQ + tl;
            float o1[8], o2[8], bgc[8], ga[8], cu0[8], cu1[8], cu2[8];
            unpack8(raw[k][0], o1); unpack8(raw[k][1], o2); unpack8(raw[k][2], bgc); unpack8(raw[k][3], ga); unpack8(raw[k][4], cu0); unpack8(raw[k][5], cu1); unpack8(raw[k][6], cu2);
            const float k1 = (tl >= 1) ? 1.f : 0.f, k2 = (tl >= 2) ? 1.f : 0.f;
            float d[8], sq = 0.f;
#pragma unroll
            for (int i = 0; i < 8; ++i) { d[i] = o1[i] - C.lam * o2[i]; sq += d[i] * d[i]; }
            sq += __shfl_xor(sq, 1); sq += __shfl_xor(sq, 2); sq += __shfl_xor(sq, 4); sq += __shfl_xor(sq, 8);
            const float r = __builtin_amdgcn_rsqf(sq * (1.0f / 128.0f) + RMS_EPS);
            float mo[8];
#pragma unroll
            for (int i = 0; i < 8; ++i) {
                const float yc = bgc[i] * (C.w0[i] * (cu2[i] * k2) + C.w1[i] * (cu1[i] * k1) + C.w2[i] * cu0[i]);
                const float ya = d[i] * r * C.g[i];
                mo[i] = sigmoidf_(ga[i]) * ya + yc; }
            v4u w; w.x = pk2(mo[0], mo[1]); w.y = pk2(mo[2], mo[3]); w.z = pk2(mo[4], mo[5]); w.w = pk2(mo[6], mo[7]);
            st16_wt((void*)(Mx + t * 1024 + c), w);
        }
    }
}

__device__ __forceinline__ void merge_wave(const MergeCtx& C, unsigned char* ws, int b, int h, int tl0, attn_body::lds_cptr stg, int lane) {
    const bf16* P = (const bf16*)(ws + WS_PROJ); const size_t PS = (size_t)M * 1024;
    const bf16* Ob = (const bf16*)(ws + WS_O); bf16* Mx = (bf16*)(ws + WS_MIX);
    const int chunk = lane & 15, c = h * 128 + 8 * chunk, oc = h * 256 + 8 * chunk;
    for (int p0 = 0; p0 < 8; p0 += 2) {
        v4u raw[2][7];
#pragma unroll
        for (int k = 0; k < 2; ++k) {
            const int rw = (p0 + k) * 4 + (lane >> 4), tl = tl0 + rw;
            const size_t t = (size_t)b * SEQ + tl;
            const size_t tm1 = (tl >= 1) ? t - 1 : t, tm2 = (tl >= 2) ? t - 2 : t;
            raw[k][0] = *(const GAS v4u*)(Ob + t * 2048 + oc); raw[k][1] = *(const LAS v4u*)(stg + (rw * 128 + 8 * chunk) * 2);
            raw[k][2] = *(const GAS v4u*)(P + 4 * PS + t * 1024 + c); raw[k][3] = *(const GAS v4u*)(P + 5 * PS + t * 1024 + c);
            raw[k][4] = *(const GAS v4u*)(P + 3 * PS + t * 1024 + c); raw[k][5] = *(const GAS v4u*)(P + 3 * PS + tm1 * 1024 + c); raw[k][6] = *(const GAS v4u*)(P + 3 * PS + tm2 * 1024 + c);
        }
        asm volatile("" ::: "memory");
#pragma unroll
        for (int k = 0; k < 2; ++k) {
            const int rw = (p0 + k) * 4 + (lane >> 4), tl = tl0 + rw;
            const size_t t = (size_t)b * SEQ + tl;
            float o1[8], o2[8], bgc[8], ga[8], cu0[8], cu1[8], cu2[8];
            unpack8(raw[k][0], o1); unpack8(raw[k][1], o2); unpack8(raw[k][2], bgc); unpack8(raw[k][3], ga); unpack8(raw[k][4], cu0); unpack8(raw[k][5], cu1); unpack8(raw[k][6], cu2);
            const float k1 = (tl >= 1) ? 1.f : 0.f, k2 = (tl >= 2) ? 1.f : 0.f;
            float d[8], sq = 0.f;
#pragma unroll
            for (int i = 0; i < 8; ++i) { d[i] = o1[i] - C.lam * o2[i]; sq += d[i] * d[i]; }
            sq += __shfl_xor(sq, 1); sq += __shfl_xor(sq, 2); sq += __shfl_xor(sq, 4); sq += __shfl_xor(sq, 8);
            const float r = __builtin_amdgcn_rsqf(sq * (1.0f / 128.0f) + RMS_EPS);
            float mo[8];
#pragma unroll
            for (int i = 0; i < 8; ++i) {
                const float yc = bgc[i] * (C.w0[i] * (cu2[i] * k2) + C.w1[i] * (cu1[i] * k1) + C.w2[i] * cu0[i]);
                const float ya = d[i] * r * C.g[i];
                mo[i] = sigmoidf_(ga[i]) * ya + yc; }
            v4u w; w.x = pk2(mo[0], mo[1]); w.y = pk2(mo[2], mo[3]); w.z = pk2(mo[4], mo[5]); w.w = pk2(mo[6], mo[7]);
            st16_wt((void*)(Mx + t * 1024 + c), w);
        }
    }
}
struct MergePost { bool on; int l, b, h;
    __device__ __forceinline__ void run(attn_body::lds_cptr stg, int tl0, int lane) const {
        const kargs_t A = KARGS(); asm volatile("s_waitcnt vmcnt(0)" ::: "memory");
        MergeCtx MC; merge_setup(MC, A, l, h, lane); merge_wave(MC, A->ws, b, h, tl0, stg, lane); } };

constexpr int TILE_TAB_OFF = RING_BYTES + 1024 + 4096;
__device__ __forceinline__ void route_phase(int l) {
    const kargs_t A = KARGS(); Frame F = make_frame(A);
    const int lane = F.lane, tid = F.tid, j = l >> 1;
    LAS float* WrT = (LAS float*)(F.lds);
    volatile LAS int* cntl = (volatile LAS int*)(F.lds + 32768);
    volatile LAS int* gbase = cntl + 8;
    volatile LAS int* li = cntl + 16;
    volatile LAS int* lr = cntl + 16 + 128;
    volatile LAS float* lw = (volatile LAS float*)(cntl + 16 + 256);
    const float* Wr = A->in[14] + (size_t)j * DM * NEXP; const float* gn = A->in[10] + (size_t)l * DM;
    for (int idx = tid; idx < DM * NEXP; idx += NWAVES * 64) { const int k = idx >> 3, e = idx & 7; WrT[e * DM + k] = Wr[idx] * gn[k]; }
    gu32* gcnt = F.ctl + CW_GCNT + j * 8 * 64;
    int* slotof = (int*)(F.ws + WS_ROUTE + RT_SLOTOF); float* wslot = (float*)(F.ws + WS_ROUTE + RT_WSLOT); float* ssslot = (float*)(F.ws + WS_ROUTE + RT_SSSLOT);
    unsigned char* xg = (unsigned char*)(F.ws + WS_O);
    for (int blk = F.vcu; blk < M / 64; blk += F.G) {
        if (tid < 8) cntl[tid] = 0;
        __syncthreads();
        float ssq[8];
        const bf16* xbr = (const bf16*)(F.ws + WS_XB) + (size_t)(blk * 64 + F.wave * 8) * DM + 8 * lane;
        v4u cur0 = *(const GAS v4u*)xbr, cur1 = *(const GAS v4u*)(xbr + 512);
#pragma unroll
        for (int rr = 0; rr < 8; ++rr) {
            const int loc = F.wave * 8 + rr;
            v4u nx0 = cur0, nx1 = cur1;
            if (rr < 7) { nx0 = *(const GAS v4u*)(xbr + (size_t)(rr + 1) * DM); nx1 = *(const GAS v4u*)(xbr + (size_t)(rr + 1) * DM + 512); }
            float v[16]; float s = 0.f;
            { float t8[8]; unpack8(cur0, t8);
#pragma unroll
              for (int i = 0; i < 8; ++i) v[i] = t8[i];
              unpack8(cur1, t8);
#pragma unroll
              for (int i = 0; i < 8; ++i) v[8 + i] = t8[i]; }
#pragma unroll
            for (int i = 0; i < 16; ++i) s += v[i] * v[i];
            s = wave_sum(s); ssq[rr] = s; const float rstd = 1.0f / sqrtf(s * (1.0f / 1024.0f) + RMS_EPS);
            float lg[8];
#pragma unroll
            for (int e = 0; e < 8; ++e) { float a = 0.f;
#pragma unroll
                for (int q = 0; q < 2; ++q) { const f32x4 w0 = *(const LAS f32x4*)(WrT + e * DM + 512 * q + 8 * lane), w1 = *(const LAS f32x4*)(WrT + e * DM + 512 * q + 8 * lane + 4);
                    a += (v[8 * q] * w0.x + v[8 * q + 1] * w0.y) + (v[8 * q + 2] * w0.z + v[8 * q + 3] * w0.w) + (v[8 * q + 4] * w1.x + v[8 * q + 5] * w1.y) + (v[8 * q + 6] * w1.z + v[8 * q + 7] * w1.w); }
                lg[e] = wave_sum(a) * rstd; }
            int i0 = 0; float v0 = lg[0];
#pragma unroll
            for (int e = 1; e < 8; ++e) if (lg[e] > v0) { v0 = lg[e]; i0 = e; }
            int i1 = -1; float v1 = -INFINITY;
#pragma unroll
            for (int e = 0; e < 8; ++e) if (e != i0 && lg[e] > v1) { v1 = lg[e]; i1 = e; }
            if (i1 < 0) i1 = (i0 + 1) & 7;
            const float wA = 1.0f / (1.0f + __expf(v1 - v0)), wB = 1.0f - wA;
            if (lane == 0) {
                const int r0 = __hip_atomic_fetch_add((LAS int*)&cntl[i0], 1, __ATOMIC_RELAXED, __HIP_MEMORY_SCOPE_WORKGROUP);
                const int r1 = __hip_atomic_fetch_add((LAS int*)&cntl[i1], 1, __ATOMIC_RELAXED, __HIP_MEMORY_SCOPE_WORKGROUP);
                li[2 * loc] = i0; li[2 * loc + 1] = i1; lr[2 * loc] = r0; lr[2 * loc + 1] = r1; lw[2 * loc] = wA; lw[2 * loc + 1] = wB;
            }
            cur0 = nx0; cur1 = nx1;
            asm volatile("" ::: "memory");
        }
        __syncthreads();
        if (tid < 8) gbase[tid] = (int)__hip_atomic_fetch_add(gcnt + tid * 64, (unsigned)cntl[tid], RLX_AGENT);
        __syncthreads();
        v4u vs[8][2];
#pragma unroll
        for (int rr = 0; rr < 8; ++rr) { vs[rr][0] = *(const GAS v4u*)(xbr + (size_t)rr * DM); vs[rr][1] = *(const GAS v4u*)(xbr + (size_t)rr * DM + 512); }
#pragma unroll
        for (int rr = 0; rr < 8; ++rr) {
            const int loc = F.wave * 8 + rr, t = blk * 64 + loc;
            const int e0 = li[2 * loc], e1 = li[2 * loc + 1];
            const int s0 = e0 * ECAP + gbase[e0] + lr[2 * loc], s1 = e1 * ECAP + gbase[e1] + lr[2 * loc + 1];
            typedef unsigned u32x2_t __attribute__((ext_vector_type(2)));
#pragma unroll
            for (int q = 0; q < 2; ++q) { float t8[8]; unpack8(vs[rr][q], t8); u32x2_t w = {0u, 0u};
                w.x = __builtin_amdgcn_cvt_pk_fp8_f32(pg8::clamp448(t8[0] * 8.f), pg8::clamp448(t8[1] * 8.f), w.x, false); w.x = __builtin_amdgcn_cvt_pk_fp8_f32(pg8::clamp448(t8[2] * 8.f), pg8::clamp448(t8[3] * 8.f), w.x, true);
                w.y = __builtin_amdgcn_cvt_pk_fp8_f32(pg8::clamp448(t8[4] * 8.f), pg8::clamp448(t8[5] * 8.f), w.y, false); w.y = __builtin_amdgcn_cvt_pk_fp8_f32(pg8::clamp448(t8[6] * 8.f), pg8::clamp448(t8[7] * 8.f), w.y, true);
                st8_wt((void*)(xg + (size_t)s0 * DM + 512 * q + 8 * lane), w); st8_wt((void*)(xg + (size_t)s1 * DM + 512 * q + 8 * lane), w); }
            if (lane == 0) { slotof[2 * t] = s0; slotof[2 * t + 1] = s1; wslot[s0] = lw[2 * loc]; wslot[s1] = lw[2 * loc + 1];
                const f32x4 sv = {ssq[rr], 0.f, 0.f, 0.f}; *(GAS f32x4*)(ssslot + 4 * (size_t)s0) = sv; *(GAS f32x4*)(ssslot + 4 * (size_t)s1) = sv; }
        }
        __syncthreads();
    }
}
__device__ __forceinline__ void build_tiles(LAS unsigned char* lds, gu32* gcnt) {
    const int tid = opaque_tid(); LAS int* tab = (LAS int*)(lds + TILE_TAB_OFF);
    int seg = 0, ent = -1;
#pragma unroll
    for (int e = 0; e < 8; ++e) { const int nte = ((int)__hip_atomic_load(gcnt + e * 64, RLX_AGENT) + 255) >> 8;
        if (tid >= seg && tid < seg + nte) ent = (e << 16) | (e * (ECAP / 256) + (tid - seg)); seg += nte; }
    if (tid < 255 && ent >= 0) tab[tid] = ent;
    if (tid == 0) tab[255] = seg;
    __syncthreads();
}
__device__ __forceinline__ void combine_phase(int l) {
    const kargs_t A = KARGS(); Frame F = make_frame(A);
    const int lane = F.lane; const int gw = F.vcu * NWAVES + F.wave, NGW = F.G * NWAVES;
    const int* slotof = (const int*)(F.ws + WS_ROUTE + RT_SLOTOF); const bf16* Y = (const bf16*)(F.ws + WS_Y); bf16* xb = (bf16*)(F.ws + WS_XB);
    volatile LAS int* segc = (volatile LAS int*)(F.lds);
    if (F.tid == 0) { gu32* gcnt = F.ctl + CW_GCNT + (l >> 1) * 8 * 64; int s = 0; for (int e = 0; e < 8; ++e) { segc[e] = s; s += (((int)__hip_atomic_load(gcnt + e * 64, RLX_AGENT) + 255) >> 8) << 8; } }
    __syncthreads();
    float* ssn = (float*)(F.ws + WS_SS) + (size_t)(2 * l + 2) * M * 4; const bool fin = (l == DEPTH - 1);
    const float* gf = A->in[18];
    for (int t0 = gw * 4; t0 < M; t0 += NGW * 4) {
        v2u xa[4][4], ya[4][4], yb[4][4];
#pragma unroll
        for (int r = 0; r < 4; ++r) { const int t = t0 + r; const int p0 = slotof[2 * t], p1 = slotof[2 * t + 1];
            const int s0 = segc[p0 >> ECAP_LOG] + (p0 & (ECAP - 1)), s1 = segc[p1 >> ECAP_LOG] + (p1 & (ECAP - 1));
            const GAS v2u* xr = (const GAS v2u*)(xb + (size_t)t * DM) + lane;
            const GAS v2u* y0 = (const GAS v2u*)(Y + (size_t)s0 * DM) + lane; const GAS v2u* y1 = (const GAS v2u*)(Y + (size_t)s1 * DM) + lane;
#pragma unroll
            for (int q = 0; q < 4; ++q) { xa[r][q] = xr[64 * q]; ya[r][q] = y0[64 * q]; yb[r][q] = y1[64 * q]; } }
        asm volatile("" ::: "memory");
#pragma unroll
        for (int r = 0; r < 4; ++r) { const int t = t0 + r; float s = 0.f; f32x4 v[4];
#pragma unroll
            for (int q = 0; q < 4; ++q) { const v2u c = xa[r][q], a = ya[r][q], b = yb[r][q]; f32x4& x = v[q];
                x.x = bflo(c.x) + (bflo(a.x) + bflo(b.x)); x.y = bfhi(c.x) + (bfhi(a.x) + bfhi(b.x)); x.z = bflo(c.y) + (bflo(a.y) + bflo(b.y)); x.w = bfhi(c.y) + (bfhi(a.y) + bfhi(b.y));
                s += (x.x * x.x + x.y * x.y) + (x.z * x.z + x.w * x.w); }
            s = wave_sum(s);
            if (!fin) {
                GAS v2u* o8 = (GAS v2u*)(xb + (size_t)t * DM) + lane;
#pragma unroll
                for (int q = 0; q < 4; ++q) { v2u w; w.x = pk2(v[q].x, v[q].y); w.y = pk2(v[q].z, v[q].w); st8_wt((void*)(o8 + 64 * q), w); }
                if ((INPROJ_F8_MASK & 4) && INPROJ_F8(l + 1)) {
                    GAS unsigned* q8 = (GAS unsigned*)(F.ws + WS_O + (size_t)t * DM) + lane;
#pragma unroll
                    for (int q = 0; q < 4; ++q) { unsigned w = 0u;
                        w = __builtin_amdgcn_cvt_pk_fp8_f32(pg8::clamp448(v[q].x * 8.0f), pg8::clamp448(v[q].y * 8.0f), w, false);
                        w = __builtin_amdgcn_cvt_pk_fp8_f32(pg8::clamp448(v[q].z * 8.0f), pg8::clamp448(v[q].w * 8.0f), w, true); q8[64 * q] = w; } }
                if (lane == 0) *(GAS f32x4*)(ssn + 4 * (size_t)t) = (f32x4){s, 0.f, 0.f, 0.f};
            } else {
                const float rstd = 1.0f / sqrtf(s * (1.0f / 1024.0f) + RMS_EPS);
                GAS f32x4* xo = (GAS f32x4*)(F.X + (size_t)t * DM) + lane;
#pragma unroll
                for (int q = 0; q < 4; ++q) { const f32x4 gg = *((const GAS f32x4*)gf + lane + 64 * q); xo[64 * q] = v[q] * rstd * gg; }
            } }
    }
}

__device__ __forceinline__ XcdBarrier make_bar(unsigned char* ws) {
    extern __shared__ __attribute__((aligned(16))) unsigned char lds[];
    XcdBarrier b; b.bar = (unsigned*)(ws + WS_CTL) + CW_BAR; b.x = xb_xcc_id(); b.st = (volatile LAS unsigned*)((LAS unsigned char*)lds + MISC_OFF) + 8; return b;
}
__global__ void __launch_bounds__(NWAVES * 64, 2) trunk_fwd(Args args_unused) {
    extern __shared__ __attribute__((aligned(16))) unsigned char lds[];
    { const int tid = threadIdx.x;
      for (int u = tid; u < (LDS_BYTES - LDSCTL_OFF) / 4; u += NWAVES * 64) ((LAS unsigned*)((LAS unsigned char*)lds + LDSCTL_OFF))[u] = 0u;
      __syncthreads();
      if (!MK_PER_PHASE) { const kargs_t A = KARGS(); (void)xcd_barrier_post((unsigned*)(A->ws + WS_CTL) + CW_BAR, (volatile LAS unsigned*)((LAS unsigned char*)lds + MISC_OFF) + 8); } }
    int ph = 0;
#define PH_ON ({ const kargs_t Ap_ = KARGS(); ph >= Ap_->ph_lo && ph < Ap_->ph_hi; })
#define PH_END do { if (!MK_PER_PHASE && PH_ON && ph + 1 < KARGS()->ph_hi) { const kargs_t A_ = KARGS(); xcd_barrier(make_bar(A_->ws)); } ++ph; } while (0)

    for (int rep_ = 0; rep_ < (((PROBE_DUP >> 0) & 1) ? 2 : 1); ++rep_) if (((PH_MASK >> 0) & 1) && PH_ON) p0_prologue();
    PH_END;

    for (int l = 0; l < DEPTH; ++l) {
        for (int rep_ = 0; rep_ < (((PROBE_DUP >> 1) & 1) ? 2 : 1); ++rep_) if (((PH_MASK >> 1) & 1) && PH_ON) {
            const kargs_t A = KARGS(); unsigned char* ws = A->ws;
#if STAGGER_INPROJ
            if ((opaque_bid() >> 3) & 1) { const int n_ = INPROJ_F8(l) ? STAGGER_INPROJ : 2 * STAGGER_INPROJ; for (int i_ = 0; i_ < n_; ++i_) __builtin_amdgcn_s_sleep(127); }
#endif
            pg8::StaticOrder S; S.init(M, IN_W, opaque_grid(), opaque_bid());
            if ((INPROJ_F8_MASK != 0) && INPROJ_F8(l)) {
                pg8::Gemm g{(const bf16*)(ws + WS_O), (const bf16*)(ws + WS_WIN + (size_t)l * IN_W * DM * 2), M, IN_W, DM, 0};
                pg8::EpiProj E{(bf16*)(ws + WS_PROJ), (const float*)(ws + WS_SS) + (size_t)(2 * l) * M * 4, (const float*)(ws + WS_ROPEC), (const float*)(ws + WS_ROPES), attn_body::C2, 1.0f / 2048.0f};
                pg8::gemm_phase<pg8::EpiProj, pg8::StaticOrder, PG8_ALIGN, PG8_SP2, true>((LAS unsigned char*)lds + RING_OFF, g, S, E);
            } else {
            pg8::Gemm g{(const bf16*)(ws + WS_XB), (const bf16*)(ws + WS_WIN) + (size_t)l * IN_W * DM, M, IN_W, DM, 0};
            pg8::EpiProj E{(bf16*)(ws + WS_PROJ), (const float*)(ws + WS_SS) + (size_t)(2 * l) * M * 4, (const float*)(ws + WS_ROPEC), (const float*)(ws + WS_ROPES), attn_body::C2};
            pg8::gemm_phase<pg8::EpiProj, pg8::StaticOrder, PG8_ALIGN, PG8_SP2>((LAS unsigned char*)lds + RING_OFF, g, S, E); }
        }
        PH_END;
        for (int rep_ = 0; rep_ < (((PROBE_DUP >> 2) & 1) ? 2 : 1); ++rep_) if (((PH_MASK >> 2) & 1) && PH_ON) {
            const kargs_t A = KARGS(); unsigned char* ws = A->ws;
            const attn_body::bf16* Qb = (const attn_body::bf16*)(ws + WS_PROJ); attn_body::bf16* Ob = (attn_body::bf16*)(ws + WS_O);
            const int G = opaque_grid(), bx = opaque_bid(), vcu = (G % 8 == 0) ? (bx % 8) * (G / 8) + bx / 8 : bx;
            attn_body::AttnCarry cy; cy.primed = false; cy.s0 = 0;
#pragma unroll
            for (int d0 = 0; d0 < 4; ++d0) cy.qr[d0] = (attn_body::bf16x8){0, 0, 0, 0, 0, 0, 0, 0};
            for (int vc = vcu; vc < 256; vc += G) {
                const int bh = vc >> 2, b = bh >> 3, h = bh & 7;
                for (int u = 0; u < 4; ++u) {
                    const int mp = u & 1, qb = (u >> 1) ? (vc & 3) : 7 - (vc & 3);
                    if (((vc >> 2) & 3) == u) {
                        const kargs_t A3 = KARGS(); const int tid3 = opaque_tid(); int grp3 = l + 1; asm volatile("" : "+s"(grp3));
                        convert_group(A3, A3->ws, grp3, vc * NWAVES + (tid3 >> 6), 256 * NWAVES, tid3 & 63);
                    }
                    const attn_body::bf16* Qh = Qb + (size_t)b * SEQ * 1024 + (2 * h + mp) * 64;
                    const attn_body::bf16* Vh = Qb + (size_t)2 * M * 1024 + (size_t)b * SEQ * 1024 + h * 128;
                    attn_body::AttnNext nx; nx.has = (u < 3); nx.qb = ((u + 1) >> 1) ? (vc & 3) : 7 - (vc & 3);
                    nx.Qh = Qb + (size_t)b * SEQ * 1024 + (2 * h + ((u + 1) & 1)) * 64; nx.Kh = nx.Qh + (size_t)M * 1024; nx.Vh = Vh;
                    const MergePost post{mp == 1, l, b, h};
                    attn_body::attn_unit128<8>(qb, Qh, Qh + (size_t)M * 1024, Vh, Ob + (size_t)b * SEQ * 2048 + h * 256 + mp * 128, (char*)lds + RING_OFF, post, nx, cy);
                }
            }
        }
        PH_END;
        for (int rep_ = 0; rep_ < (((PROBE_DUP >> 4) & 1) ? 2 : 1); ++rep_) if (((PH_MASK >> 4) & 1) && PH_ON) {
            const kargs_t A = KARGS(); unsigned char* ws = A->ws;
            pg8::Gemm g{(const bf16*)(ws + WS_MIX), (const bf16*)(ws + WS_WOUT) + (size_t)l * DM * DM, M, DM, DM, 0};
            pg8::StaticOrder S; S.init(M, DM, opaque_grid(), opaque_bid());
            if (l & 1) { pg8::EpiResidLite E{(bf16*)(ws + WS_XB), nullptr};
                pg8::gemm_phase<pg8::EpiResidLite, pg8::StaticOrder, PG8_ALIGN, PG8_SP2>((LAS unsigned char*)lds + RING_OFF, g, S, E); }
            else if (DENSE_F8(l >> 1)) { pg8::EpiResidF8X E{(bf16*)(ws + WS_XB), (float*)(ws + WS_SS) + (size_t)(2 * l + 1) * M * 4, (unsigned char*)(ws + WS_O), 1.0f};
                pg8::gemm_phase<pg8::EpiResidF8X, pg8::StaticOrder, PG8_ALIGN, PG8_SP2>((LAS unsigned char*)lds + RING_OFF, g, S, E); }
            else { pg8::EpiResid E{(bf16*)(ws + WS_XB), (float*)(ws + WS_SS) + (size_t)(2 * l + 1) * M * 4};
                pg8::gemm_phase<pg8::EpiResid, pg8::StaticOrder, PG8_ALIGN, PG8_SP2>((LAS unsigned char*)lds + RING_OFF, g, S, E); }
        }
        PH_END;
        if ((l & 1) == 0) {
            for (int rep_ = 0; rep_ < (((PROBE_DUP >> 5) & 1) ? 2 : 1); ++rep_) if (((PH_MASK >> 5) & 1) && PH_ON) {
                const kargs_t A = KARGS(); unsigned char* ws = A->ws; const int j = l >> 1;
                pg8::StaticOrder S; S.init(M, 2 * DFF, opaque_grid(), opaque_bid());
                if (DENSE_F8(j)) {
                    pg8::Gemm g{(const bf16*)(ws + WS_O), (const bf16*)(ws + WS_WGU + (size_t)j * 2 * DFF * DM * 2), M, 2 * DFF, DM, 0};
                    pg8::EpiSwigluF8 E{(void*)(ws + WS_PROJ), DFF, (const float*)(ws + WS_SS) + (size_t)(2 * l + 1) * M * 4, 1.0f / 2048.0f};
                    pg8::gemm_phase<pg8::EpiSwigluF8, pg8::StaticOrder, PG8_ALIGN, PG8_SP2, true>((LAS unsigned char*)lds + RING_OFF, g, S, E);
                } else {
                pg8::Gemm g{(const bf16*)(ws + WS_XB), (const bf16*)(ws + WS_WGU) + (size_t)j * 2 * DFF * DM, M, 2 * DFF, DM, 0};
                if (((DENSE_DN_F8_MASK & ~DENSE_F8_MASK) != 0) && DENSE_DN_F8(j)) {
                    pg8::EpiSwigluF8 E{(void*)(ws + WS_PROJ), DFF, (const float*)(ws + WS_SS) + (size_t)(2 * l + 1) * M * 4, 1.0f};
                    pg8::gemm_phase<pg8::EpiSwigluF8, pg8::StaticOrder, PG8_ALIGN, PG8_SP2>((LAS unsigned char*)lds + RING_OFF, g, S, E);
                } else {
                pg8::EpiSwiglu E{(void*)(ws + WS_PROJ), DFF, (const float*)(ws + WS_SS) + (size_t)(2 * l + 1) * M * 4, 1.0f};
                pg8::gemm_phase<pg8::EpiSwiglu, pg8::StaticOrder, PG8_ALIGN, PG8_SP2>((LAS unsigned char*)lds + RING_OFF, g, S, E); } }
            }
            PH_END;
            for (int rep_ = 0; rep_ < (((PROBE_DUP >> 6) & 1) ? 2 : 1); ++rep_) if (((PH_MASK >> 6) & 1) && PH_ON) {
                const kargs_t A = KARGS(); unsigned char* ws = A->ws; const int j = l >> 1;
                pg8::StaticOrder S; S.init(M, DM, opaque_grid(), opaque_bid());
                constexpr bool C_F8_X = ((DENSE_DN_F8_MASK & 1) && (INPROJ_F8_MASK & 2)) || ((DENSE_DN_F8_MASK & 2) && (INPROJ_F8_MASK & 8));
                constexpr bool C_F8_N = ((DENSE_DN_F8_MASK & 1) && !(INPROJ_F8_MASK & 2)) || ((DENSE_DN_F8_MASK & 2) && !(INPROJ_F8_MASK & 8));
                constexpr bool C_BF_X = (!(DENSE_DN_F8_MASK & 1) && (INPROJ_F8_MASK & 2)) || (!(DENSE_DN_F8_MASK & 2) && (INPROJ_F8_MASK & 8));
                const bool f8x = INPROJ_F8(l + 1);
                if (C_F8_X && DENSE_DN_F8(j) && f8x) {
                    pg8::Gemm g{(const bf16*)(ws + WS_PROJ), (const bf16*)(ws + WS_WD + (size_t)j * DM * DFF * 2), M, DM, DFF, 0};
                    pg8::EpiResidF8X E{(bf16*)(ws + WS_XB), (float*)(ws + WS_SS) + (size_t)(2 * l + 2) * M * 4, (unsigned char*)(ws + WS_O), 1.0f / 2048.0f};
                    pg8::gemm_phase<pg8::EpiResidF8X, pg8::StaticOrder, PG8_ALIGN, PG8_SP2, true>((LAS unsigned char*)lds + RING_OFF, g, S, E);
                } else if (C_F8_N && DENSE_DN_F8(j)) {
                    pg8::Gemm g{(const bf16*)(ws + WS_PROJ), (const bf16*)(ws + WS_WD + (size_t)j * DM * DFF * 2), M, DM, DFF, 0};
                    pg8::EpiResid E{(bf16*)(ws + WS_XB), (float*)(ws + WS_SS) + (size_t)(2 * l + 2) * M * 4, nullptr, 1.0f / 2048.0f};
                    pg8::gemm_phase<pg8::EpiResid, pg8::StaticOrder, PG8_ALIGN, PG8_SP2, true>((LAS unsigned char*)lds + RING_OFF, g, S, E);
                } else if (C_BF_X && f8x) {
                    pg8::Gemm g{(const bf16*)(ws + WS_PROJ), (const bf16*)(ws + WS_WD) + (size_t)j * DM * DFF, M, DM, DFF, 0};
                    pg8::EpiResidF8X E{(bf16*)(ws + WS_XB), (float*)(ws + WS_SS) + (size_t)(2 * l + 2) * M * 4, (unsigned char*)(ws + WS_O), 1.0f};
                    pg8::gemm_phase<pg8::EpiResidF8X, pg8::StaticOrder, PG8_ALIGN, PG8_SP2>((LAS unsigned char*)lds + RING_OFF, g, S, E);
                } else {
                pg8::Gemm g{(const bf16*)(ws + WS_PROJ), (const bf16*)(ws + WS_WD) + (size_t)j * DM * DFF, M, DM, DFF, 0};
                pg8::EpiResid E{(bf16*)(ws + WS_XB), (float*)(ws + WS_SS) + (size_t)(2 * l + 2) * M * 4};
                pg8::gemm_phase<pg8::EpiResid, pg8::StaticOrder, PG8_ALIGN, PG8_SP2>((LAS unsigned char*)lds + RING_OFF, g, S, E); }
            }
            PH_END;
        } else {
            for (int rep_ = 0; rep_ < (((PROBE_DUP >> 7) & 1) ? 2 : 1); ++rep_) if (((PH_MASK >> 7) & 1) && PH_ON) route_phase(l);
            PH_END;
            for (int rep_ = 0; rep_ < (((PROBE_DUP >> 9) & 1) ? 2 : 1); ++rep_) if (((PH_MASK >> 9) & 1) && PH_ON) {
                const kargs_t A = KARGS(); unsigned char* ws = A->ws; const int j = l >> 1;
                build_tiles((LAS unsigned char*)lds, (gu32*)(ws + WS_CTL) + CW_GCNT + j * 8 * 64);
                const LAS int* tab = (const LAS int*)((LAS unsigned char*)lds + TILE_TAB_OFF);
                const int ntl = __builtin_amdgcn_readfirstlane(tab[255]);
                pg8::Gemm g{(const bf16*)(ws + WS_O), (const bf16*)(ws + WS_WEGU + (size_t)j * 8 * 2 * DFFE * DM), NEXP * ECAP, 2 * DFFE, DM, (size_t)2 * DFFE * DM};
                pg8::GroupedOrder S; S.init(ntl, 2 * DFFE, opaque_grid(), opaque_bid(), tab, true);
                pg8::EpiSwigluF8 E{(void*)(ws + WS_PROJ), DFFE, (const float*)(ws + WS_ROUTE + RT_SSSLOT), 1.0f / 2048.0f};
                pg8::gemm_phase<pg8::EpiSwigluF8, pg8::GroupedOrder, PG8_ALIGN, PG8_SP2, true>((LAS unsigned char*)lds + RING_OFF, g, S, E);
            }
            PH_END;
            for (int rep_ = 0; rep_ < (((PROBE_DUP >> 10) & 1) ? 2 : 1); ++rep_) if (((PH_MASK >> 10) & 1) && PH_ON) {
                const kargs_t A = KARGS(); unsigned char* ws = A->ws; const int j = l >> 1;
                build_tiles((LAS unsigned char*)lds, (gu32*)(ws + WS_CTL) + CW_GCNT + j * 8 * 64);
                const LAS int* tab = (const LAS int*)((LAS unsigned char*)lds + TILE_TAB_OFF);
                const int ntl = __builtin_amdgcn_readfirstlane(tab[255]);
                pg8::Gemm g{(const bf16*)(ws + WS_PROJ), (const bf16*)(ws + WS_WED + (size_t)j * 8 * DM * DFFE), MSLOT, DM, DFFE, (size_t)DM * DFFE};
                pg8::GroupedOrder S; S.init(ntl, DM, opaque_grid(), opaque_bid(), tab, false);
                pg8::EpiSlot E{(bf16*)(ws + WS_Y), (const float*)(ws + WS_ROUTE + RT_WSLOT), 1.0f / 2048.0f};
                pg8::gemm_phase<pg8::EpiSlot, pg8::GroupedOrder, PG8_ALIGN, PG8_SP2, true>((LAS unsigned char*)lds + RING_OFF, g, S, E);
            }
            PH_END;
            for (int rep_ = 0; rep_ < (((PROBE_DUP >> 11) & 1) ? 2 : 1); ++rep_) if (((PH_MASK >> 11) & 1) && PH_ON) combine_phase(l);
            PH_END;
        }
    }
#undef PH_ON
#undef PH_END
}

constexpr int N_PHASES = 1 + 2 * 5 + 2 * 7;

extern "C" void kernel_launch(void* const* d_in, const int* in_sizes, int n_in, void* d_out, int out_size, void* d_ws, size_t ws_size, hipStream_t stream) {
    static int grid = 0;
    if (grid == 0) {
        if (n_in != 19 || in_sizes[0] != M * DM || out_size != M * DM || ws_size < WS_END) { fprintf(stderr, "kernel_launch: unexpected shapes / workspace (n_in %d, in0 %d, out %d, ws %zu < %zu); nothing launched\n", n_in, n_in > 0 ? in_sizes[0] : -1, out_size, ws_size, (size_t)WS_END); grid = -1; return; }
        int dev = 0, cus = 0, per_cu = 0;
        if (hipGetDevice(&dev) != hipSuccess || hipDeviceGetAttribute(&cus, hipDeviceAttributeMultiprocessorCount, dev) != hipSuccess) { grid = -1; return; }
        if (hipFuncSetAttribute((const void*)trunk_fwd, hipFuncAttributeMaxDynamicSharedMemorySize, LDS_BYTES) != hipSuccess) { fprintf(stderr, "kernel_launch: hipFuncSetAttribute failed\n"); grid = -1; return; }
        if (hipOccupancyMaxActiveBlocksPerMultiprocessor(&per_cu, (const void*)trunk_fwd, NWAVES * 64, LDS_BYTES) != hipSuccess || per_cu < 1)
            fprintf(stderr, "kernel_launch: note: occupancy query reports %d workgroups per CU\n", per_cu);
        (void)hipGetLastError();
        grid = cus;
        if (grid > 256) grid = 256;
    }
    if (grid < 0) return;
    if (hipMemsetAsync((char*)d_ws + WS_CTL, 0, CTL_ZERO_BYTES, stream) != hipSuccess) return;
    Args a{};
    for (int i = 0; i < 19; ++i) a.in[i] = (const float*)d_in[i];
    a.out = (float*)d_out; a.ws = (unsigned char*)d_ws;
#if MK_PER_PHASE
    for (int p = 0; p < N_PHASES; ++p) { a.ph_lo = p; a.ph_hi = p + 1; hipLaunchKernelGGL(trunk_fwd, dim3(grid), dim3(NWAVES * 64), LDS_BYTES, stream, a); }
#else
    a.ph_lo = 0; a.ph_hi = N_PHASES;
    hipLaunchKernelGGL(trunk_fwd, dim3(grid), dim3(NWAVES * 64), LDS_BYTES, stream, a);
#endif
}
```

```cpp
#include <hip/hip_runtime.h>
#include <hip/hip_bf16.h>
#include <cstdio>
#include <cstdint>
#include <cmath>

#ifndef PH_MASK
#define PH_MASK 0xFFFF
#endif
#ifndef DENSE_F8_MASK
#define DENSE_F8_MASK 2
#endif
#define DENSE_F8(j) (((DENSE_F8_MASK) >> (j)) & 1)
#ifndef DENSE_DN_F8_MASK
#define DENSE_DN_F8_MASK 3
#endif
#define DENSE_DN_F8(j) (((DENSE_DN_F8_MASK) >> (j)) & 1)
static_assert((DENSE_DN_F8_MASK & DENSE_F8_MASK) == DENSE_F8_MASK, "an fp8 gate|up GEMM writes fp8 hidden activations: its down projection is fp8 too");
#ifndef INPROJ_F8_MASK
#define INPROJ_F8_MASK 12
#endif
#define INPROJ_F8(l) (((INPROJ_F8_MASK) >> (l)) & 1)
static_assert((INPROJ_F8_MASK & 1) == 0, "layer 0's in-projection reads the prologue's bf16 x");
#ifndef PROBE_DUP
#define PROBE_DUP 0
#endif
#ifndef MK_PER_PHASE
#define MK_PER_PHASE 0
#endif

constexpr int BATCH = 8, SEQ = 2048, DM = 1024, DEPTH = 4;
constexpr int M = BATCH * SEQ;
constexpr int NHEADS = 8;
constexpr int IN_W = 8192;
constexpr int DFF = 2816, DFFE = 3584, NEXP = 8;
constexpr int MSLOT = 2 * M + NEXP * 256;
constexpr float RMS_EPS = 1e-5f;

__device__ __forceinline__ int opaque_tid() { int t = threadIdx.x; asm volatile("" : "+v"(t)); return t; }
__device__ __forceinline__ int opaque_bid() { int t = blockIdx.x; asm volatile("" : "+s"(t)); return t; }
__device__ __forceinline__ int opaque_grid() { int t = gridDim.x; asm volatile("" : "+s"(t)); return t; }

typedef unsigned wt_u32x4 __attribute__((ext_vector_type(4))); typedef unsigned wt_u32x2 __attribute__((ext_vector_type(2)));
__device__ __forceinline__ void st16_wt(void* p, wt_u32x4 v) { asm volatile("global_store_dwordx4 %0, %1, off sc1\n\ts_nop 1" :: "v"(p), "v"(v) : "memory"); }
__device__ __forceinline__ void st8_wt(void* p, wt_u32x2 v) { asm volatile("global_store_dwordx2 %0, %1, off sc1" :: "v"(p), "v"(v) : "memory"); }

namespace pg8 {
#define PG8_LAS __attribute__((address_space(3)))
typedef unsigned short bf16_t;
typedef short bf16x8 __attribute__((ext_vector_type(8)));
typedef float f32x4 __attribute__((ext_vector_type(4)));
typedef unsigned u32x4 __attribute__((ext_vector_type(4)));
constexpr int BM = 256, BK = 64, HALF = 128, HTB = HALF * BK * 2, STAGE_BYTES = 8 * HTB, NXCD = 8, WGM = 8;

__host__ __device__ __forceinline__ int lds_byte(int r, int c) { const int st = (r >> 4) * 2 + (c >> 5), rr = r & 15, cc = c & 31, ob = rr * 64 + cc * 2; return st * 1024 + (ob ^ (((ob >> 9) & 1) << 5)); }
__host__ __device__ __forceinline__ void stage_rc(int b, int& R, int& C) { const int st = b / 1024, sb = b % 1024, swz = sb ^ (((sb >> 9) & 1) << 5); R = (st >> 1) * 16 + swz / 64; C = (st & 1) * 32 + (swz % 64) / 2; }
__host__ __device__ __forceinline__ int perm32(int rho) { const int n = rho >> 4, i = rho & 15; return 8 * (i >> 2) + 4 * n + (i & 3); }

struct Unit { int pm, pn, be, pa, ps; };
struct Gemm { const bf16_t* A; const bf16_t* Bt; int M, N, K; size_t bstride; };

struct StaticOrder {
    int nM, nN, nwg, G, c;
    __host__ __device__ void init(int M_, int N_, int G_, int c_) { nM = M_ / BM; nN = N_ / BM; nwg = nM * nN; G = G_; c = c_; }
    __host__ __device__ bool next(int i, Unit& u) const {
        const long L = (long)i * G + c; if (L >= nwg) return false;
        int wgid = (int)L; { const int q = nwg / NXCD, r = nwg % NXCD, xcd = wgid % NXCD, off = wgid / NXCD; wgid = (xcd < r ? xcd * (q + 1) : r * (q + 1) + (xcd - r) * q) + off; }
        const int nig = WGM * nN, gid = wgid / nig, fm = gid * WGM, gsz = (nM - fm) < WGM ? (nM - fm) : WGM;
        u.pm = fm + ((wgid % nig) % gsz); u.pn = (wgid % nig) / gsz; u.be = 0; u.pa = u.pm; u.ps = u.pm; return true;
    }
    __device__ __forceinline__ void a_ready(const Unit&) const {}
    __device__ __forceinline__ void done(const Unit&) const {}
};
struct GroupedOrder {
    int nM, nN, nwg, G, c; const PG8_LAS int* tab; bool sparseA;
    __device__ void init(int nM_, int N_, int G_, int c_, const PG8_LAS int* tab_, bool sparseA_) { nM = nM_; nN = N_ / BM; nwg = nM * nN; G = G_; c = c_; tab = tab_; sparseA = sparseA_; }
    __device__ bool next(int i, Unit& u) const {
        const long L = (long)i * G + c; if (L >= nwg) return false;
        int wgid = (int)L; { const int q = nwg / NXCD, r = nwg % NXCD, xcd = wgid % NXCD, off = wgid / NXCD; wgid = (xcd < r ? xcd * (q + 1) : r * (q + 1) + (xcd - r) * q) + off; }
        const int nig = WGM * nN, gid = wgid / nig, fm = gid * WGM, gsz = (nM - fm) < WGM ? (nM - fm) : WGM;
        u.pm = fm + ((wgid % nig) % gsz); u.pn = (wgid % nig) / gsz;
        const int ent = __builtin_amdgcn_readfirstlane(tab[u.pm]); u.be = ent >> 16; u.ps = ent & 0xffff; u.pa = sparseA ? u.ps : u.pm; return true;
    }
    __device__ __forceinline__ void a_ready(const Unit&) const {}
    __device__ __forceinline__ void done(const Unit&) const {}
};

constexpr int RSC_OFF = 131072 + 8192;
__device__ __forceinline__ unsigned cvt_pk_bf16(float lo, float hi) { unsigned r; asm volatile("v_cvt_pk_bf16_f32 %0, %1, %2" : "=v"(r) : "v"(lo), "v"(hi)); return r; }
__device__ __forceinline__ u32x4 pack8(const f32x4 a, const f32x4 b) { u32x4 w; w.x = cvt_pk_bf16(a[0], a[1]); w.y = cvt_pk_bf16(a[2], a[3]); w.z = cvt_pk_bf16(b[0], b[1]); w.w = cvt_pk_bf16(b[2], b[3]); return w; }
__device__ __forceinline__ float rstd_of(const float* ss4) { const f32x4 p = *(const f32x4*)ss4; return __builtin_amdgcn_rsqf(((p[0] + p[1]) + (p[2] + p[3])) * (1.0f / 1024.0f) + RMS_EPS); }

struct EpiProj {
    static constexpr bool PERM = true, AFTER_DRAIN = false, NEEDS_ALIGN = false;
    bf16_t* P; const float* ss; const float* ropeC; const float* ropeS; float qscale; float ascale = 1.0f;
    mutable int pmc = -1;
    __device__ __forceinline__ PG8_LAS float* rsc_lds() const { extern __shared__ __attribute__((aligned(16))) unsigned char lds_all[]; return (PG8_LAS float*)((PG8_LAS unsigned char*)lds_all + RSC_OFF) + opaque_tid(); }
    __device__ __forceinline__ void refresh(const Unit& u, int wr, int fr) const {
        if (u.pm != pmc) { pmc = u.pm; const int row0 = u.pm * BM + wr * 64 + fr; f32x4 t_[8]; PG8_LAS float* rc = rsc_lds();
#pragma unroll
            for (int i = 0; i < 8; ++i) t_[i] = *(const f32x4*)(ss + 4 * (size_t)(row0 + (i >> 2) * HALF + (i & 3) * 16));
#pragma unroll
            for (int i = 0; i < 8; ++i) rc[i * 512] = __builtin_amdgcn_rsqf(((t_[i][0] + t_[i][1]) + (t_[i][2] + t_[i][3])) * (1.0f / 1024.0f) + RMS_EPS) * ascale;
            asm volatile("s_waitcnt lgkmcnt(0)" ::: "memory"); }
    }
    __device__ __forceinline__ void half(const f32x4 (&acc)[2][2][4][2], const Unit& u, int ai, int wr, int wc, int fr, int fq) const {
        asm volatile("" : "+v"(fr), "+v"(fq));
        refresh(u, wr, fr);
        float rsc[4]; { const PG8_LAS float* rc = rsc_lds();
#pragma unroll
            for (int m = 0; m < 4; ++m) rsc[m] = rc[(ai * 4 + m) * 512]; }
        const int t = u.pn >> 2, ct = u.pn & 3;
        bf16_t* base = P + (size_t)t * ((size_t)M * 1024);
        const int row0 = u.pm * BM + wr * 64 + fr;
        if (t < 2) {
            const float sc = (t == 0) ? qscale : 1.0f;
            int fqo = fq; asm volatile("" : "+v"(fqo));
            const int hcol = ct * 256 + wc * 64 + 8 * fq;
#pragma unroll
            for (int m = 0; m < 4; ++m) {
                const int row = row0 + ai * HALF + m * 16; const float rs = rsc[m] * sc; const int pos = row & (SEQ - 1);
                const f32x4 c0 = *(const f32x4*)(ropeC + pos * 32 + 8 * fqo), c1 = *(const f32x4*)(ropeC + pos * 32 + 8 * fqo + 4);
                const f32x4 s0 = *(const f32x4*)(ropeS + pos * 32 + 8 * fqo), s1 = *(const f32x4*)(ropeS + pos * 32 + 8 * fqo + 4);
                const f32x4 l0 = acc[ai][0][m][0] * rs, l1 = acc[ai][0][m][1] * rs, h0 = acc[ai][1][m][0] * rs, h1 = acc[ai][1][m][1] * rs;
                const f32x4 ol0 = l0 * c0 - h0 * s0, ol1 = l1 * c1 - h1 * s1, oh0 = h0 * c0 + l0 * s0, oh1 = h1 * c1 + l1 * s1;
                bf16_t* rowp = base + (size_t)row * 1024 + hcol;
                st16_wt(rowp, pack8(ol0, ol1)); st16_wt(rowp + 32, pack8(oh0, oh1));
                if (m & 1) asm volatile("" ::: "memory");
            }
        } else if (u.pn < 12 || u.pn >= 28) {
            bf16_t* b2 = P + (size_t)(u.pn < 12 ? 2 : 5) * ((size_t)M * 1024);
            const int col0 = ct * 256 + wc * 32 + 8 * fq;
#pragma unroll
            for (int m = 0; m < 4; ++m) {
                const int row = row0 + ai * HALF + m * 16; const float rs = rsc[m];
                bf16_t* rowp = b2 + (size_t)row * 1024 + col0;
#pragma unroll
                for (int bj = 0; bj < 2; ++bj) st16_wt(rowp + bj * HALF, pack8(acc[ai][bj][m][0] * rs, acc[ai][bj][m][1] * rs));
            }
        } else {
            const bool conv = u.pn < 20;
            bf16_t* b2 = P + (size_t)(conv ? 3 : 4) * ((size_t)M * 1024);
            const int col0 = (u.pn - (conv ? 12 : 20)) * HALF + wc * 32 + 8 * fq;
#pragma unroll
            for (int m = 0; m < 4; ++m) {
                const int row = row0 + ai * HALF + m * 16; const float rs = rsc[m];
                f32x4 o[2];
#pragma unroll
                for (int n = 0; n < 2; ++n) {
                    const f32x4 x0 = acc[ai][0][m][n] * rs, x1 = acc[ai][1][m][n] * rs;
                    if (conv) o[n] = x0 * x1;
                    else {
#pragma unroll
                        for (int i = 0; i < 4; ++i) o[n][i] = x0[i] * __builtin_amdgcn_rcpf(1.0f + __builtin_amdgcn_exp2f(x1[i] * -1.4426950408889634f)); }
                }
                st16_wt(b2 + (size_t)row * 1024 + col0, pack8(o[0], o[1]));
            }
        }
    }
    __device__ __forceinline__ void qk_all(const f32x4 (&acc)[2][2][4][2], const Unit& u, int wr, int wc, int fr, int fq) const {
        asm volatile("" : "+v"(fr), "+v"(fq));
        refresh(u, wr, fr);
        const int t = u.pn >> 2, ct = u.pn & 3;
        const float sc = (t == 0) ? qscale : 1.0f;
        const int row0 = u.pm * BM + wr * 64 + fr;
        u32x4 outs[2][4][2];
#pragma unroll
        for (int ai = 0; ai < 2; ++ai) {
            float rsc[4]; { const PG8_LAS float* rc = rsc_lds();
#pragma unroll
                for (int m = 0; m < 4; ++m) rsc[m] = rc[(ai * 4 + m) * 512]; }
#pragma unroll
            for (int m = 0; m < 4; ++m) {
                const int row = row0 + ai * HALF + m * 16; const float rs = rsc[m] * sc; const int pos = row & (SEQ - 1);
                const f32x4 c0 = *(const f32x4*)(ropeC + pos * 32 + 8 * fq), c1 = *(const f32x4*)(ropeC + pos * 32 + 8 * fq + 4);
                const f32x4 s0 = *(const f32x4*)(ropeS + pos * 32 + 8 * fq), s1 = *(const f32x4*)(ropeS + pos * 32 + 8 * fq + 4);
                const f32x4 l0 = acc[ai][0][m][0] * rs, l1 = acc[ai][0][m][1] * rs, h0 = acc[ai][1][m][0] * rs, h1 = acc[ai][1][m][1] * rs;
                outs[ai][m][0] = pack8(l0 * c0 - h0 * s0, l1 * c1 - h1 * s1); outs[ai][m][1] = pack8(h0 * c0 + l0 * s0, h1 * c1 + l1 * s1);
                asm volatile("" : "+v"(outs[ai][m][0]), "+v"(outs[ai][m][1]) :: "memory");
            }
        }
        asm volatile("" ::: "memory");
        bf16_t* base = P + (size_t)t * ((size_t)M * 1024) + ct * 256 + wc * 64 + 8 * fq;
#pragma unroll
        for (int ai = 0; ai < 2; ++ai)
#pragma unroll
            for (int m = 0; m < 4; ++m) { bf16_t* rowp = base + (size_t)(row0 + ai * HALF + m * 16) * 1024;
                st16_wt(rowp, outs[ai][m][0]); st16_wt(rowp + 32, outs[ai][m][1]); }
    }
    __device__ __forceinline__ void operator()(const f32x4 (&acc)[2][2][4][2], const Unit& u, int wr, int wc, int fr, int fq) const {
        if (u.pn < 8) qk_all(acc, u, wr, wc, fr, fq); else { half(acc, u, 0, wr, wc, fr, fq); half(acc, u, 1, wr, wc, fr, fq); } }
};
__device__ __forceinline__ float clamp448(float v) { return __builtin_fminf(__builtin_fmaxf(v, -448.0f), 448.0f); }
template <bool F8OUT> struct EpiSwigluT {
    static constexpr bool PERM = true, AFTER_DRAIN = false, NEEDS_ALIGN = false;
    void* H; int ldh; const float* ss; float ascale;
    mutable int pmc = -1;
    __device__ __forceinline__ PG8_LAS float* rsc_lds() const { extern __shared__ __attribute__((aligned(16))) unsigned char lds_all[]; return (PG8_LAS float*)((PG8_LAS unsigned char*)lds_all + RSC_OFF) + opaque_tid(); }
    __device__ __forceinline__ void refresh(const Unit& u, int wr, int fr) const {
        if (u.pm != pmc) { pmc = u.pm; const int srow0 = u.ps * BM + wr * 64 + fr;
            f32x4 t_[8]; PG8_LAS float* rc = rsc_lds();
#pragma unroll
            for (int i = 0; i < 8; ++i) t_[i] = *(const f32x4*)(ss + 4 * (size_t)(srow0 + (i >> 2) * HALF + (i & 3) * 16));
#pragma unroll
            for (int i = 0; i < 8; ++i) rc[i * 512] = __builtin_amdgcn_rsqf(((t_[i][0] + t_[i][1]) + (t_[i][2] + t_[i][3])) * (1.0f / 1024.0f) + RMS_EPS) * ascale;
            asm volatile("s_waitcnt lgkmcnt(0)" ::: "memory"); }
    }
    __device__ __forceinline__ void half(const f32x4 (&acc)[2][2][4][2], const Unit& u, int ai, int wr, int wc, int fr, int fq) const {
        asm volatile("" : "+v"(fr), "+v"(fq));
        refresh(u, wr, fr);
        float rsc[4]; { const PG8_LAS float* rc = rsc_lds();
#pragma unroll
            for (int m = 0; m < 4; ++m) rsc[m] = rc[(ai * 4 + m) * 512]; }
        const int row0 = u.pm * BM + wr * 64 + fr, col0 = u.pn * HALF + wc * 32 + 8 * fq;
#pragma unroll
        for (int m = 0; m < 4; ++m) {
            const int row = row0 + ai * HALF + m * 16; const float rs = rsc[m];
            f32x4 o[2];
            {
                const float rse = rs * -1.4426950408889634f, rs2 = rs * rs * (F8OUT ? 8.0f : 1.0f);
                f32x4 e[2], p[2];
#pragma unroll
                for (int n = 0; n < 2; ++n) { e[n] = acc[ai][0][m][n] * rse; p[n] = (acc[ai][0][m][n] * acc[ai][1][m][n]) * rs2; }
#pragma unroll
                for (int n = 0; n < 2; ++n)
#pragma unroll
                    for (int i = 0; i < 4; ++i) e[n][i] = __builtin_amdgcn_exp2f(e[n][i]);
#pragma unroll
                for (int n = 0; n < 2; ++n) e[n] = e[n] + 1.0f;
#pragma unroll
                for (int n = 0; n < 2; ++n)
#pragma unroll
                    for (int i = 0; i < 4; ++i) e[n][i] = __builtin_amdgcn_rcpf(e[n][i]);
#pragma unroll
                for (int n = 0; n < 2; ++n) o[n] = p[n] * e[n];
            }
            if constexpr (F8OUT) {
                unsigned w0 = 0u, w1 = 0u;
                w0 = __builtin_amdgcn_cvt_pk_fp8_f32(clamp448(o[0][0]), clamp448(o[0][1]), w0, false); w0 = __builtin_amdgcn_cvt_pk_fp8_f32(clamp448(o[0][2]), clamp448(o[0][3]), w0, true);
                w1 = __builtin_amdgcn_cvt_pk_fp8_f32(clamp448(o[1][0]), clamp448(o[1][1]), w1, false); w1 = __builtin_amdgcn_cvt_pk_fp8_f32(clamp448(o[1][2]), clamp448(o[1][3]), w1, true);
                typedef unsigned u32x2 __attribute__((ext_vector_type(2)));
                *(u32x2*)((unsigned char*)H + (size_t)row * ldh + col0) = (u32x2){w0, w1};
            } else {
                st16_wt((bf16_t*)H + (size_t)row * ldh + col0, pack8(o[0], o[1]));
            }
        }
    }
    __device__ __forceinline__ void operator()(const f32x4 (&acc)[2][2][4][2], const Unit& u, int wr, int wc, int fr, int fq) const { half(acc, u, 0, wr, wc, fr, fq); half(acc, u, 1, wr, wc, fr, fq); }
};
typedef EpiSwigluT<false> EpiSwiglu;
typedef EpiSwigluT<true> EpiSwigluF8;
constexpr int EPI_TAB_OFF = 131072 + 1024;
template <bool LITE, bool F8X = false> struct EpiResidT {
    static constexpr bool PERM = true, AFTER_DRAIN = false, NEEDS_ALIGN = !LITE;
    bf16_t* xb; float* ssn; unsigned char* xq = nullptr; float ascale = 1.0f;
    __device__ __forceinline__ void operator()(const f32x4 (&acc)[2][2][4][2], const Unit& u, int wr, int wc, int fr, int fq) const {
        extern __shared__ __attribute__((aligned(16))) unsigned char lds_all[];
        asm volatile("" : "+v"(fr), "+v"(fq));
        PG8_LAS float* T = (PG8_LAS float*)((PG8_LAS unsigned char*)lds_all + EPI_TAB_OFF);
        const int row0 = u.pm * BM + wr * 64 + fr, col0 = u.pn * BM + wc * 32 + 8 * fq;
        u32x4 xv[2][4][2];
#pragma unroll
        for (int ai = 0; ai < 2; ++ai)
#pragma unroll
            for (int m = 0; m < 4; ++m)
#pragma unroll
                for (int bj = 0; bj < 2; ++bj) xv[ai][m][bj] = *(const u32x4*)(xb + (size_t)(row0 + ai * HALF + m * 16) * 1024 + col0 + bj * HALF);
        asm volatile("" ::: "memory");
#pragma unroll
        for (int ai = 0; ai < 2; ++ai) {
#pragma unroll
            for (int m = 0; m < 4; ++m) {
                const int row = row0 + ai * HALF + m * 16; float sq = 0.f;
#pragma unroll
                for (int bj = 0; bj < 2; ++bj) {
                    const u32x4 w = xv[ai][m][bj];
                    f32x4 x0 = {__uint_as_float(w.x << 16), __uint_as_float(w.x & 0xffff0000u), __uint_as_float(w.y << 16), __uint_as_float(w.y & 0xffff0000u)};
                    f32x4 x1 = {__uint_as_float(w.z << 16), __uint_as_float(w.z & 0xffff0000u), __uint_as_float(w.w << 16), __uint_as_float(w.w & 0xffff0000u)};
                    x0 += acc[ai][bj][m][0] * ascale; x1 += acc[ai][bj][m][1] * ascale;
                    st16_wt(xb + (size_t)row * 1024 + col0 + bj * HALF, pack8(x0, x1));
                    if constexpr (F8X) { unsigned w0 = 0u, w1 = 0u;
                        w0 = __builtin_amdgcn_cvt_pk_fp8_f32(clamp448(x0[0] * 8.0f), clamp448(x0[1] * 8.0f), w0, false); w0 = __builtin_amdgcn_cvt_pk_fp8_f32(clamp448(x0[2] * 8.0f), clamp448(x0[3] * 8.0f), w0, true);
                        w1 = __builtin_amdgcn_cvt_pk_fp8_f32(clamp448(x1[0] * 8.0f), clamp448(x1[1] * 8.0f), w1, false); w1 = __builtin_amdgcn_cvt_pk_fp8_f32(clamp448(x1[2] * 8.0f), clamp448(x1[3] * 8.0f), w1, true);
                        st8_wt(xq + (size_t)row * 1024 + col0 + bj * HALF, (wt_u32x2){w0, w1}); }
                    if constexpr (!LITE) sq += (x0[0] * x0[0] + x0[1] * x0[1]) + (x0[2] * x0[2] + x0[3] * x0[3]) + (x1[0] * x1[0] + x1[1] * x1[1]) + (x1[2] * x1[2] + x1[3] * x1[3]);
                }
                if constexpr (!LITE) { sq += __shfl_xor(sq, 16); sq += __shfl_xor(sq, 32);
                    if (fq == 0) T[(ai * HALF + wr * 64 + m * 16 + fr) * 4 + wc] = sq; }
            }
        }
        if constexpr (!LITE) {
        asm volatile("s_waitcnt lgkmcnt(0)\n\ts_barrier" ::: "memory");
        if (wc == 0 && fq == 0) {
#pragma unroll
            for (int ai = 0; ai < 2; ++ai)
#pragma unroll
                for (int m = 0; m < 4; ++m) { const int lr = ai * HALF + wr * 64 + m * 16 + fr; const f32x4 p = *(const PG8_LAS f32x4*)(T + lr * 4);
                    ssn[(size_t)(u.pm * BM + lr) * 4 + u.pn] = (p[0] + p[1]) + (p[2] + p[3]); }
        } }
    }
};
typedef EpiResidT<false> EpiResid;
typedef EpiResidT<true> EpiResidLite;
typedef EpiResidT<false, true> EpiResidF8X;
struct EpiSlot {
    static constexpr bool PERM = true, AFTER_DRAIN = false, NEEDS_ALIGN = false;
    bf16_t* Y; const float* wslot; float ascale;
    __device__ __forceinline__ void operator()(const f32x4 (&acc)[2][2][4][2], const Unit& u, int wr, int wc, int fr, int fq) const {
        asm volatile("" : "+v"(fr), "+v"(fq));
        const int row0 = u.pm * BM + wr * 64 + fr, col0 = u.pn * BM + wc * 32 + 8 * fq;
        float w[2][4];
#pragma unroll
        for (int ai = 0; ai < 2; ++ai)
#pragma unroll
            for (int m = 0; m < 4; ++m) w[ai][m] = wslot[u.ps * BM + wr * 64 + fr + ai * HALF + m * 16] * ascale;
        asm volatile("" ::: "memory");
#pragma unroll
        for (int ai = 0; ai < 2; ++ai)
#pragma unroll
            for (int m = 0; m < 4; ++m) {
                const int row = row0 + ai * HALF + m * 16;
#pragma unroll
                for (int bj = 0; bj < 2; ++bj) st16_wt(Y + (size_t)row * 1024 + col0 + bj * HALF, pack8(acc[ai][bj][m][0] * w[ai][m], acc[ai][bj][m][1] * w[ai][m]));
            }
    }
};

__device__ __forceinline__ void glds16s(unsigned voff, const void* sbase, unsigned lds_dst) { unsigned keep;
    asm volatile("s_mov_b32 %0, m0\n\ts_mov_b32 m0, %3\n\ts_nop 0\n\tglobal_load_lds_dwordx4 %1, %2\n\ts_mov_b32 m0, %0" : "=&s"(keep) : "v"(voff), "s"(sbase), "s"(lds_dst) : "memory"); }
typedef int v8i_t __attribute__((ext_vector_type(8))); typedef int v4i_t __attribute__((ext_vector_type(4)));
__device__ __forceinline__ v8i_t cat16(bf16x8 lo, bf16x8 hi) { const v4i_t a = __builtin_bit_cast(v4i_t, lo), b = __builtin_bit_cast(v4i_t, hi); return __builtin_shufflevector(a, b, 0, 1, 2, 3, 4, 5, 6, 7); }
template <class Epi, class Sched, bool ALIGN_EPI = false, bool SP2 = false, bool FP8 = false>
__device__ __forceinline__ void gemm_phase(PG8_LAS unsigned char* lds, const Gemm g, const Sched& S, const Epi& E) {
    const int tid = opaque_tid(), wid = __builtin_amdgcn_readfirstlane(tid >> 6), lane = tid & 63, wr = wid >> 2, wc = wid & 3, fr = lane & 15, fq = lane >> 4;
    const int K = FP8 ? g.K / 2 : g.K, nt = K / BK;
    unsigned voffA[2], voffB[2];
#pragma unroll
    for (int i = 0; i < 2; ++i) { int R, C; stage_rc(tid * 16 + i * 8192, R, C); const int Rb = Epi::PERM ? ((R & ~31) + perm32(R & 31)) : R;
        voffA[i] = (unsigned)(R * K + C) * 2u; voffB[i] = (unsigned)(Rb * K + C) * 2u; }
    const size_t kstep = (size_t)(BK * 2);
    const size_t hstep = (size_t)HALF * K * 2;
    const size_t tstep = 2 * hstep;
    const unsigned ldsw = (unsigned)wid * 1024u; const unsigned ldsb = (unsigned)__builtin_amdgcn_readfirstlane((int)((unsigned)(size_t)lds + ldsw));
    const int aoff = lds_byte(wr * 64 + fr, fq * 8), boff = lds_byte(wc * 32 + fr, fq * 8);
#define PG8_SA(b, h) (((b) * 2 + (h)) * HTB)
#define PG8_SB(b, h) ((4 + (b) * 2 + (h)) * HTB)
#define PG8_STAGE(bufoff, gbase, voff) do { _Pragma("unroll") for (int _i = 0; _i < 2; ++_i) \
        glds16s((voff)[_i], (const void*)(gbase), ldsb + (unsigned)((bufoff) + _i * 8192)); } while (0)
#define PG8_LDA(dst, b, h) do { _Pragma("unroll") for (int m = 0; m < 4; ++m) _Pragma("unroll") for (int k = 0; k < 2; ++k) dst[m][k] = *(const PG8_LAS bf16x8*)(lds + PG8_SA(b, h) + aoff + m * 2048 + k * 1024); } while (0)
#define PG8_LDB(dst, b, h) do { _Pragma("unroll") for (int n = 0; n < 2; ++n) _Pragma("unroll") for (int k = 0; k < 2; ++k) dst[n][k] = *(const PG8_LAS bf16x8*)(lds + PG8_SB(b, h) + boff + n * 2048 + k * 1024); } while (0)
#define PG8_MMA(ai, bj, At, Bt) do { __builtin_amdgcn_s_setprio(1); _Pragma("unroll") for (int m = 0; m < 4; ++m) _Pragma("unroll") for (int n = 0; n < 2; ++n) { \
        if constexpr (FP8) { const v8i_t bo_ = cat16(Bt[n][0], Bt[n][1]), ao_ = cat16(At[m][0], At[m][1]); \
            asm volatile("v_mfma_f32_16x16x128_f8f6f4 %0, %1, %2, %0" : "+v"(acc[ai][bj][m][n]) : "v"(bo_), "v"(ao_)); }     \
        else { _Pragma("unroll") for (int k = 0; k < 2; ++k) acc[ai][bj][m][n] = __builtin_amdgcn_mfma_f32_16x16x32_bf16(Bt[n][k], At[m][k], acc[ai][bj][m][n], 0, 0, 0); } } \
        __builtin_amdgcn_s_setprio(0); } while (0)
#define PG8_WAIT_V(n) asm volatile("s_waitcnt vmcnt(" #n ")" ::: "memory")
#define PG8_WAIT_L(n) asm volatile("s_waitcnt lgkmcnt(" #n ")" ::: "memory")
#define PG8_BAR __builtin_amdgcn_s_barrier()
#define PG8_SCHED __builtin_amdgcn_sched_barrier(0)
    Unit cur, nxt; int ui = 0;
    if (!S.next(0, cur)) return;
    f32x4 acc[2][2][4][2];
#pragma unroll
    for (int a = 0; a < 2; ++a)
#pragma unroll
        for (int b = 0; b < 2; ++b)
#pragma unroll
            for (int m = 0; m < 4; ++m)
#pragma unroll
                for (int n = 0; n < 2; ++n) { acc[a][b][m][n] = (f32x4){0.f, 0.f, 0.f, 0.f}; asm volatile("" : "+v"(acc[a][b][m][n])); }
    bf16x8 At[4][2], B0[2][2], B1[2][2];
    const char* cA = (const char*)g.A + (size_t)cur.pa * tstep; const char* cB = (const char*)g.Bt + (size_t)cur.be * g.bstride + (size_t)cur.pn * tstep;
    S.a_ready(cur);
    if constexpr (SP2) {
        PG8_STAGE(PG8_SB(0, 0), cB, voffB); PG8_STAGE(PG8_SB(0, 1), cB + hstep, voffB); PG8_STAGE(PG8_SA(0, 0), cA, voffA); PG8_STAGE(PG8_SA(0, 1), cA + hstep, voffA);
        if (wr == 1) PG8_BAR;
        PG8_WAIT_V(2); PG8_BAR;
        PG8_STAGE(PG8_SB(1, 0), cB + kstep, voffB); PG8_STAGE(PG8_SA(1, 0), cA + kstep, voffA); PG8_STAGE(PG8_SB(1, 1), cB + hstep + kstep, voffB);
        PG8_WAIT_V(6); PG8_BAR;
    } else {
        PG8_STAGE(PG8_SB(0, 0), cB, voffB); PG8_STAGE(PG8_SA(0, 0), cA, voffA); PG8_STAGE(PG8_SB(0, 1), cB + hstep, voffB); PG8_STAGE(PG8_SA(0, 1), cA + hstep, voffA);
        if (wr == 1) PG8_BAR;
        PG8_WAIT_V(4); PG8_BAR;
        PG8_STAGE(PG8_SB(1, 0), cB + kstep, voffB); PG8_STAGE(PG8_SA(1, 0), cA + kstep, voffA); PG8_STAGE(PG8_SB(1, 1), cB + hstep + kstep, voffB);
        PG8_WAIT_V(6); PG8_BAR;
    }
    for (;;) {
        const bool has_next = S.next(ui + 1, nxt);
        const char* nA = has_next ? (const char*)g.A + (size_t)nxt.pa * tstep : cA; const char* nB = has_next ? (const char*)g.Bt + (size_t)nxt.be * g.bstride + (size_t)nxt.pn * tstep : cB;
#pragma nounroll
        for (int t = 0; t < nt; t += 2) {
            const bool last = (t == nt - 2);
            const char* a1 = cA + (size_t)(t + 1) * kstep;
            const char* a2 = last ? nA : cA + (size_t)(t + 2) * kstep; const char* b2 = last ? nB : cB + (size_t)(t + 2) * kstep;
            const char* a3 = a2 + kstep; const char* b3 = b2 + kstep;
            if (last && has_next) S.a_ready(nxt);
            if constexpr (SP2) {
            PG8_LDB(B0, 0, 0); PG8_LDB(B1, 0, 1); PG8_SCHED; PG8_LDA(At, 0, 0); PG8_STAGE(PG8_SA(1, 1), a1 + hstep, voffA);
            PG8_WAIT_V(8); PG8_WAIT_L(0); PG8_BAR; PG8_MMA(0, 0, At, B0); PG8_MMA(0, 1, At, B1); PG8_BAR; PG8_SCHED;
            PG8_LDA(At, 0, 1); PG8_STAGE(PG8_SB(0, 0), b2, voffB); PG8_STAGE(PG8_SB(0, 1), b2 + hstep, voffB); PG8_STAGE(PG8_SA(0, 0), a2, voffA);
            PG8_WAIT_V(8); PG8_WAIT_L(0); PG8_BAR; PG8_MMA(1, 0, At, B0); PG8_MMA(1, 1, At, B1); PG8_BAR; PG8_SCHED;
            PG8_LDB(B0, 1, 0); PG8_LDB(B1, 1, 1); PG8_SCHED; PG8_LDA(At, 1, 0); PG8_STAGE(PG8_SA(0, 1), a2 + hstep, voffA);
            PG8_WAIT_V(8); PG8_WAIT_L(0); PG8_BAR; PG8_MMA(0, 0, At, B0); PG8_MMA(0, 1, At, B1); PG8_BAR; PG8_SCHED;
            PG8_LDA(At, 1, 1); PG8_STAGE(PG8_SB(1, 0), b3, voffB); PG8_STAGE(PG8_SB(1, 1), b3 + hstep, voffB); PG8_STAGE(PG8_SA(1, 0), a3, voffA);
            PG8_WAIT_V(8); PG8_WAIT_L(0); PG8_BAR; PG8_MMA(1, 0, At, B0); PG8_MMA(1, 1, At, B1); PG8_BAR; PG8_SCHED;
            } else {
            PG8_LDB(B0, 0, 0); PG8_SCHED; PG8_LDA(At, 0, 0); PG8_STAGE(PG8_SA(1, 1), a1 + hstep, voffA);
            PG8_WAIT_L(8); PG8_BAR; PG8_WAIT_L(0); PG8_MMA(0, 0, At, B0); PG8_BAR; PG8_SCHED;
            PG8_LDB(B1, 0, 1); PG8_STAGE(PG8_SB(0, 0), b2, voffB);
            PG8_BAR; PG8_WAIT_L(0); PG8_MMA(0, 1, At, B1); PG8_BAR;
            PG8_LDA(At, 0, 1); PG8_STAGE(PG8_SA(0, 0), a2, voffA);
            PG8_BAR; PG8_WAIT_L(0); PG8_MMA(1, 0, At, B0); PG8_BAR; PG8_SCHED;
            PG8_STAGE(PG8_SB(0, 1), b2 + hstep, voffB);
            PG8_WAIT_V(6); PG8_BAR; PG8_MMA(1, 1, At, B1); PG8_BAR;
            PG8_LDB(B0, 1, 0); PG8_SCHED; PG8_LDA(At, 1, 0); PG8_STAGE(PG8_SA(0, 1), a2 + hstep, voffA);
            PG8_WAIT_L(8); PG8_BAR; PG8_WAIT_L(0); PG8_MMA(0, 0, At, B0); PG8_BAR; PG8_SCHED;
            PG8_LDB(B1, 1, 1); PG8_STAGE(PG8_SB(1, 0), b3, voffB);
            PG8_BAR; PG8_WAIT_L(0); PG8_MMA(0, 1, At, B1); PG8_BAR;
            PG8_LDA(At, 1, 1); PG8_STAGE(PG8_SA(1, 0), a3, voffA);
            PG8_BAR; PG8_WAIT_L(0); PG8_MMA(1, 0, At, B0); PG8_BAR; PG8_SCHED;
            PG8_STAGE(PG8_SB(1, 1), b3 + hstep, voffB);
            PG8_WAIT_V(6); PG8_BAR; PG8_MMA(1, 1, At, B1); PG8_BAR;
            }
        }
        if constexpr (ALIGN_EPI) { if (wr == 0) PG8_BAR; }
        static_assert(ALIGN_EPI || !Epi::NEEDS_ALIGN, "this epilogue contains a workgroup barrier: both halves must run it together");
        if constexpr (!Epi::AFTER_DRAIN) { E(acc, cur, wr, wc, fr, fq); S.done(cur); }
        if (!has_next) break;
#pragma unroll
        for (int a = 0; a < 2; ++a)
#pragma unroll
            for (int b = 0; b < 2; ++b)
#pragma unroll
                for (int m = 0; m < 4; ++m)
#pragma unroll
                    for (int n = 0; n < 2; ++n) { acc[a][b][m][n] = (f32x4){0.f, 0.f, 0.f, 0.f}; asm volatile("" : "+v"(acc[a][b][m][n])); }
        cur = nxt; cA = nA; cB = nB; ++ui;
        if constexpr (ALIGN_EPI) { if (wr == 1) PG8_BAR; }
    }
    PG8_WAIT_V(0);
    if constexpr (!ALIGN_EPI) { if (wr == 0) PG8_BAR; }
    PG8_BAR;
#undef PG8_SA
#undef PG8_SB
#undef PG8_STAGE
#undef PG8_LDA
#undef PG8_LDB
#undef PG8_MMA
#undef PG8_WAIT_V
#undef PG8_WAIT_L
#undef PG8_BAR
#undef PG8_SCHED
}

}

#ifndef PG8_SP2
#define PG8_SP2 true
#endif
#ifndef PG8_ALIGN
#define PG8_ALIGN true
#endif

namespace attn_body {
using bf16=__hip_bfloat16;
using bf16x8=__attribute__((ext_vector_type(8)))short;
using s16x4=__attribute__((ext_vector_type(4)))short;
using f32x16=__attribute__((ext_vector_type(16)))float;
using u32x4=__attribute__((ext_vector_type(4)))unsigned;
constexpr int D=64;
constexpr int PQ=1024,PK=1024,PV=1024,PO=2048;
constexpr int NW=8,QBLK=32,QB=QBLK*NW,KVBLK=64;
__device__ __forceinline__ int crow(int r,int hi){return (r&3)+8*(r>>2)+4*hi;}
#define SBAR() __builtin_amdgcn_sched_barrier(0)
__device__ __forceinline__ void cmask(f32x16&p0,f32x16&p1,int jb,int qrel,int hi){
  const float NEG=-INFINITY; int kb=64*jb+4*hi;
  #pragma unroll
  for(int r=0;r<16;++r){int kv=kb+(r&3)+8*(r>>2); if(kv>qrel)p0[r]=NEG; if(kv+32>qrel)p1[r]=NEG;}
}
constexpr int NSLOT=3, SLOTB=8192;
constexpr int LDS_K=0, LDS_V=NSLOT*SLOTB, LDS_WS=2*NSLOT*SLOTB, LDS_OST=LDS_WS+NW*64*4, LDS_BYTES=LDS_OST+NW*4096;
constexpr float C2=0.125f*1.4426950408889634f;
__device__ __forceinline__ void glds16(const void*gsrc,unsigned lds_dst){unsigned keep;
  asm volatile("s_mov_b32 %0, m0\n\ts_mov_b32 m0, %2\n\ts_nop 0\n\tglobal_load_lds_dwordx4 %1, off\n\ts_mov_b32 m0, %0":"=&s"(keep):"v"(gsrc),"s"(lds_dst):"memory");}
__device__ __forceinline__ float max3f(float a,float b,float c){float r;asm("v_max3_f32 %0, %1, %2, %3":"=v"(r):"v"(a),"v"(b),"v"(c));return r;}
__device__ __forceinline__ float max2f(float a,float b){float r;asm("v_max_f32_e32 %0, %1, %2":"=v"(r):"v"(a),"v"(b));return r;}
__device__ __forceinline__ float fadd_s(float a,float b){float r;asm("v_add_f32_e32 %0, %1, %2":"=v"(r):"v"(a),"v"(b));return r;}
__device__ __forceinline__ float fsub_s(float a,float b){float r;asm("v_sub_f32_e32 %0, %1, %2":"=v"(r):"v"(a),"v"(b));return r;}
typedef float f32x2_t __attribute__((ext_vector_type(2))); typedef __bf16 bf16x2_t __attribute__((ext_vector_type(2)));
__device__ __forceinline__ unsigned cvtpk_s(float lo,float hi){f32x2_t v={lo,hi};bf16x2_t b=__builtin_convertvector(v,bf16x2_t);return __builtin_bit_cast(unsigned,b);}
#define WAIT_BAR(N) asm volatile("s_waitcnt vmcnt(" #N ") lgkmcnt(0)\n\ts_barrier":::"memory")

__device__ __forceinline__ void qkt(f32x16&p0,f32x16&p1,const char*Kslot,const bf16x8*qr,const f32x16&negm,int r32,int hi){
  const char*kb=Kslot+hi*1024+r32*16;
  #pragma unroll
  for(int d0=0;d0<4;++d0){
    const bf16x8 b0=*reinterpret_cast<const bf16x8*>(kb+d0*2048);
    const bf16x8 b1=*reinterpret_cast<const bf16x8*>(kb+d0*2048+512);
    if(d0==0){p0=__builtin_amdgcn_mfma_f32_32x32x16_bf16(b0,qr[0],negm,0,0,0);p1=__builtin_amdgcn_mfma_f32_32x32x16_bf16(b1,qr[0],negm,0,0,0);}
    else{p0=__builtin_amdgcn_mfma_f32_32x32x16_bf16(b0,qr[d0],p0,0,0,0);p1=__builtin_amdgcn_mfma_f32_32x32x16_bf16(b1,qr[d0],p1,0,0,0);}}
}
typedef __attribute__((address_space(3))) const char* lds_cptr;
typedef short v4i16_t __attribute__((ext_vector_type(4)));
__device__ __forceinline__ void kload8(bf16x8*kf,lds_cptr kp){
  kf[0]=*(const __attribute__((address_space(3))) bf16x8*)(kp);      kf[1]=*(const __attribute__((address_space(3))) bf16x8*)(kp+512);
  kf[2]=*(const __attribute__((address_space(3))) bf16x8*)(kp+2048); kf[3]=*(const __attribute__((address_space(3))) bf16x8*)(kp+2560);
  kf[4]=*(const __attribute__((address_space(3))) bf16x8*)(kp+4096); kf[5]=*(const __attribute__((address_space(3))) bf16x8*)(kp+4608);
  kf[6]=*(const __attribute__((address_space(3))) bf16x8*)(kp+6144); kf[7]=*(const __attribute__((address_space(3))) bf16x8*)(kp+6656);
}
__device__ __forceinline__ void kload2(bf16x8*kf,lds_cptr kp,int j){ kf[2*j]=*(const __attribute__((address_space(3))) bf16x8*)(kp+j*2048); kf[2*j+1]=*(const __attribute__((address_space(3))) bf16x8*)(kp+j*2048+512); }
__device__ __forceinline__ s16x4 vtr(lds_cptr p){ return __builtin_bit_cast(s16x4,__builtin_amdgcn_ds_read_tr16_b64_v4i16((__attribute__((address_space(3))) v4i16_t*)p)); }
__device__ __forceinline__ float rowmax(const f32x16&p0,const f32x16&p1){
  float a=max3f(p0[0],p0[1],p1[0]),b=max3f(p0[2],p0[3],p1[1]);a=max3f(a,p1[2],p1[3]);
  #pragma unroll
  for(int r=4;r<16;r+=4){a=max3f(a,p0[r],p0[r+1]);b=max3f(b,p0[r+2],p0[r+3]);a=max3f(a,p1[r],p1[r+1]);b=max3f(b,p1[r+2],p1[r+3]);}
  const float m=max2f(a,b);
  auto rr=__builtin_amdgcn_permlane32_swap(__float_as_uint(m),__float_as_uint(m),false,false);
  return max2f(__uint_as_float(rr[0]),__uint_as_float(rr[1]));
}
__device__ __forceinline__ void pv(f32x16*o,int vb,bf16x8 pa0,bf16x8 pa1,bf16x8 pa2,bf16x8 pa3){
  #pragma unroll
  for(int d0=0;d0<2;++d0){s16x4 lo[4],hi[4];
    #pragma unroll
    for(int ks=0;ks<4;++ks){
      asm volatile("ds_read_b64_tr_b16 %0,%1 offset:%c2":"=&v"(lo[ks]):"v"(vb),"i"(d0*4096+ks*1024):"memory");
      asm volatile("ds_read_b64_tr_b16 %0,%1 offset:%c2":"=&v"(hi[ks]):"v"(vb),"i"(d0*4096+ks*1024+512):"memory");}
    asm volatile("s_waitcnt lgkmcnt(0)":::"memory");SBAR();
    #define PK(k) (bf16x8){lo[k][0],lo[k][1],lo[k][2],lo[k][3],hi[k][0],hi[k][1],hi[k][2],hi[k][3]}
    o[d0]=__builtin_amdgcn_mfma_f32_32x32x16_bf16(pa0,PK(0),o[d0],0,0,0);
    o[d0]=__builtin_amdgcn_mfma_f32_32x32x16_bf16(pa1,PK(1),o[d0],0,0,0);
    o[d0]=__builtin_amdgcn_mfma_f32_32x32x16_bf16(pa2,PK(2),o[d0],0,0,0);
    o[d0]=__builtin_amdgcn_mfma_f32_32x32x16_bf16(pa3,PK(3),o[d0],0,0,0);
    #undef PK
  }
}
#ifndef ATTN_STORE16
#define ATTN_STORE16(p,v) st16_wt((void*)(p),(v))
#endif
template<int THRL> __device__ __forceinline__ void attn_unit(int qb,const bf16*Qh,const bf16*__restrict__ Kh,const bf16*__restrict__ Vh,bf16*Oh,char*shm){
  const int tid=opaque_tid(),lane=tid&63,r32=lane&31,hi=lane>>5; const int wid=__builtin_amdgcn_readfirstlane(tid>>6);
  const int q0=qb*QB;
  const bf16*Qw=Qh+(long)(q0+wid*QBLK)*PQ;
  const unsigned lds0=(unsigned)(uintptr_t)shm;
  float*wsf=(float*)(shm+LDS_WS)+wid*64;
  const bf16*ksrc=Kh+(long)lane*PK+wid*8;
  const bf16*vsrc=Vh+(long)(16*(wid&3)+(lane>>2))*PV+(wid>>2)*32+(lane&3)*8;
  const unsigned kdst=lds0+LDS_K+wid*1024, vdst=lds0+LDS_V+wid*1024;
  #define DMA_K(t,slot) glds16(ksrc+(long)(t)*KVBLK*PK,(unsigned)__builtin_amdgcn_readfirstlane(kdst+(slot)))
  #define DMA_V(t,slot) glds16(vsrc+(long)(t)*KVBLK*PV,(unsigned)__builtin_amdgcn_readfirstlane(vdst+(slot)))
  const int vb0=(int)(lds0+LDS_V)+((lane>>4)&1)*32+(lane&3)*8+(4*hi+((lane&15)>>2))*64;
  const char*Kbase=shm+LDS_K; bf16x8 kf[8];
  const lds_cptr shm3=(lds_cptr)shm; const lds_cptr kp0=shm3+LDS_K+hi*1024+r32*16; const lds_cptr vp0=shm3+LDS_V+((lane>>4)&1)*32+(lane&3)*8+(4*hi+((lane&15)>>2))*64;
  const int NT=(q0+QB)/KVBLK;
  DMA_K(0,0);DMA_V(0,0);DMA_K(1,SLOTB);
  bf16x8 qr[4];
  #pragma unroll
  for(int d0=0;d0<4;++d0)qr[d0]=*reinterpret_cast<const bf16x8*>(&Qw[(long)r32*PQ+d0*16+hi*8]);
  float mhat=0.f,l_reg=0.f;f32x16 o[2];o[0]=f32x16{};o[1]=f32x16{};f32x16 negm=f32x16{};asm volatile("":"+v"(negm));
  const int qrel=wid*QBLK+r32;
  #define CMASK(P0,P1,t) do{int jb_=(t)-(NT-4); if(jb_>=0)cmask(P0,P1,jb_,qrel,hi);}while(0)
  bool resc=false;
  #define START(P0,P1) do{ const float rm=rowmax(P0,P1); resc=false; \
    { const float dl=rm; mhat=fadd_s(mhat,dl); \
      _Pragma("unroll") for(int r=0;r<16;++r){P0[r]=fsub_s(P0[r],dl);P1[r]=fsub_s(P1[r],dl);} \
      _Pragma("unroll") for(int r=0;r<16;++r)negm[r]=-mhat; asm volatile("":"+v"(negm)); } \
    _Pragma("unroll") for(int r=0;r<16;++r)P0[r]=__builtin_amdgcn_exp2f(P0[r]); }while(0)
  #define RESC() do{ if(resc){ asm volatile("s_waitcnt lgkmcnt(0)":::"memory"); \
      _Pragma("unroll") for(int d_=0;d_<2;++d_) _Pragma("unroll") for(int r=0;r<16;++r)o[d_][r]*=wsf[crow(r,hi)]; } }while(0)
  f32x16 pA0,pA1,pB0,pB1;
  int sl_prev=0,sl_cur=0,sl_next=SLOTB;
  #define ROT() do{sl_prev=sl_cur;sl_cur=sl_next;sl_next=(sl_next==(NSLOT-1)*SLOTB)?0:sl_next+SLOTB;}while(0)
  DMA_K(2,2*SLOTB);
  WAIT_BAR(3);
  qkt(pA0,pA1,Kbase,qr,negm,r32,hi);asm volatile("s_nop 15\n\ts_nop 7":"+v"(pA0),"+v"(pA1));CMASK(pA0,pA1,0);
  START(pA0,pA1);
  _Pragma("unroll") for(int r=0;r<16;++r)pA1[r]=__builtin_amdgcn_exp2f(pA1[r]);
  WAIT_BAR(0);
  DMA_K(3,0);DMA_V(1,SLOTB);
  ROT();
  kload8(kf,kp0+sl_cur);
  WAIT_BAR(2);
  s16x4 vlo[8],vhi[8]; u32x4 pw0,pw1,pw2,pw3;
  #define PKW(P,B) cvtpk_s(P[B],P[B+1])
  #define PAF(k) __builtin_bit_cast(bf16x8,pw##k)
  #define VFR(i) (bf16x8){vlo[i][0],vlo[i][1],vlo[i][2],vlo[i][3],vhi[i][0],vhi[i][1],vhi[i][2],vhi[i][3]}
  #define PIN(x) asm volatile("":"+v"(x))
  #define MX3(a,b,c) __builtin_fmaxf(__builtin_fmaxf((a),(b)),(c))
  #define GAPA(MF,A0,A1,A2,A3,W0,W1,PW) do{ MF; sacc+=A0; sacc+=A1; sacc+=A2; sacc+=A3; PIN(sacc); W0; W1; PIN(PW); SBAR(); }while(0)
  #define EX(v) __builtin_amdgcn_exp2f(v)
  #define GAPB(MF,X,B) do{ MF; X[B]=EX(X[B]); X[B+1]=EX(X[B+1]); X[B+2]=EX(X[B+2]); X[B+3]=EX(X[B+3]); PIN(X); SBAR(); }while(0)
  #define VRD(i) do{ vlo[i]=vtr(vp_+(((i)>>2)*4096+((i)&3)*1024)); vhi[i]=vtr(vp_+(((i)>>2)*4096+((i)&3)*1024+512)); }while(0)
  #define KRD(G,j) do{ if(G){ kload2(kf,kp0+sl_next,j); SBAR(); } }while(0)
  #define STEP(C0,C1,P0,P1,t,GK,GV,GL) do{ SBAR(); \
    const lds_cptr vp_=vp0+sl_prev; \
    VRD(0); SBAR(); float sacc=(P0[0]+P0[1]); \
    GAPA(C0=__builtin_amdgcn_mfma_f32_32x32x16_bf16(kf[0],qr[0],negm,0,0,0), P0[2],P0[3],P0[4],P0[5],     pw0[0]=PKW(P0,0), pw0[1]=PKW(P0,2), pw0); \
    VRD(4); SBAR(); GAPA(C1=__builtin_amdgcn_mfma_f32_32x32x16_bf16(kf[1],qr[0],negm,0,0,0), P0[6],P0[7],P0[8],P0[9],     pw0[2]=PKW(P0,4), pw0[3]=PKW(P0,6), pw0); \
    VRD(1); SBAR(); GAPA(C0=__builtin_amdgcn_mfma_f32_32x32x16_bf16(kf[2],qr[1],C0,0,0,0),   P0[10],P0[11],P0[12],P0[13], pw1[0]=PKW(P0,8), pw1[1]=PKW(P0,10), pw1); \
    VRD(5); SBAR(); GAPA(C1=__builtin_amdgcn_mfma_f32_32x32x16_bf16(kf[3],qr[1],C1,0,0,0),   P0[14],P0[15],P1[0],P1[1],   pw1[2]=PKW(P0,12),pw1[3]=PKW(P0,14), pw1); \
    VRD(2); SBAR(); GAPA(C0=__builtin_amdgcn_mfma_f32_32x32x16_bf16(kf[4],qr[2],C0,0,0,0),   P1[2],P1[3],P1[4],P1[5],     pw2[0]=PKW(P1,0), pw2[1]=PKW(P1,2), pw2); \
    VRD(6); SBAR(); GAPA(C1=__builtin_amdgcn_mfma_f32_32x32x16_bf16(kf[5],qr[2],C1,0,0,0),   P1[6],P1[7],P1[8],P1[9],     pw2[2]=PKW(P1,4), pw2[3]=PKW(P1,6), pw2); \
    VRD(3); SBAR(); GAPA(C0=__builtin_amdgcn_mfma_f32_32x32x16_bf16(kf[6],qr[3],C0,0,0,0),   P1[10],P1[11],P1[12],P1[13], pw3[0]=PKW(P1,8), pw3[1]=PKW(P1,10), pw3); \
    VRD(7); SBAR(); GAPA(C1=__builtin_amdgcn_mfma_f32_32x32x16_bf16(kf[7],qr[3],C1,0,0,0),   P1[14],P1[15],0.f,0.f,       pw3[2]=PKW(P1,12),pw3[3]=PKW(P1,14), pw3); \
    l_reg+=sacc; \
    if(GK){DMA_K((t)+3,sl_cur);} if(GV){DMA_V((t)+1,sl_next);} \
    CMASK(C0,C1,t); \
    { float a=MX3(C0[0],C0[1],C1[0]),b=MX3(C0[2],C0[3],C1[1]); a=MX3(a,C1[2],C1[3]); \
      _Pragma("unroll") for(int r=4;r<16;r+=4){a=MX3(a,C0[r],C0[r+1]);b=MX3(b,C0[r+2],C0[r+3]);a=MX3(a,C1[r],C1[r+1]);b=MX3(b,C1[r+2],C1[r+3]);} \
      float rm=__builtin_fmaxf(a,b); { auto rr=__builtin_amdgcn_permlane32_swap(__float_as_uint(rm),__float_as_uint(rm),false,false); rm=__builtin_fmaxf(__uint_as_float(rr[0]),__uint_as_float(rr[1])); } \
      resc=false; \
      if(__builtin_expect(__any(rm>(float)THRL),0)){ const float dl=__builtin_fmaxf(rm,0.f); mhat+=dl; \
        _Pragma("unroll") for(int r=0;r<16;++r){C0[r]-=dl;C1[r]-=dl;} \
        _Pragma("unroll") for(int r=0;r<16;++r)negm[r]=-mhat; asm volatile("":"+v"(negm)); \
        const float f=__builtin_amdgcn_exp2f(-dl); l_reg*=f; if(hi==0)wsf[r32]=f; resc=true; } } \
    SBAR(); \
    GAPB(o[0]=__builtin_amdgcn_mfma_f32_32x32x16_bf16(PAF(0),VFR(0),o[0],0,0,0), C0,0); \
    GAPB(o[1]=__builtin_amdgcn_mfma_f32_32x32x16_bf16(PAF(0),VFR(4),o[1],0,0,0), C0,4); \
    KRD(GL,0); GAPB(o[0]=__builtin_amdgcn_mfma_f32_32x32x16_bf16(PAF(1),VFR(1),o[0],0,0,0), C0,8); \
    KRD(GL,1); GAPB(o[1]=__builtin_amdgcn_mfma_f32_32x32x16_bf16(PAF(1),VFR(5),o[1],0,0,0), C0,12); \
    KRD(GL,2); GAPB(o[0]=__builtin_amdgcn_mfma_f32_32x32x16_bf16(PAF(2),VFR(2),o[0],0,0,0), C1,0); \
    KRD(GL,3); GAPB(o[1]=__builtin_amdgcn_mfma_f32_32x32x16_bf16(PAF(2),VFR(6),o[1],0,0,0), C1,4); \
    GAPB(o[0]=__builtin_amdgcn_mfma_f32_32x32x16_bf16(PAF(3),VFR(3),o[0],0,0,0), C1,8); \
    GAPB(o[1]=__builtin_amdgcn_mfma_f32_32x32x16_bf16(PAF(3),VFR(7),o[1],0,0,0), C1,12); \
    }while(0)
  int t=1;
  #undef CMASK
  #define CMASK(P0,P1,t) do{}while(0)
  for(;t+5<NT;t+=2){
    STEP(pB0,pB1,pA0,pA1,t,true,true,true);     WAIT_BAR(2); RESC(); ROT();
    STEP(pA0,pA1,pB0,pB1,t+1,true,true,true);   WAIT_BAR(2); RESC(); ROT();
  }
  #undef CMASK
  #define CMASK(P0,P1,t) do{int jb_=(t)-(NT-4); if(jb_>=0)cmask(P0,P1,jb_,qrel,hi);}while(0)
  #define ENDW(tt) do{ if((tt)+3<NT){WAIT_BAR(2);} else if((tt)+2<NT){WAIT_BAR(1);} else {WAIT_BAR(0);} }while(0)
  for(;t+1<NT;t+=2){
    STEP(pB0,pB1,pA0,pA1,t,(t+3<NT),(t+1<NT),(t+1<NT));       ENDW(t);   RESC(); ROT();
    STEP(pA0,pA1,pB0,pB1,t+1,(t+4<NT),(t+2<NT),(t+2<NT));     ENDW(t+1); RESC(); ROT();
  }
  STEP(pB0,pB1,pA0,pA1,NT-1,false,false,false); RESC();
  { float sacc=pB0[0]+pB0[1]; _Pragma("unroll") for(int r=2;r<16;++r)sacc+=pB0[r]; _Pragma("unroll") for(int r=0;r<16;++r)sacc+=pB1[r]; l_reg+=sacc;
    pw0=(u32x4){PKW(pB0,0),PKW(pB0,2),PKW(pB0,4),PKW(pB0,6)};pw1=(u32x4){PKW(pB0,8),PKW(pB0,10),PKW(pB0,12),PKW(pB0,14)};pw2=(u32x4){PKW(pB1,0),PKW(pB1,2),PKW(pB1,4),PKW(pB1,6)};pw3=(u32x4){PKW(pB1,8),PKW(pB1,10),PKW(pB1,12),PKW(pB1,14)};
    SBAR(); pv(o,vb0+sl_cur,PAF(0),PAF(1),PAF(2),PAF(3)); }
  #undef PKW
  #undef PAF
  #undef VFR
  #undef PIN
  #undef MX3
  #undef GAPA
  #undef GAPB
  #undef EX
  #undef VRD
  #undef KRD
  #undef STEP
  #undef ENDW
  {auto rr=__builtin_amdgcn_permlane32_swap(__float_as_uint(l_reg),__float_as_uint(l_reg),false,false);l_reg=__uint_as_float(rr[0])+__uint_as_float(rr[1]);}
  if(hi==0)wsf[32+r32]=l_reg;asm volatile("s_waitcnt lgkmcnt(0)":::"memory");
  float rli[16];
  #pragma unroll
  for(int r=0;r<16;++r)rli[r]=__builtin_amdgcn_rcpf(wsf[32+crow(r,hi)]);
  bf16*Ow=Oh+(long)(q0+wid*QBLK)*PO;
  { bf16*stg=(bf16*)(shm+LDS_OST)+wid*2048;
    #pragma unroll
    for(int r=0;r<16;++r){const int orow=crow(r,hi);
      #pragma unroll
      for(int d0=0;d0<2;++d0)stg[orow*64+d0*32+r32]=__float2bfloat16(o[d0][r]*rli[r]);}
    asm volatile("s_waitcnt lgkmcnt(0)":::"memory");
    #pragma unroll
    for(int i=0;i<4;++i){const int row=i*8+(lane>>3),ch=lane&7; const u32x4 v=*(const u32x4*)(stg+row*64+ch*8); ATTN_STORE16(Ow+(long)row*PO+ch*8,v);} }
  asm volatile("s_waitcnt lgkmcnt(0)\n\ts_barrier":::"memory");
  #undef DMA_K
  #undef DMA_V
  #undef CMASK
  #undef START
  #undef RESC
  #undef ROT
}

constexpr int VSLOT=2*SLOTB;
constexpr int L2_K=0, L2_V=NSLOT*SLOTB, L2_WS=L2_V+NSLOT*VSLOT, L2_OST=L2_WS+NW*64*4, L2_BYTES=L2_OST+NW*4096;
__device__ __forceinline__ void pv128(f32x16*o,int vb,bf16x8 pa0,bf16x8 pa1,bf16x8 pa2,bf16x8 pa3){
  #pragma unroll
  for(int d0=0;d0<4;++d0){s16x4 lo[4],hi[4];
    #pragma unroll
    for(int ks=0;ks<4;++ks){
      asm volatile("ds_read_b64_tr_b16 %0,%1 offset:%c2":"=&v"(lo[ks]):"v"(vb),"i"(d0*4096+ks*1024):"memory");
      asm volatile("ds_read_b64_tr_b16 %0,%1 offset:%c2":"=&v"(hi[ks]):"v"(vb),"i"(d0*4096+ks*1024+512):"memory");}
    asm volatile("s_waitcnt lgkmcnt(0)":::"memory");SBAR();
    #define PK(k) (bf16x8){lo[k][0],lo[k][1],lo[k][2],lo[k][3],hi[k][0],hi[k][1],hi[k][2],hi[k][3]}
    o[d0]=__builtin_amdgcn_mfma_f32_32x32x16_bf16(pa0,PK(0),o[d0],0,0,0);
    o[d0]=__builtin_amdgcn_mfma_f32_32x32x16_bf16(pa1,PK(1),o[d0],0,0,0);
    o[d0]=__builtin_amdgcn_mfma_f32_32x32x16_bf16(pa2,PK(2),o[d0],0,0,0);
    o[d0]=__builtin_amdgcn_mfma_f32_32x32x16_bf16(pa3,PK(3),o[d0],0,0,0);
    #undef PK
  }
}
struct AttnNext { bool has; int qb; const bf16* Qh; const bf16* Kh; const bf16* Vh; };
struct AttnCarry { bool primed; int s0; bf16x8 qr[4]; };
template<int THRL,class Post> __device__ __forceinline__ void attn_unit128(int qb,const bf16*Qh,const bf16*__restrict__ Kh,const bf16*__restrict__ Vh,bf16*Oh,char*shm,const Post&post,const AttnNext&nx,AttnCarry&cy){
  const int tid=opaque_tid(),lane=tid&63,r32=lane&31,hi=lane>>5; const int wid=__builtin_amdgcn_readfirstlane(tid>>6);
  const int q0=qb*QB;
  const bf16*Qw=Qh+(long)(q0+wid*QBLK)*PQ;
  const unsigned lds0=(unsigned)(uintptr_t)shm;
  float*wsf=(float*)(shm+L2_WS)+wid*64;
  const bf16*ksrc=Kh+(long)lane*PK+wid*8;
  const bf16*vsrc=Vh+(long)(16*(wid&3)+(lane>>2))*PV+(wid>>2)*32+(lane&3)*8;
  const unsigned kdst=lds0+L2_K+wid*1024, vdst=lds0+L2_V+wid*1024;
  #define DMA_K(t,slot) glds16(ksrc+(long)(t)*KVBLK*PK,(unsigned)__builtin_amdgcn_readfirstlane(kdst+(slot)))
  #define DMA_V(t,slot) do{ glds16(vsrc+(long)(t)*KVBLK*PV,(unsigned)__builtin_amdgcn_readfirstlane(vdst+2*(slot))); glds16(vsrc+(long)(t)*KVBLK*PV+64,(unsigned)__builtin_amdgcn_readfirstlane(vdst+2*(slot)+8192)); }while(0)
  const char*Kbase=shm+L2_K; bf16x8 kf[8];
  const lds_cptr shm3=(lds_cptr)shm; const lds_cptr kp0=shm3+L2_K+hi*1024+r32*16; const lds_cptr vp0=shm3+L2_V+((lane>>4)&1)*32+(lane&3)*8+(4*hi+((lane&15)>>2))*64;
  const int NT=(q0+QB)/KVBLK;
  const bool primed=cy.primed; const int s0=primed?cy.s0:0, s1=(s0==(NSLOT-1)*SLOTB)?0:s0+SLOTB, s2=(s1==(NSLOT-1)*SLOTB)?0:s1+SLOTB;
  bf16x8 (&qr)[4]=cy.qr;
  if(!primed){
    DMA_K(0,s0);DMA_V(0,s0);DMA_K(1,s1);
    #pragma unroll
    for(int d0=0;d0<4;++d0)qr[d0]=*reinterpret_cast<const bf16x8*>(&Qw[(long)r32*PQ+d0*16+hi*8]);
  }
  float mhat=0.f,l_reg=0.f;f32x16 o[4];o[0]=f32x16{};o[1]=f32x16{};o[2]=f32x16{};o[3]=f32x16{};f32x16 negm=f32x16{};asm volatile("":"+v"(negm));
  const int qrel=wid*QBLK+r32;
  #define CMASK(P0,P1,t) do{int jb_=(t)-(NT-4); if(jb_>=0)cmask(P0,P1,jb_,qrel,hi);}while(0)
  bool resc=false;
  #define RESC() do{ if(resc){ asm volatile("s_waitcnt lgkmcnt(0)":::"memory"); \
      _Pragma("unroll") for(int d_=0;d_<4;++d_) _Pragma("unroll") for(int r=0;r<16;++r)o[d_][r]*=wsf[crow(r,hi)]; } }while(0)
  f32x16 c0,c1;
  int sl_prev=s0,sl_cur=s0,sl_next=s1;
  #define ROT() do{sl_prev=sl_cur;sl_cur=sl_next;sl_next=(sl_next==(NSLOT-1)*SLOTB)?0:sl_next+SLOTB;}while(0)
  if(!primed){
    DMA_K(2,s2);
    WAIT_BAR(3);
  }
  qkt(c0,c1,Kbase+s0,qr,negm,r32,hi);asm volatile("s_nop 15\n\ts_nop 7":"+v"(c0),"+v"(c1));CMASK(c0,c1,0);
  u32x4 pw0,pw1,pw2,pw3;
  #define PKW(P,B) cvtpk_s(P[B],P[(B)+1])
  { const float rm=rowmax(c0,c1); mhat=fadd_s(mhat,rm);
    _Pragma("unroll") for(int r=0;r<16;++r){c0[r]=fsub_s(c0[r],rm);c1[r]=fsub_s(c1[r],rm);}
    _Pragma("unroll") for(int r=0;r<16;++r)negm[r]=-mhat; asm volatile("":"+v"(negm));
    _Pragma("unroll") for(int r=0;r<16;++r){c0[r]=__builtin_amdgcn_exp2f(c0[r]);c1[r]=__builtin_amdgcn_exp2f(c1[r]);}
    float sacc=c0[0]+c0[1]; _Pragma("unroll") for(int r=2;r<16;++r)sacc+=c0[r]; _Pragma("unroll") for(int r=0;r<8;++r)sacc+=c1[r]; l_reg+=sacc;
    pw0=(u32x4){PKW(c0,0),PKW(c0,2),PKW(c0,4),PKW(c0,6)};pw1=(u32x4){PKW(c0,8),PKW(c0,10),PKW(c0,12),PKW(c0,14)};pw2=(u32x4){PKW(c1,0),PKW(c1,2),PKW(c1,4),PKW(c1,6)}; }
  WAIT_BAR(0);
  DMA_K(3,s0);DMA_V(1,s1);
  ROT();
  kload8(kf,kp0+sl_cur);
  WAIT_BAR(3);
  s16x4 vlo[8],vhi[8];
  #define PAF(k) __builtin_bit_cast(bf16x8,pw##k)
  #define VFR(i) (bf16x8){vlo[i][0],vlo[i][1],vlo[i][2],vlo[i][3],vhi[i][0],vhi[i][1],vhi[i][2],vhi[i][3]}
  #define PIN(x) asm volatile("":"+v"(x))
  #define MX3(a,b,c) __builtin_fmaxf(__builtin_fmaxf((a),(b)),(c))
  #define EX(v) __builtin_amdgcn_exp2f(v)
  #define VRDF(sl,db,ks) do{ vlo[sl]=vtr(vp_+((db)*4096+(ks)*1024)); vhi[sl]=vtr(vp_+((db)*4096+(ks)*1024+512)); }while(0)
  #define KRD(G,j) do{ if(G){ kload2(kf,kp0+sl_next,j); SBAR(); } }while(0)
  #define MFQ(C,KF,Q,CIN) C=__builtin_amdgcn_mfma_f32_32x32x16_bf16(KF,Q,CIN,0,0,0)
  #define MFO(DB,KS,SL) o[DB]=__builtin_amdgcn_mfma_f32_32x32x16_bf16(PAF(KS),VFR(SL),o[DB],0,0,0)
  #define EX2(X,B) do{ X[B]=EX(X[B]); X[(B)+1]=EX(X[(B)+1]); PIN(X); }while(0)
  #define SPK(Y,PB,PW,W) do{ sacc+=Y[PB]; sacc+=Y[(PB)+1]; PIN(sacc); PW[W]=PKW(Y,PB); PIN(PW); }while(0)
  #define STEP(t,GK,GV,GL) do{ SBAR(); \
    const lds_cptr vp_=vp0+2*sl_prev; float sacc; \
    VRDF(0,0,0); SBAR(); MFQ(c0,kf[0],qr[0],negm); sacc=(c1[8]+c1[9]); sacc+=c1[10]; sacc+=c1[11]; sacc+=c1[12]; sacc+=c1[13]; sacc+=c1[14]; sacc+=c1[15]; PIN(sacc); \
                         pw3[0]=PKW(c1,8); pw3[1]=PKW(c1,10); pw3[2]=PKW(c1,12); pw3[3]=PKW(c1,14); PIN(pw3); SBAR(); \
    VRDF(1,1,0); SBAR(); MFQ(c1,kf[1],qr[0],negm); SBAR(); \
    VRDF(2,2,0); SBAR(); MFQ(c0,kf[2],qr[1],c0); SBAR(); \
    VRDF(3,3,0); SBAR(); MFQ(c1,kf[3],qr[1],c1); SBAR(); \
    VRDF(4,0,1); SBAR(); MFQ(c0,kf[4],qr[2],c0); SBAR(); \
    VRDF(5,1,1); SBAR(); MFQ(c1,kf[5],qr[2],c1); SBAR(); \
    VRDF(6,2,1); SBAR(); MFQ(c0,kf[6],qr[3],c0); SBAR(); \
    VRDF(7,3,1); SBAR(); MFQ(c1,kf[7],qr[3],c1); SBAR(); \
    l_reg+=sacc; sacc=0.f; \
    if(GK){DMA_K((t)+3,sl_cur);} if(GV){DMA_V((t)+1,sl_next);} \
    CMASK(c0,c1,t); \
    { float a=MX3(c0[0],c0[1],c1[0]),b=MX3(c0[2],c0[3],c1[1]); a=MX3(a,c1[2],c1[3]); \
      _Pragma("unroll") for(int r=4;r<16;r+=4){a=MX3(a,c0[r],c0[r+1]);b=MX3(b,c0[r+2],c0[r+3]);a=MX3(a,c1[r],c1[r+1]);b=MX3(b,c1[r+2],c1[r+3]);} \
      float rm=__builtin_fmaxf(a,b); { auto rr=__builtin_amdgcn_permlane32_swap(__float_as_uint(rm),__float_as_uint(rm),false,false); rm=__builtin_fmaxf(__uint_as_float(rr[0]),__uint_as_float(rr[1])); } \
      resc=false; \
      if(__builtin_expect(__any(rm>(float)THRL),0)){ const float dl=__builtin_fmaxf(rm,0.f); mhat+=dl; \
        _Pragma("unroll") for(int r=0;r<16;++r){c0[r]-=dl;c1[r]-=dl;} \
        _Pragma("unroll") for(int r=0;r<16;++r)negm[r]=-mhat; asm volatile("":"+v"(negm)); \
        const float f=__builtin_amdgcn_exp2f(-dl); l_reg*=f; if(hi==0)wsf[r32]=f; resc=true; } } \
    SBAR(); \
    MFO(0,0,0); VRDF(0,0,2); EX2(c0,0);  SBAR(); \
    MFO(1,0,1); VRDF(1,1,2); EX2(c0,2);  SBAR(); \
    MFO(2,0,2); VRDF(2,2,2); EX2(c0,4);  SBAR(); \
    MFO(3,0,3); VRDF(3,3,2); EX2(c0,6);  SBAR(); \
    MFO(0,1,4); VRDF(4,0,3); EX2(c0,8);  SPK(c0,0,pw0,0); SBAR(); \
    MFO(1,1,5); VRDF(5,1,3); EX2(c0,10); SPK(c0,2,pw0,1); SBAR(); \
    MFO(2,1,6); VRDF(6,2,3); EX2(c0,12); SPK(c0,4,pw0,2); SBAR(); \
    MFO(3,1,7); VRDF(7,3,3); EX2(c0,14); SPK(c0,6,pw0,3); SBAR(); \
    KRD(GL,0); MFO(0,2,0); EX2(c1,0);  SPK(c0,8,pw1,0);  SBAR(); \
    KRD(GL,1); MFO(1,2,1); EX2(c1,2);  SPK(c0,10,pw1,1); SBAR(); \
    KRD(GL,2); MFO(2,2,2); EX2(c1,4);  SPK(c0,12,pw1,2); SBAR(); \
    KRD(GL,3); MFO(3,2,3); EX2(c1,6);  SPK(c0,14,pw1,3); SBAR(); \
    MFO(0,3,4); EX2(c1,8);  SPK(c1,0,pw2,0); SBAR(); \
    MFO(1,3,5); EX2(c1,10); SPK(c1,2,pw2,1); SBAR(); \
    MFO(2,3,6); EX2(c1,12); SPK(c1,4,pw2,2); SBAR(); \
    MFO(3,3,7); EX2(c1,14); SPK(c1,6,pw2,3); SBAR(); \
    l_reg+=sacc; \
    }while(0)
  int t=1;
  #undef CMASK
  #define CMASK(P0,P1,t) do{}while(0)
  for(;t+4<NT;++t){ STEP(t,true,true,true); WAIT_BAR(3); RESC(); ROT(); }
  #undef CMASK
  #define CMASK(P0,P1,t) do{int jb_=(t)-(NT-4); if(jb_>=0)cmask(P0,P1,jb_,qrel,hi);}while(0)
  const bool hn=nx.has;
  const long kadj=hn?(long)(nx.Kh-Kh)-(long)NT*KVBLK*PK:0L, vadj=hn?(long)(nx.Vh-Vh)-(long)NT*KVBLK*PV:0L;
  #undef DMA_K
  #undef DMA_V
  #define DMA_K(t,slot) glds16(ksrc+(long)(t)*KVBLK*PK+(((t)>=NT)?kadj:0L),(unsigned)__builtin_amdgcn_readfirstlane(kdst+(slot)))
  #define DMA_V(t,slot) do{ const bf16*vs_=vsrc+(long)(t)*KVBLK*PV+(((t)>=NT)?vadj:0L); glds16(vs_,(unsigned)__builtin_amdgcn_readfirstlane(vdst+2*(slot))); glds16(vs_+64,(unsigned)__builtin_amdgcn_readfirstlane(vdst+2*(slot)+8192)); }while(0)
  #define ENDW(tt) do{ if(hn||(tt)+3<NT){WAIT_BAR(3);} else if((tt)+2<NT){WAIT_BAR(2);} else {WAIT_BAR(0);} }while(0)
  for(;t+1<NT;++t){ STEP(t,(hn||t+3<NT),true,true); ENDW(t); RESC(); ROT(); }
  STEP(NT-1,hn,hn,false);
  if(hn){
    const bf16*QwN=nx.Qh+(long)(nx.qb*QB+wid*QBLK)*PQ;
    #pragma unroll
    for(int d0=0;d0<4;++d0)qr[d0]=*reinterpret_cast<const bf16x8*>(&QwN[(long)r32*PQ+d0*16+hi*8]);
    WAIT_BAR(7);
  }
  cy.primed=hn; cy.s0=sl_next;
  RESC();
  { float sacc=(c1[8]+c1[9]); _Pragma("unroll") for(int r=10;r<16;++r)sacc+=c1[r]; l_reg+=sacc;
    pw3=(u32x4){PKW(c1,8),PKW(c1,10),PKW(c1,12),PKW(c1,14)};
    SBAR(); pv128(o,(int)(unsigned)(uintptr_t)vp0+2*sl_cur,PAF(0),PAF(1),PAF(2),PAF(3)); }
  #undef PKW
  #undef PAF
  #undef VFR
  #undef PIN
  #undef MX3
  #undef EX
  #undef VRDF
  #undef KRD
  #undef MFQ
  #undef MFO
  #undef EX2
  #undef SPK
  #undef STEP
  #undef ENDW
  {auto rr=__builtin_amdgcn_permlane32_swap(__float_as_uint(l_reg),__float_as_uint(l_reg),false,false);l_reg=__uint_as_float(rr[0])+__uint_as_float(rr[1]);}
  if(hi==0)wsf[32+r32]=l_reg;asm volatile("s_waitcnt lgkmcnt(0)":::"memory");
  float rli[16];
  #pragma unroll
  for(int r=0;r<16;++r)rli[r]=__builtin_amdgcn_rcpf(wsf[32+crow(r,hi)]);
  if(post.on){
    asm volatile("s_waitcnt lgkmcnt(0)\n\ts_barrier":::"memory");
    const int so=__builtin_amdgcn_readfirstlane((wid<4)?(L2_OST+wid*8192):(L2_V+2*((wid<6)?sl_prev:sl_cur)+(wid&1)*8192));
    bf16*stg=(bf16*)(shm+so);
    #pragma unroll
    for(int r=0;r<16;++r){const int orow=crow(r,hi);
      #pragma unroll
      for(int d0=0;d0<4;++d0)stg[orow*128+d0*32+r32]=__float2bfloat16(o[d0][r]*rli[r]);}
    asm volatile("s_waitcnt lgkmcnt(0)":::"memory");
    post.run((lds_cptr)shm+so,q0+wid*QBLK,lane);
  } else {
  bf16*Ow=Oh+(long)(q0+wid*QBLK)*PO;
  { bf16*stg=(bf16*)(shm+L2_OST)+wid*2048;
    #pragma unroll
    for(int h2=0;h2<2;++h2){
      #pragma unroll
      for(int r=0;r<16;++r){const int orow=crow(r,hi);
        #pragma unroll
        for(int d0=0;d0<2;++d0)stg[orow*64+d0*32+r32]=__float2bfloat16(o[2*h2+d0][r]*rli[r]);}
      asm volatile("s_waitcnt lgkmcnt(0)":::"memory");
      #pragma unroll
      for(int i=0;i<4;++i){const int row=i*8+(lane>>3),ch=lane&7; const u32x4 v=*(const u32x4*)(stg+row*64+ch*8); ATTN_STORE16(Ow+(long)row*PO+h2*64+ch*8,v);}
      asm volatile("s_waitcnt lgkmcnt(0)":::"memory"); } }
  }
  asm volatile("s_waitcnt lgkmcnt(0)\n\ts_barrier":::"memory");
  #undef DMA_K
  #undef DMA_V
  #undef CMASK
  #undef RESC
  #undef ROT
}
constexpr int ATTN_LDS_BYTES=L2_BYTES;
#undef SBAR
#undef WAIT_BAR
}

constexpr int NWAVES = 8;
constexpr size_t MiB = 1u << 20;
constexpr size_t WS_CTL = 0, CTL_ZERO_BYTES = 1 * MiB;
constexpr size_t WS_ROPEC = 1 * MiB, WS_ROPES = WS_ROPEC + 256 * 1024;
constexpr size_t WS_ROUTE = 2 * MiB;
constexpr int ECAP = M, ECAP_LOG = 14;
static_assert((1 << ECAP_LOG) == ECAP, "ECAP");
constexpr size_t RT_SLOTOF = 0, RT_WSLOT = 128 * 1024, RT_SSSLOT = 1024 * 1024;
constexpr size_t WS_SS = 6 * MiB;
constexpr size_t WS_WIN = 10 * MiB;
constexpr size_t WS_WOUT = WS_WIN + 64 * MiB;
constexpr size_t WS_WGU = WS_WOUT + 8 * MiB;
constexpr size_t WS_WD = WS_WGU + 22 * MiB;
constexpr size_t WS_WEGU = WS_WD + 11 * MiB;
constexpr size_t WS_WED = WS_WEGU + 224 * MiB;
constexpr size_t WS_XB = WS_WED + 112 * MiB;
constexpr size_t WS_PROJ = WS_XB + 32 * MiB;
constexpr size_t WS_O = WS_PROJ + 256 * MiB;
constexpr size_t WS_MIX = WS_O + 64 * MiB;
constexpr size_t WS_Y = WS_MIX + 32 * MiB;
constexpr size_t WS_END = WS_Y + 68 * MiB;
static_assert((size_t)MSLOT * DFFE * 2 <= 256 * MiB && (size_t)MSLOT * 1024 * 2 <= 68 * MiB && (size_t)MSLOT * 1024 * 2 <= 96 * MiB, "overlays");
static_assert((size_t)NEXP * ECAP * 4 <= 896 * 1024 && RT_SSSLOT + (size_t)NEXP * ECAP * 16 <= 4 * MiB && (size_t)9 * M * 16 <= 4 * MiB && (size_t)NEXP * ECAP * 1024 <= 164 * MiB, "routing / ss map; sparse expert inputs overlay O | MIX | Y");
constexpr int CW_TMO = 0, CW_CODE = 1;
constexpr int CW_BAR = 4096;
constexpr int CW_GCNT = 16384;

constexpr int RING_OFF = 0, RING_BYTES = 131072;
constexpr int LDSCTL_OFF = RING_BYTES, MISC_OFF = LDSCTL_OFF + 320;
constexpr int LDS_BYTES = 163840;
static_assert(MISC_OFF + 128 <= LDS_BYTES, "LDS map");

#define GAS __attribute__((address_space(1)))
#define LAS __attribute__((address_space(3)))
typedef unsigned short bf16;
typedef unsigned v4u __attribute__((ext_vector_type(4)));
typedef unsigned v2u __attribute__((ext_vector_type(2)));
typedef float f32x4 __attribute__((ext_vector_type(4)));
typedef GAS unsigned gu32;
#define RLX_AGENT __ATOMIC_RELAXED, __HIP_MEMORY_SCOPE_AGENT
#define LDS_WAIT() asm volatile("s_waitcnt lgkmcnt(0)" ::: "memory")
#define VM_WAIT() asm volatile("s_waitcnt vmcnt(0)" ::: "memory")
__device__ __forceinline__ unsigned f2bf(float f) { unsigned u = __builtin_bit_cast(unsigned, f); return (u + 0x7fffu + ((u >> 16) & 1u)) >> 16; }
__device__ __forceinline__ unsigned pk2(float lo, float hi) { return f2bf(lo) | (f2bf(hi) << 16); }
__device__ __forceinline__ float bflo(unsigned w) { return __uint_as_float(w << 16); }
__device__ __forceinline__ float bfhi(unsigned w) { return __uint_as_float(w & 0xffff0000u); }

#define XB_TMO      128
#define XB_XCNT(j)  (256  + 64 * (j))
#define XB_XSUB(j)  (1280 + 64 * (j))
#define XB_XGEN(j)  (2304 + 64 * (j))
#define XB_TOP      3328
#define XB_TOPGEN   3392
#define XCD_BAR_WORDS 3456
#define XB_SPIN_CAP (1u << 18)
__device__ __forceinline__ unsigned xb_ld(unsigned* p)              { return __hip_atomic_load(p, __ATOMIC_RELAXED, __HIP_MEMORY_SCOPE_AGENT); }
__device__ __forceinline__ unsigned xb_add(unsigned* p, unsigned v) { return __hip_atomic_fetch_add(p, v, __ATOMIC_RELAXED, __HIP_MEMORY_SCOPE_AGENT); }
__device__ __forceinline__ unsigned xb_xcc_id() { return (unsigned)__builtin_amdgcn_s_getreg((3 << 11) | 20) & 0xFu; }
#define XB_SPIN(cond, bar) do { unsigned _sp = 0; while (cond) { __builtin_amdgcn_s_sleep(1); \
    if ((++_sp & 255u) == 0u) { if (xb_ld(&(bar)[XB_TMO])) break; if (_sp > XB_SPIN_CAP) { atomicAdd(&(bar)[XB_TMO], 1u); break; } } } } while (0)
struct XcdBarrier { unsigned* bar; unsigned x; volatile LAS unsigned* st; };
__device__ __forceinline__ XcdBarrier xcd_barrier_post(unsigned* bar, volatile LAS unsigned* st) {
    XcdBarrier b; b.bar = bar; b.x = xb_xcc_id(); b.st = st;
    if (threadIdx.x == 0) (void)xb_add(&bar[XB_XCNT(b.x)], 1u);
    return b;
}
__device__ __forceinline__ void xcd_barrier_complete(unsigned* bar, unsigned x, unsigned& nloc, unsigned& nx) {
    const unsigned G = gridDim.x * gridDim.y * gridDim.z;
    unsigned sum, cnt, mine, sp = 0u;
    for (;;) {
        sum = 0u; cnt = 0u; mine = 0u;
#pragma unroll
        for (unsigned j = 0; j < 16; ++j) { const unsigned c = xb_ld(&bar[XB_XCNT(j)]); sum += c; cnt += (c > 0u) ? 1u : 0u; mine = (j == x) ? c : mine; }
        if (sum == G) break;
        __builtin_amdgcn_s_sleep(1);
        if ((++sp & 255u) == 0u) { if (xb_ld(&bar[XB_TMO])) break; if (sp > XB_SPIN_CAP) { atomicAdd(&bar[XB_TMO], 1u); break; } }
    }
    nloc = mine > 0u ? mine : 1u; nx = cnt > 0u ? cnt : 1u;
}
__device__ __forceinline__ void xcd_barrier(const XcdBarrier& b) {
    asm volatile("s_waitcnt vmcnt(0)" ::: "memory");
    __syncthreads();
    if (threadIdx.x == 0) {
        unsigned* bar = b.bar;
        __builtin_amdgcn_s_waitcnt(0);
        unsigned nloc = b.st[0], nx = b.st[1];
        if (nloc == 0u) { xcd_barrier_complete(bar, b.x, nloc, nx); b.st[0] = nloc; b.st[1] = nx; }
        const unsigned old = xb_add(&bar[XB_XSUB(b.x)], 1u);
        const unsigned gen = old / nloc;
        if (old + 1u == (gen + 1u) * nloc) {
            __builtin_amdgcn_fence(__ATOMIC_RELEASE, "agent");
            asm volatile("s_waitcnt vmcnt(0)" ::: "memory");
            const unsigned og = xb_add(&bar[XB_TOP], 1u);
            const unsigned tg = og / nx;
            if (og + 1u == (tg + 1u) * nx) xb_add(&bar[XB_TOPGEN], 1u);
            else XB_SPIN(xb_ld(&bar[XB_TOPGEN]) == tg, bar);
            __builtin_amdgcn_fence(__ATOMIC_ACQUIRE, "agent");
            xb_add(&bar[XB_XGEN(b.x)], 1u);
            asm volatile("s_waitcnt vmcnt(0)" ::: "memory");
        } else {
            XB_SPIN(xb_ld(&bar[XB_XGEN(b.x)]) == gen, bar);
            __builtin_amdgcn_fence(__ATOMIC_ACQUIRE, "agent");
            asm volatile("s_waitcnt vmcnt(0)" ::: "memory");
        }
    }
    __syncthreads();
}

struct Args { const float* in[19]; float* out; unsigned char* ws; int ph_lo, ph_hi; };
static_assert(sizeof(Args) == 19 * 8 + 8 + 8 + 8, "Args has no padding");

typedef const __attribute__((address_space(4))) Args* kargs_t;
#define KARGS() ({ kargs_t p_ = (kargs_t)__builtin_amdgcn_kernarg_segment_ptr(); asm volatile("" : "+s"(p_)); p_; })
struct Frame {
    LAS unsigned char* lds;
    int tid, lane, wave;
    int vcu, G;
    unsigned char* ws;
    gu32* ctl;
    float* X;
};
__device__ __forceinline__ Frame make_frame(kargs_t ap) {
    extern __shared__ __attribute__((aligned(16))) unsigned char lds[];
    Frame F; F.lds = (LAS unsigned char*)lds; F.tid = opaque_tid(); F.lane = F.tid & 63; F.wave = __builtin_amdgcn_readfirstlane(F.tid >> 6);
    F.G = opaque_grid(); { const int bx = opaque_bid(); F.vcu = (F.G % 8 == 0) ? (bx % 8) * (F.G / 8) + bx / 8 : bx; }
    F.ws = ap->ws; F.ctl = (gu32*)(F.ws + WS_CTL); F.X = ap->out; return F;
}

__device__ __forceinline__ float wave_sum(float v) {
#pragma unroll
    for (int o = 1; o < 64; o <<= 1) v += __shfl_xor(v, o);
    return v;
}

template <int KIND>
__device__ __forceinline__ int rowmap(int n) {
    if (KIND == 1) {
        if (n < 2048) { const int tile = n >> 8, hh = (n >> 6) & 3, half = (n >> 5) & 1, j = n & 31; return tile * 256 + half * 128 + hh * 32 + j; }
        if (n < 3072) return n;
        if (n < 4096) { const int c = n - 3072; return (20 + (c >> 7)) * 256 + (c & 127); }
        if (n < 5120) { const int c = n - 4096; return (12 + (c >> 7)) * 256 + (c & 127); }
        if (n < 6144) { const int c = n - 5120; return (12 + (c >> 7)) * 256 + 128 + (c & 127); }
        if (n < 7168) { return 28 * 256 + (n - 6144); }
        { const int c = n - 7168; return (20 + (c >> 7)) * 256 + 128 + (c & 127); }
    }
    if (KIND == 2) return (n >> 7) * 256 + (n & 127);
    if (KIND == 3) return (n >> 7) * 256 + 128 + (n & 127);
    return n;
}
__device__ __forceinline__ void cvt_ld(const float* __restrict__ W, int N, int item, int lane, f32x4 (&v)[8]) {
    const int nblk = N >> 5, kb = item / nblk, nb = item - kb * nblk;
    const int l8 = lane & 7, kg = lane >> 3;
    const int k0 = kb * 64 + kg * 8, n0 = nb * 32 + l8 * 4;
#pragma unroll
    for (int r = 0; r < 8; ++r) v[r] = *(const GAS f32x4*)(W + (size_t)(k0 + r) * N + n0);
}
template <int KIND>
__device__ __forceinline__ void cvt_st(int K, int N, const float* __restrict__ gain, bf16* __restrict__ WT, int item, int lane, f32x4 (&v)[8]) {
    const int nblk = N >> 5, kb = item / nblk, nb = item - kb * nblk;
    const int l8 = lane & 7, kg = lane >> 3;
    const int k0 = kb * 64 + kg * 8, n0 = nb * 32 + l8 * 4;
    if (gain) {
        const f32x4 g0 = *(const GAS f32x4*)(gain + k0), g1 = *(const GAS f32x4*)(gain + k0 + 4);
#pragma unroll
        for (int r = 0; r < 4; ++r) { v[r] = v[r] * g0[r]; v[r + 4] = v[r + 4] * g1[r]; }
    }
#pragma unroll
    for (int i = 0; i < 4; ++i) {
        v4u o; o.x = pk2(v[0][i], v[1][i]); o.y = pk2(v[2][i], v[3][i]); o.z = pk2(v[4][i], v[5][i]); o.w = pk2(v[6][i], v[7][i]);
        st16_wt((void*)(WT + (size_t)rowmap<KIND>(n0 + i) * K + k0), o);
    }
}

__device__ __forceinline__ void cvt_ld_f8(const float* __restrict__ W, int N, int item, int lane, f32x4 (&v)[16]) {
    const int nblk = N >> 5, kb = item / nblk, nb = item - kb * nblk;
    const int l8 = lane & 7, kg = lane >> 3;
    const int k0 = kb * 128 + kg * 16, n0 = nb * 32 + l8 * 4;
#pragma unroll
    for (int r = 0; r < 16; ++r) v[r] = __builtin_nontemporal_load((const GAS f32x4*)(W + (size_t)(k0 + r) * N + n0));
}
template <int KIND>
__device__ __forceinline__ void cvt_st_f8(int K, int N, const float* __restrict__ gain, unsigned char* __restrict__ WT, int item, int lane, f32x4 (&v)[16]) {
    const int nblk = N >> 5, kb = item / nblk, nb = item - kb * nblk;
    const int l8 = lane & 7, kg = lane >> 3;
    const int k0 = kb * 128 + kg * 16, n0 = nb * 32 + l8 * 4;
#pragma unroll
    for (int q = 0; q < 4; ++q) { f32x4 g = {256.f, 256.f, 256.f, 256.f}; if (gain) g = *(const GAS f32x4*)(gain + k0 + 4 * q) * 256.f;
#pragma unroll
        for (int r = 0; r < 4; ++r) v[4 * q + r] = v[4 * q + r] * g[r]; }
#pragma unroll
    for (int i = 0; i < 4; ++i) {
        v4u o;
#pragma unroll
        for (int q = 0; q < 4; ++q) { unsigned w = 0u;
            w = __builtin_amdgcn_cvt_pk_fp8_f32(pg8::clamp448(v[4 * q][i]), pg8::clamp448(v[4 * q + 1][i]), w, false);
            w = __builtin_amdgcn_cvt_pk_fp8_f32(pg8::clamp448(v[4 * q + 2][i]), pg8::clamp448(v[4 * q + 3][i]), w, true); o[q] = w; }
        st16_wt((void*)(WT + (size_t)rowmap<KIND>(n0 + i) * K + k0), o);
    }
}

template <int KIND>
__device__ __forceinline__ void cvt_st_b16(int K, int N, const float* __restrict__ gain, bf16* __restrict__ WT, int item, int lane, f32x4 (&v)[16]) {
    const int nblk = N >> 5, kb = item / nblk, nb = item - kb * nblk;
    const int l8 = lane & 7, kg = lane >> 3;
    const int k0 = kb * 128 + kg * 16, n0 = nb * 32 + l8 * 4;
    if (gain) {
#pragma unroll
        for (int q = 0; q < 4; ++q) { const f32x4 g = *(const GAS f32x4*)(gain + k0 + 4 * q);
#pragma unroll
            for (int r = 0; r < 4; ++r) v[4 * q + r] = v[4 * q + r] * g[r]; } }
#pragma unroll
    for (int i = 0; i < 4; ++i) {
        v4u o0, o1; o0.x = pk2(v[0][i], v[1][i]); o0.y = pk2(v[2][i], v[3][i]); o0.z = pk2(v[4][i], v[5][i]); o0.w = pk2(v[6][i], v[7][i]);
        o1.x = pk2(v[8][i], v[9][i]); o1.y = pk2(v[10][i], v[11][i]); o1.z = pk2(v[12][i], v[13][i]); o1.w = pk2(v[14][i], v[15][i]);
        bf16* q = WT + (size_t)rowmap<KIND>(n0 + i) * K + k0;
        *(GAS v4u*)q = o0; *(GAS v4u*)(q + 8) = o1;
    }
}

template <int KIND>
__device__ __forceinline__ void cvt_run(const float* __restrict__ W, int K, int N, const float* __restrict__ gain, bf16* __restrict__ WT, int it0, int NI, int nranks, int lane) {
    constexpr int NP = 4;
    for (int it = it0; it < NI; it += NP * nranks) {
        f32x4 v[NP][8];
#pragma unroll
        for (int q = 0; q < NP; ++q) { const int ii = it + q * nranks; if (ii < NI) cvt_ld(W, N, ii, lane, v[q]); }
        asm volatile("" ::: "memory");
#pragma unroll
        for (int q = 0; q < NP; ++q) { const int ii = it + q * nranks; if (ii < NI) cvt_st<KIND>(K, N, gain, WT, ii, lane, v[q]); }
    }
}
template <int KIND>
__device__ __forceinline__ void cvt_run_f8(const float* __restrict__ W, int K, int N, const float* __restrict__ gain, unsigned char* __restrict__ WT, int it0, int NI, int nranks, int lane) {
    constexpr int NP = 2;
    for (int it = it0; it < NI; it += NP * nranks) {
        f32x4 v[NP][16];
#pragma unroll
        for (int q = 0; q < NP; ++q) { const int ii = it + q * nranks; if (ii < NI) cvt_ld_f8(W, N, ii, lane, v[q]); }
        asm volatile("" ::: "memory");
#pragma unroll
        for (int q = 0; q < NP; ++q) { const int ii = it + q * nranks; if (ii < NI) cvt_st_f8<KIND>(K, N, gain, WT, ii, lane, v[q]); }
    }
}

__device__ __forceinline__ void convert_group(kargs_t A, unsigned char* ws, int grp, int rank, int nranks, int lane) {
    constexpr int I_IN = (DM / 128) * (IN_W / 32), I_OUT = (DM / 128) * (DM / 32), I_G = (DM / 128) * (DFF / 32), I_D = (DFF / 128) * (DM / 32), I_EG = (DM / 128) * (DFFE / 32), I_ED = (DFFE / 128) * (DM / 32);
    const int in_n = (grp < 4) ? 1 : 0, d_n = (grp == 1 || grp == 2) ? 1 : 0, e_lo = (grp - 1) * 4, e_n = (grp >= 1) ? 4 : 0;
    const int c0 = in_n * I_IN, c1 = c0 + in_n * I_OUT, c2 = c1 + d_n * I_G, c3 = c2 + d_n * I_G, c4 = c3 + d_n * I_D, c5 = c4 + e_n * I_EG, c6 = c5 + e_n * I_EG, c7 = c6 + e_n * I_ED;
    const int j = grp, jd = grp - 1;
    for (int it = rank; it < c7; it += 2 * nranks) {
        f32x4 v[2][16];
#pragma unroll
        for (int q = 0; q < 2; ++q) { const int ii = it + q * nranks;
            if (ii < c7) { const float* W; int N, r;
                if (ii < c0) { W = A->in[2] + (size_t)j * DM * IN_W; N = IN_W; r = ii; }
                else if (ii < c1) { W = A->in[9] + (size_t)j * DM * DM; N = DM; r = ii - c0; }
                else if (ii < c2) { W = A->in[11] + (size_t)jd * DM * DFF; N = DFF; r = ii - c1; }
                else if (ii < c3) { W = A->in[12] + (size_t)jd * DM * DFF; N = DFF; r = ii - c2; }
                else if (ii < c4) { W = A->in[13] + (size_t)jd * DFF * DM; N = DM; r = ii - c3; }
                else if (ii < c5) { const int rr = ii - c4, jj = rr / I_EG; r = rr - jj * I_EG; W = A->in[15] + (size_t)(e_lo + jj) * DM * DFFE; N = DFFE; }
                else if (ii < c6) { const int rr = ii - c5, jj = rr / I_EG; r = rr - jj * I_EG; W = A->in[16] + (size_t)(e_lo + jj) * DM * DFFE; N = DFFE; }
                else { const int rr = ii - c6, jj = rr / I_ED; r = rr - jj * I_ED; W = A->in[17] + (size_t)(e_lo + jj) * DFFE * DM; N = DM; }
                cvt_ld_f8(W, N, r, lane, v[q]); } }
        asm volatile("" ::: "memory");
#pragma unroll
        for (int q = 0; q < 2; ++q) { const int ii = it + q * nranks;
            if (ii < c7) {
                if (ii < c0) { const int r = ii;
                    if (INPROJ_F8(j)) cvt_st_f8<1>(DM, IN_W, A->in[1] + j * DM, (unsigned char*)(ws + WS_WIN) + (size_t)j * IN_W * DM * 2, r, lane, v[q]);
                    else cvt_st_b16<1>(DM, IN_W, A->in[1] + j * DM, (bf16*)(ws + WS_WIN) + (size_t)j * IN_W * DM, r, lane, v[q]); }
                else if (ii < c1) cvt_st_b16<0>(DM, DM, nullptr, (bf16*)(ws + WS_WOUT) + (size_t)j * DM * DM, ii - c0, lane, v[q]);
                else if (ii < c2) { const int r = ii - c1;
                    if (DENSE_F8(jd)) cvt_st_f8<2>(DM, DFF, A->in[10] + (2 * jd) * DM, (unsigned char*)(ws + WS_WGU) + (size_t)jd * 2 * DFF * DM * 2, r, lane, v[q]);
                    else cvt_st_b16<2>(DM, DFF, A->in[10] + (2 * jd) * DM, (bf16*)(ws + WS_WGU) + (size_t)jd * 2 * DFF * DM, r, lane, v[q]); }
                else if (ii < c3) { const int r = ii - c2;
                    if (DENSE_F8(jd)) cvt_st_f8<3>(DM, DFF, A->in[10] + (2 * jd) * DM, (unsigned char*)(ws + WS_WGU) + (size_t)jd * 2 * DFF * DM * 2, r, lane, v[q]);
                    else cvt_st_b16<3>(DM, DFF, A->in[10] + (2 * jd) * DM, (bf16*)(ws + WS_WGU) + (size_t)jd * 2 * DFF * DM, r, lane, v[q]); }
                else if (ii < c4) { const int r = ii - c3;
                    if (DENSE_DN_F8(jd)) cvt_st_f8<0>(DFF, DM, nullptr, (unsigned char*)(ws + WS_WD) + (size_t)jd * DM * DFF * 2, r, lane, v[q]);
                    else cvt_st_b16<0>(DFF, DM, nullptr, (bf16*)(ws + WS_WD) + (size_t)jd * DM * DFF, r, lane, v[q]); }
                else if (ii < c5) { const int rr = ii - c4, jj = rr / I_EG, r = rr - jj * I_EG, je = e_lo + jj;
                    cvt_st_f8<2>(DM, DFFE, A->in[10] + (2 * (je >> 3) + 1) * DM, (unsigned char*)(ws + WS_WEGU) + (size_t)je * 2 * DFFE * DM, r, lane, v[q]); }
                else if (ii < c6) { const int rr = ii - c5, jj = rr / I_EG, r = rr - jj * I_EG, je = e_lo + jj;
                    cvt_st_f8<3>(DM, DFFE, A->in[10] + (2 * (je >> 3) + 1) * DM, (unsigned char*)(ws + WS_WEGU) + (size_t)je * 2 * DFFE * DM, r, lane, v[q]); }
                else { const int rr = ii - c6, jj = rr / I_ED, r = rr - jj * I_ED, je = e_lo + jj;
                    cvt_st_f8<0>(DFFE, DM, nullptr, (unsigned char*)(ws + WS_WED) + (size_t)je * DM * DFFE, r, lane, v[q]); } } }
    }
}
__device__ __forceinline__ void p0_prologue() {
    const kargs_t A = KARGS(); Frame F = make_frame(A);
    const int gw = F.vcu * NWAVES + F.wave, NGW = F.G * NWAVES, lane = F.lane;
    unsigned char* ws = F.ws;
    convert_group(A, ws, 0, gw, NGW, lane);
    { float* rc = (float*)(ws + WS_ROPEC); float* rs = (float*)(ws + WS_ROPES);
      for (int idx = (F.vcu * NWAVES + F.wave) * 64 + lane; idx < SEQ * 32; idx += NGW * 64) {
          const int pos = idx >> 5, i = idx & 31;
          const float inv = __builtin_amdgcn_exp2f(-(float)i * 0.4152410118609203f);
          const float ang = (float)pos * inv;
          const double rev = (double)ang * 0.15915494309189535; const float fr = (float)(rev - __builtin_rint(rev));
          rc[idx] = __builtin_amdgcn_cosf(fr); rs[idx] = __builtin_amdgcn_sinf(fr); } }
    { const float* x = A->in[0]; float* ss = (float*)(ws + WS_SS); bf16* xb = (bf16*)(ws + WS_XB);
      for (int m0 = gw * 4; m0 < M; m0 += NGW * 4) {
          f32x4 v[4][4];
#pragma unroll
          for (int r = 0; r < 4; ++r) { const GAS f32x4* xr = (const GAS f32x4*)(x + (size_t)(m0 + r) * DM) + lane;
#pragma unroll
              for (int j = 0; j < 4; ++j) v[r][j] = xr[64 * j]; }
#pragma unroll
          for (int r = 0; r < 4; ++r) { const int m = m0 + r; GAS v2u* o8 = (GAS v2u*)(xb + (size_t)m * DM) + lane; float s = 0.f;
#pragma unroll
              for (int j = 0; j < 4; ++j) { const f32x4 q = v[r][j]; s += (q.x * q.x + q.y * q.y) + (q.z * q.z + q.w * q.w); v2u w; w.x = pk2(q.x, q.y); w.y = pk2(q.z, q.w); st8_wt((void*)(o8 + 64 * j), w); }
              s = wave_sum(s); if (lane == 0) *(GAS f32x4*)(ss + 4 * (size_t)m) = (f32x4){s, 0.f, 0.f, 0.f}; } } }
}

__device__ __forceinline__ float sigmoidf_(float x) { return __builtin_amdgcn_rcpf(1.0f + __builtin_amdgcn_exp2f(x * -1.4426950408889634f)); }
__device__ __forceinline__ void unpack8(const v4u w, float (&f)[8]) { f[0] = bflo(w.x); f[1] = bfhi(w.x); f[2] = bflo(w.y); f[3] = bfhi(w.y); f[4] = bflo(w.z); f[5] = bfhi(w.z); f[6] = bflo(w.w); f[7] = bfhi(w.w); }
struct MergeCtx { float lam, one_m_li; float w0[8], w1[8], w2[8], g[8]; };
__device__ __forceinline__ void merge_setup(MergeCtx& C, kargs_t A, int l, int h, int tid) {
    const int lane = tid & 63, chunk = tid & 15;
    const float lam_init = (l == 0) ? 0.2f : (l == 1) ? 0.35550906759096934f : (l == 2) ? 0.4707130183435842f : 0.5560582041556406f;
    const float a1 = A->in[4][l * 64 + lane] * A->in[5][l * 64 + lane], a2 = A->in[6][l * 64 + lane] * A->in[7][l * 64 + lane];
    const float s1 = wave_sum(a1), s2 = wave_sum(a2);
    C.lam = __builtin_amdgcn_exp2f(s1 * 1.4426950408889634f) - __builtin_amdgcn_exp2f(s2 * 1.4426950408889634f) + lam_init; C.one_m_li = 1.0f - lam_init;
    const float* cw = A->in[3] + (size_t)l * 3 * DM + h * 128 + 8 * chunk; const float* sg = A->in[8] + l * 128 + 8 * chunk;
#pragma unroll
    for (int i = 0; i < 8; ++i) { C.w0[i] = cw[i]; C.w1[i] = cw[DM + i]; C.w2[i] = cw[2 * DM + i]; C.g[i] = sg[i] * C.one_m_li; }
}
__device__ __forceinline__ void merge_block(const MergeCtx& C, unsigned char* ws, int b, int h, int qb, int tid) {
    const bf16* P = (const bf16*)(ws + WS_PROJ); const size_t PS = (size_t)M * 1024;
    const bf16* Ob = (const bf16*)(ws + WS_O); bf16* Mx = (bf16*)(ws + WS_MIX);
    const int chunk = tid & 15, c = h * 128 + 8 * chunk, oc = h * 256 + 8 * chunk;
    for (int it0 = 0; it0 < 8; it0 += 2) {
        v4u raw[2][7];
#pragma unroll
        for (int k = 0; k < 2; ++k) {
            const int tl = qb * 256 + (it0 + k) * 32 + (tid >> 4);
            const size_t t = (size_t)b * SEQ + tl;
            const size_t tm1 = (tl >= 1) ? t - 1 : t, tm2 = (tl >= 2) ? t - 2 : t;
            raw[k][0] = *(const GAS v4u*)(Ob + t * 2048 + oc); raw[k][1] = *(const GAS v4u*)(Ob + t * 2048 + oc + 128);
            raw[k][2] = *(const GAS v4u*)(P + 4 * PS + t * 1024 + c); raw[k][3] = *(const GAS v4u*)(P + 5 * PS + t * 1024 + c);
            raw[k][4] = *(const GAS v4u*)(P + 3 * PS + t * 1024 + c); raw[k][5] = *(const GAS v4u*)(P + 3 * PS + tm1 * 1024 + c); raw[k][6] = *(const GAS v4u*)(P + 3 * PS + tm2 * 1024 + c);
        }
        asm volatile("" ::: "memory");
#pragma unroll
        for (int k = 0; k < 2; ++k) {
            const int tl = qb * 256 + (it0 + k) * 32 + (tid >> 4);
            const size_t t = (size_t)b * SEQ + tl;
            float o1[8], o2[8], bgc[8], ga[8], cu0[8], cu1[8], cu2[8];
            unpack8(raw[k][0], o1); unpack8(raw[k][1], o2); unpack8(raw[k][2], bgc); unpack8(raw[k][3], ga); unpack8(raw[k][4], cu0); unpack8(raw[k][5], cu1); unpack8(raw[k][6], cu2);
            const float k1 = (tl >= 1) ? 1.f : 0.f, k2 = (tl >= 2) ? 1.f : 0.f;
            float d[8], sq = 0.f;
#pragma unroll
            for (int i = 0; i < 8; ++i) { d[i] = o1[i] - C.lam * o2[i]; sq += d[i] * d[i]; }
            sq += __shfl_xor(sq, 1); sq += __shfl_xor(sq, 2); sq += __shfl_xor(sq, 4); sq += __shfl_xor(sq, 8);
            const float r = __builtin_amdgcn_rsqf(sq * (1.0f / 128.0f) + RMS_EPS);
            float mo[8];
#pragma unroll
            for (int i = 0; i < 8; ++i) {
                const float yc = bgc[i] * (C.w0[i] * (cu2[i] * k2) + C.w1[i] * (cu1[i] * k1) + C.w2[i] * cu0[i]);
                const float ya = d[i] * r * C.g[i];
                mo[i] = sigmoidf_(ga[i]) * ya + yc; }
            v4u w; w.x = pk2(mo[0], mo[1]); w.y = pk2(mo[2], mo[3]); w.z = pk2(mo[4], mo[5]); w.w = pk2(mo[6], mo[7]);
            st16_wt((void*)(Mx + t * 1024 + c), w);
        }
    }
}

__device__ __forceinline__ void merge_wave(const MergeCtx& C, unsigned char* ws, int b, int h, int tl0, attn_body::lds_cptr stg, int lane) {
    const bf16* P = (const bf16*)(ws + WS_PROJ); const size_t PS = (size_t)M * 1024;
    const bf16* Ob = (const bf16*)(ws + WS_O); bf16* Mx = (bf16*)(ws + WS_MIX);
    const int chunk = lane & 15, c = h * 128 + 8 * chunk, oc = h * 256 + 8 * chunk;
    for (int p0 = 0; p0 < 8; p0 += 2) {
        v4u raw[2][7];
#pragma unroll
        for (int k = 0; k < 2; ++k) {
            const int rw = (p0 + k) * 4 + (lane >> 4), tl = tl0 + rw;
            const size_t t = (size_t)b * SEQ + tl;
            const size_t tm1 = (tl >= 1) ? t - 1 : t, tm2 = (tl >= 2) ? t - 2 : t;
            raw[k][0] = *(const GAS v4u*)(Ob + t * 2048 + oc); raw[k][1] = *(const LAS v4u*)(stg + (rw * 128 + 8 * chunk) * 2);
            raw[k][2] = *(const GAS v4u*)(P + 4 * PS + t * 1024 + c); raw[k][3] = *(const GAS v4u*)(P + 5 * PS + t * 1024 + c);
            raw[k][4] = *(const GAS v4u*)(P + 3 * PS + t * 1024 + c); raw[k][5] = *(const GAS v4u*)(P + 3 * PS + tm1 * 1024 + c); raw[k][6] = *(const GAS v4u*)(P + 3 * PS + tm2 * 1024 + c);
        }
        asm volatile("" ::: "memory");
#pragma unroll
        for (int k = 0; k < 2; ++k) {
            const int rw = (p0 + k) * 4 + (lane >> 4), tl = tl0 + rw;
            const size_t t = (size_t)b * SEQ + tl;
            float o1[8], o2[8], bgc[8], ga[8], cu0[8], cu1[8], cu2[8];
            unpack8(raw[k][0], o1); unpack8(raw[k][1], o2); unpack8(raw[k][2], bgc); unpack8(raw[k][3], ga); unpack8(raw[k][4], cu0); unpack8(raw[k][5], cu1); unpack8(raw[k][6], cu2);
            const float k1 = (tl >= 1) ? 1.f : 0.f, k2 = (tl >= 2) ? 1.f : 0.f;
            float d[8], sq = 0.f;
#pragma unroll
            for (int i = 0; i < 8; ++i) { d[i] = o1[i] - C.lam * o2[i]; sq += d[i] * d[i]; }
            sq += __shfl_xor(sq, 1); sq += __shfl_xor(sq, 2); sq += __shfl_xor(sq, 4); sq += __shfl_xor(sq, 8);
            const float r = __builtin_amdgcn_rsqf(sq * (1.0f / 128.0f) + RMS_EPS);
            float mo[8];
#pragma unroll
            for (int i = 0; i < 8; ++i) {
                const float yc = bgc[i] * (C.w0[i] * (cu2[i] * k2) + C.w1[i] * (cu1[i] * k1) + C.w2[i] * cu0[i]);
                const float ya = d[i] * r * C.g[i];
                mo[i] = sigmoidf_(ga[i]) * ya + yc; }
            v4u w; w.x = pk2(mo[0], mo[1]); w.y = pk2(mo[2], mo[3]); w.z = pk2(mo[4], mo[5]); w.w = pk2(mo[6], mo[7]);
            st16_wt((void*)(Mx + t * 1024 + c), w);
        }
    }
}
struct MergePost { bool on; int l, b, h;
    __device__ __forceinline__ void run(attn_body::lds_cptr stg, int tl0, int lane) const {
        const kargs_t A = KARGS(); asm volatile("s_waitcnt vmcnt(0)" ::: "memory");
        MergeCtx MC; merge_setup(MC, A, l, h, lane); merge_wave(MC, A->ws, b, h, tl0, stg, lane); } };

constexpr int TILE_TAB_OFF = RING_BYTES + 1024 + 4096;
__device__ __forceinline__ void route_phase(int l) {
    const kargs_t A = KARGS(); Frame F = make_frame(A);
    const int lane = F.lane, tid = F.tid, j = l >> 1;
    LAS float* WrT = (LAS float*)(F.lds);
    volatile LAS int* cntl = (volatile LAS int*)(F.lds + 32768);
    volatile LAS int* gbase = cntl + 8;
    volatile LAS int* li = cntl + 16;
    volatile LAS int* lr = cntl + 16 + 128;
    volatile LAS float* lw = (volatile LAS float*)(cntl + 16 + 256);
    const float* Wr = A->in[14] + (size_t)j * DM * NEXP; const float* gn = A->in[10] + (size_t)l * DM;
    for (int idx = tid; idx < DM * NEXP; idx += NWAVES * 64) { const int k = idx >> 3, e = idx & 7; WrT[e * DM + k] = Wr[idx] * gn[k]; }
    gu32* gcnt = F.ctl + CW_GCNT + j * 8 * 64;
    int* slotof = (int*)(F.ws + WS_ROUTE + RT_SLOTOF); float* wslot = (float*)(F.ws + WS_ROUTE + RT_WSLOT); float* ssslot = (float*)(F.ws + WS_ROUTE + RT_SSSLOT);
    unsigned char* xg = (unsigned char*)(F.ws + WS_O);
    for (int blk = F.vcu; blk < M / 64; blk += F.G) {
        if (tid < 8) cntl[tid] = 0;
        __syncthreads();
        float ssq[8];
        const bf16* xbr = (const bf16*)(F.ws + WS_XB) + (size_t)(blk * 64 + F.wave * 8) * DM + 8 * lane;
        v4u cur0 = *(const GAS v4u*)xbr, cur1 = *(const GAS v4u*)(xbr + 512);
#pragma unroll
        for (int rr = 0; rr < 8; ++rr) {
            const int loc = F.wave * 8 + rr;
            v4u nx0 = cur0, nx1 = cur1;
            if (rr < 7) { nx0 = *(const GAS v4u*)(xbr + (size_t)(rr + 1) * DM); nx1 = *(const GAS v4u*)(xbr + (size_t)(rr + 1) * DM + 512); }
            float v[16]; float s = 0.f;
            { float t8[8]; unpack8(cur0, t8);
#pragma unroll
              for (int i = 0; i < 8; ++i) v[i] = t8[i];
              unpack8(cur1, t8);
#pragma unroll
              for (int i = 0; i < 8; ++i) v[8 + i] = t8[i]; }
#pragma unroll
            for (int i = 0; i < 16; ++i) s += v[i] * v[i];
            s = wave_sum(s); ssq[rr] = s; const float rstd = 1.0f / sqrtf(s * (1.0f / 1024.0f) + RMS_EPS);
            float lg[8];
#pragma unroll
            for (int e = 0; e < 8; ++e) { float a = 0.f;
#pragma unroll
                for (int q = 0; q < 2; ++q) { const f32x4 w0 = *(const LAS f32x4*)(WrT + e * DM + 512 * q + 8 * lane), w1 = *(const LAS f32x4*)(WrT + e * DM + 512 * q + 8 * lane + 4);
                    a += (v[8 * q] * w0.x + v[8 * q + 1] * w0.y) + (v[8 * q + 2] * w0.z + v[8 * q + 3] * w0.w) + (v[8 * q + 4] * w1.x + v[8 * q + 5] * w1.y) + (v[8 * q + 6] * w1.z + v[8 * q + 7] * w1.w); }
                lg[e] = wave_sum(a) * rstd; }
            int i0 = 0; float v0 = lg[0];
#pragma unroll
            for (int e = 1; e < 8; ++e) if (lg[e] > v0) { v0 = lg[e]; i0 = e; }
            int i1 = -1; float v1 = -INFINITY;
#pragma unroll
            for (int e = 0; e < 8; ++e) if (e != i0 && lg[e] > v1) { v1 = lg[e]; i1 = e; }
            if (i1 < 0) i1 = (i0 + 1) & 7;
            const float wA = 1.0f / (1.0f + __expf(v1 - v0)), wB = 1.0f - wA;
            if (lane == 0) {
                const int r0 = __hip_atomic_fetch_add((LAS int*)&cntl[i0], 1, __ATOMIC_RELAXED, __HIP_MEMORY_SCOPE_WORKGROUP);
                const int r1 = __hip_atomic_fetch_add((LAS int*)&cntl[i1], 1, __ATOMIC_RELAXED, __HIP_MEMORY_SCOPE_WORKGROUP);
                li[2 * loc] = i0; li[2 * loc + 1] = i1; lr[2 * loc] = r0; lr[2 * loc + 1] = r1; lw[2 * loc] = wA; lw[2 * loc + 1] = wB;
            }
            cur0 = nx0; cur1 = nx1;
            asm volatile("" ::: "memory");
        }
        __syncthreads();
        if (tid < 8) gbase[tid] = (int)__hip_atomic_fetch_add(gcnt + tid * 64, (unsigned)cntl[tid], RLX_AGENT);
        __syncthreads();
        v4u vs[8][2];
#pragma unroll
        for (int rr = 0; rr < 8; ++rr) { vs[rr][0] = *(const GAS v4u*)(xbr + (size_t)rr * DM); vs[rr][1] = *(const GAS v4u*)(xbr + (size_t)rr * DM + 512); }
#pragma unroll
        for (int rr = 0; rr < 8; ++rr) {
            const int loc = F.wave * 8 + rr, t = blk * 64 + loc;
            const int e0 = li[2 * loc], e1 = li[2 * loc + 1];
            const int s0 = e0 * ECAP + gbase[e0] + lr[2 * loc], s1 = e1 * ECAP + gbase[e1] + lr[2 * loc + 1];
            typedef unsigned u32x2_t __attribute__((ext_vector_type(2)));
#pragma unroll
            for (int q = 0; q < 2; ++q) { float t8[8]; unpack8(vs[rr][q], t8); u32x2_t w = {0u, 0u};
                w.x = __builtin_amdgcn_cvt_pk_fp8_f32(pg8::clamp448(t8[0] * 8.f), pg8::clamp448(t8[1] * 8.f), w.x, false); w.x = __builtin_amdgcn_cvt_pk_fp8_f32(pg8::clamp448(t8[2] * 8.f), pg8::clamp448(t8[3] * 8.f), w.x, true);
                w.y = __builtin_amdgcn_cvt_pk_fp8_f32(pg8::clamp448(t8[4] * 8.f), pg8::clamp448(t8[5] * 8.f), w.y, false); w.y = __builtin_amdgcn_cvt_pk_fp8_f32(pg8::clamp448(t8[6] * 8.f), pg8::clamp448(t8[7] * 8.f), w.y, true);
                st8_wt((void*)(xg + (size_t)s0 * DM + 512 * q + 8 * lane), w); st8_wt((void*)(xg + (size_t)s1 * DM + 512 * q + 8 * lane), w); }
            if (lane == 0) { slotof[2 * t] = s0; slotof[2 * t + 1] = s1; wslot[s0] = lw[2 * loc]; wslot[s1] = lw[2 * loc + 1];
                const f32x4 sv = {ssq[rr], 0.f, 0.f, 0.f}; *(GAS f32x4*)(ssslot + 4 * (size_t)s0) = sv; *(GAS f32x4*)(ssslot + 4 * (size_t)s1) = sv; }
        }
        __syncthreads();
    }
}
__device__ __forceinline__ void build_tiles(LAS unsigned char* lds, gu32* gcnt) {
    const int tid = opaque_tid(); LAS int* tab = (LAS int*)(lds + TILE_TAB_OFF);
    int seg = 0, ent = -1;
#pragma unroll
    for (int e = 0; e < 8; ++e) { const int nte = ((int)__hip_atomic_load(gcnt + e * 64, RLX_AGENT) + 255) >> 8;
        if (tid >= seg && tid < seg + nte) ent = (e << 16) | (e * (ECAP / 256) + (tid - seg)); seg += nte; }
    if (tid < 255 && ent >= 0) tab[tid] = ent;
    if (tid == 0) tab[255] = seg;
    __syncthreads();
}
__device__ __forceinline__ void combine_phase(int l) {
    const kargs_t A = KARGS(); Frame F = make_frame(A);
    const int lane = F.lane; const int gw = F.vcu * NWAVES + F.wave, NGW = F.G * NWAVES;
    const int* slotof = (const int*)(F.ws + WS_ROUTE + RT_SLOTOF); const bf16* Y = (const bf16*)(F.ws + WS_Y); bf16* xb = (bf16*)(F.ws + WS_XB);
    volatile LAS int* segc = (volatile LAS int*)(F.lds);
    if (F.tid == 0) { gu32* gcnt = F.ctl + CW_GCNT + (l >> 1) * 8 * 64; int s = 0; for (int e = 0; e < 8; ++e) { segc[e] = s; s += (((int)__hip_atomic_load(gcnt + e * 64, RLX_AGENT) + 255) >> 8) << 8; } }
    __syncthreads();
    float* ssn = (float*)(F.ws + WS_SS) + (size_t)(2 * l + 2) * M * 4; const bool fin = (l == DEPTH - 1);
    const float* gf = A->in[18];
    for (int t0 = gw * 4; t0 < M; t0 += NGW * 4) {
        v2u xa[4][4], ya[4][4], yb[4][4];
#pragma unroll
        for (int r = 0; r < 4; ++r) { const int t = t0 + r; const int p0 = slotof[2 * t], p1 = slotof[2 * t + 1];
            const int s0 = segc[p0 >> ECAP_LOG] + (p0 & (ECAP - 1)), s1 = segc[p1 >> ECAP_LOG] + (p1 & (ECAP - 1));
            const GAS v2u* xr = (const GAS v2u*)(xb + (size_t)t * DM) + lane;
            const GAS v2u* y0 = (const GAS v2u*)(Y + (size_t)s0 * DM) + lane; const GAS v2u* y1 = (const GAS v2u*)(Y + (size_t)s1 * DM) + lane;
#pragma unroll
            for (int q = 0; q < 4; ++q) { xa[r][q] = xr[64 * q]; ya[r][q] = y0[64 * q]; yb[r][q] = y1[64 * q]; } }
        asm volatile("" ::: "memory");
#pragma unroll
        for (int r = 0; r < 4; ++r) { const int t = t0 + r; float s = 0.f; f32x4 v[4];
#pragma unroll
            for (int q = 0; q < 4; ++q) { const v2u c = xa[r][q], a = ya[r][q], b = yb[r][q]; f32x4& x = v[q];
                x.x = bflo(c.x) + (bflo(a.x) + bflo(b.x)); x.y = bfhi(c.x) + (bfhi(a.x) + bfhi(b.x)); x.z = bflo(c.y) + (bflo(a.y) + bflo(b.y)); x.w = bfhi(c.y) + (bfhi(a.y) + bfhi(b.y));
                s += (x.x * x.x + x.y * x.y) + (x.z * x.z + x.w * x.w); }
            s = wave_sum(s);
            if (!fin) {
                GAS v2u* o8 = (GAS v2u*)(xb + (size_t)t * DM) + lane;
#pragma unroll
                for (int q = 0; q < 4; ++q) { v2u w; w.x = pk2(v[q].x, v[q].y); w.y = pk2(v[q].z, v[q].w); st8_wt((void*)(o8 + 64 * q), w); }
                if ((INPROJ_F8_MASK & 4) && INPROJ_F8(l + 1)) {
                    GAS unsigned* q8 = (GAS unsigned*)(F.ws + WS_O + (size_t)t * DM) + lane;
#pragma unroll
                    for (int q = 0; q < 4; ++q) { unsigned w = 0u;
                        w = __builtin_amdgcn_cvt_pk_fp8_f32(pg8::clamp448(v[q].x * 8.0f), pg8::clamp448(v[q].y * 8.0f), w, false);
                        w = __builtin_amdgcn_cvt_pk_fp8_f32(pg8::clamp448(v[q].z * 8.0f), pg8::clamp448(v[q].w * 8.0f), w, true); q8[64 * q] = w; } }
                if (lane == 0) *(GAS f32x4*)(ssn + 4 * (size_t)t) = (f32x4){s, 0.f, 0.f, 0.f};
            } else {
                const float rstd = 1.0f / sqrtf(s * (1.0f / 1024.0f) + RMS_EPS);
                GAS f32x4* xo = (GAS f32x4*)(F.X + (size_t)t * DM) + lane;
#pragma unroll
                for (int q = 0; q < 4; ++q) { const f32x4 gg = *((const GAS f32x4*)gf + lane + 64 * q); xo[64 * q] = v[q] * rstd * gg; }
            } }
    }
}

__device__ __forceinline__ XcdBarrier make_bar(unsigned char* ws) {
    extern __shared__ __attribute__((aligned(16))) unsigned char lds[];
    XcdBarrier b; b.bar = (unsigned*)(ws + WS_CTL) + CW_BAR; b.x = xb_xcc_id(); b.st = (volatile LAS unsigned*)((LAS unsigned char*)lds + MISC_OFF) + 8; return b;
}
__global__ void __launch_bounds__(NWAVES * 64, 2) trunk_fwd(Args args_unused) {
    extern __shared__ __attribute__((aligned(16))) unsigned char lds[];
    { const int tid = threadIdx.x;
      for (int u = tid; u < (LDS_BYTES - LDSCTL_OFF) / 4; u += NWAVES * 64) ((LAS unsigned*)((LAS unsigned char*)lds + LDSCTL_OFF))[u] = 0u;
      __syncthreads();
      if (!MK_PER_PHASE) { const kargs_t A = KARGS(); (void)xcd_barrier_post((unsigned*)(A->ws + WS_CTL) + CW_BAR, (volatile LAS unsigned*)((LAS unsigned char*)lds + MISC_OFF) + 8); } }
    int ph = 0;
#define PH_ON ({ const kargs_t Ap_ = KARGS(); ph >= Ap_->ph_lo && ph < Ap_->ph_hi; })
#define PH_END do { if (!MK_PER_PHASE && PH_ON && ph + 1 < KARGS()->ph_hi) { const kargs_t A_ = KARGS(); xcd_barrier(make_bar(A_->ws)); } ++ph; } while (0)

    for (int rep_ = 0; rep_ < (((PROBE_DUP >> 0) & 1) ? 2 : 1); ++rep_) if (((PH_MASK >> 0) & 1) && PH_ON) p0_prologue();
    PH_END;

    for (int l = 0; l < DEPTH; ++l) {
        for (int rep_ = 0; rep_ < (((PROBE_DUP >> 1) & 1) ? 2 : 1); ++rep_) if (((PH_MASK >> 1) & 1) && PH_ON) {
            const kargs_t A = KARGS(); unsigned char* ws = A->ws;
            pg8::StaticOrder S; S.init(M, IN_W, opaque_grid(), opaque_bid());
            if ((INPROJ_F8_MASK != 0) && INPROJ_F8(l)) {
                pg8::Gemm g{(const bf16*)(ws + WS_O), (const bf16*)(ws + WS_WIN + (size_t)l * IN_W * DM * 2), M, IN_W, DM, 0};
                pg8::EpiProj E{(bf16*)(ws + WS_PROJ), (const float*)(ws + WS_SS) + (size_t)(2 * l) * M * 4, (const float*)(ws + WS_ROPEC), (const float*)(ws + WS_ROPES), attn_body::C2, 1.0f / 2048.0f};
                pg8::gemm_phase<pg8::EpiProj, pg8::StaticOrder, PG8_ALIGN, PG8_SP2, true>((LAS unsigned char*)lds + RING_OFF, g, S, E);
            } else {
            pg8::Gemm g{(const bf16*)(ws + WS_XB), (const bf16*)(ws + WS_WIN) + (size_t)l * IN_W * DM, M, IN_W, DM, 0};
            pg8::EpiProj E{(bf16*)(ws + WS_PROJ), (const float*)(ws + WS_SS) + (size_t)(2 * l) * M * 4, (const float*)(ws + WS_ROPEC), (const float*)(ws + WS_ROPES), attn_body::C2};
            pg8::gemm_phase<pg8::EpiProj, pg8::StaticOrder, PG8_ALIGN, PG8_SP2>((LAS unsigned char*)lds + RING_OFF, g, S, E); }
        }
        PH_END;
        for (int rep_ = 0; rep_ < (((PROBE_DUP >> 2) & 1) ? 2 : 1); ++rep_) if (((PH_MASK >> 2) & 1) && PH_ON) {
            const kargs_t A = KARGS(); unsigned char* ws = A->ws;
            const attn_body::bf16* Qb = (const attn_body::bf16*)(ws + WS_PROJ); attn_body::bf16* Ob = (attn_body::bf16*)(ws + WS_O);
            const int G = opaque_grid(), bx = opaque_bid(), vcu = (G % 8 == 0) ? (bx % 8) * (G / 8) + bx / 8 : bx;
            attn_body::AttnCarry cy; cy.primed = false; cy.s0 = 0;
#pragma unroll
            for (int d0 = 0; d0 < 4; ++d0) cy.qr[d0] = (attn_body::bf16x8){0, 0, 0, 0, 0, 0, 0, 0};
            for (int vc = vcu; vc < 256; vc += G) {
                const int bh = vc >> 2, b = bh >> 3, h = bh & 7;
                for (int u = 0; u < 4; ++u) {
                    const int mp = u & 1, qb = (u >> 1) ? (vc & 3) : 7 - (vc & 3);
                    if (((vc >> 2) & 3) == u) {
                        const kargs_t A3 = KARGS(); const int tid3 = opaque_tid(); int grp3 = l + 1; asm volatile("" : "+s"(grp3));
                        convert_group(A3, A3->ws, grp3, vc * NWAVES + (tid3 >> 6), 256 * NWAVES, tid3 & 63);
                    }
                    const attn_body::bf16* Qh = Qb + (size_t)b * SEQ * 1024 + (2 * h + mp) * 64;
                    const attn_body::bf16* Vh = Qb + (size_t)2 * M * 1024 + (size_t)b * SEQ * 1024 + h * 128;
                    attn_body::AttnNext nx; nx.has = (u < 3); nx.qb = ((u + 1) >> 1) ? (vc & 3) : 7 - (vc & 3);
                    nx.Qh = Qb + (size_t)b * SEQ * 1024 + (2 * h + ((u + 1) & 1)) * 64; nx.Kh = nx.Qh + (size_t)M * 1024; nx.Vh = Vh;
                    const MergePost post{mp == 1, l, b, h};
                    attn_body::attn_unit128<8>(qb, Qh, Qh + (size_t)M * 1024, Vh, Ob + (size_t)b * SEQ * 2048 + h * 256 + mp * 128, (char*)lds + RING_OFF, post, nx, cy);
                }
            }
        }
        PH_END;
        for (int rep_ = 0; rep_ < (((PROBE_DUP >> 4) & 1) ? 2 : 1); ++rep_) if (((PH_MASK >> 4) & 1) && PH_ON) {
            const kargs_t A = KARGS(); unsigned char* ws = A->ws;
            pg8::Gemm g{(const bf16*)(ws + WS_MIX), (const bf16*)(ws + WS_WOUT) + (size_t)l * DM * DM, M, DM, DM, 0};
            pg8::StaticOrder S; S.init(M, DM, opaque_grid(), opaque_bid());
            if (l & 1) { pg8::EpiResidLite E{(bf16*)(ws + WS_XB), nullptr};
                pg8::gemm_phase<pg8::EpiResidLite, pg8::StaticOrder, PG8_ALIGN, PG8_SP2>((LAS unsigned char*)lds + RING_OFF, g, S, E); }
            else if (DENSE_F8(l >> 1)) { pg8::EpiResidF8X E{(bf16*)(ws + WS_XB), (float*)(ws + WS_SS) + (size_t)(2 * l + 1) * M * 4, (unsigned char*)(ws + WS_O), 1.0f};
                pg8::gemm_phase<pg8::EpiResidF8X, pg8::StaticOrder, PG8_ALIGN, PG8_SP2>((LAS unsigned char*)lds + RING_OFF, g, S, E); }
            else { pg8::EpiResid E{(bf16*)(ws + WS_XB), (float*)(ws + WS_SS) + (size_t)(2 * l + 1) * M * 4};
                pg8::gemm_phase<pg8::EpiResid, pg8::StaticOrder, PG8_ALIGN, PG8_SP2>((LAS unsigned char*)lds + RING_OFF, g, S, E); }
        }
        PH_END;
        if ((l & 1) == 0) {
            for (int rep_ = 0; rep_ < (((PROBE_DUP >> 5) & 1) ? 2 : 1); ++rep_) if (((PH_MASK >> 5) & 1) && PH_ON) {
                const kargs_t A = KARGS(); unsigned char* ws = A->ws; const int j = l >> 1;
                pg8::StaticOrder S; S.init(M, 2 * DFF, opaque_grid(), opaque_bid());
                if (DENSE_F8(j)) {
                    pg8::Gemm g{(const bf16*)(ws + WS_O), (const bf16*)(ws + WS_WGU + (size_t)j * 2 * DFF * DM * 2), M, 2 * DFF, DM, 0};
                    pg8::EpiSwigluF8 E{(void*)(ws + WS_PROJ), DFF, (const float*)(ws + WS_SS) + (size_t)(2 * l + 1) * M * 4, 1.0f / 2048.0f};
                    pg8::gemm_phase<pg8::EpiSwigluF8, pg8::StaticOrder, PG8_ALIGN, PG8_SP2, true>((LAS unsigned char*)lds + RING_OFF, g, S, E);
                } else {
                pg8::Gemm g{(const bf16*)(ws + WS_XB), (const bf16*)(ws + WS_WGU) + (size_t)j * 2 * DFF * DM, M, 2 * DFF, DM, 0};
                if (((DENSE_DN_F8_MASK & ~DENSE_F8_MASK) != 0) && DENSE_DN_F8(j)) {
                    pg8::EpiSwigluF8 E{(void*)(ws + WS_PROJ), DFF, (const float*)(ws + WS_SS) + (size_t)(2 * l + 1) * M * 4, 1.0f};
                    pg8::gemm_phase<pg8::EpiSwigluF8, pg8::StaticOrder, PG8_ALIGN, PG8_SP2>((LAS unsigned char*)lds + RING_OFF, g, S, E);
                } else {
                pg8::EpiSwiglu E{(void*)(ws + WS_PROJ), DFF, (const float*)(ws + WS_SS) + (size_t)(2 * l + 1) * M * 4, 1.0f};
                pg8::gemm_phase<pg8::EpiSwiglu, pg8::StaticOrder, PG8_ALIGN, PG8_SP2>((LAS unsigned char*)lds + RING_OFF, g, S, E); } }
            }
            PH_END;
            for (int rep_ = 0; rep_ < (((PROBE_DUP >> 6) & 1) ? 2 : 1); ++rep_) if (((PH_MASK >> 6) & 1) && PH_ON) {
                const kargs_t A = KARGS(); unsigned char* ws = A->ws; const int j = l >> 1;
                pg8::StaticOrder S; S.init(M, DM, opaque_grid(), opaque_bid());
                constexpr bool C_F8_X = ((DENSE_DN_F8_MASK & 1) && (INPROJ_F8_MASK & 2)) || ((DENSE_DN_F8_MASK & 2) && (INPROJ_F8_MASK & 8));
                constexpr bool C_F8_N = ((DENSE_DN_F8_MASK & 1) && !(INPROJ_F8_MASK & 2)) || ((DENSE_DN_F8_MASK & 2) && !(INPROJ_F8_MASK & 8));
                constexpr bool C_BF_X = (!(DENSE_DN_F8_MASK & 1) && (INPROJ_F8_MASK & 2)) || (!(DENSE_DN_F8_MASK & 2) && (INPROJ_F8_MASK & 8));
                const bool f8x = INPROJ_F8(l + 1);
                if (C_F8_X && DENSE_DN_F8(j) && f8x) {
                    pg8::Gemm g{(const bf16*)(ws + WS_PROJ), (const bf16*)(ws + WS_WD + (size_t)j * DM * DFF * 2), M, DM, DFF, 0};
                    pg8::EpiResidF8X E{(bf16*)(ws + WS_XB), (float*)(ws + WS_SS) + (size_t)(2 * l + 2) * M * 4, (unsigned char*)(ws + WS_O), 1.0f / 2048.0f};
                    pg8::gemm_phase<pg8::EpiResidF8X, pg8::StaticOrder, PG8_ALIGN, PG8_SP2, true>((LAS unsigned char*)lds + RING_OFF, g, S, E);
                } else if (C_F8_N && DENSE_DN_F8(j)) {
                    pg8::Gemm g{(const bf16*)(ws + WS_PROJ), (const bf16*)(ws + WS_WD + (size_t)j * DM * DFF * 2), M, DM, DFF, 0};
                    pg8::EpiResid E{(bf16*)(ws + WS_XB), (float*)(ws + WS_SS) + (size_t)(2 * l + 2) * M * 4, nullptr, 1.0f / 2048.0f};
                    pg8::gemm_phase<pg8::EpiResid, pg8::StaticOrder, PG8_ALIGN, PG8_SP2, true>((LAS unsigned char*)lds + RING_OFF, g, S, E);
                } else if (C_BF_X && f8x) {
                    pg8::Gemm g{(const bf16*)(ws + WS_PROJ), (const bf16*)(ws + WS_WD) + (size_t)j * DM * DFF, M, DM, DFF, 0};
                    pg8::EpiResidF8X E{(bf16*)(ws + WS_XB), (float*)(ws + WS_SS) + (size_t)(2 * l + 2) * M * 4, (unsigned char*)(ws + WS_O), 1.0f};
                    pg8::gemm_phase<pg8::EpiResidF8X, pg8::StaticOrder, PG8_ALIGN, PG8_SP2>((LAS unsigned char*)lds + RING_OFF, g, S, E);
                } else {
                pg8::Gemm g{(const bf16*)(ws + WS_PROJ), (const bf16*)(ws + WS_WD) + (size_t)j * DM * DFF, M, DM, DFF, 0};
                pg8::EpiResid E{(bf16*)(ws + WS_XB), (float*)(ws + WS_SS) + (size_t)(2 * l + 2) * M * 4};
                pg8::gemm_phase<pg8::EpiResid, pg8::StaticOrder, PG8_ALIGN, PG8_SP2>((LAS unsigned char*)lds + RING_OFF, g, S, E); }
            }
            PH_END;
        } else {
            for (int rep_ = 0; rep_ < (((PROBE_DUP >> 7) & 1) ? 2 : 1); ++rep_) if (((PH_MASK >> 7) & 1) && PH_ON) route_phase(l);
            PH_END;
            for (int rep_ = 0; rep_ < (((PROBE_DUP >> 9) & 1) ? 2 : 1); ++rep_) if (((PH_MASK >> 9) & 1) && PH_ON) {
                const kargs_t A = KARGS(); unsigned char* ws = A->ws; const int j = l >> 1;
                build_tiles((LAS unsigned char*)lds, (gu32*)(ws + WS_CTL) + CW_GCNT + j * 8 * 64);
                const LAS int* tab = (const LAS int*)((LAS unsigned char*)lds + TILE_TAB_OFF);
                const int ntl = __builtin_amdgcn_readfirstlane(tab[255]);
                pg8::Gemm g{(const bf16*)(ws + WS_O), (const bf16*)(ws + WS_WEGU + (size_t)j * 8 * 2 * DFFE * DM), NEXP * ECAP, 2 * DFFE, DM, (size_t)2 * DFFE * DM};
                pg8::GroupedOrder S; S.init(ntl, 2 * DFFE, opaque_grid(), opaque_bid(), tab, true);
                pg8::EpiSwigluF8 E{(void*)(ws + WS_PROJ), DFFE, (const float*)(ws + WS_ROUTE + RT_SSSLOT), 1.0f / 2048.0f};
                pg8::gemm_phase<pg8::EpiSwigluF8, pg8::GroupedOrder, PG8_ALIGN, PG8_SP2, true>((LAS unsigned char*)lds + RING_OFF, g, S, E);
            }
            PH_END;
            for (int rep_ = 0; rep_ < (((PROBE_DUP >> 10) & 1) ? 2 : 1); ++rep_) if (((PH_MASK >> 10) & 1) && PH_ON) {
                const kargs_t A = KARGS(); unsigned char* ws = A->ws; const int j = l >> 1;
                build_tiles((LAS unsigned char*)lds, (gu32*)(ws + WS_CTL) + CW_GCNT + j * 8 * 64);
                const LAS int* tab = (const LAS int*)((LAS unsigned char*)lds + TILE_TAB_OFF);
                const int ntl = __builtin_amdgcn_readfirstlane(tab[255]);
                pg8::Gemm g{(const bf16*)(ws + WS_PROJ), (const bf16*)(ws + WS_WED + (size_t)j * 8 * DM * DFFE), MSLOT, DM, DFFE, (size_t)DM * DFFE};
                pg8::GroupedOrder S; S.init(ntl, DM, opaque_grid(), opaque_bid(), tab, false);
                pg8::EpiSlot E{(bf16*)(ws + WS_Y), (const float*)(ws + WS_ROUTE + RT_WSLOT), 1.0f / 2048.0f};
                pg8::gemm_phase<pg8::EpiSlot, pg8::GroupedOrder, PG8_ALIGN, PG8_SP2, true>((LAS unsigned char*)lds + RING_OFF, g, S, E);
            }
            PH_END;
            for (int rep_ = 0; rep_ < (((PROBE_DUP >> 11) & 1) ? 2 : 1); ++rep_) if (((PH_MASK >> 11) & 1) && PH_ON) combine_phase(l);
            PH_END;
        }
    }
#undef PH_ON
#undef PH_END
}

constexpr int N_PHASES = 1 + 2 * 5 + 2 * 7;

extern "C" void kernel_launch(void* const* d_in, const int* in_sizes, int n_in, void* d_out, int out_size, void* d_ws, size_t ws_size, hipStream_t stream) {
    static int grid = 0;
    if (grid == 0) {
        if (n_in != 19 || in_sizes[0] != M * DM || out_size != M * DM || ws_size < WS_END) { fprintf(stderr, "kernel_launch: unexpected shapes / workspace (n_in %d, in0 %d, out %d, ws %zu < %zu); nothing launched\n", n_in, n_in > 0 ? in_sizes[0] : -1, out_size, ws_size, (size_t)WS_END); grid = -1; return; }
        int dev = 0, cus = 0, per_cu = 0;
        if (hipGetDevice(&dev) != hipSuccess || hipDeviceGetAttribute(&cus, hipDeviceAttributeMultiprocessorCount, dev) != hipSuccess) { grid = -1; return; }
        if (hipFuncSetAttribute((const void*)trunk_fwd, hipFuncAttributeMaxDynamicSharedMemorySize, LDS_BYTES) != hipSuccess) { fprintf(stderr, "kernel_launch: hipFuncSetAttribute failed\n"); grid = -1; return; }
        if (hipOccupancyMaxActiveBlocksPerMultiprocessor(&per_cu, (const void*)trunk_fwd, NWAVES * 64, LDS_BYTES) != hipSuccess || per_cu < 1)
            fprintf(stderr, "kernel_launch: note: occupancy query reports %d workgroups per CU\n", per_cu);
        (void)hipGetLastError();
        grid = cus;
        if (grid > 256) grid = 256;
    }
    if (grid < 0) return;
    if (hipMemsetAsync((char*)d_ws + WS_CTL, 0, CTL_ZERO_BYTES, stream) != hipSuccess) return;
    Args a{};
    for (int i = 0; i < 19; ++i) a.in[i] = (const float*)d_in[i];
    a.out = (float*)d_out; a.ws = (unsigned char*)d_ws;
#if MK_PER_PHASE
    for (int p = 0; p < N_PHASES; ++p) { a.ph_lo = p; a.ph_hi = p + 1; hipLaunchKernelGGL(trunk_fwd, dim3(grid), dim3(NWAVES * 64), LDS_BYTES, stream, a); }
#else
    a.ph_lo = 0; a.ph_hi = N_PHASES;
    hipLaunchKernelGGL(trunk_fwd, dim3(grid), dim3(NWAVES * 64), LDS_BYTES, stream, a);
#endif
}
```

```cpp
#include <hip/hip_runtime.h>
#include <hip/hip_bf16.h>
#include <cstdio>
#include <cstdint>
#include <cmath>

#ifndef PH_MASK
#define PH_MASK 0xFFFF
#endif
#ifndef DENSE_F8_MASK
#define DENSE_F8_MASK 2
#endif
#define DENSE_F8(j) (((DENSE_F8_MASK) >> (j)) & 1)
#ifndef DENSE_DN_F8_MASK
#define DENSE_DN_F8_MASK 3
#endif
#define DENSE_DN_F8(j) (((DENSE_DN_F8_MASK) >> (j)) & 1)
static_assert((DENSE_DN_F8_MASK & DENSE_F8_MASK) == DENSE_F8_MASK, "an fp8 gate|up GEMM writes fp8 hidden activations: its down projection is fp8 too");
#ifndef INPROJ_F8_MASK
#define INPROJ_F8_MASK 12
#endif
#define INPROJ_F8(l) (((INPROJ_F8_MASK) >> (l)) & 1)
static_assert((INPROJ_F8_MASK & 1) == 0, "layer 0's in-projection reads the prologue's bf16 x");
#ifndef PROBE_DUP
#define PROBE_DUP 0
#endif
#ifndef MK_PER_PHASE
#define MK_PER_PHASE 0
#endif

constexpr int BATCH = 8, SEQ = 2048, DM = 1024, DEPTH = 4;
constexpr int M = BATCH * SEQ;
constexpr int NHEADS = 8;
constexpr int IN_W = 8192;
constexpr int DFF = 2816, DFFE = 3584, NEXP = 8;
constexpr int MSLOT = 2 * M + NEXP * 256;
constexpr float RMS_EPS = 1e-5f;

__device__ __forceinline__ int opaque_tid() { int t = threadIdx.x; asm volatile("" : "+v"(t)); return t; }
__device__ __forceinline__ int opaque_bid() { int t = blockIdx.x; asm volatile("" : "+s"(t)); return t; }
__device__ __forceinline__ int opaque_grid() { int t = gridDim.x; asm volatile("" : "+s"(t)); return t; }

typedef unsigned wt_u32x4 __attribute__((ext_vector_type(4))); typedef unsigned wt_u32x2 __attribute__((ext_vector_type(2)));
__device__ __forceinline__ void st16_wt(void* p, wt_u32x4 v) { asm volatile("global_store_dwordx4 %0, %1, off sc1\n\ts_nop 1" :: "v"(p), "v"(v) : "memory"); }
__device__ __forceinline__ void st8_wt(void* p, wt_u32x2 v) { asm volatile("global_store_dwordx2 %0, %1, off sc1" :: "v"(p), "v"(v) : "memory"); }

namespace pg8 {
#define PG8_LAS __attribute__((address_space(3)))
typedef unsigned short bf16_t;
typedef short bf16x8 __attribute__((ext_vector_type(8)));
typedef float f32x4 __attribute__((ext_vector_type(4)));
typedef unsigned u32x4 __attribute__((ext_vector_type(4)));
constexpr int BM = 256, BK = 64, HALF = 128, HTB = HALF * BK * 2, STAGE_BYTES = 8 * HTB, NXCD = 8, WGM = 8;

__host__ __device__ __forceinline__ int lds_byte(int r, int c) { const int st = (r >> 4) * 2 + (c >> 5), rr = r & 15, cc = c & 31, ob = rr * 64 + cc * 2; return st * 1024 + (ob ^ (((ob >> 9) & 1) << 5)); }
__host__ __device__ __forceinline__ void stage_rc(int b, int& R, int& C) { const int st = b / 1024, sb = b % 1024, swz = sb ^ (((sb >> 9) & 1) << 5); R = (st >> 1) * 16 + swz / 64; C = (st & 1) * 32 + (swz % 64) / 2; }
__host__ __device__ __forceinline__ int perm32(int rho) { const int n = rho >> 4, i = rho & 15; return 8 * (i >> 2) + 4 * n + (i & 3); }

struct Unit { int pm, pn, be, pa, ps; };
struct Gemm { const bf16_t* A; const bf16_t* Bt; int M, N, K; size_t bstride; };

struct StaticOrder {
    int nM, nN, nwg, G, c;
    __host__ __device__ void init(int M_, int N_, int G_, int c_) { nM = M_ / BM; nN = N_ / BM; nwg = nM * nN; G = G_; c = c_; }
    __host__ __device__ bool next(int i, Unit& u) const {
        const long L = (long)i * G + c; if (L >= nwg) return false;
        int wgid = (int)L; { const int q = nwg / NXCD, r = nwg % NXCD, xcd = wgid % NXCD, off = wgid / NXCD; wgid = (xcd < r ? xcd * (q + 1) : r * (q + 1) + (xcd - r) * q) + off; }
        const int nig = WGM * nN, gid = wgid / nig, fm = gid * WGM, gsz = (nM - fm) < WGM ? (nM - fm) : WGM;
        u.pm = fm + ((wgid % nig) % gsz); u.pn = (wgid % nig) / gsz; u.be = 0; u.pa = u.pm; u.ps = u.pm; return true;
    }
    __device__ __forceinline__ void a_ready(const Unit&) const {}
    __device__ __forceinline__ void done(const Unit&) const {}
};
struct GroupedOrder {
    int nM, nN, nwg, G, c; const PG8_LAS int* tab; bool sparseA;
    __device__ void init(int nM_, int N_, int G_, int c_, const PG8_LAS int* tab_, bool sparseA_) { nM = nM_; nN = N_ / BM; nwg = nM * nN; G = G_; c = c_; tab = tab_; sparseA = sparseA_; }
    __device__ bool next(int i, Unit& u) const {
        const long L = (long)i * G + c; if (L >= nwg) return false;
        int wgid = (int)L; { const int q = nwg / NXCD, r = nwg % NXCD, xcd = wgid % NXCD, off = wgid / NXCD; wgid = (xcd < r ? xcd * (q + 1) : r * (q + 1) + (xcd - r) * q) + off; }
        const int nig = WGM * nN, gid = wgid / nig, fm = gid * WGM, gsz = (nM - fm) < WGM ? (nM - fm) : WGM;
        u.pm = fm + ((wgid % nig) % gsz); u.pn = (wgid % nig) / gsz;
        const int ent = __builtin_amdgcn_readfirstlane(tab[u.pm]); u.be = ent >> 16; u.ps = ent & 0xffff; u.pa = sparseA ? u.ps : u.pm; return true;
    }
    __device__ __forceinline__ void a_ready(const Unit&) const {}
    __device__ __forceinline__ void done(const Unit&) const {}
};

constexpr int RSC_OFF = 131072 + 8192;
__device__ __forceinline__ unsigned cvt_pk_bf16(float lo, float hi) { unsigned r; asm volatile("v_cvt_pk_bf16_f32 %0, %1, %2" : "=v"(r) : "v"(lo), "v"(hi)); return r; }
__device__ __forceinline__ u32x4 pack8(const f32x4 a, const f32x4 b) { u32x4 w; w.x = cvt_pk_bf16(a[0], a[1]); w.y = cvt_pk_bf16(a[2], a[3]); w.z = cvt_pk_bf16(b[0], b[1]); w.w = cvt_pk_bf16(b[2], b[3]); return w; }
__device__ __forceinline__ float rstd_of(const float* ss4) { const f32x4 p = *(const f32x4*)ss4; return __builtin_amdgcn_rsqf(((p[0] + p[1]) + (p[2] + p[3])) * (1.0f / 1024.0f) + RMS_EPS); }

struct EpiProj {
    static constexpr bool PERM = true, AFTER_DRAIN = false, NEEDS_ALIGN = false;
    bf16_t* P; const float* ss; const float* ropeC; const float* ropeS; float qscale; float ascale = 1.0f;
    mutable int pmc = -1;
    __device__ __forceinline__ PG8_LAS float* rsc_lds() const { extern __shared__ __attribute__((aligned(16))) unsigned char lds_all[]; return (PG8_LAS float*)((PG8_LAS unsigned char*)lds_all + RSC_OFF) + opaque_tid(); }
    __device__ __forceinline__ void refresh(const Unit& u, int wr, int fr) const {
        if (u.pm != pmc) { pmc = u.pm; const int row0 = u.pm * BM + wr * 64 + fr; f32x4 t_[8]; PG8_LAS float* rc = rsc_lds();
#pragma unroll
            for (int i = 0; i < 8; ++i) t_[i] = *(const f32x4*)(ss + 4 * (size_t)(row0 + (i >> 2) * HALF + (i & 3) * 16));
#pragma unroll
            for (int i = 0; i < 8; ++i) rc[i * 512] = __builtin_amdgcn_rsqf(((t_[i][0] + t_[i][1]) + (t_[i][2] + t_[i][3])) * (1.0f / 1024.0f) + RMS_EPS) * ascale;
            asm volatile("s_waitcnt lgkmcnt(0)" ::: "memory"); }
    }
    __device__ __forceinline__ void half(const f32x4 (&acc)[2][2][4][2], const Unit& u, int ai, int wr, int wc, int fr, int fq) const {
        asm volatile("" : "+v"(fr), "+v"(fq));
        refresh(u, wr, fr);
        float rsc[4]; { const PG8_LAS float* rc = rsc_lds();
#pragma unroll
            for (int m = 0; m < 4; ++m) rsc[m] = rc[(ai * 4 + m) * 512]; }
        const int t = u.pn >> 2, ct = u.pn & 3;
        bf16_t* base = P + (size_t)t * ((size_t)M * 1024);
        const int row0 = u.pm * BM + wr * 64 + fr;
        if (t < 2) {
            const float sc = (t == 0) ? qscale : 1.0f;
            int fqo = fq; asm volatile("" : "+v"(fqo));
            const int hcol = ct * 256 + wc * 64 + 8 * fq;
#pragma unroll
            for (int m = 0; m < 4; ++m) {
                const int row = row0 + ai * HALF + m * 16; const float rs = rsc[m] * sc; const int pos = row & (SEQ - 1);
                const f32x4 c0 = *(const f32x4*)(ropeC + pos * 32 + 8 * fqo), c1 = *(const f32x4*)(ropeC + pos * 32 + 8 * fqo + 4);
                const f32x4 s0 = *(const f32x4*)(ropeS + pos * 32 + 8 * fqo), s1 = *(const f32x4*)(ropeS + pos * 32 + 8 * fqo + 4);
                const f32x4 l0 = acc[ai][0][m][0] * rs, l1 = acc[ai][0][m][1] * rs, h0 = acc[ai][1][m][0] * rs, h1 = acc[ai][1][m][1] * rs;
                const f32x4 ol0 = l0 * c0 - h0 * s0, ol1 = l1 * c1 - h1 * s1, oh0 = h0 * c0 + l0 * s0, oh1 = h1 * c1 + l1 * s1;
                bf16_t* rowp = base + (size_t)row * 1024 + hcol;
                st16_wt(rowp, pack8(ol0, ol1)); st16_wt(rowp + 32, pack8(oh0, oh1));
                if (m & 1) asm volatile("" ::: "memory");
            }
        } else if (u.pn < 12 || u.pn >= 28) {
            bf16_t* b2 = P + (size_t)(u.pn < 12 ? 2 : 5) * ((size_t)M * 1024);
            const int col0 = ct * 256 + wc * 64 + 8 * fq;
#pragma unroll
            for (int m = 0; m < 4; ++m) {
                const int row = row0 + ai * HALF + m * 16; const float rs = rsc[m];
                bf16_t* rowp = b2 + (size_t)row * 1024 + col0;
#pragma unroll
                for (int bj = 0; bj < 2; ++bj) st16_wt(rowp + bj * 32, pack8(acc[ai][bj][m][0] * rs, acc[ai][bj][m][1] * rs));
            }
        } else {
            const bool conv = u.pn < 20;
            bf16_t* b2 = P + (size_t)(conv ? 3 : 4) * ((size_t)M * 1024);
            const int col0 = (u.pn - (conv ? 12 : 20)) * HALF + wc * 32 + 8 * fq;
#pragma unroll
            for (int m = 0; m < 4; ++m) {
                const int row = row0 + ai * HALF + m * 16; const float rs = rsc[m];
                f32x4 o[2];
#pragma unroll
                for (int n = 0; n < 2; ++n) {
                    const f32x4 x0 = acc[ai][0][m][n] * rs, x1 = acc[ai][1][m][n] * rs;
                    if (conv) o[n] = x0 * x1;
                    else {
#pragma unroll
                        for (int i = 0; i < 4; ++i) o[n][i] = x0[i] * __builtin_amdgcn_rcpf(1.0f + __builtin_amdgcn_exp2f(x1[i] * -1.4426950408889634f)); }
                }
                st16_wt(b2 + (size_t)row * 1024 + col0, pack8(o[0], o[1]));
            }
        }
    }
    __device__ __forceinline__ void operator()(const f32x4 (&acc)[2][2][4][2], const Unit& u, int wr, int wc, int fr, int fq) const { half(acc, u, 0, wr, wc, fr, fq); half(acc, u, 1, wr, wc, fr, fq); }
};
__device__ __forceinline__ float clamp448(float v) { return __builtin_fminf(__builtin_fmaxf(v, -448.0f), 448.0f); }
template <bool F8OUT> struct EpiSwigluT {
    static constexpr bool PERM = true, AFTER_DRAIN = false, NEEDS_ALIGN = false;
    void* H; int ldh; const float* ss; float ascale;
    mutable int pmc = -1;
    __device__ __forceinline__ PG8_LAS float* rsc_lds() const { extern __shared__ __attribute__((aligned(16))) unsigned char lds_all[]; return (PG8_LAS float*)((PG8_LAS unsigned char*)lds_all + RSC_OFF) + opaque_tid(); }
    __device__ __forceinline__ void refresh(const Unit& u, int wr, int fr) const {
        if (u.pm != pmc) { pmc = u.pm; const int srow0 = u.ps * BM + wr * 64 + fr;
            f32x4 t_[8]; PG8_LAS float* rc = rsc_lds();
#pragma unroll
            for (int i = 0; i < 8; ++i) t_[i] = *(const f32x4*)(ss + 4 * (size_t)(srow0 + (i >> 2) * HALF + (i & 3) * 16));
#pragma unroll
            for (int i = 0; i < 8; ++i) rc[i * 512] = __builtin_amdgcn_rsqf(((t_[i][0] + t_[i][1]) + (t_[i][2] + t_[i][3])) * (1.0f / 1024.0f) + RMS_EPS) * ascale;
            asm volatile("s_waitcnt lgkmcnt(0)" ::: "memory"); }
    }
    __device__ __forceinline__ void half(const f32x4 (&acc)[2][2][4][2], const Unit& u, int ai, int wr, int wc, int fr, int fq) const {
        asm volatile("" : "+v"(fr), "+v"(fq));
        refresh(u, wr, fr);
        float rsc[4]; { const PG8_LAS float* rc = rsc_lds();
#pragma unroll
            for (int m = 0; m < 4; ++m) rsc[m] = rc[(ai * 4 + m) * 512]; }
        const int row0 = u.pm * BM + wr * 64 + fr, col0 = u.pn * HALF + wc * 32 + 8 * fq;
#pragma unroll
        for (int m = 0; m < 4; ++m) {
            const int row = row0 + ai * HALF + m * 16; const float rs = rsc[m];
            f32x4 o[2];
            {
                const float rse = rs * -1.4426950408889634f, rs2 = rs * rs * (F8OUT ? 8.0f : 1.0f);
                f32x4 e[2], p[2];
#pragma unroll
                for (int n = 0; n < 2; ++n) { e[n] = acc[ai][0][m][n] * rse; p[n] = (acc[ai][0][m][n] * acc[ai][1][m][n]) * rs2; }
#pragma unroll
                for (int n = 0; n < 2; ++n)
#pragma unroll
                    for (int i = 0; i < 4; ++i) e[n][i] = __builtin_amdgcn_exp2f(e[n][i]);
#pragma unroll
                for (int n = 0; n < 2; ++n) e[n] = e[n] + 1.0f;
#pragma unroll
                for (int n = 0; n < 2; ++n)
#pragma unroll
                    for (int i = 0; i < 4; ++i) e[n][i] = __builtin_amdgcn_rcpf(e[n][i]);
#pragma unroll
                for (int n = 0; n < 2; ++n) o[n] = p[n] * e[n];
            }
            if constexpr (F8OUT) {
                unsigned w0 = 0u, w1 = 0u;
                w0 = __builtin_amdgcn_cvt_pk_fp8_f32(clamp448(o[0][0]), clamp448(o[0][1]), w0, false); w0 = __builtin_amdgcn_cvt_pk_fp8_f32(clamp448(o[0][2]), clamp448(o[0][3]), w0, true);
                w1 = __builtin_amdgcn_cvt_pk_fp8_f32(clamp448(o[1][0]), clamp448(o[1][1]), w1, false); w1 = __builtin_amdgcn_cvt_pk_fp8_f32(clamp448(o[1][2]), clamp448(o[1][3]), w1, true);
                typedef unsigned u32x2 __attribute__((ext_vector_type(2)));
                *(u32x2*)((unsigned char*)H + (size_t)row * ldh + col0) = (u32x2){w0, w1};
            } else {
                st16_wt((bf16_t*)H + (size_t)row * ldh + col0, pack8(o[0], o[1]));
            }
        }
    }
    __device__ __forceinline__ void operator()(const f32x4 (&acc)[2][2][4][2], const Unit& u, int wr, int wc, int fr, int fq) const { half(acc, u, 0, wr, wc, fr, fq); half(acc, u, 1, wr, wc, fr, fq); }
};
typedef EpiSwigluT<false> EpiSwiglu;
typedef EpiSwigluT<true> EpiSwigluF8;
constexpr int EPI_TAB_OFF = 131072 + 1024;
template <bool LITE, bool F8X = false> struct EpiResidT {
    static constexpr bool PERM = true, AFTER_DRAIN = false, NEEDS_ALIGN = !LITE;
    bf16_t* xb; float* ssn; unsigned char* xq = nullptr; float ascale = 1.0f;
    __device__ __forceinline__ void operator()(const f32x4 (&acc)[2][2][4][2], const Unit& u, int wr, int wc, int fr, int fq) const {
        extern __shared__ __attribute__((aligned(16))) unsigned char lds_all[];
        PG8_LAS float* T = (PG8_LAS float*)((PG8_LAS unsigned char*)lds_all + EPI_TAB_OFF);
        const int row0 = u.pm * BM + wr * 64 + fr, col0 = u.pn * BM + wc * 64 + 8 * fq;
#pragma unroll
        for (int ai = 0; ai < 2; ++ai) {
            u32x4 xv[4][2];
#pragma unroll
            for (int m = 0; m < 4; ++m)
#pragma unroll
                for (int bj = 0; bj < 2; ++bj) xv[m][bj] = *(const u32x4*)(xb + (size_t)(row0 + ai * HALF + m * 16) * 1024 + col0 + bj * 32);
            asm volatile("" ::: "memory");
#pragma unroll
            for (int m = 0; m < 4; ++m) {
                const int row = row0 + ai * HALF + m * 16; float sq = 0.f;
#pragma unroll
                for (int bj = 0; bj < 2; ++bj) {
                    const u32x4 w = xv[m][bj];
                    f32x4 x0 = {__uint_as_float(w.x << 16), __uint_as_float(w.x & 0xffff0000u), __uint_as_float(w.y << 16), __uint_as_float(w.y & 0xffff0000u)};
                    f32x4 x1 = {__uint_as_float(w.z << 16), __uint_as_float(w.z & 0xffff0000u), __uint_as_float(w.w << 16), __uint_as_float(w.w & 0xffff0000u)};
                    x0 += acc[ai][bj][m][0] * ascale; x1 += acc[ai][bj][m][1] * ascale;
                    st16_wt(xb + (size_t)row * 1024 + col0 + bj * 32, pack8(x0, x1));
                    if constexpr (F8X) { unsigned w0 = 0u, w1 = 0u;
                        w0 = __builtin_amdgcn_cvt_pk_fp8_f32(clamp448(x0[0] * 8.0f), clamp448(x0[1] * 8.0f), w0, false); w0 = __builtin_amdgcn_cvt_pk_fp8_f32(clamp448(x0[2] * 8.0f), clamp448(x0[3] * 8.0f), w0, true);
                        w1 = __builtin_amdgcn_cvt_pk_fp8_f32(clamp448(x1[0] * 8.0f), clamp448(x1[1] * 8.0f), w1, false); w1 = __builtin_amdgcn_cvt_pk_fp8_f32(clamp448(x1[2] * 8.0f), clamp448(x1[3] * 8.0f), w1, true);
                        st8_wt(xq + (size_t)row * 1024 + col0 + bj * 32, (wt_u32x2){w0, w1}); }
                    if constexpr (!LITE) sq += (x0[0] * x0[0] + x0[1] * x0[1]) + (x0[2] * x0[2] + x0[3] * x0[3]) + (x1[0] * x1[0] + x1[1] * x1[1]) + (x1[2] * x1[2] + x1[3] * x1[3]);
                }
                if constexpr (!LITE) { sq += __shfl_xor(sq, 16); sq += __shfl_xor(sq, 32);
                    if (fq == 0) T[(ai * HALF + wr * 64 + m * 16 + fr) * 4 + wc] = sq; }
            }
        }
        if constexpr (!LITE) {
        asm volatile("s_waitcnt lgkmcnt(0)\n\ts_barrier" ::: "memory");
        if (wc == 0 && fq == 0) {
#pragma unroll
            for (int ai = 0; ai < 2; ++ai)
#pragma unroll
                for (int m = 0; m < 4; ++m) { const int lr = ai * HALF + wr * 64 + m * 16 + fr; const f32x4 p = *(const PG8_LAS f32x4*)(T + lr * 4);
                    ssn[(size_t)(u.pm * BM + lr) * 4 + u.pn] = (p[0] + p[1]) + (p[2] + p[3]); }
        } }
    }
};
typedef EpiResidT<false> EpiResid;
typedef EpiResidT<true> EpiResidLite;
typedef EpiResidT<false, true> EpiResidF8X;
struct EpiSlot {
    static constexpr bool PERM = true, AFTER_DRAIN = false, NEEDS_ALIGN = false;
    bf16_t* Y; const float* wslot; float ascale;
    __device__ __forceinline__ void half(const f32x4 (&acc)[2][2][4][2], const Unit& u, int ai, int wr, int wc, int fr, int fq) const {
        asm volatile("" : "+v"(fr), "+v"(fq));
        const int row0 = u.pm * BM + wr * 64 + fr, col0 = u.pn * BM + wc * 64 + 8 * fq;
        float w[4];
#pragma unroll
        for (int m = 0; m < 4; ++m) w[m] = wslot[u.ps * BM + wr * 64 + fr + ai * HALF + m * 16] * ascale;
#pragma unroll
        for (int m = 0; m < 4; ++m) {
            const int row = row0 + ai * HALF + m * 16;
#pragma unroll
            for (int bj = 0; bj < 2; ++bj) st16_wt(Y + (size_t)row * 1024 + col0 + bj * 32, pack8(acc[ai][bj][m][0] * w[m], acc[ai][bj][m][1] * w[m]));
        }
    }
    __device__ __forceinline__ void operator()(const f32x4 (&acc)[2][2][4][2], const Unit& u, int wr, int wc, int fr, int fq) const { half(acc, u, 0, wr, wc, fr, fq); half(acc, u, 1, wr, wc, fr, fq); }
};

__device__ __forceinline__ void glds16s(unsigned voff, const void* sbase, unsigned lds_dst) { unsigned keep;
    asm volatile("s_mov_b32 %0, m0\n\ts_mov_b32 m0, %3\n\ts_nop 0\n\tglobal_load_lds_dwordx4 %1, %2\n\ts_mov_b32 m0, %0" : "=&s"(keep) : "v"(voff), "s"(sbase), "s"(lds_dst) : "memory"); }
typedef int v8i_t __attribute__((ext_vector_type(8))); typedef int v4i_t __attribute__((ext_vector_type(4)));
__device__ __forceinline__ v8i_t cat16(bf16x8 lo, bf16x8 hi) { const v4i_t a = __builtin_bit_cast(v4i_t, lo), b = __builtin_bit_cast(v4i_t, hi); return __builtin_shufflevector(a, b, 0, 1, 2, 3, 4, 5, 6, 7); }
template <class Epi, class Sched, bool ALIGN_EPI = false, bool SP2 = false, bool FP8 = false>
__device__ __forceinline__ void gemm_phase(PG8_LAS unsigned char* lds, const Gemm g, const Sched& S, const Epi& E) {
    const int tid = opaque_tid(), wid = __builtin_amdgcn_readfirstlane(tid >> 6), lane = tid & 63, wr = wid >> 2, wc = wid & 3, fr = lane & 15, fq = lane >> 4;
    const int K = FP8 ? g.K / 2 : g.K, nt = K / BK;
    unsigned voffA[2], voffB[2];
#pragma unroll
    for (int i = 0; i < 2; ++i) { int R, C; stage_rc(tid * 16 + i * 8192, R, C); const int Rb = Epi::PERM ? (64 * (R >> 5) + perm32(R & 31)) : R;
        voffA[i] = (unsigned)(R * K + C) * 2u; voffB[i] = (unsigned)(Rb * K + C) * 2u; }
    const size_t kstep = (size_t)(BK * 2);
    const size_t hstep = (size_t)HALF * K * 2;
    const size_t tstep = 2 * hstep;
    const size_t hstepB = Epi::PERM ? (size_t)32 * K * 2 : hstep;
    const unsigned ldsw = (unsigned)wid * 1024u; const unsigned ldsb = (unsigned)__builtin_amdgcn_readfirstlane((int)((unsigned)(size_t)lds + ldsw));
    const int aoff = lds_byte(wr * 64 + fr, fq * 8), boff = lds_byte(wc * 32 + fr, fq * 8);
#define PG8_SA(b, h) (((b) * 2 + (h)) * HTB)
#define PG8_SB(b, h) ((4 + (b) * 2 + (h)) * HTB)
#define PG8_STAGE(bufoff, gbase, voff) do { _Pragma("unroll") for (int _i = 0; _i < 2; ++_i) \
        glds16s((voff)[_i], (const void*)(gbase), ldsb + (unsigned)((bufoff) + _i * 8192)); } while (0)
#define PG8_LDA(dst, b, h) do { _Pragma("unroll") for (int m = 0; m < 4; ++m) _Pragma("unroll") for (int k = 0; k < 2; ++k) dst[m][k] = *(const PG8_LAS bf16x8*)(lds + PG8_SA(b, h) + aoff + m * 2048 + k * 1024); } while (0)
#define PG8_LDB(dst, b, h) do { _Pragma("unroll") for (int n = 0; n < 2; ++n) _Pragma("unroll") for (int k = 0; k < 2; ++k) dst[n][k] = *(const PG8_LAS bf16x8*)(lds + PG8_SB(b, h) + boff + n * 2048 + k * 1024); } while (0)
#define PG8_MMA(ai, bj, At, Bt) do { __builtin_amdgcn_s_setprio(1); _Pragma("unroll") for (int m = 0; m < 4; ++m) _Pragma("unroll") for (int n = 0; n < 2; ++n) { \
        if constexpr (FP8) { const v8i_t bo_ = cat16(Bt[n][0], Bt[n][1]), ao_ = cat16(At[m][0], At[m][1]); \
            asm volatile("v_mfma_f32_16x16x128_f8f6f4 %0, %1, %2, %0" : "+v"(acc[ai][bj][m][n]) : "v"(bo_), "v"(ao_)); }     \
        else { _Pragma("unroll") for (int k = 0; k < 2; ++k) acc[ai][bj][m][n] = __builtin_amdgcn_mfma_f32_16x16x32_bf16(Bt[n][k], At[m][k], acc[ai][bj][m][n], 0, 0, 0); } } \
        __builtin_amdgcn_s_setprio(0); } while (0)
#define PG8_WAIT_V(n) asm volatile("s_waitcnt vmcnt(" #n ")" ::: "memory")
#define PG8_WAIT_L(n) asm volatile("s_waitcnt lgkmcnt(" #n ")" ::: "memory")
#define PG8_BAR __builtin_amdgcn_s_barrier()
#define PG8_SCHED __builtin_amdgcn_sched_barrier(0)
    Unit cur, nxt; int ui = 0;
    if (!S.next(0, cur)) return;
    f32x4 acc[2][2][4][2];
#pragma unroll
    for (int a = 0; a < 2; ++a)
#pragma unroll
        for (int b = 0; b < 2; ++b)
#pragma unroll
            for (int m = 0; m < 4; ++m)
#pragma unroll
                for (int n = 0; n < 2; ++n) { acc[a][b][m][n] = (f32x4){0.f, 0.f, 0.f, 0.f}; asm volatile("" : "+v"(acc[a][b][m][n])); }
    bf16x8 At[4][2], B0[2][2], B1[2][2];
    const char* cA = (const char*)g.A + (size_t)cur.pa * tstep; const char* cB = (const char*)g.Bt + (size_t)cur.be * g.bstride + (size_t)cur.pn * tstep;
    S.a_ready(cur);
    if constexpr (SP2) {
        PG8_STAGE(PG8_SB(0, 0), cB, voffB); PG8_STAGE(PG8_SB(0, 1), cB + hstepB, voffB); PG8_STAGE(PG8_SA(0, 0), cA, voffA); PG8_STAGE(PG8_SA(0, 1), cA + hstep, voffA);
        if (wr == 1) PG8_BAR;
        PG8_WAIT_V(2); PG8_BAR;
        PG8_STAGE(PG8_SB(1, 0), cB + kstep, voffB); PG8_STAGE(PG8_SA(1, 0), cA + kstep, voffA); PG8_STAGE(PG8_SB(1, 1), cB + hstepB + kstep, voffB);
        PG8_WAIT_V(6); PG8_BAR;
    } else {
        PG8_STAGE(PG8_SB(0, 0), cB, voffB); PG8_STAGE(PG8_SA(0, 0), cA, voffA); PG8_STAGE(PG8_SB(0, 1), cB + hstepB, voffB); PG8_STAGE(PG8_SA(0, 1), cA + hstep, voffA);
        if (wr == 1) PG8_BAR;
        PG8_WAIT_V(4); PG8_BAR;
        PG8_STAGE(PG8_SB(1, 0), cB + kstep, voffB); PG8_STAGE(PG8_SA(1, 0), cA + kstep, voffA); PG8_STAGE(PG8_SB(1, 1), cB + hstepB + kstep, voffB);
        PG8_WAIT_V(6); PG8_BAR;
    }
    for (;;) {
        const bool has_next = S.next(ui + 1, nxt);
        const char* nA = has_next ? (const char*)g.A + (size_t)nxt.pa * tstep : cA; const char* nB = has_next ? (const char*)g.Bt + (size_t)nxt.be * g.bstride + (size_t)nxt.pn * tstep : cB;
#pragma nounroll
        for (int t = 0; t < nt; t += 2) {
            const bool last = (t == nt - 2);
            const char* a1 = cA + (size_t)(t + 1) * kstep;
            const char* a2 = last ? nA : cA + (size_t)(t + 2) * kstep; const char* b2 = last ? nB : cB + (size_t)(t + 2) * kstep;
            const char* a3 = a2 + kstep; const char* b3 = b2 + kstep;
            if (last && has_next) S.a_ready(nxt);
            if constexpr (SP2) {
            PG8_LDB(B0, 0, 0); PG8_LDB(B1, 0, 1); PG8_SCHED; PG8_LDA(At, 0, 0); PG8_STAGE(PG8_SA(1, 1), a1 + hstep, voffA);
            PG8_WAIT_V(8); PG8_WAIT_L(0); PG8_BAR; PG8_MMA(0, 0, At, B0); PG8_MMA(0, 1, At, B1); PG8_BAR; PG8_SCHED;
            PG8_LDA(At, 0, 1); PG8_STAGE(PG8_SB(0, 0), b2, voffB); PG8_STAGE(PG8_SB(0, 1), b2 + hstepB, voffB); PG8_STAGE(PG8_SA(0, 0), a2, voffA);
            PG8_WAIT_V(8); PG8_WAIT_L(0); PG8_BAR; PG8_MMA(1, 0, At, B0); PG8_MMA(1, 1, At, B1); PG8_BAR; PG8_SCHED;
            PG8_LDB(B0, 1, 0); PG8_LDB(B1, 1, 1); PG8_SCHED; PG8_LDA(At, 1, 0); PG8_STAGE(PG8_SA(0, 1), a2 + hstep, voffA);
            PG8_WAIT_V(8); PG8_WAIT_L(0); PG8_BAR; PG8_MMA(0, 0, At, B0); PG8_MMA(0, 1, At, B1); PG8_BAR; PG8_SCHED;
            PG8_LDA(At, 1, 1); PG8_STAGE(PG8_SB(1, 0), b3, voffB); PG8_STAGE(PG8_SB(1, 1), b3 + hstepB, voffB); PG8_STAGE(PG8_SA(1, 0), a3, voffA);
            PG8_WAIT_V(8); PG8_WAIT_L(0); PG8_BAR; PG8_MMA(1, 0, At, B0); PG8_MMA(1, 1, At, B1); PG8_BAR; PG8_SCHED;
            } else {
            PG8_LDB(B0, 0, 0); PG8_SCHED; PG8_LDA(At, 0, 0); PG8_STAGE(PG8_SA(1, 1), a1 + hstep, voffA);
            PG8_WAIT_L(8); PG8_BAR; PG8_WAIT_L(0); PG8_MMA(0, 0, At, B0); PG8_BAR; PG8_SCHED;
            PG8_LDB(B1, 0, 1); PG8_STAGE(PG8_SB(0, 0), b2, voffB);
            PG8_BAR; PG8_WAIT_L(0); PG8_MMA(0, 1, At, B1); PG8_BAR;
            PG8_LDA(At, 0, 1); PG8_STAGE(PG8_SA(0, 0), a2, voffA);
            PG8_BAR; PG8_WAIT_L(0); PG8_MMA(1, 0, At, B0); PG8_BAR; PG8_SCHED;
            PG8_STAGE(PG8_SB(0, 1), b2 + hstepB, voffB);
            PG8_WAIT_V(6); PG8_BAR; PG8_MMA(1, 1, At, B1); PG8_BAR;
            PG8_LDB(B0, 1, 0); PG8_SCHED; PG8_LDA(At, 1, 0); PG8_STAGE(PG8_SA(0, 1), a2 + hstep, voffA);
            PG8_WAIT_L(8); PG8_BAR; PG8_WAIT_L(0); PG8_MMA(0, 0, At, B0); PG8_BAR; PG8_SCHED;
            PG8_LDB(B1, 1, 1); PG8_STAGE(PG8_SB(1, 0), b3, voffB);
            PG8_BAR; PG8_WAIT_L(0); PG8_MMA(0, 1, At, B1); PG8_BAR;
            PG8_LDA(At, 1, 1); PG8_STAGE(PG8_SA(1, 0), a3, voffA);
            PG8_BAR; PG8_WAIT_L(0); PG8_MMA(1, 0, At, B0); PG8_BAR; PG8_SCHED;
            PG8_STAGE(PG8_SB(1, 1), b3 + hstepB, voffB);
            PG8_WAIT_V(6); PG8_BAR; PG8_MMA(1, 1, At, B1); PG8_BAR;
            }
        }
        if constexpr (ALIGN_EPI) { if (wr == 0) PG8_BAR; }
        static_assert(ALIGN_EPI || !Epi::NEEDS_ALIGN, "this epilogue contains a workgroup barrier: both halves must run it together");
        if constexpr (!Epi::AFTER_DRAIN) { E(acc, cur, wr, wc, fr, fq); S.done(cur); }
        if (!has_next) break;
#pragma unroll
        for (int a = 0; a < 2; ++a)
#pragma unroll
            for (int b = 0; b < 2; ++b)
#pragma unroll
                for (int m = 0; m < 4; ++m)
#pragma unroll
                    for (int n = 0; n < 2; ++n) { acc[a][b][m][n] = (f32x4){0.f, 0.f, 0.f, 0.f}; asm volatile("" : "+v"(acc[a][b][m][n])); }
        cur = nxt; cA = nA; cB = nB; ++ui;
        if constexpr (ALIGN_EPI) { if (wr == 1) PG8_BAR; }
    }
    PG8_WAIT_V(0);
    if constexpr (!ALIGN_EPI) { if (wr == 0) PG8_BAR; }
    PG8_BAR;
#undef PG8_SA
#undef PG8_SB
#undef PG8_STAGE
#undef PG8_LDA
#undef PG8_LDB
#undef PG8_MMA
#undef PG8_WAIT_V
#undef PG8_WAIT_L
#undef PG8_BAR
#undef PG8_SCHED
}

}

#ifndef PG8_SP2
#define PG8_SP2 true
#endif
#ifndef PG8_ALIGN
#define PG8_ALIGN true
#endif

namespace attn_body {
using bf16=__hip_bfloat16;
using bf16x8=__attribute__((ext_vector_type(8)))short;
using s16x4=__attribute__((ext_vector_type(4)))short;
using f32x16=__attribute__((ext_vector_type(16)))float;
using u32x4=__attribute__((ext_vector_type(4)))unsigned;
constexpr int D=64;
constexpr int PQ=1024,PK=1024,PV=1024,PO=2048;
constexpr int NW=8,QBLK=32,QB=QBLK*NW,KVBLK=64;
__device__ __forceinline__ int crow(int r,int hi){return (r&3)+8*(r>>2)+4*hi;}
#define SBAR() __builtin_amdgcn_sched_barrier(0)
__device__ __forceinline__ void cmask(f32x16&p0,f32x16&p1,int jb,int qrel,int hi){
  const float NEG=-INFINITY; int kb=64*jb+4*hi;
  #pragma unroll
  for(int r=0;r<16;++r){int kv=kb+(r&3)+8*(r>>2); if(kv>qrel)p0[r]=NEG; if(kv+32>qrel)p1[r]=NEG;}
}
constexpr int NSLOT=3, SLOTB=8192;
constexpr int LDS_K=0, LDS_V=NSLOT*SLOTB, LDS_WS=2*NSLOT*SLOTB, LDS_OST=LDS_WS+NW*64*4, LDS_BYTES=LDS_OST+NW*4096;
constexpr float C2=0.125f*1.4426950408889634f;
__device__ __forceinline__ void glds16(const void*gsrc,unsigned lds_dst){unsigned keep;
  asm volatile("s_mov_b32 %0, m0\n\ts_mov_b32 m0, %2\n\ts_nop 0\n\tglobal_load_lds_dwordx4 %1, off\n\ts_mov_b32 m0, %0":"=&s"(keep):"v"(gsrc),"s"(lds_dst):"memory");}
__device__ __forceinline__ float max3f(float a,float b,float c){float r;asm("v_max3_f32 %0, %1, %2, %3":"=v"(r):"v"(a),"v"(b),"v"(c));return r;}
__device__ __forceinline__ float max2f(float a,float b){float r;asm("v_max_f32_e32 %0, %1, %2":"=v"(r):"v"(a),"v"(b));return r;}
__device__ __forceinline__ float fadd_s(float a,float b){float r;asm("v_add_f32_e32 %0, %1, %2":"=v"(r):"v"(a),"v"(b));return r;}
__device__ __forceinline__ float fsub_s(float a,float b){float r;asm("v_sub_f32_e32 %0, %1, %2":"=v"(r):"v"(a),"v"(b));return r;}
typedef float f32x2_t __attribute__((ext_vector_type(2))); typedef __bf16 bf16x2_t __attribute__((ext_vector_type(2)));
__device__ __forceinline__ unsigned cvtpk_s(float lo,float hi){f32x2_t v={lo,hi};bf16x2_t b=__builtin_convertvector(v,bf16x2_t);return __builtin_bit_cast(unsigned,b);}
#define WAIT_BAR(N) asm volatile("s_waitcnt vmcnt(" #N ") lgkmcnt(0)\n\ts_barrier":::"memory")

__device__ __forceinline__ void qkt(f32x16&p0,f32x16&p1,const char*Kslot,const bf16x8*qr,const f32x16&negm,int r32,int hi){
  const char*kb=Kslot+hi*1024+r32*16;
  #pragma unroll
  for(int d0=0;d0<4;++d0){
    const bf16x8 b0=*reinterpret_cast<const bf16x8*>(kb+d0*2048);
    const bf16x8 b1=*reinterpret_cast<const bf16x8*>(kb+d0*2048+512);
    if(d0==0){p0=__builtin_amdgcn_mfma_f32_32x32x16_bf16(b0,qr[0],negm,0,0,0);p1=__builtin_amdgcn_mfma_f32_32x32x16_bf16(b1,qr[0],negm,0,0,0);}
    else{p0=__builtin_amdgcn_mfma_f32_32x32x16_bf16(b0,qr[d0],p0,0,0,0);p1=__builtin_amdgcn_mfma_f32_32x32x16_bf16(b1,qr[d0],p1,0,0,0);}}
}
typedef __attribute__((address_space(3))) const char* lds_cptr;
typedef short v4i16_t __attribute__((ext_vector_type(4)));
__device__ __forceinline__ void kload8(bf16x8*kf,lds_cptr kp){
  kf[0]=*(const __attribute__((address_space(3))) bf16x8*)(kp);      kf[1]=*(const __attribute__((address_space(3))) bf16x8*)(kp+512);
  kf[2]=*(const __attribute__((address_space(3))) bf16x8*)(kp+2048); kf[3]=*(const __attribute__((address_space(3))) bf16x8*)(kp+2560);
  kf[4]=*(const __attribute__((address_space(3))) bf16x8*)(kp+4096); kf[5]=*(const __attribute__((address_space(3))) bf16x8*)(kp+4608);
  kf[6]=*(const __attribute__((address_space(3))) bf16x8*)(kp+6144); kf[7]=*(const __attribute__((address_space(3))) bf16x8*)(kp+6656);
}
__device__ __forceinline__ void kload2(bf16x8*kf,lds_cptr kp,int j){ kf[2*j]=*(const __attribute__((address_space(3))) bf16x8*)(kp+j*2048); kf[2*j+1]=*(const __attribute__((address_space(3))) bf16x8*)(kp+j*2048+512); }
__device__ __forceinline__ s16x4 vtr(lds_cptr p){ return __builtin_bit_cast(s16x4,__builtin_amdgcn_ds_read_tr16_b64_v4i16((__attribute__((address_space(3))) v4i16_t*)p)); }
__device__ __forceinline__ float rowmax(const f32x16&p0,const f32x16&p1){
  float a=max3f(p0[0],p0[1],p1[0]),b=max3f(p0[2],p0[3],p1[1]);a=max3f(a,p1[2],p1[3]);
  #pragma unroll
  for(int r=4;r<16;r+=4){a=max3f(a,p0[r],p0[r+1]);b=max3f(b,p0[r+2],p0[r+3]);a=max3f(a,p1[r],p1[r+1]);b=max3f(b,p1[r+2],p1[r+3]);}
  const float m=max2f(a,b);
  auto rr=__builtin_amdgcn_permlane32_swap(__float_as_uint(m),__float_as_uint(m),false,false);
  return max2f(__uint_as_float(rr[0]),__uint_as_float(rr[1]));
}
__device__ __forceinline__ void pv(f32x16*o,int vb,bf16x8 pa0,bf16x8 pa1,bf16x8 pa2,bf16x8 pa3){
  #pragma unroll
  for(int d0=0;d0<2;++d0){s16x4 lo[4],hi[4];
    #pragma unroll
    for(int ks=0;ks<4;++ks){
      asm volatile("ds_read_b64_tr_b16 %0,%1 offset:%c2":"=&v"(lo[ks]):"v"(vb),"i"(d0*4096+ks*1024):"memory");
      asm volatile("ds_read_b64_tr_b16 %0,%1 offset:%c2":"=&v"(hi[ks]):"v"(vb),"i"(d0*4096+ks*1024+512):"memory");}
    asm volatile("s_waitcnt lgkmcnt(0)":::"memory");SBAR();
    #define PK(k) (bf16x8){lo[k][0],lo[k][1],lo[k][2],lo[k][3],hi[k][0],hi[k][1],hi[k][2],hi[k][3]}
    o[d0]=__builtin_amdgcn_mfma_f32_32x32x16_bf16(pa0,PK(0),o[d0],0,0,0);
    o[d0]=__builtin_amdgcn_mfma_f32_32x32x16_bf16(pa1,PK(1),o[d0],0,0,0);
    o[d0]=__builtin_amdgcn_mfma_f32_32x32x16_bf16(pa2,PK(2),o[d0],0,0,0);
    o[d0]=__builtin_amdgcn_mfma_f32_32x32x16_bf16(pa3,PK(3),o[d0],0,0,0);
    #undef PK
  }
}
#ifndef ATTN_STORE16
#define ATTN_STORE16(p,v) st16_wt((void*)(p),(v))
#endif
template<int THRL> __device__ __forceinline__ void attn_unit(int qb,const bf16*Qh,const bf16*__restrict__ Kh,const bf16*__restrict__ Vh,bf16*Oh,char*shm){
  const int tid=opaque_tid(),lane=tid&63,r32=lane&31,hi=lane>>5; const int wid=__builtin_amdgcn_readfirstlane(tid>>6);
  const int q0=qb*QB;
  const bf16*Qw=Qh+(long)(q0+wid*QBLK)*PQ;
  const unsigned lds0=(unsigned)(uintptr_t)shm;
  float*wsf=(float*)(shm+LDS_WS)+wid*64;
  const bf16*ksrc=Kh+(long)lane*PK+wid*8;
  const bf16*vsrc=Vh+(long)(16*(wid&3)+(lane>>2))*PV+(wid>>2)*32+(lane&3)*8;
  const unsigned kdst=lds0+LDS_K+wid*1024, vdst=lds0+LDS_V+wid*1024;
  #define DMA_K(t,slot) glds16(ksrc+(long)(t)*KVBLK*PK,(unsigned)__builtin_amdgcn_readfirstlane(kdst+(slot)))
  #define DMA_V(t,slot) glds16(vsrc+(long)(t)*KVBLK*PV,(unsigned)__builtin_amdgcn_readfirstlane(vdst+(slot)))
  const int vb0=(int)(lds0+LDS_V)+((lane>>4)&1)*32+(lane&3)*8+(4*hi+((lane&15)>>2))*64;
  const char*Kbase=shm+LDS_K; bf16x8 kf[8];
  const lds_cptr shm3=(lds_cptr)shm; const lds_cptr kp0=shm3+LDS_K+hi*1024+r32*16; const lds_cptr vp0=shm3+LDS_V+((lane>>4)&1)*32+(lane&3)*8+(4*hi+((lane&15)>>2))*64;
  const int NT=(q0+QB)/KVBLK;
  DMA_K(0,0);DMA_V(0,0);DMA_K(1,SLOTB);
  bf16x8 qr[4];
  #pragma unroll
  for(int d0=0;d0<4;++d0)qr[d0]=*reinterpret_cast<const bf16x8*>(&Qw[(long)r32*PQ+d0*16+hi*8]);
  float mhat=0.f,l_reg=0.f;f32x16 o[2];o[0]=f32x16{};o[1]=f32x16{};f32x16 negm=f32x16{};asm volatile("":"+v"(negm));
  const int qrel=wid*QBLK+r32;
  #define CMASK(P0,P1,t) do{int jb_=(t)-(NT-4); if(jb_>=0)cmask(P0,P1,jb_,qrel,hi);}while(0)
  bool resc=false;
  #define START(P0,P1) do{ const float rm=rowmax(P0,P1); resc=false; \
    { const float dl=rm; mhat=fadd_s(mhat,dl); \
      _Pragma("unroll") for(int r=0;r<16;++r){P0[r]=fsub_s(P0[r],dl);P1[r]=fsub_s(P1[r],dl);} \
      _Pragma("unroll") for(int r=0;r<16;++r)negm[r]=-mhat; asm volatile("":"+v"(negm)); } \
    _Pragma("unroll") for(int r=0;r<16;++r)P0[r]=__builtin_amdgcn_exp2f(P0[r]); }while(0)
  #define RESC() do{ if(resc){ asm volatile("s_waitcnt lgkmcnt(0)":::"memory"); \
      _Pragma("unroll") for(int d_=0;d_<2;++d_) _Pragma("unroll") for(int r=0;r<16;++r)o[d_][r]*=wsf[crow(r,hi)]; } }while(0)
  f32x16 pA0,pA1,pB0,pB1;
  int sl_prev=0,sl_cur=0,sl_next=SLOTB;
  #define ROT() do{sl_prev=sl_cur;sl_cur=sl_next;sl_next=(sl_next==(NSLOT-1)*SLOTB)?0:sl_next+SLOTB;}while(0)
  DMA_K(2,2*SLOTB);
  WAIT_BAR(3);
  qkt(pA0,pA1,Kbase,qr,negm,r32,hi);asm volatile("s_nop 15\n\ts_nop 7":"+v"(pA0),"+v"(pA1));CMASK(pA0,pA1,0);
  START(pA0,pA1);
  _Pragma("unroll") for(int r=0;r<16;++r)pA1[r]=__builtin_amdgcn_exp2f(pA1[r]);
  WAIT_BAR(0);
  DMA_K(3,0);DMA_V(1,SLOTB);
  ROT();
  kload8(kf,kp0+sl_cur);
  WAIT_BAR(2);
  s16x4 vlo[8],vhi[8]; u32x4 pw0,pw1,pw2,pw3;
  #define PKW(P,B) cvtpk_s(P[B],P[B+1])
  #define PAF(k) __builtin_bit_cast(bf16x8,pw##k)
  #define VFR(i) (bf16x8){vlo[i][0],vlo[i][1],vlo[i][2],vlo[i][3],vhi[i][0],vhi[i][1],vhi[i][2],vhi[i][3]}
  #define PIN(x) asm volatile("":"+v"(x))
  #define MX3(a,b,c) __builtin_fmaxf(__builtin_fmaxf((a),(b)),(c))
  #define GAPA(MF,A0,A1,A2,A3,W0,W1,PW) do{ MF; sacc+=A0; sacc+=A1; sacc+=A2; sacc+=A3; PIN(sacc); W0; W1; PIN(PW); SBAR(); }while(0)
  #define EX(v) __builtin_amdgcn_exp2f(v)
  #define GAPB(MF,X,B) do{ MF; X[B]=EX(X[B]); X[B+1]=EX(X[B+1]); X[B+2]=EX(X[B+2]); X[B+3]=EX(X[B+3]); PIN(X); SBAR(); }while(0)
  #define VRD(i) do{ vlo[i]=vtr(vp_+(((i)>>2)*4096+((i)&3)*1024)); vhi[i]=vtr(vp_+(((i)>>2)*4096+((i)&3)*1024+512)); }while(0)
  #define KRD(G,j) do{ if(G){ kload2(kf,kp0+sl_next,j); SBAR(); } }while(0)
  #define STEP(C0,C1,P0,P1,t,GK,GV,GL) do{ SBAR(); \
    const lds_cptr vp_=vp0+sl_prev; \
    VRD(0); SBAR(); float sacc=(P0[0]+P0[1]); \
    GAPA(C0=__builtin_amdgcn_mfma_f32_32x32x16_bf16(kf[0],qr[0],negm,0,0,0), P0[2],P0[3],P0[4],P0[5],     pw0[0]=PKW(P0,0), pw0[1]=PKW(P0,2), pw0); \
    VRD(4); SBAR(); GAPA(C1=__builtin_amdgcn_mfma_f32_32x32x16_bf16(kf[1],qr[0],negm,0,0,0), P0[6],P0[7],P0[8],P0[9],     pw0[2]=PKW(P0,4), pw0[3]=PKW(P0,6), pw0); \
    VRD(1); SBAR(); GAPA(C0=__builtin_amdgcn_mfma_f32_32x32x16_bf16(kf[2],qr[1],C0,0,0,0),   P0[10],P0[11],P0[12],P0[13], pw1[0]=PKW(P0,8), pw1[1]=PKW(P0,10), pw1); \
    VRD(5); SBAR(); GAPA(C1=__builtin_amdgcn_mfma_f32_32x32x16_bf16(kf[3],qr[1],C1,0,0,0),   P0[14],P0[15],P1[0],P1[1],   pw1[2]=PKW(P0,12),pw1[3]=PKW(P0,14), pw1); \
    VRD(2); SBAR(); GAPA(C0=__builtin_amdgcn_mfma_f32_32x32x16_bf16(kf[4],qr[2],C0,0,0,0),   P1[2],P1[3],P1[4],P1[5],     pw2[0]=PKW(P1,0), pw2[1]=PKW(P1,2), pw2); \
    VRD(6); SBAR(); GAPA(C1=__builtin_amdgcn_mfma_f32_32x32x16_bf16(kf[5],qr[2],C1,0,0,0),   P1[6],P1[7],P1[8],P1[9],     pw2[2]=PKW(P1,4), pw2[3]=PKW(P1,6), pw2); \
    VRD(3); SBAR(); GAPA(C0=__builtin_amdgcn_mfma_f32_32x32x16_bf16(kf[6],qr[3],C0,0,0,0),   P1[10],P1[11],P1[12],P1[13], pw3[0]=PKW(P1,8), pw3[1]=PKW(P1,10), pw3); \
    VRD(7); SBAR(); GAPA(C1=__builtin_amdgcn_mfma_f32_32x32x16_bf16(kf[7],qr[3],C1,0,0,0),   P1[14],P1[15],0.f,0.f,       pw3[2]=PKW(P1,12),pw3[3]=PKW(P1,14), pw3); \
    l_reg+=sacc; \
    if(GK){DMA_K((t)+3,sl_cur);} if(GV){DMA_V((t)+1,sl_next);} \
    CMASK(C0,C1,t); \
    { float a=MX3(C0[0],C0[1],C1[0]),b=MX3(C0[2],C0[3],C1[1]); a=MX3(a,C1[2],C1[3]); \
      _Pragma("unroll") for(int r=4;r<16;r+=4){a=MX3(a,C0[r],C0[r+1]);b=MX3(b,C0[r+2],C0[r+3]);a=MX3(a,C1[r],C1[r+1]);b=MX3(b,C1[r+2],C1[r+3]);} \
      float rm=__builtin_fmaxf(a,b); { auto rr=__builtin_amdgcn_permlane32_swap(__float_as_uint(rm),__float_as_uint(rm),false,false); rm=__builtin_fmaxf(__uint_as_float(rr[0]),__uint_as_float(rr[1])); } \
      resc=false; \
      if(__builtin_expect(__any(rm>(float)THRL),0)){ const float dl=__builtin_fmaxf(rm,0.f); mhat+=dl; \
        _Pragma("unroll") for(int r=0;r<16;++r){C0[r]-=dl;C1[r]-=dl;} \
        _Pragma("unroll") for(int r=0;r<16;++r)negm[r]=-mhat; asm volatile("":"+v"(negm)); \
        const float f=__builtin_amdgcn_exp2f(-dl); l_reg*=f; if(hi==0)wsf[r32]=f; resc=true; } } \
    SBAR(); \
    GAPB(o[0]=__builtin_amdgcn_mfma_f32_32x32x16_bf16(PAF(0),VFR(0),o[0],0,0,0), C0,0); \
    GAPB(o[1]=__builtin_amdgcn_mfma_f32_32x32x16_bf16(PAF(0),VFR(4),o[1],0,0,0), C0,4); \
    KRD(GL,0); GAPB(o[0]=__builtin_amdgcn_mfma_f32_32x32x16_bf16(PAF(1),VFR(1),o[0],0,0,0), C0,8); \
    KRD(GL,1); GAPB(o[1]=__builtin_amdgcn_mfma_f32_32x32x16_bf16(PAF(1),VFR(5),o[1],0,0,0), C0,12); \
    KRD(GL,2); GAPB(o[0]=__builtin_amdgcn_mfma_f32_32x32x16_bf16(PAF(2),VFR(2),o[0],0,0,0), C1,0); \
    KRD(GL,3); GAPB(o[1]=__builtin_amdgcn_mfma_f32_32x32x16_bf16(PAF(2),VFR(6),o[1],0,0,0), C1,4); \
    GAPB(o[0]=__builtin_amdgcn_mfma_f32_32x32x16_bf16(PAF(3),VFR(3),o[0],0,0,0), C1,8); \
    GAPB(o[1]=__builtin_amdgcn_mfma_f32_32x32x16_bf16(PAF(3),VFR(7),o[1],0,0,0), C1,12); \
    }while(0)
  int t=1;
  #undef CMASK
  #define CMASK(P0,P1,t) do{}while(0)
  for(;t+5<NT;t+=2){
    STEP(pB0,pB1,pA0,pA1,t,true,true,true);     WAIT_BAR(2); RESC(); ROT();
    STEP(pA0,pA1,pB0,pB1,t+1,true,true,true);   WAIT_BAR(2); RESC(); ROT();
  }
  #undef CMASK
  #define CMASK(P0,P1,t) do{int jb_=(t)-(NT-4); if(jb_>=0)cmask(P0,P1,jb_,qrel,hi);}while(0)
  #define ENDW(tt) do{ if((tt)+3<NT){WAIT_BAR(2);} else if((tt)+2<NT){WAIT_BAR(1);} else {WAIT_BAR(0);} }while(0)
  for(;t+1<NT;t+=2){
    STEP(pB0,pB1,pA0,pA1,t,(t+3<NT),(t+1<NT),(t+1<NT));       ENDW(t);   RESC(); ROT();
    STEP(pA0,pA1,pB0,pB1,t+1,(t+4<NT),(t+2<NT),(t+2<NT));     ENDW(t+1); RESC(); ROT();
  }
  STEP(pB0,pB1,pA0,pA1,NT-1,false,false,false); RESC();
  { float sacc=pB0[0]+pB0[1]; _Pragma("unroll") for(int r=2;r<16;++r)sacc+=pB0[r]; _Pragma("unroll") for(int r=0;r<16;++r)sacc+=pB1[r]; l_reg+=sacc;
    pw0=(u32x4){PKW(pB0,0),PKW(pB0,2),PKW(pB0,4),PKW(pB0,6)};pw1=(u32x4){PKW(pB0,8),PKW(pB0,10),PKW(pB0,12),PKW(pB0,14)};pw2=(u32x4){PKW(pB1,0),PKW(pB1,2),PKW(pB1,4),PKW(pB1,6)};pw3=(u32x4){PKW(pB1,8),PKW(pB1,10),PKW(pB1,12),PKW(pB1,14)};
    SBAR(); pv(o,vb0+sl_cur,PAF(0),PAF(1),PAF(2),PAF(3)); }
  #undef PKW
  #undef PAF
  #undef VFR
  #undef PIN
  #undef MX3
  #undef GAPA
  #undef GAPB
  #undef EX
  #undef VRD
  #undef KRD
  #undef STEP
  #undef ENDW
  {auto rr=__builtin_amdgcn_permlane32_swap(__float_as_uint(l_reg),__float_as_uint(l_reg),false,false);l_reg=__uint_as_float(rr[0])+__uint_as_float(rr[1]);}
  if(hi==0)wsf[32+r32]=l_reg;asm volatile("s_waitcnt lgkmcnt(0)":::"memory");
  float rli[16];
  #pragma unroll
  for(int r=0;r<16;++r)rli[r]=__builtin_amdgcn_rcpf(wsf[32+crow(r,hi)]);
  bf16*Ow=Oh+(long)(q0+wid*QBLK)*PO;
  { bf16*stg=(bf16*)(shm+LDS_OST)+wid*2048;
    #pragma unroll
    for(int r=0;r<16;++r){const int orow=crow(r,hi);
      #pragma unroll
      for(int d0=0;d0<2;++d0)stg[orow*64+d0*32+r32]=__float2bfloat16(o[d0][r]*rli[r]);}
    asm volatile("s_waitcnt lgkmcnt(0)":::"memory");
    #pragma unroll
    for(int i=0;i<4;++i){const int row=i*8+(lane>>3),ch=lane&7; const u32x4 v=*(const u32x4*)(stg+row*64+ch*8); ATTN_STORE16(Ow+(long)row*PO+ch*8,v);} }
  asm volatile("s_waitcnt lgkmcnt(0)\n\ts_barrier":::"memory");
  #undef DMA_K
  #undef DMA_V
  #undef CMASK
  #undef START
  #undef RESC
  #undef ROT
}

constexpr int VSLOT=2*SLOTB;
constexpr int L2_K=0, L2_V=NSLOT*SLOTB, L2_WS=L2_V+NSLOT*VSLOT, L2_OST=L2_WS+NW*64*4, L2_BYTES=L2_OST+NW*4096;
__device__ __forceinline__ void pv128(f32x16*o,int vb,bf16x8 pa0,bf16x8 pa1,bf16x8 pa2,bf16x8 pa3){
  #pragma unroll
  for(int d0=0;d0<4;++d0){s16x4 lo[4],hi[4];
    #pragma unroll
    for(int ks=0;ks<4;++ks){
      asm volatile("ds_read_b64_tr_b16 %0,%1 offset:%c2":"=&v"(lo[ks]):"v"(vb),"i"(d0*4096+ks*1024):"memory");
      asm volatile("ds_read_b64_tr_b16 %0,%1 offset:%c2":"=&v"(hi[ks]):"v"(vb),"i"(d0*4096+ks*1024+512):"memory");}
    asm volatile("s_waitcnt lgkmcnt(0)":::"memory");SBAR();
    #define PK(k) (bf16x8){lo[k][0],lo[k][1],lo[k][2],lo[k][3],hi[k][0],hi[k][1],hi[k][2],hi[k][3]}
    o[d0]=__builtin_amdgcn_mfma_f32_32x32x16_bf16(pa0,PK(0),o[d0],0,0,0);
    o[d0]=__builtin_amdgcn_mfma_f32_32x32x16_bf16(pa1,PK(1),o[d0],0,0,0);
    o[d0]=__builtin_amdgcn_mfma_f32_32x32x16_bf16(pa2,PK(2),o[d0],0,0,0);
    o[d0]=__builtin_amdgcn_mfma_f32_32x32x16_bf16(pa3,PK(3),o[d0],0,0,0);
    #undef PK
  }
}
struct AttnNext { bool has; int qb; const bf16* Qh; const bf16* Kh; const bf16* Vh; };
struct AttnCarry { bool primed; int s0; bf16x8 qr[4]; };
template<int THRL,class Post> __device__ __forceinline__ void attn_unit128(int qb,const bf16*Qh,const bf16*__restrict__ Kh,const bf16*__restrict__ Vh,bf16*Oh,char*shm,const Post&post,const AttnNext&nx,AttnCarry&cy){
  const int tid=opaque_tid(),lane=tid&63,r32=lane&31,hi=lane>>5; const int wid=__builtin_amdgcn_readfirstlane(tid>>6);
  const int q0=qb*QB;
  const bf16*Qw=Qh+(long)(q0+wid*QBLK)*PQ;
  const unsigned lds0=(unsigned)(uintptr_t)shm;
  float*wsf=(float*)(shm+L2_WS)+wid*64;
  const bf16*ksrc=Kh+(long)lane*PK+wid*8;
  const bf16*vsrc=Vh+(long)(16*(wid&3)+(lane>>2))*PV+(wid>>2)*32+(lane&3)*8;
  const unsigned kdst=lds0+L2_K+wid*1024, vdst=lds0+L2_V+wid*1024;
  #define DMA_K(t,slot) glds16(ksrc+(long)(t)*KVBLK*PK,(unsigned)__builtin_amdgcn_readfirstlane(kdst+(slot)))
  #define DMA_V(t,slot) do{ glds16(vsrc+(long)(t)*KVBLK*PV,(unsigned)__builtin_amdgcn_readfirstlane(vdst+2*(slot))); glds16(vsrc+(long)(t)*KVBLK*PV+64,(unsigned)__builtin_amdgcn_readfirstlane(vdst+2*(slot)+8192)); }while(0)
  const char*Kbase=shm+L2_K; bf16x8 kf[8];
  const lds_cptr shm3=(lds_cptr)shm; const lds_cptr kp0=shm3+L2_K+hi*1024+r32*16; const lds_cptr vp0=shm3+L2_V+((lane>>4)&1)*32+(lane&3)*8+(4*hi+((lane&15)>>2))*64;
  const int NT=(q0+QB)/KVBLK;
  const bool primed=cy.primed; const int s0=primed?cy.s0:0, s1=(s0==(NSLOT-1)*SLOTB)?0:s0+SLOTB, s2=(s1==(NSLOT-1)*SLOTB)?0:s1+SLOTB;
  bf16x8 (&qr)[4]=cy.qr;
  if(!primed){
    DMA_K(0,s0);DMA_V(0,s0);DMA_K(1,s1);
    #pragma unroll
    for(int d0=0;d0<4;++d0)qr[d0]=*reinterpret_cast<const bf16x8*>(&Qw[(long)r32*PQ+d0*16+hi*8]);
  }
  float mhat=0.f,l_reg=0.f;f32x16 o[4];o[0]=f32x16{};o[1]=f32x16{};o[2]=f32x16{};o[3]=f32x16{};f32x16 negm=f32x16{};asm volatile("":"+v"(negm));
  const int qrel=wid*QBLK+r32;
  #define CMASK(P0,P1,t) do{int jb_=(t)-(NT-4); if(jb_>=0)cmask(P0,P1,jb_,qrel,hi);}while(0)
  bool resc=false;
  #define RESC() do{ if(resc){ asm volatile("s_waitcnt lgkmcnt(0)":::"memory"); \
      _Pragma("unroll") for(int d_=0;d_<4;++d_) _Pragma("unroll") for(int r=0;r<16;++r)o[d_][r]*=wsf[crow(r,hi)]; } }while(0)
  f32x16 c0,c1;
  int sl_prev=s0,sl_cur=s0,sl_next=s1;
  #define ROT() do{sl_prev=sl_cur;sl_cur=sl_next;sl_next=(sl_next==(NSLOT-1)*SLOTB)?0:sl_next+SLOTB;}while(0)
  if(!primed){
    DMA_K(2,s2);
    WAIT_BAR(3);
  }
  qkt(c0,c1,Kbase+s0,qr,negm,r32,hi);asm volatile("s_nop 15\n\ts_nop 7":"+v"(c0),"+v"(c1));CMASK(c0,c1,0);
  u32x4 pw0,pw1,pw2,pw3;
  #define PKW(P,B) cvtpk_s(P[B],P[(B)+1])
  { const float rm=rowmax(c0,c1); mhat=fadd_s(mhat,rm);
    _Pragma("unroll") for(int r=0;r<16;++r){c0[r]=fsub_s(c0[r],rm);c1[r]=fsub_s(c1[r],rm);}
    _Pragma("unroll") for(int r=0;r<16;++r)negm[r]=-mhat; asm volatile("":"+v"(negm));
    _Pragma("unroll") for(int r=0;r<16;++r){c0[r]=__builtin_amdgcn_exp2f(c0[r]);c1[r]=__builtin_amdgcn_exp2f(c1[r]);}
    float sacc=c0[0]+c0[1]; _Pragma("unroll") for(int r=2;r<16;++r)sacc+=c0[r]; _Pragma("unroll") for(int r=0;r<8;++r)sacc+=c1[r]; l_reg+=sacc;
    pw0=(u32x4){PKW(c0,0),PKW(c0,2),PKW(c0,4),PKW(c0,6)};pw1=(u32x4){PKW(c0,8),PKW(c0,10),PKW(c0,12),PKW(c0,14)};pw2=(u32x4){PKW(c1,0),PKW(c1,2),PKW(c1,4),PKW(c1,6)}; }
  WAIT_BAR(0);
  DMA_K(3,s0);DMA_V(1,s1);
  ROT();
  kload8(kf,kp0+sl_cur);
  WAIT_BAR(3);
  s16x4 vlo[8],vhi[8];
  #define PAF(k) __builtin_bit_cast(bf16x8,pw##k)
  #define VFR(i) (bf16x8){vlo[i][0],vlo[i][1],vlo[i][2],vlo[i][3],vhi[i][0],vhi[i][1],vhi[i][2],vhi[i][3]}
  #define PIN(x) asm volatile("":"+v"(x))
  #define MX3(a,b,c) __builtin_fmaxf(__builtin_fmaxf((a),(b)),(c))
  #define EX(v) __builtin_amdgcn_exp2f(v)
  #define VRDF(sl,db,ks) do{ vlo[sl]=vtr(vp_+((db)*4096+(ks)*1024)); vhi[sl]=vtr(vp_+((db)*4096+(ks)*1024+512)); }while(0)
  #define KRD(G,j) do{ if(G){ kload2(kf,kp0+sl_next,j); SBAR(); } }while(0)
  #define MFQ(C,KF,Q,CIN) C=__builtin_amdgcn_mfma_f32_32x32x16_bf16(KF,Q,CIN,0,0,0)
  #define MFO(DB,KS,SL) o[DB]=__builtin_amdgcn_mfma_f32_32x32x16_bf16(PAF(KS),VFR(SL),o[DB],0,0,0)
  #define EX2(X,B) do{ X[B]=EX(X[B]); X[(B)+1]=EX(X[(B)+1]); PIN(X); }while(0)
  #define SPK(Y,PB,PW,W) do{ sacc+=Y[PB]; sacc+=Y[(PB)+1]; PIN(sacc); PW[W]=PKW(Y,PB); PIN(PW); }while(0)
  #define STEP(t,GK,GV,GL) do{ SBAR(); \
    const lds_cptr vp_=vp0+2*sl_prev; float sacc; \
    VRDF(0,0,0); SBAR(); MFQ(c0,kf[0],qr[0],negm); sacc=(c1[8]+c1[9]); sacc+=c1[10]; sacc+=c1[11]; sacc+=c1[12]; sacc+=c1[13]; sacc+=c1[14]; sacc+=c1[15]; PIN(sacc); \
                         pw3[0]=PKW(c1,8); pw3[1]=PKW(c1,10); pw3[2]=PKW(c1,12); pw3[3]=PKW(c1,14); PIN(pw3); SBAR(); \
    VRDF(1,1,0); SBAR(); MFQ(c1,kf[1],qr[0],negm); SBAR(); \
    VRDF(2,2,0); SBAR(); MFQ(c0,kf[2],qr[1],c0); SBAR(); \
    VRDF(3,3,0); SBAR(); MFQ(c1,kf[3],qr[1],c1); SBAR(); \
    VRDF(4,0,1); SBAR(); MFQ(c0,kf[4],qr[2],c0); SBAR(); \
    VRDF(5,1,1); SBAR(); MFQ(c1,kf[5],qr[2],c1); SBAR(); \
    VRDF(6,2,1); SBAR(); MFQ(c0,kf[6],qr[3],c0); SBAR(); \
    VRDF(7,3,1); SBAR(); MFQ(c1,kf[7],qr[3],c1); SBAR(); \
    l_reg+=sacc; sacc=0.f; \
    if(GK){DMA_K((t)+3,sl_cur);} if(GV){DMA_V((t)+1,sl_next);} \
    CMASK(c0,c1,t); \
    { float a=MX3(c0[0],c0[1],c1[0]),b=MX3(c0[2],c0[3],c1[1]); a=MX3(a,c1[2],c1[3]); \
      _Pragma("unroll") for(int r=4;r<16;r+=4){a=MX3(a,c0[r],c0[r+1]);b=MX3(b,c0[r+2],c0[r+3]);a=MX3(a,c1[r],c1[r+1]);b=MX3(b,c1[r+2],c1[r+3]);} \
      float rm=__builtin_fmaxf(a,b); { auto rr=__builtin_amdgcn_permlane32_swap(__float_as_uint(rm),__float_as_uint(rm),false,false); rm=__builtin_fmaxf(__uint_as_float(rr[0]),__uint_as_float(rr[1])); } \
      resc=false; \
      if(__builtin_expect(__any(rm>(float)THRL),0)){ const float dl=__builtin_fmaxf(rm,0.f); mhat+=dl; \
        _Pragma("unroll") for(int r=0;r<16;++r){c0[r]-=dl;c1[r]-=dl;} \
        _Pragma("unroll") for(int r=0;r<16;++r)negm[r]=-mhat; asm volatile("":"+v"(negm)); \
        const float f=__builtin_amdgcn_exp2f(-dl); l_reg*=f; if(hi==0)wsf[r32]=f; resc=true; } } \
    SBAR(); \
    MFO(0,0,0); VRDF(0,0,2); EX2(c0,0);  SBAR(); \
    MFO(1,0,1); VRDF(1,1,2); EX2(c0,2);  SBAR(); \
    MFO(2,0,2); VRDF(2,2,2); EX2(c0,4);  SBAR(); \
    MFO(3,0,3); VRDF(3,3,2); EX2(c0,6);  SBAR(); \
    MFO(0,1,4); VRDF(4,0,3); EX2(c0,8);  SPK(c0,0,pw0,0); SBAR(); \
    MFO(1,1,5); VRDF(5,1,3); EX2(c0,10); SPK(c0,2,pw0,1); SBAR(); \
    MFO(2,1,6); VRDF(6,2,3); EX2(c0,12); SPK(c0,4,pw0,2); SBAR(); \
    MFO(3,1,7); VRDF(7,3,3); EX2(c0,14); SPK(c0,6,pw0,3); SBAR(); \
    KRD(GL,0); MFO(0,2,0); EX2(c1,0);  SPK(c0,8,pw1,0);  SBAR(); \
    KRD(GL,1); MFO(1,2,1); EX2(c1,2);  SPK(c0,10,pw1,1); SBAR(); \
    KRD(GL,2); MFO(2,2,2); EX2(c1,4);  SPK(c0,12,pw1,2); SBAR(); \
    KRD(GL,3); MFO(3,2,3); EX2(c1,6);  SPK(c0,14,pw1,3); SBAR(); \
    MFO(0,3,4); EX2(c1,8);  SPK(c1,0,pw2,0); SBAR(); \
    MFO(1,3,5); EX2(c1,10); SPK(c1,2,pw2,1); SBAR(); \
    MFO(2,3,6); EX2(c1,12); SPK(c1,4,pw2,2); SBAR(); \
    MFO(3,3,7); EX2(c1,14); SPK(c1,6,pw2,3); SBAR(); \
    l_reg+=sacc; \
    }while(0)
  int t=1;
  #undef CMASK
  #define CMASK(P0,P1,t) do{}while(0)
  for(;t+4<NT;++t){ STEP(t,true,true,true); WAIT_BAR(3); RESC(); ROT(); }
  #undef CMASK
  #define CMASK(P0,P1,t) do{int jb_=(t)-(NT-4); if(jb_>=0)cmask(P0,P1,jb_,qrel,hi);}while(0)
  const bool hn=nx.has;
  const long kadj=hn?(long)(nx.Kh-Kh)-(long)NT*KVBLK*PK:0L, vadj=hn?(long)(nx.Vh-Vh)-(long)NT*KVBLK*PV:0L;
  #undef DMA_K
  #undef DMA_V
  #define DMA_K(t,slot) glds16(ksrc+(long)(t)*KVBLK*PK+(((t)>=NT)?kadj:0L),(unsigned)__builtin_amdgcn_readfirstlane(kdst+(slot)))
  #define DMA_V(t,slot) do{ const bf16*vs_=vsrc+(long)(t)*KVBLK*PV+(((t)>=NT)?vadj:0L); glds16(vs_,(unsigned)__builtin_amdgcn_readfirstlane(vdst+2*(slot))); glds16(vs_+64,(unsigned)__builtin_amdgcn_readfirstlane(vdst+2*(slot)+8192)); }while(0)
  #define ENDW(tt) do{ if(hn||(tt)+3<NT){WAIT_BAR(3);} else if((tt)+2<NT){WAIT_BAR(2);} else {WAIT_BAR(0);} }while(0)
  for(;t+1<NT;++t){ STEP(t,(hn||t+3<NT),true,true); ENDW(t); RESC(); ROT(); }
  STEP(NT-1,hn,hn,false);
  if(hn){
    const bf16*QwN=nx.Qh+(long)(nx.qb*QB+wid*QBLK)*PQ;
    #pragma unroll
    for(int d0=0;d0<4;++d0)qr[d0]=*reinterpret_cast<const bf16x8*>(&QwN[(long)r32*PQ+d0*16+hi*8]);
    WAIT_BAR(7);
  }
  cy.primed=hn; cy.s0=sl_next;
  RESC();
  { float sacc=(c1[8]+c1[9]); _Pragma("unroll") for(int r=10;r<16;++r)sacc+=c1[r]; l_reg+=sacc;
    pw3=(u32x4){PKW(c1,8),PKW(c1,10),PKW(c1,12),PKW(c1,14)};
    SBAR(); pv128(o,(int)(unsigned)(uintptr_t)vp0+2*sl_cur,PAF(0),PAF(1),PAF(2),PAF(3)); }
  #undef PKW
  #undef PAF
  #undef VFR
  #undef PIN
  #undef MX3
  #undef EX
  #undef VRDF
  #undef KRD
  #undef MFQ
  #undef MFO
  #undef EX2
  #undef SPK
  #undef STEP
  #undef ENDW
  {auto rr=__builtin_amdgcn_permlane32_swap(__float_as_uint(l_reg),__float_as_uint(l_reg),false,false);l_reg=__uint_as_float(rr[0])+__uint_as_float(rr[1]);}
  if(hi==0)wsf[32+r32]=l_reg;asm volatile("s_waitcnt lgkmcnt(0)":::"memory");
  float rli[16];
  #pragma unroll
  for(int r=0;r<16;++r)rli[r]=__builtin_amdgcn_rcpf(wsf[32+crow(r,hi)]);
  if(post.on){
    asm volatile("s_waitcnt lgkmcnt(0)\n\ts_barrier":::"memory");
    const int so=__builtin_amdgcn_readfirstlane((wid<4)?(L2_OST+wid*8192):(L2_V+2*((wid<6)?sl_prev:sl_cur)+(wid&1)*8192));
    bf16*stg=(bf16*)(shm+so);
    #pragma unroll
    for(int r=0;r<16;++r){const int orow=crow(r,hi);
      #pragma unroll
      for(int d0=0;d0<4;++d0)stg[orow*128+d0*32+r32]=__float2bfloat16(o[d0][r]*rli[r]);}
    asm volatile("s_waitcnt lgkmcnt(0)":::"memory");
    post.run((lds_cptr)shm+so,q0+wid*QBLK,lane);
  } else {
  bf16*Ow=Oh+(long)(q0+wid*QBLK)*PO;
  { bf16*stg=(bf16*)(shm+L2_OST)+wid*2048;
    #pragma unroll
    for(int h2=0;h2<2;++h2){
      #pragma unroll
      for(int r=0;r<16;++r){const int orow=crow(r,hi);
        #pragma unroll
        for(int d0=0;d0<2;++d0)stg[orow*64+d0*32+r32]=__float2bfloat16(o[2*h2+d0][r]*rli[r]);}
      asm volatile("s_waitcnt lgkmcnt(0)":::"memory");
      #pragma unroll
      for(int i=0;i<4;++i){const int row=i*8+(lane>>3),ch=lane&7; const u32x4 v=*(const u32x4*)(stg+row*64+ch*8); ATTN_STORE16(Ow+(long)row*PO+h2*64+ch*8,v);}
      asm volatile("s_waitcnt lgkmcnt(0)":::"memory"); } }
  }
  asm volatile("s_waitcnt lgkmcnt(0)\n\ts_barrier":::"memory");
  #undef DMA_K
  #undef DMA_V
  #undef CMASK
  #undef RESC
  #undef ROT
}
constexpr int ATTN_LDS_BYTES=L2_BYTES;
#undef SBAR
#undef WAIT_BAR
}

constexpr int NWAVES = 8;
constexpr size_t MiB = 1u << 20;
constexpr size_t WS_CTL = 0, CTL_ZERO_BYTES = 1 * MiB;
constexpr size_t WS_ROPEC = 1 * MiB, WS_ROPES = WS_ROPEC + 256 * 1024;
constexpr size_t WS_ROUTE = 2 * MiB;
constexpr int ECAP = M, ECAP_LOG = 14;
static_assert((1 << ECAP_LOG) == ECAP, "ECAP");
constexpr size_t RT_SLOTOF = 0, RT_WSLOT = 128 * 1024, RT_SSSLOT = 1024 * 1024;
constexpr size_t WS_SS = 6 * MiB;
constexpr size_t WS_WIN = 10 * MiB;
constexpr size_t WS_WOUT = WS_WIN + 64 * MiB;
constexpr size_t WS_WGU = WS_WOUT + 8 * MiB;
constexpr size_t WS_WD = WS_WGU + 22 * MiB;
constexpr size_t WS_WEGU = WS_WD + 11 * MiB;
constexpr size_t WS_WED = WS_WEGU + 224 * MiB;
constexpr size_t WS_XB = WS_WED + 112 * MiB;
constexpr size_t WS_PROJ = WS_XB + 32 * MiB;
constexpr size_t WS_O = WS_PROJ + 256 * MiB;
constexpr size_t WS_MIX = WS_O + 64 * MiB;
constexpr size_t WS_Y = WS_MIX + 32 * MiB;
constexpr size_t WS_END = WS_Y + 68 * MiB;
static_assert((size_t)MSLOT * DFFE * 2 <= 256 * MiB && (size_t)MSLOT * 1024 * 2 <= 68 * MiB && (size_t)MSLOT * 1024 * 2 <= 96 * MiB, "overlays");
static_assert((size_t)NEXP * ECAP * 4 <= 896 * 1024 && RT_SSSLOT + (size_t)NEXP * ECAP * 16 <= 4 * MiB && (size_t)9 * M * 16 <= 4 * MiB && (size_t)NEXP * ECAP * 1024 <= 164 * MiB, "routing / ss map; sparse expert inputs overlay O | MIX | Y");
constexpr int CW_TMO = 0, CW_CODE = 1;
constexpr int CW_BAR = 4096;
constexpr int CW_GCNT = 16384;

constexpr int RING_OFF = 0, RING_BYTES = 131072;
constexpr int LDSCTL_OFF = RING_BYTES, MISC_OFF = LDSCTL_OFF + 320;
constexpr int LDS_BYTES = 163840;
static_assert(MISC_OFF + 128 <= LDS_BYTES, "LDS map");

#define GAS __attribute__((address_space(1)))
#define LAS __attribute__((address_space(3)))
typedef unsigned short bf16;
typedef unsigned v4u __attribute__((ext_vector_type(4)));
typedef unsigned v2u __attribute__((ext_vector_type(2)));
typedef float f32x4 __attribute__((ext_vector_type(4)));
typedef GAS unsigned gu32;
#define RLX_AGENT __ATOMIC_RELAXED, __HIP_MEMORY_SCOPE_AGENT
#define LDS_WAIT() asm volatile("s_waitcnt lgkmcnt(0)" ::: "memory")
#define VM_WAIT() asm volatile("s_waitcnt vmcnt(0)" ::: "memory")
__device__ __forceinline__ unsigned f2bf(float f) { unsigned u = __builtin_bit_cast(unsigned, f); return (u + 0x7fffu + ((u >> 16) & 1u)) >> 16; }
__device__ __forceinline__ unsigned pk2(float lo, float hi) { return f2bf(lo) | (f2bf(hi) << 16); }
__device__ __forceinline__ float bflo(unsigned w) { return __uint_as_float(w << 16); }
__device__ __forceinline__ float bfhi(unsigned w) { return __uint_as_float(w & 0xffff0000u); }

#define XB_TMO      128
#define XB_XCNT(j)  (256  + 64 * (j))
#define XB_XSUB(j)  (1280 + 64 * (j))
#define XB_XGEN(j)  (2304 + 64 * (j))
#define XB_TOP      3328
#define XB_TOPGEN   3392
#define XCD_BAR_WORDS 3456
#define XB_SPIN_CAP (1u << 18)
__device__ __forceinline__ unsigned xb_ld(unsigned* p)              { return __hip_atomic_load(p, __ATOMIC_RELAXED, __HIP_MEMORY_SCOPE_AGENT); }
__device__ __forceinline__ unsigned xb_add(unsigned* p, unsigned v) { return __hip_atomic_fetch_add(p, v, __ATOMIC_RELAXED, __HIP_MEMORY_SCOPE_AGENT); }
__device__ __forceinline__ unsigned xb_xcc_id() { return (unsigned)__builtin_amdgcn_s_getreg((3 << 11) | 20) & 0xFu; }
#define XB_SPIN(cond, bar) do { unsigned _sp = 0; while (cond) { __builtin_amdgcn_s_sleep(1); \
    if ((++_sp & 255u) == 0u) { if (xb_ld(&(bar)[XB_TMO])) break; if (_sp > XB_SPIN_CAP) { atomicAdd(&(bar)[XB_TMO], 1u); break; } } } } while (0)
struct XcdBarrier { unsigned* bar; unsigned x; volatile LAS unsigned* st; };
__device__ __forceinline__ XcdBarrier xcd_barrier_post(unsigned* bar, volatile LAS unsigned* st) {
    XcdBarrier b; b.bar = bar; b.x = xb_xcc_id(); b.st = st;
    if (threadIdx.x == 0) (void)xb_add(&bar[XB_XCNT(b.x)], 1u);
    return b;
}
__device__ __forceinline__ void xcd_barrier_complete(unsigned* bar, unsigned x, unsigned& nloc, unsigned& nx) {
    const unsigned G = gridDim.x * gridDim.y * gridDim.z;
    unsigned sum, cnt, mine, sp = 0u;
    for (;;) {
        sum = 0u; cnt = 0u; mine = 0u;
#pragma unroll
        for (unsigned j = 0; j < 16; ++j) { const unsigned c = xb_ld(&bar[XB_XCNT(j)]); sum += c; cnt += (c > 0u) ? 1u : 0u; mine = (j == x) ? c : mine; }
        if (sum == G) break;
        __builtin_amdgcn_s_sleep(1);
        if ((++sp & 255u) == 0u) { if (xb_ld(&bar[XB_TMO])) break; if (sp > XB_SPIN_CAP) { atomicAdd(&bar[XB_TMO], 1u); break; } }
    }
    nloc = mine > 0u ? mine : 1u; nx = cnt > 0u ? cnt : 1u;
}
__device__ __forceinline__ void xcd_barrier(const XcdBarrier& b) {
    asm volatile("s_waitcnt vmcnt(0)" ::: "memory");
    __syncthreads();
    if (threadIdx.x == 0) {
        unsigned* bar = b.bar;
        __builtin_amdgcn_s_waitcnt(0);
        unsigned nloc = b.st[0], nx = b.st[1];
        if (nloc == 0u) { xcd_barrier_complete(bar, b.x, nloc, nx); b.st[0] = nloc; b.st[1] = nx; }
        const unsigned old = xb_add(&bar[XB_XSUB(b.x)], 1u);
        const unsigned gen = old / nloc;
        if (old + 1u == (gen + 1u) * nloc) {
            __builtin_amdgcn_fence(__ATOMIC_RELEASE, "agent");
            asm volatile("s_waitcnt vmcnt(0)" ::: "memory");
            const unsigned og = xb_add(&bar[XB_TOP], 1u);
            const unsigned tg = og / nx;
            if (og + 1u == (tg + 1u) * nx) xb_add(&bar[XB_TOPGEN], 1u);
            else XB_SPIN(xb_ld(&bar[XB_TOPGEN]) == tg, bar);
            __builtin_amdgcn_fence(__ATOMIC_ACQUIRE, "agent");
            xb_add(&bar[XB_XGEN(b.x)], 1u);
            asm volatile("s_waitcnt vmcnt(0)" ::: "memory");
        } else {
            XB_SPIN(xb_ld(&bar[XB_XGEN(b.x)]) == gen, bar);
            __builtin_amdgcn_fence(__ATOMIC_ACQUIRE, "agent");
            asm volatile("s_waitcnt vmcnt(0)" ::: "memory");
        }
    }
    __syncthreads();
}

struct Args { const float* in[19]; float* out; unsigned char* ws; int ph_lo, ph_hi; };
static_assert(sizeof(Args) == 19 * 8 + 8 + 8 + 8, "Args has no padding");

typedef const __attribute__((address_space(4))) Args* kargs_t;
#define KARGS() ({ kargs_t p_ = (kargs_t)__builtin_amdgcn_kernarg_segment_ptr(); asm volatile("" : "+s"(p_)); p_; })
struct Frame {
    LAS unsigned char* lds;
    int tid, lane, wave;
    int vcu, G;
    unsigned char* ws;
    gu32* ctl;
    float* X;
};
__device__ __forceinline__ Frame make_frame(kargs_t ap) {
    extern __shared__ __attribute__((aligned(16))) unsigned char lds[];
    Frame F; F.lds = (LAS unsigned char*)lds; F.tid = opaque_tid(); F.lane = F.tid & 63; F.wave = __builtin_amdgcn_readfirstlane(F.tid >> 6);
    F.G = opaque_grid(); { const int bx = opaque_bid(); F.vcu = (F.G % 8 == 0) ? (bx % 8) * (F.G / 8) + bx / 8 : bx; }
    F.ws = ap->ws; F.ctl = (gu32*)(F.ws + WS_CTL); F.X = ap->out; return F;
}

__device__ __forceinline__ float wave_sum(float v) {
#pragma unroll
    for (int o = 1; o < 64; o <<= 1) v += __shfl_xor(v, o);
    return v;
}

template <int KIND>
__device__ __forceinline__ int rowmap(int n) {
    if (KIND == 1) {
        if (n < 3072) return n;
        if (n < 4096) { const int c = n - 3072; return (20 + (c >> 7)) * 256 + ((c & 127) >> 5) * 64 + (c & 31); }
        if (n < 5120) { const int c = n - 4096; return (12 + (c >> 7)) * 256 + ((c & 127) >> 5) * 64 + (c & 31); }
        if (n < 6144) { const int c = n - 5120; return (12 + (c >> 7)) * 256 + ((c & 127) >> 5) * 64 + 32 + (c & 31); }
        if (n < 7168) { return 28 * 256 + (n - 6144); }
        { const int c = n - 7168; return (20 + (c >> 7)) * 256 + ((c & 127) >> 5) * 64 + 32 + (c & 31); }
    }
    if (KIND == 2) return (n >> 7) * 256 + ((n & 127) >> 5) * 64 + (n & 31);
    if (KIND == 3) return (n >> 7) * 256 + ((n & 127) >> 5) * 64 + 32 + (n & 31);
    return n;
}
__device__ __forceinline__ void cvt_ld(const float* __restrict__ W, int N, int item, int lane, f32x4 (&v)[8]) {
    const int nblk = N >> 5, kb = item / nblk, nb = item - kb * nblk;
    const int l8 = lane & 7, kg = lane >> 3;
    const int k0 = kb * 64 + kg * 8, n0 = nb * 32 + l8 * 4;
#pragma unroll
    for (int r = 0; r < 8; ++r) v[r] = *(const GAS f32x4*)(W + (size_t)(k0 + r) * N + n0);
}
template <int KIND>
__device__ __forceinline__ void cvt_st(int K, int N, const float* __restrict__ gain, bf16* __restrict__ WT, int item, int lane, f32x4 (&v)[8]) {
    const int nblk = N >> 5, kb = item / nblk, nb = item - kb * nblk;
    const int l8 = lane & 7, kg = lane >> 3;
    const int k0 = kb * 64 + kg * 8, n0 = nb * 32 + l8 * 4;
    if (gain) {
        const f32x4 g0 = *(const GAS f32x4*)(gain + k0), g1 = *(const GAS f32x4*)(gain + k0 + 4);
#pragma unroll
        for (int r = 0; r < 4; ++r) { v[r] = v[r] * g0[r]; v[r + 4] = v[r + 4] * g1[r]; }
    }
#pragma unroll
    for (int i = 0; i < 4; ++i) {
        v4u o; o.x = pk2(v[0][i], v[1][i]); o.y = pk2(v[2][i], v[3][i]); o.z = pk2(v[4][i], v[5][i]); o.w = pk2(v[6][i], v[7][i]);
        st16_wt((void*)(WT + (size_t)rowmap<KIND>(n0 + i) * K + k0), o);
    }
}

__device__ __forceinline__ void cvt_ld_f8(const float* __restrict__ W, int N, int item, int lane, f32x4 (&v)[16]) {
    const int nblk = N >> 5, kb = item / nblk, nb = item - kb * nblk;
    const int l8 = lane & 7, kg = lane >> 3;
    const int k0 = kb * 128 + kg * 16, n0 = nb * 32 + l8 * 4;
#pragma unroll
    for (int r = 0; r < 16; ++r) v[r] = __builtin_nontemporal_load((const GAS f32x4*)(W + (size_t)(k0 + r) * N + n0));
}
template <int KIND>
__device__ __forceinline__ void cvt_st_f8(int K, int N, const float* __restrict__ gain, unsigned char* __restrict__ WT, int item, int lane, f32x4 (&v)[16]) {
    const int nblk = N >> 5, kb = item / nblk, nb = item - kb * nblk;
    const int l8 = lane & 7, kg = lane >> 3;
    const int k0 = kb * 128 + kg * 16, n0 = nb * 32 + l8 * 4;
#pragma unroll
    for (int q = 0; q < 4; ++q) { f32x4 g = {256.f, 256.f, 256.f, 256.f}; if (gain) g = *(const GAS f32x4*)(gain + k0 + 4 * q) * 256.f;
#pragma unroll
        for (int r = 0; r < 4; ++r) v[4 * q + r] = v[4 * q + r] * g[r]; }
#pragma unroll
    for (int i = 0; i < 4; ++i) {
        v4u o;
#pragma unroll
        for (int q = 0; q < 4; ++q) { unsigned w = 0u;
            w = __builtin_amdgcn_cvt_pk_fp8_f32(pg8::clamp448(v[4 * q][i]), pg8::clamp448(v[4 * q + 1][i]), w, false);
            w = __builtin_amdgcn_cvt_pk_fp8_f32(pg8::clamp448(v[4 * q + 2][i]), pg8::clamp448(v[4 * q + 3][i]), w, true); o[q] = w; }
        st16_wt((void*)(WT + (size_t)rowmap<KIND>(n0 + i) * K + k0), o);
    }
}

template <int KIND>
__device__ __forceinline__ void cvt_st_b16(int K, int N, const float* __restrict__ gain, bf16* __restrict__ WT, int item, int lane, f32x4 (&v)[16]) {
    const int nblk = N >> 5, kb = item / nblk, nb = item - kb * nblk;
    const int l8 = lane & 7, kg = lane >> 3;
    const int k0 = kb * 128 + kg * 16, n0 = nb * 32 + l8 * 4;
    if (gain) {
#pragma unroll
        for (int q = 0; q < 4; ++q) { const f32x4 g = *(const GAS f32x4*)(gain + k0 + 4 * q);
#pragma unroll
            for (int r = 0; r < 4; ++r) v[4 * q + r] = v[4 * q + r] * g[r]; } }
#pragma unroll
    for (int i = 0; i < 4; ++i) {
        v4u o0, o1; o0.x = pk2(v[0][i], v[1][i]); o0.y = pk2(v[2][i], v[3][i]); o0.z = pk2(v[4][i], v[5][i]); o0.w = pk2(v[6][i], v[7][i]);
        o1.x = pk2(v[8][i], v[9][i]); o1.y = pk2(v[10][i], v[11][i]); o1.z = pk2(v[12][i], v[13][i]); o1.w = pk2(v[14][i], v[15][i]);
        bf16* q = WT + (size_t)rowmap<KIND>(n0 + i) * K + k0;
        *(GAS v4u*)q = o0; *(GAS v4u*)(q + 8) = o1;
    }
}

template <int KIND>
__device__ __forceinline__ void cvt_run(const float* __restrict__ W, int K, int N, const float* __restrict__ gain, bf16* __restrict__ WT, int it0, int NI, int nranks, int lane) {
    constexpr int NP = 4;
    for (int it = it0; it < NI; it += NP * nranks) {
        f32x4 v[NP][8];
#pragma unroll
        for (int q = 0; q < NP; ++q) { const int ii = it + q * nranks; if (ii < NI) cvt_ld(W, N, ii, lane, v[q]); }
        asm volatile("" ::: "memory");
#pragma unroll
        for (int q = 0; q < NP; ++q) { const int ii = it + q * nranks; if (ii < NI) cvt_st<KIND>(K, N, gain, WT, ii, lane, v[q]); }
    }
}
template <int KIND>
__device__ __forceinline__ void cvt_run_f8(const float* __restrict__ W, int K, int N, const float* __restrict__ gain, unsigned char* __restrict__ WT, int it0, int NI, int nranks, int lane) {
    constexpr int NP = 2;
    for (int it = it0; it < NI; it += NP * nranks) {
        f32x4 v[NP][16];
#pragma unroll
        for (int q = 0; q < NP; ++q) { const int ii = it + q * nranks; if (ii < NI) cvt_ld_f8(W, N, ii, lane, v[q]); }
        asm volatile("" ::: "memory");
#pragma unroll
        for (int q = 0; q < NP; ++q) { const int ii = it + q * nranks; if (ii < NI) cvt_st_f8<KIND>(K, N, gain, WT, ii, lane, v[q]); }
    }
}

__device__ __forceinline__ void convert_group(kargs_t A, unsigned char* ws, int grp, int rank, int nranks, int lane) {
    constexpr int I_IN = (DM / 128) * (IN_W / 32), I_OUT = (DM / 128) * (DM / 32), I_G = (DM / 128) * (DFF / 32), I_D = (DFF / 128) * (DM / 32), I_EG = (DM / 128) * (DFFE / 32), I_ED = (DFFE / 128) * (DM / 32);
    const int in_n = (grp < 4) ? 1 : 0, d_n = (grp == 1 || grp == 2) ? 1 : 0, e_lo = (grp - 1) * 4, e_n = (grp >= 1) ? 4 : 0;
    const int c0 = in_n * I_IN, c1 = c0 + in_n * I_OUT, c2 = c1 + d_n * I_G, c3 = c2 + d_n * I_G, c4 = c3 + d_n * I_D, c5 = c4 + e_n * I_EG, c6 = c5 + e_n * I_EG, c7 = c6 + e_n * I_ED;
    const int j = grp, jd = grp - 1;
    for (int it = rank; it < c7; it += 2 * nranks) {
        f32x4 v[2][16];
#pragma unroll
        for (int q = 0; q < 2; ++q) { const int ii = it + q * nranks;
            if (ii < c7) { const float* W; int N, r;
                if (ii < c0) { W = A->in[2] + (size_t)j * DM * IN_W; N = IN_W; r = ii; }
                else if (ii < c1) { W = A->in[9] + (size_t)j * DM * DM; N = DM; r = ii - c0; }
                else if (ii < c2) { W = A->in[11] + (size_t)jd * DM * DFF; N = DFF; r = ii - c1; }
                else if (ii < c3) { W = A->in[12] + (size_t)jd * DM * DFF; N = DFF; r = ii - c2; }
                else if (ii < c4) { W = A->in[13] + (size_t)jd * DFF * DM; N = DM; r = ii - c3; }
                else if (ii < c5) { const int rr = ii - c4, jj = rr / I_EG; r = rr - jj * I_EG; W = A->in[15] + (size_t)(e_lo + jj) * DM * DFFE; N = DFFE; }
                else if (ii < c6) { const int rr = ii - c5, jj = rr / I_EG; r = rr - jj * I_EG; W = A->in[16] + (size_t)(e_lo + jj) * DM * DFFE; N = DFFE; }
                else { const int rr = ii - c6, jj = rr / I_ED; r = rr - jj * I_ED; W = A->in[17] + (size_t)(e_lo + jj) * DFFE * DM; N = DM; }
                cvt_ld_f8(W, N, r, lane, v[q]); } }
        asm volatile("" ::: "memory");
#pragma unroll
        for (int q = 0; q < 2; ++q) { const int ii = it + q * nranks;
            if (ii < c7) {
                if (ii < c0) { const int r = ii;
                    if (INPROJ_F8(j)) cvt_st_f8<1>(DM, IN_W, A->in[1] + j * DM, (unsigned char*)(ws + WS_WIN) + (size_t)j * IN_W * DM * 2, r, lane, v[q]);
                    else cvt_st_b16<1>(DM, IN_W, A->in[1] + j * DM, (bf16*)(ws + WS_WIN) + (size_t)j * IN_W * DM, r, lane, v[q]); }
                else if (ii < c1) cvt_st_b16<0>(DM, DM, nullptr, (bf16*)(ws + WS_WOUT) + (size_t)j * DM * DM, ii - c0, lane, v[q]);
                else if (ii < c2) { const int r = ii - c1;
                    if (DENSE_F8(jd)) cvt_st_f8<2>(DM, DFF, A->in[10] + (2 * jd) * DM, (unsigned char*)(ws + WS_WGU) + (size_t)jd * 2 * DFF * DM * 2, r, lane, v[q]);
                    else cvt_st_b16<2>(DM, DFF, A->in[10] + (2 * jd) * DM, (bf16*)(ws + WS_WGU) + (size_t)jd * 2 * DFF * DM, r, lane, v[q]); }
                else if (ii < c3) { const int r = ii - c2;
                    if (DENSE_F8(jd)) cvt_st_f8<3>(DM, DFF, A->in[10] + (2 * jd) * DM, (unsigned char*)(ws + WS_WGU) + (size_t)jd * 2 * DFF * DM * 2, r, lane, v[q]);
                    else cvt_st_b16<3>(DM, DFF, A->in[10] + (2 * jd) * DM, (bf16*)(ws + WS_WGU) + (size_t)jd * 2 * DFF * DM, r, lane, v[q]); }
                else if (ii < c4) { const int r = ii - c3;
                    if (DENSE_DN_F8(jd)) cvt_st_f8<0>(DFF, DM, nullptr, (unsigned char*)(ws + WS_WD) + (size_t)jd * DM * DFF * 2, r, lane, v[q]);
                    else cvt_st_b16<0>(DFF, DM, nullptr, (bf16*)(ws + WS_WD) + (size_t)jd * DM * DFF, r, lane, v[q]); }
                else if (ii < c5) { const int rr = ii - c4, jj = rr / I_EG, r = rr - jj * I_EG, je = e_lo + jj;
                    cvt_st_f8<2>(DM, DFFE, A->in[10] + (2 * (je >> 3) + 1) * DM, (unsigned char*)(ws + WS_WEGU) + (size_t)je * 2 * DFFE * DM, r, lane, v[q]); }
                else if (ii < c6) { const int rr = ii - c5, jj = rr / I_EG, r = rr - jj * I_EG, je = e_lo + jj;
                    cvt_st_f8<3>(DM, DFFE, A->in[10] + (2 * (je >> 3) + 1) * DM, (unsigned char*)(ws + WS_WEGU) + (size_t)je * 2 * DFFE * DM, r, lane, v[q]); }
                else { const int rr = ii - c6, jj = rr / I_ED, r = rr - jj * I_ED, je = e_lo + jj;
                    cvt_st_f8<0>(DFFE, DM, nullptr, (unsigned char*)(ws + WS_WED) + (size_t)je * DM * DFFE, r, lane, v[q]); } } }
    }
}
__device__ __forceinline__ void p0_prologue() {
    const kargs_t A = KARGS(); Frame F = make_frame(A);
    const int gw = F.vcu * NWAVES + F.wave, NGW = F.G * NWAVES, lane = F.lane;
    unsigned char* ws = F.ws;
    convert_group(A, ws, 0, gw, NGW, lane);
    { float* rc = (float*)(ws + WS_ROPEC); float* rs = (float*)(ws + WS_ROPES);
      for (int idx = (F.vcu * NWAVES + F.wave) * 64 + lane; idx < SEQ * 32; idx += NGW * 64) {
          const int pos = idx >> 5, i = idx & 31;
          const float inv = __builtin_amdgcn_exp2f(-(float)i * 0.4152410118609203f);
          const float ang = (float)pos * inv;
          const double rev = (double)ang * 0.15915494309189535; const float fr = (float)(rev - __builtin_rint(rev));
          rc[idx] = __builtin_amdgcn_cosf(fr); rs[idx] = __builtin_amdgcn_sinf(fr); } }
    { const float* x = A->in[0]; float* ss = (float*)(ws + WS_SS); bf16* xb = (bf16*)(ws + WS_XB);
      for (int m0 = gw * 4; m0 < M; m0 += NGW * 4) {
          f32x4 v[4][4];
#pragma unroll
          for (int r = 0; r < 4; ++r) { const GAS f32x4* xr = (const GAS f32x4*)(x + (size_t)(m0 + r) * DM) + lane;
#pragma unroll
              for (int j = 0; j < 4; ++j) v[r][j] = xr[64 * j]; }
#pragma unroll
          for (int r = 0; r < 4; ++r) { const int m = m0 + r; GAS v2u* o8 = (GAS v2u*)(xb + (size_t)m * DM) + lane; float s = 0.f;
#pragma unroll
              for (int j = 0; j < 4; ++j) { const f32x4 q = v[r][j]; s += (q.x * q.x + q.y * q.y) + (q.z * q.z + q.w * q.w); v2u w; w.x = pk2(q.x, q.y); w.y = pk2(q.z, q.w); st8_wt((void*)(o8 + 64 * j), w); }
              s = wave_sum(s); if (lane == 0) *(GAS f32x4*)(ss + 4 * (size_t)m) = (f32x4){s, 0.f, 0.f, 0.f}; } } }
}

__device__ __forceinline__ float sigmoidf_(float x) { return __builtin_amdgcn_rcpf(1.0f + __builtin_amdgcn_exp2f(x * -1.4426950408889634f)); }
__device__ __forceinline__ void unpack8(const v4u w, float (&f)[8]) { f[0] = bflo(w.x); f[1] = bfhi(w.x); f[2] = bflo(w.y); f[3] = bfhi(w.y); f[4] = bflo(w.z); f[5] = bfhi(w.z); f[6] = bflo(w.w); f[7] = bfhi(w.w); }
struct MergeCtx { float lam, one_m_li; float w0[8], w1[8], w2[8], g[8]; };
__device__ __forceinline__ void merge_setup(MergeCtx& C, kargs_t A, int l, int h, int tid) {
    const int lane = tid & 63, chunk = tid & 15;
    const float lam_init = (l == 0) ? 0.2f : (l == 1) ? 0.35550906759096934f : (l == 2) ? 0.4707130183435842f : 0.5560582041556406f;
    const float a1 = A->in[4][l * 64 + lane] * A->in[5][l * 64 + lane], a2 = A->in[6][l * 64 + lane] * A->in[7][l * 64 + lane];
    const float s1 = wave_sum(a1), s2 = wave_sum(a2);
    C.lam = __builtin_amdgcn_exp2f(s1 * 1.4426950408889634f) - __builtin_amdgcn_exp2f(s2 * 1.4426950408889634f) + lam_init; C.one_m_li = 1.0f - lam_init;
    const float* cw = A->in[3] + (size_t)l * 3 * DM + h * 128 + 8 * chunk; const float* sg = A->in[8] + l * 128 + 8 * chunk;
#pragma unroll
    for (int i = 0; i < 8; ++i) { C.w0[i] = cw[i]; C.w1[i] = cw[DM + i]; C.w2[i] = cw[2 * DM + i]; C.g[i] = sg[i] * C.one_m_li; }
}
__device__ __forceinline__ void merge_block(const MergeCtx& C, unsigned char* ws, int b, int h, int qb, int tid) {
    const bf16* P = (const bf16*)(ws + WS_PROJ); const size_t PS = (size_t)M * 1024;
    const bf16* Ob = (const bf16*)(ws + WS_O); bf16* Mx = (bf16*)(ws + WS_MIX);
    const int chunk = tid & 15, c = h * 128 + 8 * chunk, oc = h * 256 + 8 * chunk;
    for (int it0 = 0; it0 < 8; it0 += 2) {
        v4u raw[2][7];
#pragma unroll
        for (int k = 0; k < 2; ++k) {
            const int tl = qb * 256 + (it0 + k) * 32 + (tid >> 4);
            const size_t t = (size_t)b * SEQ + tl;
            const size_t tm1 = (tl >= 1) ? t - 1 : t, tm2 = (tl >= 2) ? t - 2 : t;
            raw[k][0] = *(const GAS v4u*)(Ob + t * 2048 + oc); raw[k][1] = *(const GAS v4u*)(Ob + t * 2048 + oc + 128);
            raw[k][2] = *(const GAS v4u*)(P + 4 * PS + t * 1024 + c); raw[k][3] = *(const GAS v4u*)(P + 5 * PS + t * 1024 + c);
            raw[k][4] = *(const GAS v4u*)(P + 3 * PS + t * 1024 + c); raw[k][5] = *(const GAS v4u*)(P + 3 * PS + tm1 * 1024 + c); raw[k][6] = *(const GAS v4u*)(P + 3 * PS + tm2 * 1024 + c);
        }
        asm volatile("" ::: "memory");
#pragma unroll
        for (int k = 0; k < 2; ++k) {
            const int tl = qb * 256 + (it0 + k) * 32 + (tid >> 4);
            const size_t t = (size_t)b * SEQ + tl;
            float o1[8], o2[8], bgc[8], ga[8], cu0[8], cu1[8], cu2[8];
            unpack8(raw[k][0], o1); unpack8(raw[k][1], o2); unpack8(raw[k][2], bgc); unpack8(raw[k][3], ga); unpack8(raw[k][4], cu0); unpack8(raw[k][5], cu1); unpack8(raw[k][6], cu2);
            const float k1 = (tl >= 1) ? 1.f : 0.f, k2 = (tl >= 2) ? 1.f : 0.f;
            float d[8], sq = 0.f;
#pragma unroll
            for (int i = 0; i < 8; ++i) { d[i] = o1[i] - C.lam * o2[i]; sq += d[i] * d[i]; }
            sq += __shfl_xor(sq, 1); sq += __shfl_xor(sq, 2); sq += __shfl_xor(sq, 4); sq += __shfl_xor(sq, 8);
            const float r = __builtin_amdgcn_rsqf(sq * (1.0f / 128.0f) + RMS_EPS);
            float mo[8];
#pragma unroll
            for (int i = 0; i < 8; ++i) {
                const float yc = bgc[i] * (C.w0[i] * (cu2[i] * k2) + C.w1[i] * (cu1[i] * k1) + C.w2[i] * cu0[i]);
                const float ya = d[i] * r * C.g[i];
                mo[i] = sigmoidf_(ga[i]) * ya + yc; }
            v4u w; w.x = pk2(mo[0], mo[1]); w.y = pk2(mo[2], mo[3]); w.z = pk2(mo[4], mo[5]); w.w = pk2(mo[6], mo[7]);
            st16_wt((void*)(Mx + t * 1024 + c), w);
        }
    }
}

__device__ __forceinline__ void merge_wave(const MergeCtx& C, unsigned char* ws, int b, int h, int tl0, attn_body::lds_cptr stg, int lane) {
    const bf16* P = (const bf16*)(ws + WS_PROJ); const size_t PS = (size_t)M * 1024;
    const bf16* Ob = (const bf16*)(ws + WS_O); bf16* Mx = (bf16*)(ws + WS_MIX);
    const int chunk = lane & 15, c = h * 128 + 8 * chunk, oc = h * 256 + 8 * chunk;
    for (int p0 = 0; p0 < 8; p0 += 2) {
        v4u raw[2][7];
#pragma unroll
        for (int k = 0; k < 2; ++k) {
            const int rw = (p0 + k) * 4 + (lane >> 4), tl = tl0 + rw;
            const size_t t = (size_t)b * SEQ + tl;
            const size_t tm1 = (tl >= 1) ? t - 1 : t, tm2 = (tl >= 2) ? t - 2 : t;
            raw[k][0] = *(const GAS v4u*)(Ob + t * 2048 + oc); raw[k][1] = *(const LAS v4u*)(stg + (rw * 128 + 8 * chunk) * 2);
            raw[k][2] = *(const GAS v4u*)(P + 4 * PS + t * 1024 + c); raw[k][3] = *(const GAS v4u*)(P + 5 * PS + t * 1024 + c);
            raw[k][4] = *(const GAS v4u*)(P + 3 * PS + t * 1024 + c); raw[k][5] = *(const GAS v4u*)(P + 3 * PS + tm1 * 1024 + c); raw[k][6] = *(const GAS v4u*)(P + 3 * PS + tm2 * 1024 + c);
        }
        asm volatile("" ::: "memory");
#pragma unroll
        for (int k = 0; k < 2; ++k) {
            const int rw = (p0 + k) * 4 + (lane >> 4), tl = tl0 + rw;
            const size_t t = (size_t)b * SEQ + tl;
            float o1[8], o2[8], bgc[8], ga[8], cu0[8], cu1[8], cu2[8];
            unpack8(raw[k][0], o1); unpack8(raw[k][1], o2); unpack8(raw[k][2], bgc); unpack8(raw[k][3], ga); unpack8(raw[k][4], cu0); unpack8(raw[k][5], cu1); unpack8(raw[k][6], cu2);
            const float k1 = (tl >= 1) ? 1.f : 0.f, k2 = (tl >= 2) ? 1.f : 0.f;
            float d[8], sq = 0.f;
#pragma unroll
            for (int i = 0; i < 8; ++i) { d[i] = o1[i] - C.lam * o2[i]; sq += d[i] * d[i]; }
            sq += __shfl_xor(sq, 1); sq += __shfl_xor(sq, 2); sq += __shfl_xor(sq, 4); sq += __shfl_xor(sq, 8);
            const float r = __builtin_amdgcn_rsqf(sq * (1.0f / 128.0f) + RMS_EPS);
            float mo[8];
#pragma unroll
            for (int i = 0; i < 8; ++i) {
                const float yc = bgc[i] * (C.w0[i] * (cu2[i] * k2) + C.w1[i] * (cu1[i] * k1) + C.w2[i] * cu0[i]);
                const float ya = d[i] * r * C.g[i];
                mo[i] = sigmoidf_(ga[i]) * ya + yc; }
            v4u w; w.x = pk2(mo[0], mo[1]); w.y = pk2(mo[2], mo[3]); w.z = pk2(mo[4], mo[5]); w.w = pk2(mo[6], mo[7]);
            st16_wt((void*)(Mx + t * 1024 + c), w);
        }
    }
}
struct MergePost { bool on; int l, b, h;
    __device__ __forceinline__ void run(attn_body::lds_cptr stg, int tl0, int lane) const {
        const kargs_t A = KARGS(); asm volatile("s_waitcnt vmcnt(0)" ::: "memory");
        MergeCtx MC; merge_setup(MC, A, l, h, lane); merge_wave(MC, A->ws, b, h, tl0, stg, lane); } };

constexpr int TILE_TAB_OFF = RING_BYTES + 1024 + 4096;
__device__ __forceinline__ void route_phase(int l) {
    const kargs_t A = KARGS(); Frame F = make_frame(A);
    const int lane = F.lane, tid = F.tid, j = l >> 1;
    LAS float* WrT = (LAS float*)(F.lds);
    volatile LAS int* cntl = (volatile LAS int*)(F.lds + 32768);
    volatile LAS int* gbase = cntl + 8;
    volatile LAS int* li = cntl + 16;
    volatile LAS int* lr = cntl + 16 + 128;
    volatile LAS float* lw = (volatile LAS float*)(cntl + 16 + 256);
    const float* Wr = A->in[14] + (size_t)j * DM * NEXP; const float* gn = A->in[10] + (size_t)l * DM;
    for (int idx = tid; idx < DM * NEXP; idx += NWAVES * 64) { const int k = idx >> 3, e = idx & 7; WrT[e * DM + k] = Wr[idx] * gn[k]; }
    gu32* gcnt = F.ctl + CW_GCNT + j * 8 * 64;
    int* slotof = (int*)(F.ws + WS_ROUTE + RT_SLOTOF); float* wslot = (float*)(F.ws + WS_ROUTE + RT_WSLOT); float* ssslot = (float*)(F.ws + WS_ROUTE + RT_SSSLOT);
    unsigned char* xg = (unsigned char*)(F.ws + WS_O);
    for (int blk = F.vcu; blk < M / 64; blk += F.G) {
        if (tid < 8) cntl[tid] = 0;
        __syncthreads();
        float ssq[8];
        const bf16* xbr = (const bf16*)(F.ws + WS_XB) + (size_t)(blk * 64 + F.wave * 8) * DM + 8 * lane;
        v4u cur0 = *(const GAS v4u*)xbr, cur1 = *(const GAS v4u*)(xbr + 512);
#pragma unroll
        for (int rr = 0; rr < 8; ++rr) {
            const int loc = F.wave * 8 + rr;
            v4u nx0 = cur0, nx1 = cur1;
            if (rr < 7) { nx0 = *(const GAS v4u*)(xbr + (size_t)(rr + 1) * DM); nx1 = *(const GAS v4u*)(xbr + (size_t)(rr + 1) * DM + 512); }
            float v[16]; float s = 0.f;
            { float t8[8]; unpack8(cur0, t8);
#pragma unroll
              for (int i = 0; i < 8; ++i) v[i] = t8[i];
              unpack8(cur1, t8);
#pragma unroll
              for (int i = 0; i < 8; ++i) v[8 + i] = t8[i]; }
#pragma unroll
            for (int i = 0; i < 16; ++i) s += v[i] * v[i];
            s = wave_sum(s); ssq[rr] = s; const float rstd = 1.0f / sqrtf(s * (1.0f / 1024.0f) + RMS_EPS);
            float lg[8];
#pragma unroll
            for (int e = 0; e < 8; ++e) { float a = 0.f;
#pragma unroll
                for (int q = 0; q < 2; ++q) { const f32x4 w0 = *(const LAS f32x4*)(WrT + e * DM + 512 * q + 8 * lane), w1 = *(const LAS f32x4*)(WrT + e * DM + 512 * q + 8 * lane + 4);
                    a += (v[8 * q] * w0.x + v[8 * q + 1] * w0.y) + (v[8 * q + 2] * w0.z + v[8 * q + 3] * w0.w) + (v[8 * q + 4] * w1.x + v[8 * q + 5] * w1.y) + (v[8 * q + 6] * w1.z + v[8 * q + 7] * w1.w); }
                lg[e] = wave_sum(a) * rstd; }
            int i0 = 0; float v0 = lg[0];
#pragma unroll
            for (int e = 1; e < 8; ++e) if (lg[e] > v0) { v0 = lg[e]; i0 = e; }
            int i1 = -1; float v1 = -INFINITY;
#pragma unroll
            for (int e = 0; e < 8; ++e) if (e != i0 && lg[e] > v1) { v1 = lg[e]; i1 = e; }
            if (i1 < 0) i1 = (i0 + 1) & 7;
            const float wA = 1.0f / (1.0f + __expf(v1 - v0)), wB = 1.0f - wA;
            if (lane == 0) {
                const int r0 = __hip_atomic_fetch_add((LAS int*)&cntl[i0], 1, __ATOMIC_RELAXED, __HIP_MEMORY_SCOPE_WORKGROUP);
                const int r1 = __hip_atomic_fetch_add((LAS int*)&cntl[i1], 1, __ATOMIC_RELAXED, __HIP_MEMORY_SCOPE_WORKGROUP);
                li[2 * loc] = i0; li[2 * loc + 1] = i1; lr[2 * loc] = r0; lr[2 * loc + 1] = r1; lw[2 * loc] = wA; lw[2 * loc + 1] = wB;
            }
            cur0 = nx0; cur1 = nx1;
            asm volatile("" ::: "memory");
        }
        __syncthreads();
        if (tid < 8) gbase[tid] = (int)__hip_atomic_fetch_add(gcnt + tid * 64, (unsigned)cntl[tid], RLX_AGENT);
        __syncthreads();
        v4u vs[8][2];
#pragma unroll
        for (int rr = 0; rr < 8; ++rr) { vs[rr][0] = *(const GAS v4u*)(xbr + (size_t)rr * DM); vs[rr][1] = *(const GAS v4u*)(xbr + (size_t)rr * DM + 512); }
#pragma unroll
        for (int rr = 0; rr < 8; ++rr) {
            const int loc = F.wave * 8 + rr, t = blk * 64 + loc;
            const int e0 = li[2 * loc], e1 = li[2 * loc + 1];
            const int s0 = e0 * ECAP + gbase[e0] + lr[2 * loc], s1 = e1 * ECAP + gbase[e1] + lr[2 * loc + 1];
            typedef unsigned u32x2_t __attribute__((ext_vector_type(2)));
#pragma unroll
            for (int q = 0; q < 2; ++q) { float t8[8]; unpack8(vs[rr][q], t8); u32x2_t w = {0u, 0u};
                w.x = __builtin_amdgcn_cvt_pk_fp8_f32(pg8::clamp448(t8[0] * 8.f), pg8::clamp448(t8[1] * 8.f), w.x, false); w.x = __builtin_amdgcn_cvt_pk_fp8_f32(pg8::clamp448(t8[2] * 8.f), pg8::clamp448(t8[3] * 8.f), w.x, true);
                w.y = __builtin_amdgcn_cvt_pk_fp8_f32(pg8::clamp448(t8[4] * 8.f), pg8::clamp448(t8[5] * 8.f), w.y, false); w.y = __builtin_amdgcn_cvt_pk_fp8_f32(pg8::clamp448(t8[6] * 8.f), pg8::clamp448(t8[7] * 8.f), w.y, true);
                st8_wt((void*)(xg + (size_t)s0 * DM + 512 * q + 8 * lane), w); st8_wt((void*)(xg + (size_t)s1 * DM + 512 * q + 8 * lane), w); }
            if (lane == 0) { slotof[2 * t] = s0; slotof[2 * t + 1] = s1; wslot[s0] = lw[2 * loc]; wslot[s1] = lw[2 * loc + 1];
                const f32x4 sv = {ssq[rr], 0.f, 0.f, 0.f}; *(GAS f32x4*)(ssslot + 4 * (size_t)s0) = sv; *(GAS f32x4*)(ssslot + 4 * (size_t)s1) = sv; }
        }
        __syncthreads();
    }
}
__device__ __forceinline__ void build_tiles(LAS unsigned char* lds, gu32* gcnt) {
    const int tid = opaque_tid(); LAS int* tab = (LAS int*)(lds + TILE_TAB_OFF);
    int seg = 0, ent = -1;
#pragma unroll
    for (int e = 0; e < 8; ++e) { const int nte = ((int)__hip_atomic_load(gcnt + e * 64, RLX_AGENT) + 255) >> 8;
        if (tid >= seg && tid < seg + nte) ent = (e << 16) | (e * (ECAP / 256) + (tid - seg)); seg += nte; }
    if (tid < 255 && ent >= 0) tab[tid] = ent;
    if (tid == 0) tab[255] = seg;
    __syncthreads();
}
__device__ __forceinline__ void combine_phase(int l) {
    const kargs_t A = KARGS(); Frame F = make_frame(A);
    const int lane = F.lane; const int gw = F.vcu * NWAVES + F.wave, NGW = F.G * NWAVES;
    const int* slotof = (const int*)(F.ws + WS_ROUTE + RT_SLOTOF); const bf16* Y = (const bf16*)(F.ws + WS_Y); bf16* xb = (bf16*)(F.ws + WS_XB);
    volatile LAS int* segc = (volatile LAS int*)(F.lds);
    if (F.tid == 0) { gu32* gcnt = F.ctl + CW_GCNT + (l >> 1) * 8 * 64; int s = 0; for (int e = 0; e < 8; ++e) { segc[e] = s; s += (((int)__hip_atomic_load(gcnt + e * 64, RLX_AGENT) + 255) >> 8) << 8; } }
    __syncthreads();
    float* ssn = (float*)(F.ws + WS_SS) + (size_t)(2 * l + 2) * M * 4; const bool fin = (l == DEPTH - 1);
    const float* gf = A->in[18];
    for (int t0 = gw * 4; t0 < M; t0 += NGW * 4) {
        v2u xa[4][4], ya[4][4], yb[4][4];
#pragma unroll
        for (int r = 0; r < 4; ++r) { const int t = t0 + r; const int p0 = slotof[2 * t], p1 = slotof[2 * t + 1];
            const int s0 = segc[p0 >> ECAP_LOG] + (p0 & (ECAP - 1)), s1 = segc[p1 >> ECAP_LOG] + (p1 & (ECAP - 1));
            const GAS v2u* xr = (const GAS v2u*)(xb + (size_t)t * DM) + lane;
            const GAS v2u* y0 = (const GAS v2u*)(Y + (size_t)s0 * DM) + lane; const GAS v2u* y1 = (const GAS v2u*)(Y + (size_t)s1 * DM) + lane;
#pragma unroll
            for (int q = 0; q < 4; ++q) { xa[r][q] = xr[64 * q]; ya[r][q] = y0[64 * q]; yb[r][q] = y1[64 * q]; } }
        asm volatile("" ::: "memory");
#pragma unroll
        for (int r = 0; r < 4; ++r) { const int t = t0 + r; float s = 0.f; f32x4 v[4];
#pragma unroll
            for (int q = 0; q < 4; ++q) { const v2u c = xa[r][q], a = ya[r][q], b = yb[r][q]; f32x4& x = v[q];
                x.x = bflo(c.x) + (bflo(a.x) + bflo(b.x)); x.y = bfhi(c.x) + (bfhi(a.x) + bfhi(b.x)); x.z = bflo(c.y) + (bflo(a.y) + bflo(b.y)); x.w = bfhi(c.y) + (bfhi(a.y) + bfhi(b.y));
                s += (x.x * x.x + x.y * x.y) + (x.z * x.z + x.w * x.w); }
            s = wave_sum(s);
            if (!fin) {
                GAS v2u* o8 = (GAS v2u*)(xb + (size_t)t * DM) + lane;
#pragma unroll
                for (int q = 0; q < 4; ++q) { v2u w; w.x = pk2(v[q].x, v[q].y); w.y = pk2(v[q].z, v[q].w); st8_wt((void*)(o8 + 64 * q), w); }
                if ((INPROJ_F8_MASK & 4) && INPROJ_F8(l + 1)) {
                    GAS unsigned* q8 = (GAS unsigned*)(F.ws + WS_O + (size_t)t * DM) + lane;
#pragma unroll
                    for (int q = 0; q < 4; ++q) { unsigned w = 0u;
                        w = __builtin_amdgcn_cvt_pk_fp8_f32(pg8::clamp448(v[q].x * 8.0f), pg8::clamp448(v[q].y * 8.0f), w, false);
                        w = __builtin_amdgcn_cvt_pk_fp8_f32(pg8::clamp448(v[q].z * 8.0f), pg8::clamp448(v[q].w * 8.0f), w, true); q8[64 * q] = w; } }
                if (lane == 0) *(GAS f32x4*)(ssn + 4 * (size_t)t) = (f32x4){s, 0.f, 0.f, 0.f};
            } else {
                const float rstd = 1.0f / sqrtf(s * (1.0f / 1024.0f) + RMS_EPS);
                GAS f32x4* xo = (GAS f32x4*)(F.X + (size_t)t * DM) + lane;
#pragma unroll
                for (int q = 0; q < 4; ++q) { const f32x4 gg = *((const GAS f32x4*)gf + lane + 64 * q); xo[64 * q] = v[q] * rstd * gg; }
            } }
    }
}

__device__ __forceinline__ XcdBarrier make_bar(unsigned char* ws) {
    extern __shared__ __attribute__((aligned(16))) unsigned char lds[];
    XcdBarrier b; b.bar = (unsigned*)(ws + WS_CTL) + CW_BAR; b.x = xb_xcc_id(); b.st = (volatile LAS unsigned*)((LAS unsigned char*)lds + MISC_OFF) + 8; return b;
}
__global__ void __launch_bounds__(NWAVES * 64, 2) trunk_fwd(Args args_unused) {
    extern __shared__ __attribute__((aligned(16))) unsigned char lds[];
    { const int tid = threadIdx.x;
      for (int u = tid; u < (LDS_BYTES - LDSCTL_OFF) / 4; u += NWAVES * 64) ((LAS unsigned*)((LAS unsigned char*)lds + LDSCTL_OFF))[u] = 0u;
      __syncthreads();
      if (!MK_PER_PHASE) { const kargs_t A = KARGS(); (void)xcd_barrier_post((unsigned*)(A->ws + WS_CTL) + CW_BAR, (volatile LAS unsigned*)((LAS unsigned char*)lds + MISC_OFF) + 8); } }
    int ph = 0;
#define PH_ON ({ const kargs_t Ap_ = KARGS(); ph >= Ap_->ph_lo && ph < Ap_->ph_hi; })
#define PH_END do { if (!MK_PER_PHASE && PH_ON && ph + 1 < KARGS()->ph_hi) { const kargs_t A_ = KARGS(); xcd_barrier(make_bar(A_->ws)); } ++ph; } while (0)

    for (int rep_ = 0; rep_ < (((PROBE_DUP >> 0) & 1) ? 2 : 1); ++rep_) if (((PH_MASK >> 0) & 1) && PH_ON) p0_prologue();
    PH_END;

    for (int l = 0; l < DEPTH; ++l) {
        for (int rep_ = 0; rep_ < (((PROBE_DUP >> 1) & 1) ? 2 : 1); ++rep_) if (((PH_MASK >> 1) & 1) && PH_ON) {
            const kargs_t A = KARGS(); unsigned char* ws = A->ws;
            pg8::StaticOrder S; S.init(M, IN_W, opaque_grid(), opaque_bid());
            if ((INPROJ_F8_MASK != 0) && INPROJ_F8(l)) {
                pg8::Gemm g{(const bf16*)(ws + WS_O), (const bf16*)(ws + WS_WIN + (size_t)l * IN_W * DM * 2), M, IN_W, DM, 0};
                pg8::EpiProj E{(bf16*)(ws + WS_PROJ), (const float*)(ws + WS_SS) + (size_t)(2 * l) * M * 4, (const float*)(ws + WS_ROPEC), (const float*)(ws + WS_ROPES), attn_body::C2, 1.0f / 2048.0f};
                pg8::gemm_phase<pg8::EpiProj, pg8::StaticOrder, PG8_ALIGN, PG8_SP2, true>((LAS unsigned char*)lds + RING_OFF, g, S, E);
            } else {
            pg8::Gemm g{(const bf16*)(ws + WS_XB), (const bf16*)(ws + WS_WIN) + (size_t)l * IN_W * DM, M, IN_W, DM, 0};
            pg8::EpiProj E{(bf16*)(ws + WS_PROJ), (const float*)(ws + WS_SS) + (size_t)(2 * l) * M * 4, (const float*)(ws + WS_ROPEC), (const float*)(ws + WS_ROPES), attn_body::C2};
            pg8::gemm_phase<pg8::EpiProj, pg8::StaticOrder, PG8_ALIGN, PG8_SP2>((LAS unsigned char*)lds + RING_OFF, g, S, E); }
        }
        PH_END;
        for (int rep_ = 0; rep_ < (((PROBE_DUP >> 2) & 1) ? 2 : 1); ++rep_) if (((PH_MASK >> 2) & 1) && PH_ON) {
            const kargs_t A = KARGS(); unsigned char* ws = A->ws;
            const attn_body::bf16* Qb = (const attn_body::bf16*)(ws + WS_PROJ); attn_body::bf16* Ob = (attn_body::bf16*)(ws + WS_O);
            const int G = opaque_grid(), bx = opaque_bid(), vcu = (G % 8 == 0) ? (bx % 8) * (G / 8) + bx / 8 : bx;
            attn_body::AttnCarry cy; cy.primed = false; cy.s0 = 0;
#pragma unroll
            for (int d0 = 0; d0 < 4; ++d0) cy.qr[d0] = (attn_body::bf16x8){0, 0, 0, 0, 0, 0, 0, 0};
            for (int vc = vcu; vc < 256; vc += G) {
                const int bh = vc >> 2, b = bh >> 3, h = bh & 7;
                for (int u = 0; u < 4; ++u) {
                    const int mp = u & 1, qb = (u >> 1) ? (vc & 3) : 7 - (vc & 3);
                    if (((vc >> 2) & 3) == u) {
                        const kargs_t A3 = KARGS(); const int tid3 = opaque_tid(); int grp3 = l + 1; asm volatile("" : "+s"(grp3));
                        convert_group(A3, A3->ws, grp3, vc * NWAVES + (tid3 >> 6), 256 * NWAVES, tid3 & 63);
                    }
                    const attn_body::bf16* Qh = Qb + (size_t)b * SEQ * 1024 + (2 * h + mp) * 64;
                    const attn_body::bf16* Vh = Qb + (size_t)2 * M * 1024 + (size_t)b * SEQ * 1024 + h * 128;
                    attn_body::AttnNext nx; nx.has = (u < 3); nx.qb = ((u + 1) >> 1) ? (vc & 3) : 7 - (vc & 3);
                    nx.Qh = Qb + (size_t)b * SEQ * 1024 + (2 * h + ((u + 1) & 1)) * 64; nx.Kh = nx.Qh + (size_t)M * 1024; nx.Vh = Vh;
                    const MergePost post{mp == 1, l, b, h};
                    attn_body::attn_unit128<8>(qb, Qh, Qh + (size_t)M * 1024, Vh, Ob + (size_t)b * SEQ * 2048 + h * 256 + mp * 128, (char*)lds + RING_OFF, post, nx, cy);
                }
            }
        }
        PH_END;
        for (int rep_ = 0; rep_ < (((PROBE_DUP >> 4) & 1) ? 2 : 1); ++rep_) if (((PH_MASK >> 4) & 1) && PH_ON) {
            const kargs_t A = KARGS(); unsigned char* ws = A->ws;
            pg8::Gemm g{(const bf16*)(ws + WS_MIX), (const bf16*)(ws + WS_WOUT) + (size_t)l * DM * DM, M, DM, DM, 0};
            pg8::StaticOrder S; S.init(M, DM, opaque_grid(), opaque_bid());
            if (l & 1) { pg8::EpiResidLite E{(bf16*)(ws + WS_XB), nullptr};
                pg8::gemm_phase<pg8::EpiResidLite, pg8::StaticOrder, PG8_ALIGN, PG8_SP2>((LAS unsigned char*)lds + RING_OFF, g, S, E); }
            else if (DENSE_F8(l >> 1)) { pg8::EpiResidF8X E{(bf16*)(ws + WS_XB), (float*)(ws + WS_SS) + (size_t)(2 * l + 1) * M * 4, (unsigned char*)(ws + WS_O), 1.0f};
                pg8::gemm_phase<pg8::EpiResidF8X, pg8::StaticOrder, PG8_ALIGN, PG8_SP2>((LAS unsigned char*)lds + RING_OFF, g, S, E); }
            else { pg8::EpiResid E{(bf16*)(ws + WS_XB), (float*)(ws + WS_SS) + (size_t)(2 * l + 1) * M * 4};
                pg8::gemm_phase<pg8::EpiResid, pg8::StaticOrder, PG8_ALIGN, PG8_SP2>((LAS unsigned char*)lds + RING_OFF, g, S, E); }
        }
        PH_END;
        if ((l & 1) == 0) {
            for (int rep_ = 0; rep_ < (((PROBE_DUP >> 5) & 1) ? 2 : 1); ++rep_) if (((PH_MASK >> 5) & 1) && PH_ON) {
                const kargs_t A = KARGS(); unsigned char* ws = A->ws; const int j = l >> 1;
                pg8::StaticOrder S; S.init(M, 2 * DFF, opaque_grid(), opaque_bid());
                if (DENSE_F8(j)) {
                    pg8::Gemm g{(const bf16*)(ws + WS_O), (const bf16*)(ws + WS_WGU + (size_t)j * 2 * DFF * DM * 2), M, 2 * DFF, DM, 0};
                    pg8::EpiSwigluF8 E{(void*)(ws + WS_PROJ), DFF, (const float*)(ws + WS_SS) + (size_t)(2 * l + 1) * M * 4, 1.0f / 2048.0f};
                    pg8::gemm_phase<pg8::EpiSwigluF8, pg8::StaticOrder, PG8_ALIGN, PG8_SP2, true>((LAS unsigned char*)lds + RING_OFF, g, S, E);
                } else {
                pg8::Gemm g{(const bf16*)(ws + WS_XB), (const bf16*)(ws + WS_WGU) + (size_t)j * 2 * DFF * DM, M, 2 * DFF, DM, 0};
                if (((DENSE_DN_F8_MASK & ~DENSE_F8_MASK) != 0) && DENSE_DN_F8(j)) {
                    pg8::EpiSwigluF8 E{(void*)(ws + WS_PROJ), DFF, (const float*)(ws + WS_SS) + (size_t)(2 * l + 1) * M * 4, 1.0f};
                    pg8::gemm_phase<pg8::EpiSwigluF8, pg8::StaticOrder, PG8_ALIGN, PG8_SP2>((LAS unsigned char*)lds + RING_OFF, g, S, E);
                } else {
                pg8::EpiSwiglu E{(void*)(ws + WS_PROJ), DFF, (const float*)(ws + WS_SS) + (size_t)(2 * l + 1) * M * 4, 1.0f};
                pg8::gemm_phase<pg8::EpiSwiglu, pg8::StaticOrder, PG8_ALIGN, PG8_SP2>((LAS unsigned char*)lds + RING_OFF, g, S, E); } }
            }
            PH_END;
            for (int rep_ = 0; rep_ < (((PROBE_DUP >> 6) & 1) ? 2 : 1); ++rep_) if (((PH_MASK >> 6) & 1) && PH_ON) {
                const kargs_t A = KARGS(); unsigned char* ws = A->ws; const int j = l >> 1;
                pg8::StaticOrder S; S.init(M, DM, opaque_grid(), opaque_bid());
                constexpr bool C_F8_X = ((DENSE_DN_F8_MASK & 1) && (INPROJ_F8_MASK & 2)) || ((DENSE_DN_F8_MASK & 2) && (INPROJ_F8_MASK & 8));
                constexpr bool C_F8_N = ((DENSE_DN_F8_MASK & 1) && !(INPROJ_F8_MASK & 2)) || ((DENSE_DN_F8_MASK & 2) && !(INPROJ_F8_MASK & 8));
                constexpr bool C_BF_X = (!(DENSE_DN_F8_MASK & 1) && (INPROJ_F8_MASK & 2)) || (!(DENSE_DN_F8_MASK & 2) && (INPROJ_F8_MASK & 8));
                const bool f8x = INPROJ_F8(l + 1);
                if (C_F8_X && DENSE_DN_F8(j) && f8x) {
                    pg8::Gemm g{(const bf16*)(ws + WS_PROJ), (const bf16*)(ws + WS_WD + (size_t)j * DM * DFF * 2), M, DM, DFF, 0};
                    pg8::EpiResidF8X E{(bf16*)(ws + WS_XB), (float*)(ws + WS_SS) + (size_t)(2 * l + 2) * M * 4, (unsigned char*)(ws + WS_O), 1.0f / 2048.0f};
                    pg8::gemm_phase<pg8::EpiResidF8X, pg8::StaticOrder, PG8_ALIGN, PG8_SP2, true>((LAS unsigned char*)lds + RING_OFF, g, S, E);
                } else if (C_F8_N && DENSE_DN_F8(j)) {
                    pg8::Gemm g{(const bf16*)(ws + WS_PROJ), (const bf16*)(ws + WS_WD + (size_t)j * DM * DFF * 2), M, DM, DFF, 0};
                    pg8::EpiResid E{(bf16*)(ws + WS_XB), (float*)(ws + WS_SS) + (size_t)(2 * l + 2) * M * 4, nullptr, 1.0f / 2048.0f};
                    pg8::gemm_phase<pg8::EpiResid, pg8::StaticOrder, PG8_ALIGN, PG8_SP2, true>((LAS unsigned char*)lds + RING_OFF, g, S, E);
                } else if (C_BF_X && f8x) {
                    pg8::Gemm g{(const bf16*)(ws + WS_PROJ), (const bf16*)(ws + WS_WD) + (size_t)j * DM * DFF, M, DM, DFF, 0};
                    pg8::EpiResidF8X E{(bf16*)(ws + WS_XB), (float*)(ws + WS_SS) + (size_t)(2 * l + 2) * M * 4, (unsigned char*)(ws + WS_O), 1.0f};
                    pg8::gemm_phase<pg8::EpiResidF8X, pg8::StaticOrder, PG8_ALIGN, PG8_SP2>((LAS unsigned char*)lds + RING_OFF, g, S, E);
                } else {
                pg8::Gemm g{(const bf16*)(ws + WS_PROJ), (const bf16*)(ws + WS_WD) + (size_t)j * DM * DFF, M, DM, DFF, 0};
                pg8::EpiResid E{(bf16*)(ws + WS_XB), (float*)(ws + WS_SS) + (size_t)(2 * l + 2) * M * 4};
                pg8::gemm_phase<pg8::EpiResid, pg8::StaticOrder, PG8_ALIGN, PG8_SP2>((LAS unsigned char*)lds + RING_OFF, g, S, E); }
            }
            PH_END;
        } else {
            for (int rep_ = 0; rep_ < (((PROBE_DUP >> 7) & 1) ? 2 : 1); ++rep_) if (((PH_MASK >> 7) & 1) && PH_ON) route_phase(l);
            PH_END;
            for (int rep_ = 0; rep_ < (((PROBE_DUP >> 9) & 1) ? 2 : 1); ++rep_) if (((PH_MASK >> 9) & 1) && PH_ON) {
                const kargs_t A = KARGS(); unsigned char* ws = A->ws; const int j = l >> 1;
                build_tiles((LAS unsigned char*)lds, (gu32*)(ws + WS_CTL) + CW_GCNT + j * 8 * 64);
                const LAS int* tab = (const LAS int*)((LAS unsigned char*)lds + TILE_TAB_OFF);
                const int ntl = __builtin_amdgcn_readfirstlane(tab[255]);
                pg8::Gemm g{(const bf16*)(ws + WS_O), (const bf16*)(ws + WS_WEGU + (size_t)j * 8 * 2 * DFFE * DM), NEXP * ECAP, 2 * DFFE, DM, (size_t)2 * DFFE * DM};
                pg8::GroupedOrder S; S.init(ntl, 2 * DFFE, opaque_grid(), opaque_bid(), tab, true);
                pg8::EpiSwigluF8 E{(void*)(ws + WS_PROJ), DFFE, (const float*)(ws + WS_ROUTE + RT_SSSLOT), 1.0f / 2048.0f};
                pg8::gemm_phase<pg8::EpiSwigluF8, pg8::GroupedOrder, PG8_ALIGN, PG8_SP2, true>((LAS unsigned char*)lds + RING_OFF, g, S, E);
            }
            PH_END;
            for (int rep_ = 0; rep_ < (((PROBE_DUP >> 10) & 1) ? 2 : 1); ++rep_) if (((PH_MASK >> 10) & 1) && PH_ON) {
                const kargs_t A = KARGS(); unsigned char* ws = A->ws; const int j = l >> 1;
                build_tiles((LAS unsigned char*)lds, (gu32*)(ws + WS_CTL) + CW_GCNT + j * 8 * 64);
                const LAS int* tab = (const LAS int*)((LAS unsigned char*)lds + TILE_TAB_OFF);
                const int ntl = __builtin_amdgcn_readfirstlane(tab[255]);
                pg8::Gemm g{(const bf16*)(ws + WS_PROJ), (const bf16*)(ws + WS_WED + (size_t)j * 8 * DM * DFFE), MSLOT, DM, DFFE, (size_t)DM * DFFE};
                pg8::GroupedOrder S; S.init(ntl, DM, opaque_grid(), opaque_bid(), tab, false);
                pg8::EpiSlot E{(bf16*)(ws + WS_Y), (const float*)(ws + WS_ROUTE + RT_WSLOT), 1.0f / 2048.0f};
                pg8::gemm_phase<pg8::EpiSlot, pg8::GroupedOrder, PG8_ALIGN, PG8_SP2, true>((LAS unsigned char*)lds + RING_OFF, g, S, E);
            }
            PH_END;
            for (int rep_ = 0; rep_ < (((PROBE_DUP >> 11) & 1) ? 2 : 1); ++rep_) if (((PH_MASK >> 11) & 1) && PH_ON) combine_phase(l);
            PH_END;
        }
    }
#undef PH_ON
#undef PH_END
}

constexpr int N_PHASES = 1 + 2 * 5 + 2 * 7;

extern "C" void kernel_launch(void* const* d_in, const int* in_sizes, int n_in, void* d_out, int out_size, void* d_ws, size_t ws_size, hipStream_t stream) {
    static int grid = 0;
    if (grid == 0) {
        if (n_in != 19 || in_sizes[0] != M * DM || out_size != M * DM || ws_size < WS_END) { fprintf(stderr, "kernel_launch: unexpected shapes / workspace (n_in %d, in0 %d, out %d, ws %zu < %zu); nothing launched\n", n_in, n_in > 0 ? in_sizes[0] : -1, out_size, ws_size, (size_t)WS_END); grid = -1; return; }
        int dev = 0, cus = 0, per_cu = 0;
        if (hipGetDevice(&dev) != hipSuccess || hipDeviceGetAttribute(&cus, hipDeviceAttributeMultiprocessorCount, dev) != hipSuccess) { grid = -1; return; }
        if (hipFuncSetAttribute((const void*)trunk_fwd, hipFuncAttributeMaxDynamicSharedMemorySize, LDS_BYTES) != hipSuccess) { fprintf(stderr, "kernel_launch: hipFuncSetAttribute failed\n"); grid = -1; return; }
        if (hipOccupancyMaxActiveBlocksPerMultiprocessor(&per_cu, (const void*)trunk_fwd, NWAVES * 64, LDS_BYTES) != hipSuccess || per_cu < 1)
            fprintf(stderr, "kernel_launch: note: occupancy query reports %d workgroups per CU\n", per_cu);
        (void)hipGetLastError();
        grid = cus;
        if (grid > 256) grid = 256;
    }
    if (grid < 0) return;
    if (hipMemsetAsync((char*)d_ws + WS_CTL, 0, CTL_ZERO_BYTES, stream) != hipSuccess) return;
    Args a{};
    for (int i = 0; i < 19; ++i) a.in[i] = (const float*)d_in[i];
    a.out = (float*)d_out; a.ws = (unsigned char*)d_ws;
#if MK_PER_PHASE
    for (int p = 0; p < N_PHASES; ++p) { a.ph_lo = p; a.ph_hi = p + 1; hipLaunchKernelGGL(trunk_fwd, dim3(grid), dim3(NWAVES * 64), LDS_BYTES, stream, a); }
#else
    a.ph_lo = 0; a.ph_hi = N_PHASES;
    hipLaunchKernelGGL(trunk_fwd, dim3(grid), dim3(NWAVES * 64), LDS_BYTES, stream, a);
#endif
}
```

```cpp
#include <hip/hip_runtime.h>
#include <hip/hip_bf16.h>
#include <cstdio>
#include <cstdint>
#include <cmath>

#ifndef PH_MASK
#define PH_MASK 0xFFFF
#endif
#ifndef DENSE_F8_MASK
#define DENSE_F8_MASK 2
#endif
#define DENSE_F8(j) (((DENSE_F8_MASK) >> (j)) & 1)
#ifndef DENSE_DN_F8_MASK
#define DENSE_DN_F8_MASK 3
#endif
#define DENSE_DN_F8(j) (((DENSE_DN_F8_MASK) >> (j)) & 1)
static_assert((DENSE_DN_F8_MASK & DENSE_F8_MASK) == DENSE_F8_MASK, "an fp8 gate|up GEMM writes fp8 hidden activations: its down projection is fp8 too");
#ifndef INPROJ_F8_MASK
#define INPROJ_F8_MASK 12
#endif
#define INPROJ_F8(l) (((INPROJ_F8_MASK) >> (l)) & 1)
static_assert((INPROJ_F8_MASK & 1) == 0, "layer 0's in-projection reads the prologue's bf16 x");
#ifndef PROBE_DUP
#define PROBE_DUP 0
#endif
#ifndef MK_PER_PHASE
#define MK_PER_PHASE 0
#endif

constexpr int BATCH = 8, SEQ = 2048, DM = 1024, DEPTH = 4;
constexpr int M = BATCH * SEQ;
constexpr int NHEADS = 8;
constexpr int IN_W = 8192;
constexpr int DFF = 2816, DFFE = 3584, NEXP = 8;
constexpr int MSLOT = 2 * M + NEXP * 256;
constexpr float RMS_EPS = 1e-5f;

__device__ __forceinline__ int opaque_tid() { int t = threadIdx.x; asm volatile("" : "+v"(t)); return t; }
__device__ __forceinline__ int opaque_bid() { int t = blockIdx.x; asm volatile("" : "+s"(t)); return t; }
__device__ __forceinline__ int opaque_grid() { int t = gridDim.x; asm volatile("" : "+s"(t)); return t; }

typedef unsigned wt_u32x4 __attribute__((ext_vector_type(4))); typedef unsigned wt_u32x2 __attribute__((ext_vector_type(2)));
__device__ __forceinline__ void st16_wt(void* p, wt_u32x4 v) { asm volatile("global_store_dwordx4 %0, %1, off sc1\n\ts_nop 1" :: "v"(p), "v"(v) : "memory"); }
__device__ __forceinline__ void st8_wt(void* p, wt_u32x2 v) { asm volatile("global_store_dwordx2 %0, %1, off sc1" :: "v"(p), "v"(v) : "memory"); }

namespace pg8 {
#define PG8_LAS __attribute__((address_space(3)))
typedef unsigned short bf16_t;
typedef short bf16x8 __attribute__((ext_vector_type(8)));
typedef float f32x4 __attribute__((ext_vector_type(4)));
typedef unsigned u32x4 __attribute__((ext_vector_type(4)));
constexpr int BM = 256, BK = 64, HALF = 128, HTB = HALF * BK * 2, STAGE_BYTES = 8 * HTB, NXCD = 8, WGM = 8;

__host__ __device__ __forceinline__ int lds_byte(int r, int c) { const int st = (r >> 4) * 2 + (c >> 5), rr = r & 15, cc = c & 31, ob = rr * 64 + cc * 2; return st * 1024 + (ob ^ (((ob >> 9) & 1) << 5)); }
__host__ __device__ __forceinline__ void stage_rc(int b, int& R, int& C) { const int st = b / 1024, sb = b % 1024, swz = sb ^ (((sb >> 9) & 1) << 5); R = (st >> 1) * 16 + swz / 64; C = (st & 1) * 32 + (swz % 64) / 2; }
__host__ __device__ __forceinline__ int perm32(int rho) { const int n = rho >> 4, i = rho & 15; return 8 * (i >> 2) + 4 * n + (i & 3); }

struct Unit { int pm, pn, be, pa, ps; };
struct Gemm { const bf16_t* A; const bf16_t* Bt; int M, N, K; size_t bstride; };

struct StaticOrder {
    int nM, nN, nwg, G, c;
    __host__ __device__ void init(int M_, int N_, int G_, int c_) { nM = M_ / BM; nN = N_ / BM; nwg = nM * nN; G = G_; c = c_; }
    __host__ __device__ bool next(int i, Unit& u) const {
        const long L = (long)i * G + c; if (L >= nwg) return false;
        int wgid = (int)L; { const int q = nwg / NXCD, r = nwg % NXCD, xcd = wgid % NXCD, off = wgid / NXCD; wgid = (xcd < r ? xcd * (q + 1) : r * (q + 1) + (xcd - r) * q) + off; }
        const int nig = WGM * nN, gid = wgid / nig, fm = gid * WGM, gsz = (nM - fm) < WGM ? (nM - fm) : WGM;
        u.pm = fm + ((wgid % nig) % gsz); u.pn = (wgid % nig) / gsz; u.be = 0; u.pa = u.pm; u.ps = u.pm; return true;
    }
    __device__ __forceinline__ void a_ready(const Unit&) const {}
    __device__ __forceinline__ void done(const Unit&) const {}
};
struct GroupedOrder {
    int nM, nN, nwg, G, c; const PG8_LAS int* tab; bool sparseA;
    __device__ void init(int nM_, int N_, int G_, int c_, const PG8_LAS int* tab_, bool sparseA_) { nM = nM_; nN = N_ / BM; nwg = nM * nN; G = G_; c = c_; tab = tab_; sparseA = sparseA_; }
    __device__ bool next(int i, Unit& u) const {
        const long L = (long)i * G + c; if (L >= nwg) return false;
        int wgid = (int)L; { const int q = nwg / NXCD, r = nwg % NXCD, xcd = wgid % NXCD, off = wgid / NXCD; wgid = (xcd < r ? xcd * (q + 1) : r * (q + 1) + (xcd - r) * q) + off; }
        const int nig = WGM * nN, gid = wgid / nig, fm = gid * WGM, gsz = (nM - fm) < WGM ? (nM - fm) : WGM;
        u.pm = fm + ((wgid % nig) % gsz); u.pn = (wgid % nig) / gsz;
        const int ent = __builtin_amdgcn_readfirstlane(tab[u.pm]); u.be = ent >> 16; u.ps = ent & 0xffff; u.pa = sparseA ? u.ps : u.pm; return true;
    }
    __device__ __forceinline__ void a_ready(const Unit&) const {}
    __device__ __forceinline__ void done(const Unit&) const {}
};

constexpr int RSC_OFF = 131072 + 8192;
__device__ __forceinline__ unsigned cvt_pk_bf16(float lo, float hi) { unsigned r; asm volatile("v_cvt_pk_bf16_f32 %0, %1, %2" : "=v"(r) : "v"(lo), "v"(hi)); return r; }
__device__ __forceinline__ u32x4 pack8(const f32x4 a, const f32x4 b) { u32x4 w; w.x = cvt_pk_bf16(a[0], a[1]); w.y = cvt_pk_bf16(a[2], a[3]); w.z = cvt_pk_bf16(b[0], b[1]); w.w = cvt_pk_bf16(b[2], b[3]); return w; }
__device__ __forceinline__ void st_pair128(bf16_t* rowp, int pitch, int fr, u32x4 a0, u32x4 a1) {
    u32x4 t;
#pragma unroll
    for (int i = 0; i < 4; ++i) t[i] = (unsigned)__builtin_amdgcn_update_dpp(0, (int)a1[i], 0x128  , 0xf, 0xf, false);
    const bool hi = (fr & 8) != 0;
    u32x4 x, y;
#pragma unroll
    for (int i = 0; i < 4; ++i) { x[i] = hi ? t[i] : a0[i]; y[i] = hi ? a0[i] : t[i]; }
    st16_wt(rowp + (hi ? 32 - 8 * pitch : 0), x);
    st16_wt(rowp + (hi ? 0 : 8 * pitch + 32), y);
}
__device__ __forceinline__ float rstd_of(const float* ss4) { const f32x4 p = *(const f32x4*)ss4; return __builtin_amdgcn_rsqf(((p[0] + p[1]) + (p[2] + p[3])) * (1.0f / 1024.0f) + RMS_EPS); }

struct EpiProj {
    static constexpr bool PERM = true, AFTER_DRAIN = false, NEEDS_ALIGN = false;
    bf16_t* P; const float* ss; const float* ropeC; const float* ropeS; float qscale; float ascale = 1.0f;
    mutable int pmc = -1;
    __device__ __forceinline__ PG8_LAS float* rsc_lds() const { extern __shared__ __attribute__((aligned(16))) unsigned char lds_all[]; return (PG8_LAS float*)((PG8_LAS unsigned char*)lds_all + RSC_OFF) + opaque_tid(); }
    __device__ __forceinline__ void refresh(const Unit& u, int wr, int fr) const {
        if (u.pm != pmc) { pmc = u.pm; const int row0 = u.pm * BM + wr * 64 + fr; f32x4 t_[8]; PG8_LAS float* rc = rsc_lds();
#pragma unroll
            for (int i = 0; i < 8; ++i) t_[i] = *(const f32x4*)(ss + 4 * (size_t)(row0 + (i >> 2) * HALF + (i & 3) * 16));
#pragma unroll
            for (int i = 0; i < 8; ++i) rc[i * 512] = __builtin_amdgcn_rsqf(((t_[i][0] + t_[i][1]) + (t_[i][2] + t_[i][3])) * (1.0f / 1024.0f) + RMS_EPS) * ascale;
            asm volatile("s_waitcnt lgkmcnt(0)" ::: "memory"); }
    }
    __device__ __forceinline__ void half(const f32x4 (&acc)[2][2][4][2], const Unit& u, int ai, int wr, int wc, int fr, int fq) const {
        asm volatile("" : "+v"(fr), "+v"(fq));
        refresh(u, wr, fr);
        float rsc[4]; { const PG8_LAS float* rc = rsc_lds();
#pragma unroll
            for (int m = 0; m < 4; ++m) rsc[m] = rc[(ai * 4 + m) * 512]; }
        const int t = u.pn >> 2, ct = u.pn & 3;
        bf16_t* base = P + (size_t)t * ((size_t)M * 1024);
        const int row0 = u.pm * BM + wr * 64 + fr;
        if (t < 2) {
            const float sc = (t == 0) ? qscale : 1.0f;
            int fqo = fq; asm volatile("" : "+v"(fqo));
            const int hcol = ct * 256 + wc * 64 + 8 * fq;
#pragma unroll
            for (int m = 0; m < 4; ++m) {
                const int row = row0 + ai * HALF + m * 16; const float rs = rsc[m] * sc; const int pos = row & (SEQ - 1);
                const f32x4 c0 = *(const f32x4*)(ropeC + pos * 32 + 8 * fqo), c1 = *(const f32x4*)(ropeC + pos * 32 + 8 * fqo + 4);
                const f32x4 s0 = *(const f32x4*)(ropeS + pos * 32 + 8 * fqo), s1 = *(const f32x4*)(ropeS + pos * 32 + 8 * fqo + 4);
                const f32x4 l0 = acc[ai][0][m][0] * rs, l1 = acc[ai][0][m][1] * rs, h0 = acc[ai][1][m][0] * rs, h1 = acc[ai][1][m][1] * rs;
                const f32x4 ol0 = l0 * c0 - h0 * s0, ol1 = l1 * c1 - h1 * s1, oh0 = h0 * c0 + l0 * s0, oh1 = h1 * c1 + l1 * s1;
                bf16_t* rowp = base + (size_t)row * 1024 + hcol;
                st_pair128(rowp, 1024, fr, pack8(ol0, ol1), pack8(oh0, oh1));
                if (m & 1) asm volatile("" ::: "memory");
            }
        } else if (u.pn < 12 || u.pn >= 28) {
            bf16_t* b2 = P + (size_t)(u.pn < 12 ? 2 : 5) * ((size_t)M * 1024);
            const int col0 = ct * 256 + wc * 64 + 8 * fq;
#pragma unroll
            for (int m = 0; m < 4; ++m) {
                const int row = row0 + ai * HALF + m * 16; const float rs = rsc[m];
                bf16_t* rowp = b2 + (size_t)row * 1024 + col0;
                st_pair128(rowp, 1024, fr, pack8(acc[ai][0][m][0] * rs, acc[ai][0][m][1] * rs), pack8(acc[ai][1][m][0] * rs, acc[ai][1][m][1] * rs));
            }
        } else {
            const bool conv = u.pn < 20;
            bf16_t* b2 = P + (size_t)(conv ? 3 : 4) * ((size_t)M * 1024);
            const int col0 = (u.pn - (conv ? 12 : 20)) * HALF + wc * 32 + 8 * fq;
#pragma unroll
            for (int m = 0; m < 4; ++m) {
                const int row = row0 + ai * HALF + m * 16; const float rs = rsc[m];
                f32x4 o[2];
#pragma unroll
                for (int n = 0; n < 2; ++n) {
                    const f32x4 x0 = acc[ai][0][m][n] * rs, x1 = acc[ai][1][m][n] * rs;
                    if (conv) o[n] = x0 * x1;
                    else {
#pragma unroll
                        for (int i = 0; i < 4; ++i) o[n][i] = x0[i] * __builtin_amdgcn_rcpf(1.0f + __builtin_amdgcn_exp2f(x1[i] * -1.4426950408889634f)); }
                }
                st16_wt(b2 + (size_t)row * 1024 + col0, pack8(o[0], o[1]));
            }
        }
    }
    __device__ __forceinline__ void operator()(const f32x4 (&acc)[2][2][4][2], const Unit& u, int wr, int wc, int fr, int fq) const { half(acc, u, 0, wr, wc, fr, fq); half(acc, u, 1, wr, wc, fr, fq); }
};
__device__ __forceinline__ float clamp448(float v) { return __builtin_fminf(__builtin_fmaxf(v, -448.0f), 448.0f); }
template <bool F8OUT> struct EpiSwigluT {
    static constexpr bool PERM = true, AFTER_DRAIN = false, NEEDS_ALIGN = false;
    void* H; int ldh; const float* ss; float ascale;
    mutable int pmc = -1;
    __device__ __forceinline__ PG8_LAS float* rsc_lds() const { extern __shared__ __attribute__((aligned(16))) unsigned char lds_all[]; return (PG8_LAS float*)((PG8_LAS unsigned char*)lds_all + RSC_OFF) + opaque_tid(); }
    __device__ __forceinline__ void refresh(const Unit& u, int wr, int fr) const {
        if (u.pm != pmc) { pmc = u.pm; const int srow0 = u.ps * BM + wr * 64 + fr;
            f32x4 t_[8]; PG8_LAS float* rc = rsc_lds();
#pragma unroll
            for (int i = 0; i < 8; ++i) t_[i] = *(const f32x4*)(ss + 4 * (size_t)(srow0 + (i >> 2) * HALF + (i & 3) * 16));
#pragma unroll
            for (int i = 0; i < 8; ++i) rc[i * 512] = __builtin_amdgcn_rsqf(((t_[i][0] + t_[i][1]) + (t_[i][2] + t_[i][3])) * (1.0f / 1024.0f) + RMS_EPS) * ascale;
            asm volatile("s_waitcnt lgkmcnt(0)" ::: "memory"); }
    }
    __device__ __forceinline__ void half(const f32x4 (&acc)[2][2][4][2], const Unit& u, int ai, int wr, int wc, int fr, int fq) const {
        asm volatile("" : "+v"(fr), "+v"(fq));
        refresh(u, wr, fr);
        float rsc[4]; { const PG8_LAS float* rc = rsc_lds();
#pragma unroll
            for (int m = 0; m < 4; ++m) rsc[m] = rc[(ai * 4 + m) * 512]; }
        const int row0 = u.pm * BM + wr * 64 + fr, col0 = u.pn * HALF + wc * 32 + 8 * fq;
#pragma unroll
        for (int m = 0; m < 4; ++m) {
            const int row = row0 + ai * HALF + m * 16; const float rs = rsc[m];
            f32x4 o[2];
            {
                const float rse = rs * -1.4426950408889634f, rs2 = rs * rs * (F8OUT ? 8.0f : 1.0f);
                f32x4 e[2], p[2];
#pragma unroll
                for (int n = 0; n < 2; ++n) { e[n] = acc[ai][0][m][n] * rse; p[n] = (acc[ai][0][m][n] * acc[ai][1][m][n]) * rs2; }
#pragma unroll
                for (int n = 0; n < 2; ++n)
#pragma unroll
                    for (int i = 0; i < 4; ++i) e[n][i] = __builtin_amdgcn_exp2f(e[n][i]);
#pragma unroll
                for (int n = 0; n < 2; ++n) e[n] = e[n] + 1.0f;
#pragma unroll
                for (int n = 0; n < 2; ++n)
#pragma unroll
                    for (int i = 0; i < 4; ++i) e[n][i] = __builtin_amdgcn_rcpf(e[n][i]);
#pragma unroll
                for (int n = 0; n < 2; ++n) o[n] = p[n] * e[n];
            }
            if constexpr (F8OUT) {
                unsigned w0 = 0u, w1 = 0u;
                w0 = __builtin_amdgcn_cvt_pk_fp8_f32(clamp448(o[0][0]), clamp448(o[0][1]), w0, false); w0 = __builtin_amdgcn_cvt_pk_fp8_f32(clamp448(o[0][2]), clamp448(o[0][3]), w0, true);
                w1 = __builtin_amdgcn_cvt_pk_fp8_f32(clamp448(o[1][0]), clamp448(o[1][1]), w1, false); w1 = __builtin_amdgcn_cvt_pk_fp8_f32(clamp448(o[1][2]), clamp448(o[1][3]), w1, true);
                typedef unsigned u32x2 __attribute__((ext_vector_type(2)));
                *(u32x2*)((unsigned char*)H + (size_t)row * ldh + col0) = (u32x2){w0, w1};
            } else {
                st16_wt((bf16_t*)H + (size_t)row * ldh + col0, pack8(o[0], o[1]));
            }
        }
    }
    __device__ __forceinline__ void operator()(const f32x4 (&acc)[2][2][4][2], const Unit& u, int wr, int wc, int fr, int fq) const { half(acc, u, 0, wr, wc, fr, fq); half(acc, u, 1, wr, wc, fr, fq); }
};
typedef EpiSwigluT<false> EpiSwiglu;
typedef EpiSwigluT<true> EpiSwigluF8;
constexpr int EPI_TAB_OFF = 131072 + 1024;
template <bool LITE, bool F8X = false> struct EpiResidT {
    static constexpr bool PERM = true, AFTER_DRAIN = false, NEEDS_ALIGN = !LITE;
    bf16_t* xb; float* ssn; unsigned char* xq = nullptr; float ascale = 1.0f;
    __device__ __forceinline__ void operator()(const f32x4 (&acc)[2][2][4][2], const Unit& u, int wr, int wc, int fr, int fq) const {
        extern __shared__ __attribute__((aligned(16))) unsigned char lds_all[];
        PG8_LAS float* T = (PG8_LAS float*)((PG8_LAS unsigned char*)lds_all + EPI_TAB_OFF);
        const int row0 = u.pm * BM + wr * 64 + fr, col0 = u.pn * BM + wc * 64 + 8 * fq;
#pragma unroll
        for (int ai = 0; ai < 2; ++ai) {
            u32x4 xv[4][2];
#pragma unroll
            for (int m = 0; m < 4; ++m)
#pragma unroll
                for (int bj = 0; bj < 2; ++bj) xv[m][bj] = *(const u32x4*)(xb + (size_t)(row0 + ai * HALF + m * 16) * 1024 + col0 + bj * 32);
            asm volatile("" ::: "memory");
#pragma unroll
            for (int m = 0; m < 4; ++m) {
                const int row = row0 + ai * HALF + m * 16; float sq = 0.f; u32x4 pk[2];
#pragma unroll
                for (int bj = 0; bj < 2; ++bj) {
                    const u32x4 w = xv[m][bj];
                    f32x4 x0 = {__uint_as_float(w.x << 16), __uint_as_float(w.x & 0xffff0000u), __uint_as_float(w.y << 16), __uint_as_float(w.y & 0xffff0000u)};
                    f32x4 x1 = {__uint_as_float(w.z << 16), __uint_as_float(w.z & 0xffff0000u), __uint_as_float(w.w << 16), __uint_as_float(w.w & 0xffff0000u)};
                    x0 += acc[ai][bj][m][0] * ascale; x1 += acc[ai][bj][m][1] * ascale;
                    pk[bj] = pack8(x0, x1);
                    if constexpr (F8X) { unsigned w0 = 0u, w1 = 0u;
                        w0 = __builtin_amdgcn_cvt_pk_fp8_f32(clamp448(x0[0] * 8.0f), clamp448(x0[1] * 8.0f), w0, false); w0 = __builtin_amdgcn_cvt_pk_fp8_f32(clamp448(x0[2] * 8.0f), clamp448(x0[3] * 8.0f), w0, true);
                        w1 = __builtin_amdgcn_cvt_pk_fp8_f32(clamp448(x1[0] * 8.0f), clamp448(x1[1] * 8.0f), w1, false); w1 = __builtin_amdgcn_cvt_pk_fp8_f32(clamp448(x1[2] * 8.0f), clamp448(x1[3] * 8.0f), w1, true);
                        st8_wt(xq + (size_t)row * 1024 + col0 + bj * 32, (wt_u32x2){w0, w1}); }
                    if constexpr (!LITE) sq += (x0[0] * x0[0] + x0[1] * x0[1]) + (x0[2] * x0[2] + x0[3] * x0[3]) + (x1[0] * x1[0] + x1[1] * x1[1]) + (x1[2] * x1[2] + x1[3] * x1[3]);
                }
                st_pair128(xb + (size_t)row * 1024 + col0, 1024, fr, pk[0], pk[1]);
                if constexpr (!LITE) { sq += __shfl_xor(sq, 16); sq += __shfl_xor(sq, 32);
                    if (fq == 0) T[(ai * HALF + wr * 64 + m * 16 + fr) * 4 + wc] = sq; }
            }
        }
        if constexpr (!LITE) {
        asm volatile("s_waitcnt lgkmcnt(0)\n\ts_barrier" ::: "memory");
        if (wc == 0 && fq == 0) {
#pragma unroll
            for (int ai = 0; ai < 2; ++ai)
#pragma unroll
                for (int m = 0; m < 4; ++m) { const int lr = ai * HALF + wr * 64 + m * 16 + fr; const f32x4 p = *(const PG8_LAS f32x4*)(T + lr * 4);
                    ssn[(size_t)(u.pm * BM + lr) * 4 + u.pn] = (p[0] + p[1]) + (p[2] + p[3]); }
        } }
    }
};
typedef EpiResidT<false> EpiResid;
typedef EpiResidT<true> EpiResidLite;
typedef EpiResidT<false, true> EpiResidF8X;
struct EpiSlot {
    static constexpr bool PERM = true, AFTER_DRAIN = false, NEEDS_ALIGN = false;
    bf16_t* Y; const float* wslot; float ascale;
    __device__ __forceinline__ void half(const f32x4 (&acc)[2][2][4][2], const Unit& u, int ai, int wr, int wc, int fr, int fq) const {
        asm volatile("" : "+v"(fr), "+v"(fq));
        const int row0 = u.pm * BM + wr * 64 + fr, col0 = u.pn * BM + wc * 64 + 8 * fq;
        float w[4];
#pragma unroll
        for (int m = 0; m < 4; ++m) w[m] = wslot[u.ps * BM + wr * 64 + fr + ai * HALF + m * 16] * ascale;
#pragma unroll
        for (int m = 0; m < 4; ++m) {
            const int row = row0 + ai * HALF + m * 16;
            st_pair128(Y + (size_t)row * 1024 + col0, 1024, fr, pack8(acc[ai][0][m][0] * w[m], acc[ai][0][m][1] * w[m]), pack8(acc[ai][1][m][0] * w[m], acc[ai][1][m][1] * w[m]));
        }
    }
    __device__ __forceinline__ void operator()(const f32x4 (&acc)[2][2][4][2], const Unit& u, int wr, int wc, int fr, int fq) const { half(acc, u, 0, wr, wc, fr, fq); half(acc, u, 1, wr, wc, fr, fq); }
};

__device__ __forceinline__ void glds16s(unsigned voff, const void* sbase, unsigned lds_dst) { unsigned keep;
    asm volatile("s_mov_b32 %0, m0\n\ts_mov_b32 m0, %3\n\ts_nop 0\n\tglobal_load_lds_dwordx4 %1, %2\n\ts_mov_b32 m0, %0" : "=&s"(keep) : "v"(voff), "s"(sbase), "s"(lds_dst) : "memory"); }
typedef int v8i_t __attribute__((ext_vector_type(8))); typedef int v4i_t __attribute__((ext_vector_type(4)));
__device__ __forceinline__ v8i_t cat16(bf16x8 lo, bf16x8 hi) { const v4i_t a = __builtin_bit_cast(v4i_t, lo), b = __builtin_bit_cast(v4i_t, hi); return __builtin_shufflevector(a, b, 0, 1, 2, 3, 4, 5, 6, 7); }
template <class Epi, class Sched, bool ALIGN_EPI = false, bool SP2 = false, bool FP8 = false>
__device__ __forceinline__ void gemm_phase(PG8_LAS unsigned char* lds, const Gemm g, const Sched& S, const Epi& E) {
    const int tid = opaque_tid(), wid = __builtin_amdgcn_readfirstlane(tid >> 6), lane = tid & 63, wr = wid >> 2, wc = wid & 3, fr = lane & 15, fq = lane >> 4;
    const int K = FP8 ? g.K / 2 : g.K, nt = K / BK;
    unsigned voffA[2], voffB[2];
#pragma unroll
    for (int i = 0; i < 2; ++i) { int R, C; stage_rc(tid * 16 + i * 8192, R, C); const int Rb = Epi::PERM ? (64 * (R >> 5) + perm32(R & 31)) : R;
        voffA[i] = (unsigned)(R * K + C) * 2u; voffB[i] = (unsigned)(Rb * K + C) * 2u; }
    const size_t kstep = (size_t)(BK * 2);
    const size_t hstep = (size_t)HALF * K * 2;
    const size_t tstep = 2 * hstep;
    const size_t hstepB = Epi::PERM ? (size_t)32 * K * 2 : hstep;
    const unsigned ldsw = (unsigned)wid * 1024u; const unsigned ldsb = (unsigned)__builtin_amdgcn_readfirstlane((int)((unsigned)(size_t)lds + ldsw));
    const int aoff = lds_byte(wr * 64 + fr, fq * 8), boff = lds_byte(wc * 32 + fr, fq * 8);
#define PG8_SA(b, h) (((b) * 2 + (h)) * HTB)
#define PG8_SB(b, h) ((4 + (b) * 2 + (h)) * HTB)
#define PG8_STAGE(bufoff, gbase, voff) do { _Pragma("unroll") for (int _i = 0; _i < 2; ++_i) \
        glds16s((voff)[_i], (const void*)(gbase), ldsb + (unsigned)((bufoff) + _i * 8192)); } while (0)
#define PG8_LDA(dst, b, h) do { _Pragma("unroll") for (int m = 0; m < 4; ++m) _Pragma("unroll") for (int k = 0; k < 2; ++k) dst[m][k] = *(const PG8_LAS bf16x8*)(lds + PG8_SA(b, h) + aoff + m * 2048 + k * 1024); } while (0)
#define PG8_LDB(dst, b, h) do { _Pragma("unroll") for (int n = 0; n < 2; ++n) _Pragma("unroll") for (int k = 0; k < 2; ++k) dst[n][k] = *(const PG8_LAS bf16x8*)(lds + PG8_SB(b, h) + boff + n * 2048 + k * 1024); } while (0)
#define PG8_MMA(ai, bj, At, Bt) do { __builtin_amdgcn_s_setprio(1); _Pragma("unroll") for (int m = 0; m < 4; ++m) _Pragma("unroll") for (int n = 0; n < 2; ++n) { \
        if constexpr (FP8) { const v8i_t bo_ = cat16(Bt[n][0], Bt[n][1]), ao_ = cat16(At[m][0], At[m][1]); \
            asm volatile("v_mfma_f32_16x16x128_f8f6f4 %0, %1, %2, %0" : "+v"(acc[ai][bj][m][n]) : "v"(bo_), "v"(ao_)); }     \
        else { _Pragma("unroll") for (int k = 0; k < 2; ++k) acc[ai][bj][m][n] = __builtin_amdgcn_mfma_f32_16x16x32_bf16(Bt[n][k], At[m][k], acc[ai][bj][m][n], 0, 0, 0); } } \
        __builtin_amdgcn_s_setprio(0); } while (0)
#define PG8_WAIT_V(n) asm volatile("s_waitcnt vmcnt(" #n ")" ::: "memory")
#define PG8_WAIT_L(n) asm volatile("s_waitcnt lgkmcnt(" #n ")" ::: "memory")
#define PG8_BAR __builtin_amdgcn_s_barrier()
#define PG8_SCHED __builtin_amdgcn_sched_barrier(0)
    Unit cur, nxt; int ui = 0;
    if (!S.next(0, cur)) return;
    f32x4 acc[2][2][4][2];
#pragma unroll
    for (int a = 0; a < 2; ++a)
#pragma unroll
        for (int b = 0; b < 2; ++b)
#pragma unroll
            for (int m = 0; m < 4; ++m)
#pragma unroll
                for (int n = 0; n < 2; ++n) { acc[a][b][m][n] = (f32x4){0.f, 0.f, 0.f, 0.f}; asm volatile("" : "+v"(acc[a][b][m][n])); }
    bf16x8 At[4][2], B0[2][2], B1[2][2];
    const char* cA = (const char*)g.A + (size_t)cur.pa * tstep; const char* cB = (const char*)g.Bt + (size_t)cur.be * g.bstride + (size_t)cur.pn * tstep;
    S.a_ready(cur);
    if constexpr (SP2) {
        PG8_STAGE(PG8_SB(0, 0), cB, voffB); PG8_STAGE(PG8_SB(0, 1), cB + hstepB, voffB); PG8_STAGE(PG8_SA(0, 0), cA, voffA); PG8_STAGE(PG8_SA(0, 1), cA + hstep, voffA);
        if (wr == 1) PG8_BAR;
        PG8_WAIT_V(2); PG8_BAR;
        PG8_STAGE(PG8_SB(1, 0), cB + kstep, voffB); PG8_STAGE(PG8_SA(1, 0), cA + kstep, voffA); PG8_STAGE(PG8_SB(1, 1), cB + hstepB + kstep, voffB);
        PG8_WAIT_V(6); PG8_BAR;
    } else {
        PG8_STAGE(PG8_SB(0, 0), cB, voffB); PG8_STAGE(PG8_SA(0, 0), cA, voffA); PG8_STAGE(PG8_SB(0, 1), cB + hstepB, voffB); PG8_STAGE(PG8_SA(0, 1), cA + hstep, voffA);
        if (wr == 1) PG8_BAR;
        PG8_WAIT_V(4); PG8_BAR;
        PG8_STAGE(PG8_SB(1, 0), cB + kstep, voffB); PG8_STAGE(PG8_SA(1, 0), cA + kstep, voffA); PG8_STAGE(PG8_SB(1, 1), cB + hstepB + kstep, voffB);
        PG8_WAIT_V(6); PG8_BAR;
    }
    for (;;) {
        const bool has_next = S.next(ui + 1, nxt);
        const char* nA = has_next ? (const char*)g.A + (size_t)nxt.pa * tstep : cA; const char* nB = has_next ? (const char*)g.Bt + (size_t)nxt.be * g.bstride + (size_t)nxt.pn * tstep : cB;
#pragma nounroll
        for (int t = 0; t < nt; t += 2) {
            const bool last = (t == nt - 2);
            const char* a1 = cA + (size_t)(t + 1) * kstep;
            const char* a2 = last ? nA : cA + (size_t)(t + 2) * kstep; const char* b2 = last ? nB : cB + (size_t)(t + 2) * kstep;
            const char* a3 = a2 + kstep; const char* b3 = b2 + kstep;
            if (last && has_next) S.a_ready(nxt);
            if constexpr (SP2) {
            PG8_LDB(B0, 0, 0); PG8_LDB(B1, 0, 1); PG8_SCHED; PG8_LDA(At, 0, 0); PG8_STAGE(PG8_SA(1, 1), a1 + hstep, voffA);
            PG8_WAIT_V(8); PG8_WAIT_L(0); PG8_BAR; PG8_MMA(0, 0, At, B0); PG8_MMA(0, 1, At, B1); PG8_BAR; PG8_SCHED;
            PG8_LDA(At, 0, 1); PG8_STAGE(PG8_SB(0, 0), b2, voffB); PG8_STAGE(PG8_SB(0, 1), b2 + hstepB, voffB); PG8_STAGE(PG8_SA(0, 0), a2, voffA);
            PG8_WAIT_V(8); PG8_WAIT_L(0); PG8_BAR; PG8_MMA(1, 0, At, B0); PG8_MMA(1, 1, At, B1); PG8_BAR; PG8_SCHED;
            PG8_LDB(B0, 1, 0); PG8_LDB(B1, 1, 1); PG8_SCHED; PG8_LDA(At, 1, 0); PG8_STAGE(PG8_SA(0, 1), a2 + hstep, voffA);
            PG8_WAIT_V(8); PG8_WAIT_L(0); PG8_BAR; PG8_MMA(0, 0, At, B0); PG8_MMA(0, 1, At, B1); PG8_BAR; PG8_SCHED;
            PG8_LDA(At, 1, 1); PG8_STAGE(PG8_SB(1, 0), b3, voffB); PG8_STAGE(PG8_SB(1, 1), b3 + hstepB, voffB); PG8_STAGE(PG8_SA(1, 0), a3, voffA);
            PG8_WAIT_V(8); PG8_WAIT_L(0); PG8_BAR; PG8_MMA(1, 0, At, B0); PG8_MMA(1, 1, At, B1); PG8_BAR; PG8_SCHED;
            } else {
            PG8_LDB(B0, 0, 0); PG8_SCHED; PG8_LDA(At, 0, 0); PG8_STAGE(PG8_SA(1, 1), a1 + hstep, voffA);
            PG8_WAIT_L(8); PG8_BAR; PG8_WAIT_L(0); PG8_MMA(0, 0, At, B0); PG8_BAR; PG8_SCHED;
            PG8_LDB(B1, 0, 1); PG8_STAGE(PG8_SB(0, 0), b2, voffB);
            PG8_BAR; PG8_WAIT_L(0); PG8_MMA(0, 1, At, B1); PG8_BAR;
            PG8_LDA(At, 0, 1); PG8_STAGE(PG8_SA(0, 0), a2, voffA);
            PG8_BAR; PG8_WAIT_L(0); PG8_MMA(1, 0, At, B0); PG8_BAR; PG8_SCHED;
            PG8_STAGE(PG8_SB(0, 1), b2 + hstepB, voffB);
            PG8_WAIT_V(6); PG8_BAR; PG8_MMA(1, 1, At, B1); PG8_BAR;
            PG8_LDB(B0, 1, 0); PG8_SCHED; PG8_LDA(At, 1, 0); PG8_STAGE(PG8_SA(0, 1), a2 + hstep, voffA);
            PG8_WAIT_L(8); PG8_BAR; PG8_WAIT_L(0); PG8_MMA(0, 0, At, B0); PG8_BAR; PG8_SCHED;
            PG8_LDB(B1, 1, 1); PG8_STAGE(PG8_SB(1, 0), b3, voffB);
            PG8_BAR; PG8_WAIT_L(0); PG8_MMA(0, 1, At, B1); PG8_BAR;
            PG8_LDA(At, 1, 1); PG8_STAGE(PG8_SA(1, 0), a3, voffA);
            PG8_BAR; PG8_WAIT_L(0); PG8_MMA(1, 0, At, B0); PG8_BAR; PG8_SCHED;
            PG8_STAGE(PG8_SB(1, 1), b3 + hstepB, voffB);
            PG8_WAIT_V(6); PG8_BAR; PG8_MMA(1, 1, At, B1); PG8_BAR;
            }
        }
        if constexpr (ALIGN_EPI) { if (wr == 0) PG8_BAR; }
        static_assert(ALIGN_EPI || !Epi::NEEDS_ALIGN, "this epilogue contains a workgroup barrier: both halves must run it together");
        if constexpr (!Epi::AFTER_DRAIN) { E(acc, cur, wr, wc, fr, fq); S.done(cur); }
        if (!has_next) break;
#pragma unroll
        for (int a = 0; a < 2; ++a)
#pragma unroll
            for (int b = 0; b < 2; ++b)
#pragma unroll
                for (int m = 0; m < 4; ++m)
#pragma unroll
                    for (int n = 0; n < 2; ++n) { acc[a][b][m][n] = (f32x4){0.f, 0.f, 0.f, 0.f}; asm volatile("" : "+v"(acc[a][b][m][n])); }
        cur = nxt; cA = nA; cB = nB; ++ui;
        if constexpr (ALIGN_EPI) { if (wr == 1) PG8_BAR; }
    }
    PG8_WAIT_V(0);
    if constexpr (!ALIGN_EPI) { if (wr == 0) PG8_BAR; }
    PG8_BAR;
#undef PG8_SA
#undef PG8_SB
#undef PG8_STAGE
#undef PG8_LDA
#undef PG8_LDB
#undef PG8_MMA
#undef PG8_WAIT_V
#undef PG8_WAIT_L
#undef PG8_BAR
#undef PG8_SCHED
}

}

#ifndef PG8_SP2
#define PG8_SP2 true
#endif
#ifndef PG8_ALIGN
#define PG8_ALIGN true
#endif

namespace attn_body {
using bf16=__hip_bfloat16;
using bf16x8=__attribute__((ext_vector_type(8)))short;
using s16x4=__attribute__((ext_vector_type(4)))short;
using f32x16=__attribute__((ext_vector_type(16)))float;
using u32x4=__attribute__((ext_vector_type(4)))unsigned;
constexpr int D=64;
constexpr int PQ=1024,PK=1024,PV=1024,PO=2048;
constexpr int NW=8,QBLK=32,QB=QBLK*NW,KVBLK=64;
__device__ __forceinline__ int crow(int r,int hi){return (r&3)+8*(r>>2)+4*hi;}
#define SBAR() __builtin_amdgcn_sched_barrier(0)
__device__ __forceinline__ void cmask(f32x16&p0,f32x16&p1,int jb,int qrel,int hi){
  const float NEG=-INFINITY; int kb=64*jb+4*hi;
  #pragma unroll
  for(int r=0;r<16;++r){int kv=kb+(r&3)+8*(r>>2); if(kv>qrel)p0[r]=NEG; if(kv+32>qrel)p1[r]=NEG;}
}
constexpr int NSLOT=3, SLOTB=8192;
constexpr int LDS_K=0, LDS_V=NSLOT*SLOTB, LDS_WS=2*NSLOT*SLOTB, LDS_OST=LDS_WS+NW*64*4, LDS_BYTES=LDS_OST+NW*4096;
constexpr float C2=0.125f*1.4426950408889634f;
__device__ __forceinline__ void glds16(const void*gsrc,unsigned lds_dst){unsigned keep;
  asm volatile("s_mov_b32 %0, m0\n\ts_mov_b32 m0, %2\n\ts_nop 0\n\tglobal_load_lds_dwordx4 %1, off\n\ts_mov_b32 m0, %0":"=&s"(keep):"v"(gsrc),"s"(lds_dst):"memory");}
__device__ __forceinline__ float max3f(float a,float b,float c){float r;asm("v_max3_f32 %0, %1, %2, %3":"=v"(r):"v"(a),"v"(b),"v"(c));return r;}
__device__ __forceinline__ float max2f(float a,float b){float r;asm("v_max_f32_e32 %0, %1, %2":"=v"(r):"v"(a),"v"(b));return r;}
__device__ __forceinline__ float fadd_s(float a,float b){float r;asm("v_add_f32_e32 %0, %1, %2":"=v"(r):"v"(a),"v"(b));return r;}
__device__ __forceinline__ float fsub_s(float a,float b){float r;asm("v_sub_f32_e32 %0, %1, %2":"=v"(r):"v"(a),"v"(b));return r;}
typedef float f32x2_t __attribute__((ext_vector_type(2))); typedef __bf16 bf16x2_t __attribute__((ext_vector_type(2)));
__device__ __forceinline__ unsigned cvtpk_s(float lo,float hi){f32x2_t v={lo,hi};bf16x2_t b=__builtin_convertvector(v,bf16x2_t);return __builtin_bit_cast(unsigned,b);}
#define WAIT_BAR(N) asm volatile("s_waitcnt vmcnt(" #N ") lgkmcnt(0)\n\ts_barrier":::"memory")

__device__ __forceinline__ void qkt(f32x16&p0,f32x16&p1,const char*Kslot,const bf16x8*qr,const f32x16&negm,int r32,int hi){
  const char*kb=Kslot+hi*1024+r32*16;
  #pragma unroll
  for(int d0=0;d0<4;++d0){
    const bf16x8 b0=*reinterpret_cast<const bf16x8*>(kb+d0*2048);
    const bf16x8 b1=*reinterpret_cast<const bf16x8*>(kb+d0*2048+512);
    if(d0==0){p0=__builtin_amdgcn_mfma_f32_32x32x16_bf16(b0,qr[0],negm,0,0,0);p1=__builtin_amdgcn_mfma_f32_32x32x16_bf16(b1,qr[0],negm,0,0,0);}
    else{p0=__builtin_amdgcn_mfma_f32_32x32x16_bf16(b0,qr[d0],p0,0,0,0);p1=__builtin_amdgcn_mfma_f32_32x32x16_bf16(b1,qr[d0],p1,0,0,0);}}
}
typedef __attribute__((address_space(3))) const char* lds_cptr;
typedef short v4i16_t __attribute__((ext_vector_type(4)));
__device__ __forceinline__ void kload8(bf16x8*kf,lds_cptr kp){
  kf[0]=*(const __attribute__((address_space(3))) bf16x8*)(kp);      kf[1]=*(const __attribute__((address_space(3))) bf16x8*)(kp+512);
  kf[2]=*(const __attribute__((address_space(3))) bf16x8*)(kp+2048); kf[3]=*(const __attribute__((address_space(3))) bf16x8*)(kp+2560);
  kf[4]=*(const __attribute__((address_space(3))) bf16x8*)(kp+4096); kf[5]=*(const __attribute__((address_space(3))) bf16x8*)(kp+4608);
  kf[6]=*(const __attribute__((address_space(3))) bf16x8*)(kp+6144); kf[7]=*(const __attribute__((address_space(3))) bf16x8*)(kp+6656);
}
__device__ __forceinline__ void kload2(bf16x8*kf,lds_cptr kp,int j){ kf[2*j]=*(const __attribute__((address_space(3))) bf16x8*)(kp+j*2048); kf[2*j+1]=*(const __attribute__((address_space(3))) bf16x8*)(kp+j*2048+512); }
__device__ __forceinline__ s16x4 vtr(lds_cptr p){ return __builtin_bit_cast(s16x4,__builtin_amdgcn_ds_read_tr16_b64_v4i16((__attribute__((address_space(3))) v4i16_t*)p)); }
__device__ __forceinline__ float rowmax(const f32x16&p0,const f32x16&p1){
  float a=max3f(p0[0],p0[1],p1[0]),b=max3f(p0[2],p0[3],p1[1]);a=max3f(a,p1[2],p1[3]);
  #pragma unroll
  for(int r=4;r<16;r+=4){a=max3f(a,p0[r],p0[r+1]);b=max3f(b,p0[r+2],p0[r+3]);a=max3f(a,p1[r],p1[r+1]);b=max3f(b,p1[r+2],p1[r+3]);}
  const float m=max2f(a,b);
  auto rr=__builtin_amdgcn_permlane32_swap(__float_as_uint(m),__float_as_uint(m),false,false);
  return max2f(__uint_as_float(rr[0]),__uint_as_float(rr[1]));
}
__device__ __forceinline__ void pv(f32x16*o,int vb,bf16x8 pa0,bf16x8 pa1,bf16x8 pa2,bf16x8 pa3){
  #pragma unroll
  for(int d0=0;d0<2;++d0){s16x4 lo[4],hi[4];
    #pragma unroll
    for(int ks=0;ks<4;++ks){
      asm volatile("ds_read_b64_tr_b16 %0,%1 offset:%c2":"=&v"(lo[ks]):"v"(vb),"i"(d0*4096+ks*1024):"memory");
      asm volatile("ds_read_b64_tr_b16 %0,%1 offset:%c2":"=&v"(hi[ks]):"v"(vb),"i"(d0*4096+ks*1024+512):"memory");}
    asm volatile("s_waitcnt lgkmcnt(0)":::"memory");SBAR();
    #define PK(k) (bf16x8){lo[k][0],lo[k][1],lo[k][2],lo[k][3],hi[k][0],hi[k][1],hi[k][2],hi[k][3]}
    o[d0]=__builtin_amdgcn_mfma_f32_32x32x16_bf16(pa0,PK(0),o[d0],0,0,0);
    o[d0]=__builtin_amdgcn_mfma_f32_32x32x16_bf16(pa1,PK(1),o[d0],0,0,0);
    o[d0]=__builtin_amdgcn_mfma_f32_32x32x16_bf16(pa2,PK(2),o[d0],0,0,0);
    o[d0]=__builtin_amdgcn_mfma_f32_32x32x16_bf16(pa3,PK(3),o[d0],0,0,0);
    #undef PK
  }
}
#ifndef ATTN_STORE16
#define ATTN_STORE16(p,v) st16_wt((void*)(p),(v))
#endif
template<int THRL> __device__ __forceinline__ void attn_unit(int qb,const bf16*Qh,const bf16*__restrict__ Kh,const bf16*__restrict__ Vh,bf16*Oh,char*shm){
  const int tid=opaque_tid(),lane=tid&63,r32=lane&31,hi=lane>>5; const int wid=__builtin_amdgcn_readfirstlane(tid>>6);
  const int q0=qb*QB;
  const bf16*Qw=Qh+(long)(q0+wid*QBLK)*PQ;
  const unsigned lds0=(unsigned)(uintptr_t)shm;
  float*wsf=(float*)(shm+LDS_WS)+wid*64;
  const bf16*ksrc=Kh+(long)lane*PK+wid*8;
  const bf16*vsrc=Vh+(long)(16*(wid&3)+(lane>>2))*PV+(wid>>2)*32+(lane&3)*8;
  const unsigned kdst=lds0+LDS_K+wid*1024, vdst=lds0+LDS_V+wid*1024;
  #define DMA_K(t,slot) glds16(ksrc+(long)(t)*KVBLK*PK,(unsigned)__builtin_amdgcn_readfirstlane(kdst+(slot)))
  #define DMA_V(t,slot) glds16(vsrc+(long)(t)*KVBLK*PV,(unsigned)__builtin_amdgcn_readfirstlane(vdst+(slot)))
  const int vb0=(int)(lds0+LDS_V)+((lane>>4)&1)*32+(lane&3)*8+(4*hi+((lane&15)>>2))*64;
  const char*Kbase=shm+LDS_K; bf16x8 kf[8];
  const lds_cptr shm3=(lds_cptr)shm; const lds_cptr kp0=shm3+LDS_K+hi*1024+r32*16; const lds_cptr vp0=shm3+LDS_V+((lane>>4)&1)*32+(lane&3)*8+(4*hi+((lane&15)>>2))*64;
  const int NT=(q0+QB)/KVBLK;
  DMA_K(0,0);DMA_V(0,0);DMA_K(1,SLOTB);
  bf16x8 qr[4];
  #pragma unroll
  for(int d0=0;d0<4;++d0)qr[d0]=*reinterpret_cast<const bf16x8*>(&Qw[(long)r32*PQ+d0*16+hi*8]);
  float mhat=0.f,l_reg=0.f;f32x16 o[2];o[0]=f32x16{};o[1]=f32x16{};f32x16 negm=f32x16{};asm volatile("":"+v"(negm));
  const int qrel=wid*QBLK+r32;
  #define CMASK(P0,P1,t) do{int jb_=(t)-(NT-4); if(jb_>=0)cmask(P0,P1,jb_,qrel,hi);}while(0)
  bool resc=false;
  #define START(P0,P1) do{ const float rm=rowmax(P0,P1); resc=false; \
    { const float dl=rm; mhat=fadd_s(mhat,dl); \
      _Pragma("unroll") for(int r=0;r<16;++r){P0[r]=fsub_s(P0[r],dl);P1[r]=fsub_s(P1[r],dl);} \
      _Pragma("unroll") for(int r=0;r<16;++r)negm[r]=-mhat; asm volatile("":"+v"(negm)); } \
    _Pragma("unroll") for(int r=0;r<16;++r)P0[r]=__builtin_amdgcn_exp2f(P0[r]); }while(0)
  #define RESC() do{ if(resc){ asm volatile("s_waitcnt lgkmcnt(0)":::"memory"); \
      _Pragma("unroll") for(int d_=0;d_<2;++d_) _Pragma("unroll") for(int r=0;r<16;++r)o[d_][r]*=wsf[crow(r,hi)]; } }while(0)
  f32x16 pA0,pA1,pB0,pB1;
  int sl_prev=0,sl_cur=0,sl_next=SLOTB;
  #define ROT() do{sl_prev=sl_cur;sl_cur=sl_next;sl_next=(sl_next==(NSLOT-1)*SLOTB)?0:sl_next+SLOTB;}while(0)
  DMA_K(2,2*SLOTB);
  WAIT_BAR(3);
  qkt(pA0,pA1,Kbase,qr,negm,r32,hi);asm volatile("s_nop 15\n\ts_nop 7":"+v"(pA0),"+v"(pA1));CMASK(pA0,pA1,0);
  START(pA0,pA1);
  _Pragma("unroll") for(int r=0;r<16;++r)pA1[r]=__builtin_amdgcn_exp2f(pA1[r]);
  WAIT_BAR(0);
  DMA_K(3,0);DMA_V(1,SLOTB);
  ROT();
  kload8(kf,kp0+sl_cur);
  WAIT_BAR(2);
  s16x4 vlo[8],vhi[8]; u32x4 pw0,pw1,pw2,pw3;
  #define PKW(P,B) cvtpk_s(P[B],P[B+1])
  #define PAF(k) __builtin_bit_cast(bf16x8,pw##k)
  #define VFR(i) (bf16x8){vlo[i][0],vlo[i][1],vlo[i][2],vlo[i][3],vhi[i][0],vhi[i][1],vhi[i][2],vhi[i][3]}
  #define PIN(x) asm volatile("":"+v"(x))
  #define MX3(a,b,c) __builtin_fmaxf(__builtin_fmaxf((a),(b)),(c))
  #define GAPA(MF,A0,A1,A2,A3,W0,W1,PW) do{ MF; sacc+=A0; sacc+=A1; sacc+=A2; sacc+=A3; PIN(sacc); W0; W1; PIN(PW); SBAR(); }while(0)
  #define EX(v) __builtin_amdgcn_exp2f(v)
  #define GAPB(MF,X,B) do{ MF; X[B]=EX(X[B]); X[B+1]=EX(X[B+1]); X[B+2]=EX(X[B+2]); X[B+3]=EX(X[B+3]); PIN(X); SBAR(); }while(0)
  #define VRD(i) do{ vlo[i]=vtr(vp_+(((i)>>2)*4096+((i)&3)*1024)); vhi[i]=vtr(vp_+(((i)>>2)*4096+((i)&3)*1024+512)); }while(0)
  #define KRD(G,j) do{ if(G){ kload2(kf,kp0+sl_next,j); SBAR(); } }while(0)
  #define STEP(C0,C1,P0,P1,t,GK,GV,GL) do{ SBAR(); \
    const lds_cptr vp_=vp0+sl_prev; \
    VRD(0); SBAR(); float sacc=(P0[0]+P0[1]); \
    GAPA(C0=__builtin_amdgcn_mfma_f32_32x32x16_bf16(kf[0],qr[0],negm,0,0,0), P0[2],P0[3],P0[4],P0[5],     pw0[0]=PKW(P0,0), pw0[1]=PKW(P0,2), pw0); \
    VRD(4); SBAR(); GAPA(C1=__builtin_amdgcn_mfma_f32_32x32x16_bf16(kf[1],qr[0],negm,0,0,0), P0[6],P0[7],P0[8],P0[9],     pw0[2]=PKW(P0,4), pw0[3]=PKW(P0,6), pw0); \
    VRD(1); SBAR(); GAPA(C0=__builtin_amdgcn_mfma_f32_32x32x16_bf16(kf[2],qr[1],C0,0,0,0),   P0[10],P0[11],P0[12],P0[13], pw1[0]=PKW(P0,8), pw1[1]=PKW(P0,10), pw1); \
    VRD(5); SBAR(); GAPA(C1=__builtin_amdgcn_mfma_f32_32x32x16_bf16(kf[3],qr[1],C1,0,0,0),   P0[14],P0[15],P1[0],P1[1],   pw1[2]=PKW(P0,12),pw1[3]=PKW(P0,14), pw1); \
    VRD(2); SBAR(); GAPA(C0=__builtin_amdgcn_mfma_f32_32x32x16_bf16(kf[4],qr[2],C0,0,0,0),   P1[2],P1[3],P1[4],P1[5],     pw2[0]=PKW(P1,0), pw2[1]=PKW(P1,2), pw2); \
    VRD(6); SBAR(); GAPA(C1=__builtin_amdgcn_mfma_f32_32x32x16_bf16(kf[5],qr[2],C1,0,0,0),   P1[6],P1[7],P1[8],P1[9],     pw2[2]=PKW(P1,4), pw2[3]=PKW(P1,6), pw2); \
    VRD(3); SBAR(); GAPA(C0=__builtin_amdgcn_mfma_f32_32x32x16_bf16(kf[6],qr[3],C0,0,0,0),   P1[10],P1[11],P1[12],P1[13], pw3[0]=PKW(P1,8), pw3[1]=PKW(P1,10), pw3); \
    VRD(7); SBAR(); GAPA(C1=__builtin_amdgcn_mfma_f32_32x32x16_bf16(kf[7],qr[3],C1,0,0,0),   P1[14],P1[15],0.f,0.f,       pw3[2]=PKW(P1,12),pw3[3]=PKW(P1,14), pw3); \
    l_reg+=sacc; \
    if(GK){DMA_K((t)+3,sl_cur);} if(GV){DMA_V((t)+1,sl_next);} \
    CMASK(C0,C1,t); \
    { float a=MX3(C0[0],C0[1],C1[0]),b=MX3(C0[2],C0[3],C1[1]); a=MX3(a,C1[2],C1[3]); \
      _Pragma("unroll") for(int r=4;r<16;r+=4){a=MX3(a,C0[r],C0[r+1]);b=MX3(b,C0[r+2],C0[r+3]);a=MX3(a,C1[r],C1[r+1]);b=MX3(b,C1[r+2],C1[r+3]);} \
      float rm=__builtin_fmaxf(a,b); { auto rr=__builtin_amdgcn_permlane32_swap(__float_as_uint(rm),__float_as_uint(rm),false,false); rm=__builtin_fmaxf(__uint_as_float(rr[0]),__uint_as_float(rr[1])); } \
      resc=false; \
      if(__builtin_expect(__any(rm>(float)THRL),0)){ const float dl=__builtin_fmaxf(rm,0.f); mhat+=dl; \
        _Pragma("unroll") for(int r=0;r<16;++r){C0[r]-=dl;C1[r]-=dl;} \
        _Pragma("unroll") for(int r=0;r<16;++r)negm[r]=-mhat; asm volatile("":"+v"(negm)); \
        const float f=__builtin_amdgcn_exp2f(-dl); l_reg*=f; if(hi==0)wsf[r32]=f; resc=true; } } \
    SBAR(); \
    GAPB(o[0]=__builtin_amdgcn_mfma_f32_32x32x16_bf16(PAF(0),VFR(0),o[0],0,0,0), C0,0); \
    GAPB(o[1]=__builtin_amdgcn_mfma_f32_32x32x16_bf16(PAF(0),VFR(4),o[1],0,0,0), C0,4); \
    KRD(GL,0); GAPB(o[0]=__builtin_amdgcn_mfma_f32_32x32x16_bf16(PAF(1),VFR(1),o[0],0,0,0), C0,8); \
    KRD(GL,1); GAPB(o[1]=__builtin_amdgcn_mfma_f32_32x32x16_bf16(PAF(1),VFR(5),o[1],0,0,0), C0,12); \
    KRD(GL,2); GAPB(o[0]=__builtin_amdgcn_mfma_f32_32x32x16_bf16(PAF(2),VFR(2),o[0],0,0,0), C1,0); \
    KRD(GL,3); GAPB(o[1]=__builtin_amdgcn_mfma_f32_32x32x16_bf16(PAF(2),VFR(6),o[1],0,0,0), C1,4); \
    GAPB(o[0]=__builtin_amdgcn_mfma_f32_32x32x16_bf16(PAF(3),VFR(3),o[0],0,0,0), C1,8); \
    GAPB(o[1]=__builtin_amdgcn_mfma_f32_32x32x16_bf16(PAF(3),VFR(7),o[1],0,0,0), C1,12); \
    }while(0)
  int t=1;
  #undef CMASK
  #define CMASK(P0,P1,t) do{}while(0)
  for(;t+5<NT;t+=2){
    STEP(pB0,pB1,pA0,pA1,t,true,true,true);     WAIT_BAR(2); RESC(); ROT();
    STEP(pA0,pA1,pB0,pB1,t+1,true,true,true);   WAIT_BAR(2); RESC(); ROT();
  }
  #undef CMASK
  #define CMASK(P0,P1,t) do{int jb_=(t)-(NT-4); if(jb_>=0)cmask(P0,P1,jb_,qrel,hi);}while(0)
  #define ENDW(tt) do{ if((tt)+3<NT){WAIT_BAR(2);} else if((tt)+2<NT){WAIT_BAR(1);} else {WAIT_BAR(0);} }while(0)
  for(;t+1<NT;t+=2){
    STEP(pB0,pB1,pA0,pA1,t,(t+3<NT),(t+1<NT),(t+1<NT));       ENDW(t);   RESC(); ROT();
    STEP(pA0,pA1,pB0,pB1,t+1,(t+4<NT),(t+2<NT),(t+2<NT));     ENDW(t+1); RESC(); ROT();
  }
  STEP(pB0,pB1,pA0,pA1,NT-1,false,false,false); RESC();
  { float sacc=pB0[0]+pB0[1]; _Pragma("unroll") for(int r=2;r<16;++r)sacc+=pB0[r]; _Pragma("unroll") for(int r=0;r<16;++r)sacc+=pB1[r]; l_reg+=sacc;
    pw0=(u32x4){PKW(pB0,0),PKW(pB0,2),PKW(pB0,4),PKW(pB0,6)};pw1=(u32x4){PKW(pB0,8),PKW(pB0,10),PKW(pB0,12),PKW(pB0,14)};pw2=(u32x4){PKW(pB1,0),PKW(pB1,2),PKW(pB1,4),PKW(pB1,6)};pw3=(u32x4){PKW(pB1,8),PKW(pB1,10),PKW(pB1,12),PKW(pB1,14)};
    SBAR(); pv(o,vb0+sl_cur,PAF(0),PAF(1),PAF(2),PAF(3)); }
  #undef PKW
  #undef PAF
  #undef VFR
  #undef PIN
  #undef MX3
  #undef GAPA
  #undef GAPB
  #undef EX
  #undef VRD
  #undef KRD
  #undef STEP
  #undef ENDW
  {auto rr=__builtin_amdgcn_permlane32_swap(__float_as_uint(l_reg),__float_as_uint(l_reg),false,false);l_reg=__uint_as_float(rr[0])+__uint_as_float(rr[1]);}
  if(hi==0)wsf[32+r32]=l_reg;asm volatile("s_waitcnt lgkmcnt(0)":::"memory");
  float rli[16];
  #pragma unroll
  for(int r=0;r<16;++r)rli[r]=__builtin_amdgcn_rcpf(wsf[32+crow(r,hi)]);
  bf16*Ow=Oh+(long)(q0+wid*QBLK)*PO;
  { bf16*stg=(bf16*)(shm+LDS_OST)+wid*2048;
    #pragma unroll
    for(int r=0;r<16;++r){const int orow=crow(r,hi);
      #pragma unroll
      for(int d0=0;d0<2;++d0)stg[orow*64+d0*32+r32]=__float2bfloat16(o[d0][r]*rli[r]);}
    asm volatile("s_waitcnt lgkmcnt(0)":::"memory");
    #pragma unroll
    for(int i=0;i<4;++i){const int row=i*8+(lane>>3),ch=lane&7; const u32x4 v=*(const u32x4*)(stg+row*64+ch*8); ATTN_STORE16(Ow+(long)row*PO+ch*8,v);} }
  asm volatile("s_waitcnt lgkmcnt(0)\n\ts_barrier":::"memory");
  #undef DMA_K
  #undef DMA_V
  #undef CMASK
  #undef START
  #undef RESC
  #undef ROT
}

constexpr int VSLOT=2*SLOTB;
constexpr int L2_K=0, L2_V=NSLOT*SLOTB, L2_WS=L2_V+NSLOT*VSLOT, L2_OST=L2_WS+NW*64*4, L2_BYTES=L2_OST+NW*4096;
__device__ __forceinline__ void pv128(f32x16*o,int vb,bf16x8 pa0,bf16x8 pa1,bf16x8 pa2,bf16x8 pa3){
  #pragma unroll
  for(int d0=0;d0<4;++d0){s16x4 lo[4],hi[4];
    #pragma unroll
    for(int ks=0;ks<4;++ks){
      asm volatile("ds_read_b64_tr_b16 %0,%1 offset:%c2":"=&v"(lo[ks]):"v"(vb),"i"(d0*4096+ks*1024):"memory");
      asm volatile("ds_read_b64_tr_b16 %0,%1 offset:%c2":"=&v"(hi[ks]):"v"(vb),"i"(d0*4096+ks*1024+512):"memory");}
    asm volatile("s_waitcnt lgkmcnt(0)":::"memory");SBAR();
    #define PK(k) (bf16x8){lo[k][0],lo[k][1],lo[k][2],lo[k][3],hi[k][0],hi[k][1],hi[k][2],hi[k][3]}
    o[d0]=__builtin_amdgcn_mfma_f32_32x32x16_bf16(pa0,PK(0),o[d0],0,0,0);
    o[d0]=__builtin_amdgcn_mfma_f32_32x32x16_bf16(pa1,PK(1),o[d0],0,0,0);
    o[d0]=__builtin_amdgcn_mfma_f32_32x32x16_bf16(pa2,PK(2),o[d0],0,0,0);
    o[d0]=__builtin_amdgcn_mfma_f32_32x32x16_bf16(pa3,PK(3),o[d0],0,0,0);
    #undef PK
  }
}
struct AttnNext { bool has; int qb; const bf16* Qh; const bf16* Kh; const bf16* Vh; };
struct AttnCarry { bool primed; int s0; bf16x8 qr[4]; };
template<int THRL,class Post> __device__ __forceinline__ void attn_unit128(int qb,const bf16*Qh,const bf16*__restrict__ Kh,const bf16*__restrict__ Vh,bf16*Oh,char*shm,const Post&post,const AttnNext&nx,AttnCarry&cy){
  const int tid=opaque_tid(),lane=tid&63,r32=lane&31,hi=lane>>5; const int wid=__builtin_amdgcn_readfirstlane(tid>>6);
  const int q0=qb*QB;
  const bf16*Qw=Qh+(long)(q0+wid*QBLK)*PQ;
  const unsigned lds0=(unsigned)(uintptr_t)shm;
  float*wsf=(float*)(shm+L2_WS)+wid*64;
  const bf16*ksrc=Kh+(long)lane*PK+wid*8;
  const bf16*vsrc=Vh+(long)(16*(wid&3)+(lane>>2))*PV+(wid>>2)*32+(lane&3)*8;
  const unsigned kdst=lds0+L2_K+wid*1024, vdst=lds0+L2_V+wid*1024;
  #define DMA_K(t,slot) glds16(ksrc+(long)(t)*KVBLK*PK,(unsigned)__builtin_amdgcn_readfirstlane(kdst+(slot)))
  #define DMA_V(t,slot) do{ glds16(vsrc+(long)(t)*KVBLK*PV,(unsigned)__builtin_amdgcn_readfirstlane(vdst+2*(slot))); glds16(vsrc+(long)(t)*KVBLK*PV+64,(unsigned)__builtin_amdgcn_readfirstlane(vdst+2*(slot)+8192)); }while(0)
  const char*Kbase=shm+L2_K; bf16x8 kf[8];
  const lds_cptr shm3=(lds_cptr)shm; const lds_cptr kp0=shm3+L2_K+hi*1024+r32*16; const lds_cptr vp0=shm3+L2_V+((lane>>4)&1)*32+(lane&3)*8+(4*hi+((lane&15)>>2))*64;
  const int NT=(q0+QB)/KVBLK;
  const bool primed=cy.primed; const int s0=primed?cy.s0:0, s1=(s0==(NSLOT-1)*SLOTB)?0:s0+SLOTB, s2=(s1==(NSLOT-1)*SLOTB)?0:s1+SLOTB;
  bf16x8 (&qr)[4]=cy.qr;
  if(!primed){
    DMA_K(0,s0);DMA_V(0,s0);DMA_K(1,s1);
    #pragma unroll
    for(int d0=0;d0<4;++d0)qr[d0]=*reinterpret_cast<const bf16x8*>(&Qw[(long)r32*PQ+d0*16+hi*8]);
  }
  float mhat=0.f,l_reg=0.f;f32x16 o[4];o[0]=f32x16{};o[1]=f32x16{};o[2]=f32x16{};o[3]=f32x16{};f32x16 negm=f32x16{};asm volatile("":"+v"(negm));
  const int qrel=wid*QBLK+r32;
  #define CMASK(P0,P1,t) do{int jb_=(t)-(NT-4); if(jb_>=0)cmask(P0,P1,jb_,qrel,hi);}while(0)
  bool resc=false;
  #define RESC() do{ if(resc){ asm volatile("s_waitcnt lgkmcnt(0)":::"memory"); \
      _Pragma("unroll") for(int d_=0;d_<4;++d_) _Pragma("unroll") for(int r=0;r<16;++r)o[d_][r]*=wsf[crow(r,hi)]; } }while(0)
  f32x16 c0,c1;
  int sl_prev=s0,sl_cur=s0,sl_next=s1;
  #define ROT() do{sl_prev=sl_cur;sl_cur=sl_next;sl_next=(sl_next==(NSLOT-1)*SLOTB)?0:sl_next+SLOTB;}while(0)
  if(!primed){
    DMA_K(2,s2);
    WAIT_BAR(3);
  }
  qkt(c0,c1,Kbase+s0,qr,negm,r32,hi);asm volatile("s_nop 15\n\ts_nop 7":"+v"(c0),"+v"(c1));CMASK(c0,c1,0);
  u32x4 pw0,pw1,pw2,pw3;
  #define PKW(P,B) cvtpk_s(P[B],P[(B)+1])
  { const float rm=rowmax(c0,c1); mhat=fadd_s(mhat,rm);
    _Pragma("unroll") for(int r=0;r<16;++r){c0[r]=fsub_s(c0[r],rm);c1[r]=fsub_s(c1[r],rm);}
    _Pragma("unroll") for(int r=0;r<16;++r)negm[r]=-mhat; asm volatile("":"+v"(negm));
    _Pragma("unroll") for(int r=0;r<16;++r){c0[r]=__builtin_amdgcn_exp2f(c0[r]);c1[r]=__builtin_amdgcn_exp2f(c1[r]);}
    float sacc=c0[0]+c0[1]; _Pragma("unroll") for(int r=2;r<16;++r)sacc+=c0[r]; _Pragma("unroll") for(int r=0;r<8;++r)sacc+=c1[r]; l_reg+=sacc;
    pw0=(u32x4){PKW(c0,0),PKW(c0,2),PKW(c0,4),PKW(c0,6)};pw1=(u32x4){PKW(c0,8),PKW(c0,10),PKW(c0,12),PKW(c0,14)};pw2=(u32x4){PKW(c1,0),PKW(c1,2),PKW(c1,4),PKW(c1,6)}; }
  WAIT_BAR(0);
  DMA_K(3,s0);DMA_V(1,s1);
  ROT();
  kload8(kf,kp0+sl_cur);
  WAIT_BAR(3);
  s16x4 vlo[8],vhi[8];
  #define PAF(k) __builtin_bit_cast(bf16x8,pw##k)
  #define VFR(i) (bf16x8){vlo[i][0],vlo[i][1],vlo[i][2],vlo[i][3],vhi[i][0],vhi[i][1],vhi[i][2],vhi[i][3]}
  #define PIN(x) asm volatile("":"+v"(x))
  #define MX3(a,b,c) __builtin_fmaxf(__builtin_fmaxf((a),(b)),(c))
  #define EX(v) __builtin_amdgcn_exp2f(v)
  #define VRDF(sl,db,ks) do{ vlo[sl]=vtr(vp_+((db)*4096+(ks)*1024)); vhi[sl]=vtr(vp_+((db)*4096+(ks)*1024+512)); }while(0)
  #define KRD(G,j) do{ if(G){ kload2(kf,kp0+sl_next,j); SBAR(); } }while(0)
  #define MFQ(C,KF,Q,CIN) C=__builtin_amdgcn_mfma_f32_32x32x16_bf16(KF,Q,CIN,0,0,0)
  #define MFO(DB,KS,SL) o[DB]=__builtin_amdgcn_mfma_f32_32x32x16_bf16(PAF(KS),VFR(SL),o[DB],0,0,0)
  #define EX2(X,B) do{ X[B]=EX(X[B]); X[(B)+1]=EX(X[(B)+1]); PIN(X); }while(0)
  #define SPK(Y,PB,PW,W) do{ sacc+=Y[PB]; sacc+=Y[(PB)+1]; PIN(sacc); PW[W]=PKW(Y,PB); PIN(PW); }while(0)
  #define STEP(t,GK,GV,GL) do{ SBAR(); \
    const lds_cptr vp_=vp0+2*sl_prev; float sacc; \
    VRDF(0,0,0); SBAR(); MFQ(c0,kf[0],qr[0],negm); sacc=(c1[8]+c1[9]); sacc+=c1[10]; sacc+=c1[11]; sacc+=c1[12]; sacc+=c1[13]; sacc+=c1[14]; sacc+=c1[15]; PIN(sacc); \
                         pw3[0]=PKW(c1,8); pw3[1]=PKW(c1,10); pw3[2]=PKW(c1,12); pw3[3]=PKW(c1,14); PIN(pw3); SBAR(); \
    VRDF(1,1,0); SBAR(); MFQ(c1,kf[1],qr[0],negm); SBAR(); \
    VRDF(2,2,0); SBAR(); MFQ(c0,kf[2],qr[1],c0); SBAR(); \
    VRDF(3,3,0); SBAR(); MFQ(c1,kf[3],qr[1],c1); SBAR(); \
    VRDF(4,0,1); SBAR(); MFQ(c0,kf[4],qr[2],c0); SBAR(); \
    VRDF(5,1,1); SBAR(); MFQ(c1,kf[5],qr[2],c1); SBAR(); \
    VRDF(6,2,1); SBAR(); MFQ(c0,kf[6],qr[3],c0); SBAR(); \
    VRDF(7,3,1); SBAR(); MFQ(c1,kf[7],qr[3],c1); SBAR(); \
    l_reg+=sacc; sacc=0.f; \
    if(GK){DMA_K((t)+3,sl_cur);} if(GV){DMA_V((t)+1,sl_next);} \
    CMASK(c0,c1,t); \
    { float a=MX3(c0[0],c0[1],c1[0]),b=MX3(c0[2],c0[3],c1[1]); a=MX3(a,c1[2],c1[3]); \
      _Pragma("unroll") for(int r=4;r<16;r+=4){a=MX3(a,c0[r],c0[r+1]);b=MX3(b,c0[r+2],c0[r+3]);a=MX3(a,c1[r],c1[r+1]);b=MX3(b,c1[r+2],c1[r+3]);} \
      float rm=__builtin_fmaxf(a,b); { auto rr=__builtin_amdgcn_permlane32_swap(__float_as_uint(rm),__float_as_uint(rm),false,false); rm=__builtin_fmaxf(__uint_as_float(rr[0]),__uint_as_float(rr[1])); } \
      resc=false; \
      if(__builtin_expect(__any(rm>(float)THRL),0)){ const float dl=__builtin_fmaxf(rm,0.f); mhat+=dl; \
        _Pragma("unroll") for(int r=0;r<16;++r){c0[r]-=dl;c1[r]-=dl;} \
        _Pragma("unroll") for(int r=0;r<16;++r)negm[r]=-mhat; asm volatile("":"+v"(negm)); \
        const float f=__builtin_amdgcn_exp2f(-dl); l_reg*=f; if(hi==0)wsf[r32]=f; resc=true; } } \
    SBAR(); \
    MFO(0,0,0); VRDF(0,0,2); EX2(c0,0);  SBAR(); \
    MFO(1,0,1); VRDF(1,1,2); EX2(c0,2);  SBAR(); \
    MFO(2,0,2); VRDF(2,2,2); EX2(c0,4);  SBAR(); \
    MFO(3,0,3); VRDF(3,3,2); EX2(c0,6);  SBAR(); \
    MFO(0,1,4); VRDF(4,0,3); EX2(c0,8);  SPK(c0,0,pw0,0); SBAR(); \
    MFO(1,1,5); VRDF(5,1,3); EX2(c0,10); SPK(c0,2,pw0,1); SBAR(); \
    MFO(2,1,6); VRDF(6,2,3); EX2(c0,12); SPK(c0,4,pw0,2); SBAR(); \
    MFO(3,1,7); VRDF(7,3,3); EX2(c0,14); SPK(c0,6,pw0,3); SBAR(); \
    KRD(GL,0); MFO(0,2,0); EX2(c1,0);  SPK(c0,8,pw1,0);  SBAR(); \
    KRD(GL,1); MFO(1,2,1); EX2(c1,2);  SPK(c0,10,pw1,1); SBAR(); \
    KRD(GL,2); MFO(2,2,2); EX2(c1,4);  SPK(c0,12,pw1,2); SBAR(); \
    KRD(GL,3); MFO(3,2,3); EX2(c1,6);  SPK(c0,14,pw1,3); SBAR(); \
    MFO(0,3,4); EX2(c1,8);  SPK(c1,0,pw2,0); SBAR(); \
    MFO(1,3,5); EX2(c1,10); SPK(c1,2,pw2,1); SBAR(); \
    MFO(2,3,6); EX2(c1,12); SPK(c1,4,pw2,2); SBAR(); \
    MFO(3,3,7); EX2(c1,14); SPK(c1,6,pw2,3); SBAR(); \
    l_reg+=sacc; \
    }while(0)
  int t=1;
  #undef CMASK
  #define CMASK(P0,P1,t) do{}while(0)
  for(;t+4<NT;++t){ STEP(t,true,true,true); WAIT_BAR(3); RESC(); ROT(); }
  #undef CMASK
  #define CMASK(P0,P1,t) do{int jb_=(t)-(NT-4); if(jb_>=0)cmask(P0,P1,jb_,qrel,hi);}while(0)
  const bool hn=nx.has;
  const long kadj=hn?(long)(nx.Kh-Kh)-(long)NT*KVBLK*PK:0L, vadj=hn?(long)(nx.Vh-Vh)-(long)NT*KVBLK*PV:0L;
  #undef DMA_K
  #undef DMA_V
  #define DMA_K(t,slot) glds16(ksrc+(long)(t)*KVBLK*PK+(((t)>=NT)?kadj:0L),(unsigned)__builtin_amdgcn_readfirstlane(kdst+(slot)))
  #define DMA_V(t,slot) do{ const bf16*vs_=vsrc+(long)(t)*KVBLK*PV+(((t)>=NT)?vadj:0L); glds16(vs_,(unsigned)__builtin_amdgcn_readfirstlane(vdst+2*(slot))); glds16(vs_+64,(unsigned)__builtin_amdgcn_readfirstlane(vdst+2*(slot)+8192)); }while(0)
  #define ENDW(tt) do{ if(hn||(tt)+3<NT){WAIT_BAR(3);} else if((tt)+2<NT){WAIT_BAR(2);} else {WAIT_BAR(0);} }while(0)
  for(;t+1<NT;++t){ STEP(t,(hn||t+3<NT),true,true); ENDW(t); RESC(); ROT(); }
  STEP(NT-1,hn,hn,false);
  if(hn){
    const bf16*QwN=nx.Qh+(long)(nx.qb*QB+wid*QBLK)*PQ;
    #pragma unroll
    for(int d0=0;d0<4;++d0)qr[d0]=*reinterpret_cast<const bf16x8*>(&QwN[(long)r32*PQ+d0*16+hi*8]);
    WAIT_BAR(7);
  }
  cy.primed=hn; cy.s0=sl_next;
  RESC();
  { float sacc=(c1[8]+c1[9]); _Pragma("unroll") for(int r=10;r<16;++r)sacc+=c1[r]; l_reg+=sacc;
    pw3=(u32x4){PKW(c1,8),PKW(c1,10),PKW(c1,12),PKW(c1,14)};
    SBAR(); pv128(o,(int)(unsigned)(uintptr_t)vp0+2*sl_cur,PAF(0),PAF(1),PAF(2),PAF(3)); }
  #undef PKW
  #undef PAF
  #undef VFR
  #undef PIN
  #undef MX3
  #undef EX
  #undef VRDF
  #undef KRD
  #undef MFQ
  #undef MFO
  #undef EX2
  #undef SPK
  #undef STEP
  #undef ENDW
  {auto rr=__builtin_amdgcn_permlane32_swap(__float_as_uint(l_reg),__float_as_uint(l_reg),false,false);l_reg=__uint_as_float(rr[0])+__uint_as_float(rr[1]);}
  if(hi==0)wsf[32+r32]=l_reg;asm volatile("s_waitcnt lgkmcnt(0)":::"memory");
  float rli[16];
  #pragma unroll
  for(int r=0;r<16;++r)rli[r]=__builtin_amdgcn_rcpf(wsf[32+crow(r,hi)]);
  if(post.on){
    asm volatile("s_waitcnt lgkmcnt(0)\n\ts_barrier":::"memory");
    const int so=__builtin_amdgcn_readfirstlane((wid<4)?(L2_OST+wid*8192):(L2_V+2*((wid<6)?sl_prev:sl_cur)+(wid&1)*8192));
    bf16*stg=(bf16*)(shm+so);
    #pragma unroll
    for(int r=0;r<16;++r){const int orow=crow(r,hi);
      #pragma unroll
      for(int d0=0;d0<4;++d0)stg[orow*128+d0*32+r32]=__float2bfloat16(o[d0][r]*rli[r]);}
    asm volatile("s_waitcnt lgkmcnt(0)":::"memory");
    post.run((lds_cptr)shm+so,q0+wid*QBLK,lane);
  } else {
  bf16*Ow=Oh+(long)(q0+wid*QBLK)*PO;
  { bf16*stg=(bf16*)(shm+L2_OST)+wid*2048;
    #pragma unroll
    for(int h2=0;h2<2;++h2){
      #pragma unroll
      for(int r=0;r<16;++r){const int orow=crow(r,hi);
        #pragma unroll
        for(int d0=0;d0<2;++d0)stg[orow*64+d0*32+r32]=__float2bfloat16(o[2*h2+d0][r]*rli[r]);}
      asm volatile("s_waitcnt lgkmcnt(0)":::"memory");
      #pragma unroll
      for(int i=0;i<4;++i){const int row=i*8+(lane>>3),ch=lane&7; const u32x4 v=*(const u32x4*)(stg+row*64+ch*8); ATTN_STORE16(Ow+(long)row*PO+h2*64+ch*8,v);}
      asm volatile("s_waitcnt lgkmcnt(0)":::"memory"); } }
  }
  asm volatile("s_waitcnt lgkmcnt(0)\n\ts_barrier":::"memory");
  #undef DMA_K
  #undef DMA_V
  #undef CMASK
  #undef RESC
  #undef ROT
}
constexpr int ATTN_LDS_BYTES=L2_BYTES;
#undef SBAR
#undef WAIT_BAR
}

constexpr int NWAVES = 8;
constexpr size_t MiB = 1u << 20;
constexpr size_t WS_CTL = 0, CTL_ZERO_BYTES = 1 * MiB;
constexpr size_t WS_ROPEC = 1 * MiB, WS_ROPES = WS_ROPEC + 256 * 1024;
constexpr size_t WS_ROUTE = 2 * MiB;
constexpr int ECAP = M, ECAP_LOG = 14;
static_assert((1 << ECAP_LOG) == ECAP, "ECAP");
constexpr size_t RT_SLOTOF = 0, RT_WSLOT = 128 * 1024, RT_SSSLOT = 1024 * 1024;
constexpr size_t WS_SS = 6 * MiB;
constexpr size_t WS_WIN = 10 * MiB;
constexpr size_t WS_WOUT = WS_WIN + 64 * MiB;
constexpr size_t WS_WGU = WS_WOUT + 8 * MiB;
constexpr size_t WS_WD = WS_WGU + 22 * MiB;
constexpr size_t WS_WEGU = WS_WD + 11 * MiB;
constexpr size_t WS_WED = WS_WEGU + 224 * MiB;
constexpr size_t WS_XB = WS_WED + 112 * MiB;
constexpr size_t WS_PROJ = WS_XB + 32 * MiB;
constexpr size_t WS_O = WS_PROJ + 256 * MiB;
constexpr size_t WS_MIX = WS_O + 64 * MiB;
constexpr size_t WS_Y = WS_MIX + 32 * MiB;
constexpr size_t WS_END = WS_Y + 68 * MiB;
static_assert((size_t)MSLOT * DFFE * 2 <= 256 * MiB && (size_t)MSLOT * 1024 * 2 <= 68 * MiB && (size_t)MSLOT * 1024 * 2 <= 96 * MiB, "overlays");
static_assert((size_t)NEXP * ECAP * 4 <= 896 * 1024 && RT_SSSLOT + (size_t)NEXP * ECAP * 16 <= 4 * MiB && (size_t)9 * M * 16 <= 4 * MiB && (size_t)NEXP * ECAP * 1024 <= 164 * MiB, "routing / ss map; sparse expert inputs overlay O | MIX | Y");
constexpr int CW_TMO = 0, CW_CODE = 1;
constexpr int CW_BAR = 4096;
constexpr int CW_GCNT = 16384;

constexpr int RING_OFF = 0, RING_BYTES = 131072;
constexpr int LDSCTL_OFF = RING_BYTES, MISC_OFF = LDSCTL_OFF + 320;
constexpr int LDS_BYTES = 163840;
static_assert(MISC_OFF + 128 <= LDS_BYTES, "LDS map");

#define GAS __attribute__((address_space(1)))
#define LAS __attribute__((address_space(3)))
typedef unsigned short bf16;
typedef unsigned v4u __attribute__((ext_vector_type(4)));
typedef unsigned v2u __attribute__((ext_vector_type(2)));
typedef float f32x4 __attribute__((ext_vector_type(4)));
typedef GAS unsigned gu32;
#define RLX_AGENT __ATOMIC_RELAXED, __HIP_MEMORY_SCOPE_AGENT
#define LDS_WAIT() asm volatile("s_waitcnt lgkmcnt(0)" ::: "memory")
#define VM_WAIT() asm volatile("s_waitcnt vmcnt(0)" ::: "memory")
__device__ __forceinline__ unsigned f2bf(float f) { unsigned u = __builtin_bit_cast(unsigned, f); return (u + 0x7fffu + ((u >> 16) & 1u)) >> 16; }
__device__ __forceinline__ unsigned pk2(float lo, float hi) { return f2bf(lo) | (f2bf(hi) << 16); }
__device__ __forceinline__ float bflo(unsigned w) { return __uint_as_float(w << 16); }
__device__ __forceinline__ float bfhi(unsigned w) { return __uint_as_float(w & 0xffff0000u); }

#define XB_TMO      128
#define XB_XCNT(j)  (256  + 64 * (j))
#define XB_XSUB(j)  (1280 + 64 * (j))
#define XB_XGEN(j)  (2304 + 64 * (j))
#define XB_TOP      3328
#define XB_TOPGEN   3392
#define XCD_BAR_WORDS 3456
#define XB_SPIN_CAP (1u << 18)
__device__ __forceinline__ unsigned xb_ld(unsigned* p)              { return __hip_atomic_load(p, __ATOMIC_RELAXED, __HIP_MEMORY_SCOPE_AGENT); }
__device__ __forceinline__ unsigned xb_add(unsigned* p, unsigned v) { return __hip_atomic_fetch_add(p, v, __ATOMIC_RELAXED, __HIP_MEMORY_SCOPE_AGENT); }
__device__ __forceinline__ unsigned xb_xcc_id() { return (unsigned)__builtin_amdgcn_s_getreg((3 << 11) | 20) & 0xFu; }
#define XB_SPIN(cond, bar) do { unsigned _sp = 0; while (cond) { __builtin_amdgcn_s_sleep(1); \
    if ((++_sp & 255u) == 0u) { if (xb_ld(&(bar)[XB_TMO])) break; if (_sp > XB_SPIN_CAP) { atomicAdd(&(bar)[XB_TMO], 1u); break; } } } } while (0)
struct XcdBarrier { unsigned* bar; unsigned x; volatile LAS unsigned* st; };
__device__ __forceinline__ XcdBarrier xcd_barrier_post(unsigned* bar, volatile LAS unsigned* st) {
    XcdBarrier b; b.bar = bar; b.x = xb_xcc_id(); b.st = st;
    if (threadIdx.x == 0) (void)xb_add(&bar[XB_XCNT(b.x)], 1u);
    return b;
}
__device__ __forceinline__ void xcd_barrier_complete(unsigned* bar, unsigned x, unsigned& nloc, unsigned& nx) {
    const unsigned G = gridDim.x * gridDim.y * gridDim.z;
    unsigned sum, cnt, mine, sp = 0u;
    for (;;) {
        sum = 0u; cnt = 0u; mine = 0u;
#pragma unroll
        for (unsigned j = 0; j < 16; ++j) { const unsigned c = xb_ld(&bar[XB_XCNT(j)]); sum += c; cnt += (c > 0u) ? 1u : 0u; mine = (j == x) ? c : mine; }
        if (sum == G) break;
        __builtin_amdgcn_s_sleep(1);
        if ((++sp & 255u) == 0u) { if (xb_ld(&bar[XB_TMO])) break; if (sp > XB_SPIN_CAP) { atomicAdd(&bar[XB_TMO], 1u); break; } }
    }
    nloc = mine > 0u ? mine : 1u; nx = cnt > 0u ? cnt : 1u;
}
__device__ __forceinline__ void xcd_barrier(const XcdBarrier& b) {
    asm volatile("s_waitcnt vmcnt(0)" ::: "memory");
    __syncthreads();
    if (threadIdx.x == 0) {
        unsigned* bar = b.bar;
        __builtin_amdgcn_s_waitcnt(0);
        unsigned nloc = b.st[0], nx = b.st[1];
        if (nloc == 0u) { xcd_barrier_complete(bar, b.x, nloc, nx); b.st[0] = nloc; b.st[1] = nx; }
        const unsigned old = xb_add(&bar[XB_XSUB(b.x)], 1u);
        const unsigned gen = old / nloc;
        if (old + 1u == (gen + 1u) * nloc) {
            __builtin_amdgcn_fence(__ATOMIC_RELEASE, "agent");
            asm volatile("s_waitcnt vmcnt(0)" ::: "memory");
            const unsigned og = xb_add(&bar[XB_TOP], 1u);
            const unsigned tg = og / nx;
            if (og + 1u == (tg + 1u) * nx) xb_add(&bar[XB_TOPGEN], 1u);
            else XB_SPIN(xb_ld(&bar[XB_TOPGEN]) == tg, bar);
            __builtin_amdgcn_fence(__ATOMIC_ACQUIRE, "agent");
            xb_add(&bar[XB_XGEN(b.x)], 1u);
            asm volatile("s_waitcnt vmcnt(0)" ::: "memory");
        } else {
            XB_SPIN(xb_ld(&bar[XB_XGEN(b.x)]) == gen, bar);
            __builtin_amdgcn_fence(__ATOMIC_ACQUIRE, "agent");
            asm volatile("s_waitcnt vmcnt(0)" ::: "memory");
        }
    }
    __syncthreads();
}

struct Args { const float* in[19]; float* out; unsigned char* ws; int ph_lo, ph_hi; };
static_assert(sizeof(Args) == 19 * 8 + 8 + 8 + 8, "Args has no padding");

typedef const __attribute__((address_space(4))) Args* kargs_t;
#define KARGS() ({ kargs_t p_ = (kargs_t)__builtin_amdgcn_kernarg_segment_ptr(); asm volatile("" : "+s"(p_)); p_; })
struct Frame {
    LAS unsigned char* lds;
    int tid, lane, wave;
    int vcu, G;
    unsigned char* ws;
    gu32* ctl;
    float* X;
};
__device__ __forceinline__ Frame make_frame(kargs_t ap) {
    extern __shared__ __attribute__((aligned(16))) unsigned char lds[];
    Frame F; F.lds = (LAS unsigned char*)lds; F.tid = opaque_tid(); F.lane = F.tid & 63; F.wave = __builtin_amdgcn_readfirstlane(F.tid >> 6);
    F.G = opaque_grid(); { const int bx = opaque_bid(); F.vcu = (F.G % 8 == 0) ? (bx % 8) * (F.G / 8) + bx / 8 : bx; }
    F.ws = ap->ws; F.ctl = (gu32*)(F.ws + WS_CTL); F.X = ap->out; return F;
}

__device__ __forceinline__ float wave_sum(float v) {
#pragma unroll
    for (int o = 1; o < 64; o <<= 1) v += __shfl_xor(v, o);
    return v;
}

template <int KIND>
__device__ __forceinline__ int rowmap(int n) {
    if (KIND == 1) {
        if (n < 3072) return n;
        if (n < 4096) { const int c = n - 3072; return (20 + (c >> 7)) * 256 + ((c & 127) >> 5) * 64 + (c & 31); }
        if (n < 5120) { const int c = n - 4096; return (12 + (c >> 7)) * 256 + ((c & 127) >> 5) * 64 + (c & 31); }
        if (n < 6144) { const int c = n - 5120; return (12 + (c >> 7)) * 256 + ((c & 127) >> 5) * 64 + 32 + (c & 31); }
        if (n < 7168) { return 28 * 256 + (n - 6144); }
        { const int c = n - 7168; return (20 + (c >> 7)) * 256 + ((c & 127) >> 5) * 64 + 32 + (c & 31); }
    }
    if (KIND == 2) return (n >> 7) * 256 + ((n & 127) >> 5) * 64 + (n & 31);
    if (KIND == 3) return (n >> 7) * 256 + ((n & 127) >> 5) * 64 + 32 + (n & 31);
    return n;
}
__device__ __forceinline__ void cvt_ld(const float* __restrict__ W, int N, int item, int lane, f32x4 (&v)[8]) {
    const int nblk = N >> 5, kb = item / nblk, nb = item - kb * nblk;
    const int l8 = lane & 7, kg = lane >> 3;
    const int k0 = kb * 64 + kg * 8, n0 = nb * 32 + l8 * 4;
#pragma unroll
    for (int r = 0; r < 8; ++r) v[r] = *(const GAS f32x4*)(W + (size_t)(k0 + r) * N + n0);
}
template <int KIND>
__device__ __forceinline__ void cvt_st(int K, int N, const float* __restrict__ gain, bf16* __restrict__ WT, int item, int lane, f32x4 (&v)[8]) {
    const int nblk = N >> 5, kb = item / nblk, nb = item - kb * nblk;
    const int l8 = lane & 7, kg = lane >> 3;
    const int k0 = kb * 64 + kg * 8, n0 = nb * 32 + l8 * 4;
    if (gain) {
        const f32x4 g0 = *(const GAS f32x4*)(gain + k0), g1 = *(const GAS f32x4*)(gain + k0 + 4);
#pragma unroll
        for (int r = 0; r < 4; ++r) { v[r] = v[r] * g0[r]; v[r + 4] = v[r + 4] * g1[r]; }
    }
#pragma unroll
    for (int i = 0; i < 4; ++i) {
        v4u o; o.x = pk2(v[0][i], v[1][i]); o.y = pk2(v[2][i], v[3][i]); o.z = pk2(v[4][i], v[5][i]); o.w = pk2(v[6][i], v[7][i]);
        st16_wt((void*)(WT + (size_t)rowmap<KIND>(n0 + i) * K + k0), o);
    }
}

__device__ __forceinline__ void cvt_ld_f8(const float* __restrict__ W, int N, int item, int lane, f32x4 (&v)[16]) {
    const int nblk = N >> 5, kb = item / nblk, nb = item - kb * nblk;
    const int l8 = lane & 7, kg = lane >> 3;
    const int k0 = kb * 128 + kg * 16, n0 = nb * 32 + l8 * 4;
#pragma unroll
    for (int r = 0; r < 16; ++r) v[r] = __builtin_nontemporal_load((const GAS f32x4*)(W + (size_t)(k0 + r) * N + n0));
}
template <int KIND>
__device__ __forceinline__ void cvt_st_f8(int K, int N, const float* __restrict__ gain, unsigned char* __restrict__ WT, int item, int lane, f32x4 (&v)[16]) {
    const int nblk = N >> 5, kb = item / nblk, nb = item - kb * nblk;
    const int l8 = lane & 7, kg = lane >> 3;
    const int k0 = kb * 128 + kg * 16, n0 = nb * 32 + l8 * 4;
#pragma unroll
    for (int q = 0; q < 4; ++q) { f32x4 g = {256.f, 256.f, 256.f, 256.f}; if (gain) g = *(const GAS f32x4*)(gain + k0 + 4 * q) * 256.f;
#pragma unroll
        for (int r = 0; r < 4; ++r) v[4 * q + r] = v[4 * q + r] * g[r]; }
#pragma unroll
    for (int i = 0; i < 4; ++i) {
        v4u o;
#pragma unroll
        for (int q = 0; q < 4; ++q) { unsigned w = 0u;
            w = __builtin_amdgcn_cvt_pk_fp8_f32(pg8::clamp448(v[4 * q][i]), pg8::clamp448(v[4 * q + 1][i]), w, false);
            w = __builtin_amdgcn_cvt_pk_fp8_f32(pg8::clamp448(v[4 * q + 2][i]), pg8::clamp448(v[4 * q + 3][i]), w, true); o[q] = w; }
        st16_wt((void*)(WT + (size_t)rowmap<KIND>(n0 + i) * K + k0), o);
    }
}

template <int KIND>
__device__ __forceinline__ void cvt_st_b16(int K, int N, const float* __restrict__ gain, bf16* __restrict__ WT, int item, int lane, f32x4 (&v)[16]) {
    const int nblk = N >> 5, kb = item / nblk, nb = item - kb * nblk;
    const int l8 = lane & 7, kg = lane >> 3;
    const int k0 = kb * 128 + kg * 16, n0 = nb * 32 + l8 * 4;
    if (gain) {
#pragma unroll
        for (int q = 0; q < 4; ++q) { const f32x4 g = *(const GAS f32x4*)(gain + k0 + 4 * q);
#pragma unroll
            for (int r = 0; r < 4; ++r) v[4 * q + r] = v[4 * q + r] * g[r]; } }
#pragma unroll
    for (int i = 0; i < 4; ++i) {
        v4u o0, o1; o0.x = pk2(v[0][i], v[1][i]); o0.y = pk2(v[2][i], v[3][i]); o0.z = pk2(v[4][i], v[5][i]); o0.w = pk2(v[6][i], v[7][i]);
        o1.x = pk2(v[8][i], v[9][i]); o1.y = pk2(v[10][i], v[11][i]); o1.z = pk2(v[12][i], v[13][i]); o1.w = pk2(v[14][i], v[15][i]);
        bf16* q = WT + (size_t)rowmap<KIND>(n0 + i) * K + k0;
        *(GAS v4u*)q = o0; *(GAS v4u*)(q + 8) = o1;
    }
}

template <int KIND>
__device__ __forceinline__ void cvt_run(const float* __restrict__ W, int K, int N, const float* __restrict__ gain, bf16* __restrict__ WT, int it0, int NI, int nranks, int lane) {
    constexpr int NP = 4;
    for (int it = it0; it < NI; it += NP * nranks) {
        f32x4 v[NP][8];
#pragma unroll
        for (int q = 0; q < NP; ++q) { const int ii = it + q * nranks; if (ii < NI) cvt_ld(W, N, ii, lane, v[q]); }
        asm volatile("" ::: "memory");
#pragma unroll
        for (int q = 0; q < NP; ++q) { const int ii = it + q * nranks; if (ii < NI) cvt_st<KIND>(K, N, gain, WT, ii, lane, v[q]); }
    }
}
template <int KIND>
__device__ __forceinline__ void cvt_run_f8(const float* __restrict__ W, int K, int N, const float* __restrict__ gain, unsigned char* __restrict__ WT, int it0, int NI, int nranks, int lane) {
    constexpr int NP = 2;
    for (int it = it0; it < NI; it += NP * nranks) {
        f32x4 v[NP][16];
#pragma unroll
        for (int q = 0; q < NP; ++q) { const int ii = it + q * nranks; if (ii < NI) cvt_ld_f8(W, N, ii, lane, v[q]); }
        asm volatile("" ::: "memory");
#pragma unroll
        for (int q = 0; q < NP; ++q) { const int ii = it + q * nranks; if (ii < NI) cvt_st_f8<KIND>(K, N, gain, WT, ii, lane, v[q]); }
    }
}

__device__ __forceinline__ void convert_group(kargs_t A, unsigned char* ws, int grp, int rank, int nranks, int lane) {
    constexpr int I_IN = (DM / 128) * (IN_W / 32), I_OUT = (DM / 128) * (DM / 32), I_G = (DM / 128) * (DFF / 32), I_D = (DFF / 128) * (DM / 32), I_EG = (DM / 128) * (DFFE / 32), I_ED = (DFFE / 128) * (DM / 32);
    const int in_n = (grp < 4) ? 1 : 0, d_n = (grp == 1 || grp == 2) ? 1 : 0, e_lo = (grp - 1) * 4, e_n = (grp >= 1) ? 4 : 0;
    const int c0 = in_n * I_IN, c1 = c0 + in_n * I_OUT, c2 = c1 + d_n * I_G, c3 = c2 + d_n * I_G, c4 = c3 + d_n * I_D, c5 = c4 + e_n * I_EG, c6 = c5 + e_n * I_EG, c7 = c6 + e_n * I_ED;
    const int j = grp, jd = grp - 1;
    for (int it = rank; it < c7; it += 2 * nranks) {
        f32x4 v[2][16];
#pragma unroll
        for (int q = 0; q < 2; ++q) { const int ii = it + q * nranks;
            if (ii < c7) { const float* W; int N, r;
                if (ii < c0) { W = A->in[2] + (size_t)j * DM * IN_W; N = IN_W; r = ii; }
                else if (ii < c1) { W = A->in[9] + (size_t)j * DM * DM; N = DM; r = ii - c0; }
                else if (ii < c2) { W = A->in[11] + (size_t)jd * DM * DFF; N = DFF; r = ii - c1; }
                else if (ii < c3) { W = A->in[12] + (size_t)jd * DM * DFF; N = DFF; r = ii - c2; }
                else if (ii < c4) { W = A->in[13] + (size_t)jd * DFF * DM; N = DM; r = ii - c3; }
                else if (ii < c5) { const int rr = ii - c4, jj = rr / I_EG; r = rr - jj * I_EG; W = A->in[15] + (size_t)(e_lo + jj) * DM * DFFE; N = DFFE; }
                else if (ii < c6) { const int rr = ii - c5, jj = rr / I_EG; r = rr - jj * I_EG; W = A->in[16] + (size_t)(e_lo + jj) * DM * DFFE; N = DFFE; }
                else { const int rr = ii - c6, jj = rr / I_ED; r = rr - jj * I_ED; W = A->in[17] + (size_t)(e_lo + jj) * DFFE * DM; N = DM; }
                cvt_ld_f8(W, N, r, lane, v[q]); } }
        asm volatile("" ::: "memory");
#pragma unroll
        for (int q = 0; q < 2; ++q) { const int ii = it + q * nranks;
            if (ii < c7) {
                if (ii < c0) { const int r = ii;
                    if (INPROJ_F8(j)) cvt_st_f8<1>(DM, IN_W, A->in[1] + j * DM, (unsigned char*)(ws + WS_WIN) + (size_t)j * IN_W * DM * 2, r, lane, v[q]);
                    else cvt_st_b16<1>(DM, IN_W, A->in[1] + j * DM, (bf16*)(ws + WS_WIN) + (size_t)j * IN_W * DM, r, lane, v[q]); }
                else if (ii < c1) cvt_st_b16<0>(DM, DM, nullptr, (bf16*)(ws + WS_WOUT) + (size_t)j * DM * DM, ii - c0, lane, v[q]);
                else if (ii < c2) { const int r = ii - c1;
                    if (DENSE_F8(jd)) cvt_st_f8<2>(DM, DFF, A->in[10] + (2 * jd) * DM, (unsigned char*)(ws + WS_WGU) + (size_t)jd * 2 * DFF * DM * 2, r, lane, v[q]);
                    else cvt_st_b16<2>(DM, DFF, A->in[10] + (2 * jd) * DM, (bf16*)(ws + WS_WGU) + (size_t)jd * 2 * DFF * DM, r, lane, v[q]); }
                else if (ii < c3) { const int r = ii - c2;
                    if (DENSE_F8(jd)) cvt_st_f8<3>(DM, DFF, A->in[10] + (2 * jd) * DM, (unsigned char*)(ws + WS_WGU) + (size_t)jd * 2 * DFF * DM * 2, r, lane, v[q]);
                    else cvt_st_b16<3>(DM, DFF, A->in[10] + (2 * jd) * DM, (bf16*)(ws + WS_WGU) + (size_t)jd * 2 * DFF * DM, r, lane, v[q]); }
                else if (ii < c4) { const int r = ii - c3;
                    if (DENSE_DN_F8(jd)) cvt_st_f8<0>(DFF, DM, nullptr, (unsigned char*)(ws + WS_WD) + (size_t)jd * DM * DFF * 2, r, lane, v[q]);
                    else cvt_st_b16<0>(DFF, DM, nullptr, (bf16*)(ws + WS_WD) + (size_t)jd * DM * DFF, r, lane, v[q]); }
                else if (ii < c5) { const int rr = ii - c4, jj = rr / I_EG, r = rr - jj * I_EG, je = e_lo + jj;
                    cvt_st_f8<2>(DM, DFFE, A->in[10] + (2 * (je >> 3) + 1) * DM, (unsigned char*)(ws + WS_WEGU) + (size_t)je * 2 * DFFE * DM, r, lane, v[q]); }
                else if (ii < c6) { const int rr = ii - c5, jj = rr / I_EG, r = rr - jj * I_EG, je = e_lo + jj;
                    cvt_st_f8<3>(DM, DFFE, A->in[10] + (2 * (je >> 3) + 1) * DM, (unsigned char*)(ws + WS_WEGU) + (size_t)je * 2 * DFFE * DM, r, lane, v[q]); }
                else { const int rr = ii - c6, jj = rr / I_ED, r = rr - jj * I_ED, je = e_lo + jj;
                    cvt_st_f8<0>(DFFE, DM, nullptr, (unsigned char*)(ws + WS_WED) + (size_t)je * DM * DFFE, r, lane, v[q]); } } }
    }
}
__device__ __forceinline__ void p0_prologue() {
    const kargs_t A = KARGS(); Frame F = make_frame(A);
    const int gw = F.vcu * NWAVES + F.wave, NGW = F.G * NWAVES, lane = F.lane;
    unsigned char* ws = F.ws;
    convert_group(A, ws, 0, gw, NGW, lane);
    { float* rc = (float*)(ws + WS_ROPEC); float* rs = (float*)(ws + WS_ROPES);
      for (int idx = (F.vcu * NWAVES + F.wave) * 64 + lane; idx < SEQ * 32; idx += NGW * 64) {
          const int pos = idx >> 5, i = idx & 31;
          const float inv = __builtin_amdgcn_exp2f(-(float)i * 0.4152410118609203f);
          const float ang = (float)pos * inv;
          const double rev = (double)ang * 0.15915494309189535; const float fr = (float)(rev - __builtin_rint(rev));
          rc[idx] = __builtin_amdgcn_cosf(fr); rs[idx] = __builtin_amdgcn_sinf(fr); } }
    { const float* x = A->in[0]; float* ss = (float*)(ws + WS_SS); bf16* xb = (bf16*)(ws + WS_XB);
      for (int m0 = gw * 4; m0 < M; m0 += NGW * 4) {
          f32x4 v[4][4];
#pragma unroll
          for (int r = 0; r < 4; ++r) { const GAS f32x4* xr = (const GAS f32x4*)(x + (size_t)(m0 + r) * DM) + lane;
#pragma unroll
              for (int j = 0; j < 4; ++j) v[r][j] = xr[64 * j]; }
#pragma unroll
          for (int r = 0; r < 4; ++r) { const int m = m0 + r; GAS v2u* o8 = (GAS v2u*)(xb + (size_t)m * DM) + lane; float s = 0.f;
#pragma unroll
              for (int j = 0; j < 4; ++j) { const f32x4 q = v[r][j]; s += (q.x * q.x + q.y * q.y) + (q.z * q.z + q.w * q.w); v2u w; w.x = pk2(q.x, q.y); w.y = pk2(q.z, q.w); st8_wt((void*)(o8 + 64 * j), w); }
              s = wave_sum(s); if (lane == 0) *(GAS f32x4*)(ss + 4 * (size_t)m) = (f32x4){s, 0.f, 0.f, 0.f}; } } }
}

__device__ __forceinline__ float sigmoidf_(float x) { return __builtin_amdgcn_rcpf(1.0f + __builtin_amdgcn_exp2f(x * -1.4426950408889634f)); }
__device__ __forceinline__ void unpack8(const v4u w, float (&f)[8]) { f[0] = bflo(w.x); f[1] = bfhi(w.x); f[2] = bflo(w.y); f[3] = bfhi(w.y); f[4] = bflo(w.z); f[5] = bfhi(w.z); f[6] = bflo(w.w); f[7] = bfhi(w.w); }
struct MergeCtx { float lam, one_m_li; float w0[8], w1[8], w2[8], g[8]; };
__device__ __forceinline__ void merge_setup(MergeCtx& C, kargs_t A, int l, int h, int tid) {
    const int lane = tid & 63, chunk = tid & 15;
    const float lam_init = (l == 0) ? 0.2f : (l == 1) ? 0.35550906759096934f : (l == 2) ? 0.4707130183435842f : 0.5560582041556406f;
    const float a1 = A->in[4][l * 64 + lane] * A->in[5][l * 64 + lane], a2 = A->in[6][l * 64 + lane] * A->in[7][l * 64 + lane];
    const float s1 = wave_sum(a1), s2 = wave_sum(a2);
    C.lam = __builtin_amdgcn_exp2f(s1 * 1.4426950408889634f) - __builtin_amdgcn_exp2f(s2 * 1.4426950408889634f) + lam_init; C.one_m_li = 1.0f - lam_init;
    const float* cw = A->in[3] + (size_t)l * 3 * DM + h * 128 + 8 * chunk; const float* sg = A->in[8] + l * 128 + 8 * chunk;
#pragma unroll
    for (int i = 0; i < 8; ++i) { C.w0[i] = cw[i]; C.w1[i] = cw[DM + i]; C.w2[i] = cw[2 * DM + i]; C.g[i] = sg[i] * C.one_m_li; }
}
__device__ __forceinline__ void merge_block(const MergeCtx& C, unsigned char* ws, int b, int h, int qb, int tid) {
    const bf16* P = (const bf16*)(ws + WS_PROJ); const size_t PS = (size_t)M * 1024;
    const bf16* Ob = (const bf16*)(ws + WS_O); bf16* Mx = (bf16*)(ws + WS_MIX);
    const int chunk = tid & 15, c = h * 128 + 8 * chunk, oc = h * 256 + 8 * chunk;
    for (int it0 = 0; it0 < 8; it0 += 2) {
        v4u raw[2][7];
#pragma unroll
        for (int k = 0; k < 2; ++k) {
            const int tl = qb * 256 + (it0 + k) * 32 + (tid >> 4);
            const size_t t = (size_t)b * SEQ + tl;
            const size_t tm1 = (tl >= 1) ? t - 1 : t, tm2 = (tl >= 2) ? t - 2 : t;
            raw[k][0] = *(const GAS v4u*)(Ob + t * 2048 + oc); raw[k][1] = *(const GAS v4u*)(Ob + t * 2048 + oc + 128);
            raw[k][2] = *(const GAS v4u*)(P + 4 * PS + t * 1024 + c); raw[k][3] = *(const GAS v4u*)(P + 5 * PS + t * 1024 + c);
            raw[k][4] = *(const GAS v4u*)(P + 3 * PS + t * 1024 + c); raw[k][5] = *(const GAS v4u*)(P + 3 * PS + tm1 * 1024 + c); raw[k][6] = *(const GAS v4u*)(P + 3 * PS + tm2 * 1024 + c);
        }
        asm volatile("" ::: "memory");
#pragma unroll
        for (int k = 0; k < 2; ++k) {
            const int tl = qb * 256 + (it0 + k) * 32 + (tid >> 4);
            const size_t t = (size_t)b * SEQ + tl;
            float o1[8], o2[8], bgc[8], ga[8], cu0[8], cu1[8], cu2[8];
            unpack8(raw[k][0], o1); unpack8(raw[k][1], o2); unpack8(raw[k][2], bgc); unpack8(raw[k][3], ga); unpack8(raw[k][4], cu0); unpack8(raw[k][5], cu1); unpack8(raw[k][6], cu2);
            const float k1 = (tl >= 1) ? 1.f : 0.f, k2 = (tl >= 2) ? 1.f : 0.f;
            float d[8], sq = 0.f;
#pragma unroll
            for (int i = 0; i < 8; ++i) { d[i] = o1[i] - C.lam * o2[i]; sq += d[i] * d[i]; }
            sq += __shfl_xor(sq, 1); sq += __shfl_xor(sq, 2); sq += __shfl_xor(sq, 4); sq += __shfl_xor(sq, 8);
            const float r = __builtin_amdgcn_rsqf(sq * (1.0f / 128.0f) + RMS_EPS);
            float mo[8];
#pragma unroll
            for (int i = 0; i < 8; ++i) {
                const float yc = bgc[i] * (C.w0[i] * (cu2[i] * k2) + C.w1[i] * (cu1[i] * k1) + C.w2[i] * cu0[i]);
                const float ya = d[i] * r * C.g[i];
                mo[i] = sigmoidf_(ga[i]) * ya + yc; }
            v4u w; w.x = pk2(mo[0], mo[1]); w.y = pk2(mo[2], mo[3]); w.z = pk2(mo[4], mo[5]); w.w = pk2(mo[6], mo[7]);
            st16_wt((void*)(Mx + t * 1024 + c), w);
        }
    }
}

__device__ __forceinline__ void merge_wave(const MergeCtx& C, unsigned char* ws, int b, int h, int tl0, attn_body::lds_cptr stg, int lane) {
    const bf16* P = (const bf16*)(ws + WS_PROJ); const size_t PS = (size_t)M * 1024;
    const bf16* Ob = (const bf16*)(ws + WS_O); bf16* Mx = (bf16*)(ws + WS_MIX);
    const int chunk = lane & 15, c = h * 128 + 8 * chunk, oc = h * 256 + 8 * chunk;
    for (int p0 = 0; p0 < 8; p0 += 2) {
        v4u raw[2][7];
#pragma unroll
        for (int k = 0; k < 2; ++k) {
            const int rw = (p0 + k) * 4 + (lane >> 4), tl = tl0 + rw;
            const size_t t = (size_t)b * SEQ + tl;
            const size_t tm1 = (tl >= 1) ? t - 1 : t, tm2 = (tl >= 2) ? t - 2 : t;
            raw[k][0] = *(const GAS v4u*)(Ob + t * 2048 + oc); raw[k][1] = *(const LAS v4u*)(stg + (rw * 128 + 8 * chunk) * 2);
            raw[k][2] = *(const GAS v4u*)(P + 4 * PS + t * 1024 + c); raw[k][3] = *(const GAS v4u*)(P + 5 * PS + t * 1024 + c);
            raw[k][4] = *(const GAS v4u*)(P + 3 * PS + t * 1024 + c); raw[k][5] = *(const GAS v4u*)(P + 3 * PS + tm1 * 1024 + c); raw[k][6] = *(const GAS v4u*)(P + 3 * PS + tm2 * 1024 + c);
        }
        asm volatile("" ::: "memory");
#pragma unroll
        for (int k = 0; k < 2; ++k) {
            const int rw = (p0 + k) * 4 + (lane >> 4), tl = tl0 + rw;
            const size_t t = (size_t)b * SEQ + tl;
            float o1[8], o2[8], bgc[8], ga[8], cu0[8], cu1[8], cu2[8];
            unpack8(raw[k][0], o1); unpack8(raw[k][1], o2); unpack8(raw[k][2], bgc); unpack8(raw[k][3], ga); unpack8(raw[k][4], cu0); unpack8(raw[k][5], cu1); unpack8(raw[k][6], cu2);
            const float k1 = (tl >= 1) ? 1.f : 0.f, k2 = (tl >= 2) ? 1.f : 0.f;
            float d[8], sq = 0.f;
#pragma unroll
            for (int i = 0; i < 8; ++i) { d[i] = o1[i] - C.lam * o2[i]; sq += d[i] * d[i]; }
            sq += __shfl_xor(sq, 1); sq += __shfl_xor(sq, 2); sq += __shfl_xor(sq, 4); sq += __shfl_xor(sq, 8);
            const float r = __builtin_amdgcn_rsqf(sq * (1.0f / 128.0f) + RMS_EPS);
            float mo[8];
#pragma unroll
            for (int i = 0; i < 8; ++i) {
                const float yc = bgc[i] * (C.w0[i] * (cu2[i] * k2) + C.w1[i] * (cu1[i] * k1) + C.w2[i] * cu0[i]);
                const float ya = d[i] * r * C.g[i];
                mo[i] = sigmoidf_(ga[i]) * ya + yc; }
            v4u w; w.x = pk2(mo[0], mo[1]); w.y = pk2(mo[2], mo[3]); w.z = pk2(mo[4], mo[5]); w.w = pk2(mo[6], mo[7]);
            st16_wt((void*)(Mx + t * 1024 + c), w);
        }
    }
}
struct MergePost { bool on; int l, b, h;
    __device__ __forceinline__ void run(attn_body::lds_cptr stg, int tl0, int lane) const {
        const kargs_t A = KARGS(); asm volatile("s_waitcnt vmcnt(0)" ::: "memory");
        MergeCtx MC; merge_setup(MC, A, l, h, lane); merge_wave(MC, A->ws, b, h, tl0, stg, lane); } };

constexpr int TILE_TAB_OFF = RING_BYTES + 1024 + 4096;
__device__ __forceinline__ void route_phase(int l) {
    const kargs_t A = KARGS(); Frame F = make_frame(A);
    const int lane = F.lane, tid = F.tid, j = l >> 1;
    LAS float* WrT = (LAS float*)(F.lds);
    volatile LAS int* cntl = (volatile LAS int*)(F.lds + 32768);
    volatile LAS int* gbase = cntl + 8;
    volatile LAS int* li = cntl + 16;
    volatile LAS int* lr = cntl + 16 + 128;
    volatile LAS float* lw = (volatile LAS float*)(cntl + 16 + 256);
    const float* Wr = A->in[14] + (size_t)j * DM * NEXP; const float* gn = A->in[10] + (size_t)l * DM;
    for (int idx = tid; idx < DM * NEXP; idx += NWAVES * 64) { const int k = idx >> 3, e = idx & 7; WrT[e * DM + k] = Wr[idx] * gn[k]; }
    gu32* gcnt = F.ctl + CW_GCNT + j * 8 * 64;
    int* slotof = (int*)(F.ws + WS_ROUTE + RT_SLOTOF); float* wslot = (float*)(F.ws + WS_ROUTE + RT_WSLOT); float* ssslot = (float*)(F.ws + WS_ROUTE + RT_SSSLOT);
    unsigned char* xg = (unsigned char*)(F.ws + WS_O);
    for (int blk = F.vcu; blk < M / 64; blk += F.G) {
        if (tid < 8) cntl[tid] = 0;
        __syncthreads();
        float ssq[8];
        const bf16* xbr = (const bf16*)(F.ws + WS_XB) + (size_t)(blk * 64 + F.wave * 8) * DM + 8 * lane;
        v4u cur0 = *(const GAS v4u*)xbr, cur1 = *(const GAS v4u*)(xbr + 512);
#pragma unroll
        for (int rr = 0; rr < 8; ++rr) {
            const int loc = F.wave * 8 + rr;
            v4u nx0 = cur0, nx1 = cur1;
            if (rr < 7) { nx0 = *(const GAS v4u*)(xbr + (size_t)(rr + 1) * DM); nx1 = *(const GAS v4u*)(xbr + (size_t)(rr + 1) * DM + 512); }
            float v[16]; float s = 0.f;
            { float t8[8]; unpack8(cur0, t8);
#pragma unroll
              for (int i = 0; i < 8; ++i) v[i] = t8[i];
              unpack8(cur1, t8);
#pragma unroll
              for (int i = 0; i < 8; ++i) v[8 + i] = t8[i]; }
#pragma unroll
            for (int i = 0; i < 16; ++i) s += v[i] * v[i];
            s = wave_sum(s); ssq[rr] = s; const float rstd = 1.0f / sqrtf(s * (1.0f / 1024.0f) + RMS_EPS);
            float lg[8];
#pragma unroll
            for (int e = 0; e < 8; ++e) { float a = 0.f;
#pragma unroll
                for (int q = 0; q < 2; ++q) { const f32x4 w0 = *(const LAS f32x4*)(WrT + e * DM + 512 * q + 8 * lane), w1 = *(const LAS f32x4*)(WrT + e * DM + 512 * q + 8 * lane + 4);
                    a += (v[8 * q] * w0.x + v[8 * q + 1] * w0.y) + (v[8 * q + 2] * w0.z + v[8 * q + 3] * w0.w) + (v[8 * q + 4] * w1.x + v[8 * q + 5] * w1.y) + (v[8 * q + 6] * w1.z + v[8 * q + 7] * w1.w); }
                lg[e] = wave_sum(a) * rstd; }
            int i0 = 0; float v0 = lg[0];
#pragma unroll
            for (int e = 1; e < 8; ++e) if (lg[e] > v0) { v0 = lg[e]; i0 = e; }
            int i1 = -1; float v1 = -INFINITY;
#pragma unroll
            for (int e = 0; e < 8; ++e) if (e != i0 && lg[e] > v1) { v1 = lg[e]; i1 = e; }
            if (i1 < 0) i1 = (i0 + 1) & 7;
            const float wA = 1.0f / (1.0f + __expf(v1 - v0)), wB = 1.0f - wA;
            if (lane == 0) {
                const int r0 = __hip_atomic_fetch_add((LAS int*)&cntl[i0], 1, __ATOMIC_RELAXED, __HIP_MEMORY_SCOPE_WORKGROUP);
                const int r1 = __hip_atomic_fetch_add((LAS int*)&cntl[i1], 1, __ATOMIC_RELAXED, __HIP_MEMORY_SCOPE_WORKGROUP);
                li[2 * loc] = i0; li[2 * loc + 1] = i1; lr[2 * loc] = r0; lr[2 * loc + 1] = r1; lw[2 * loc] = wA; lw[2 * loc + 1] = wB;
            }
            cur0 = nx0; cur1 = nx1;
            asm volatile("" ::: "memory");
        }
        __syncthreads();
        if (tid < 8) gbase[tid] = (int)__hip_atomic_fetch_add(gcnt + tid * 64, (unsigned)cntl[tid], RLX_AGENT);
        __syncthreads();
        v4u vs[8][2];
#pragma unroll
        for (int rr = 0; rr < 8; ++rr) { vs[rr][0] = *(const GAS v4u*)(xbr + (size_t)rr * DM); vs[rr][1] = *(const GAS v4u*)(xbr + (size_t)rr * DM + 512); }
#pragma unroll
        for (int rr = 0; rr < 8; ++rr) {
            const int loc = F.wave * 8 + rr, t = blk * 64 + loc;
            const int e0 = li[2 * loc], e1 = li[2 * loc + 1];
            const int s0 = e0 * ECAP + gbase[e0] + lr[2 * loc], s1 = e1 * ECAP + gbase[e1] + lr[2 * loc + 1];
            typedef unsigned u32x2_t __attribute__((ext_vector_type(2)));
#pragma unroll
            for (int q = 0; q < 2; ++q) { float t8[8]; unpack8(vs[rr][q], t8); u32x2_t w = {0u, 0u};
                w.x = __builtin_amdgcn_cvt_pk_fp8_f32(pg8::clamp448(t8[0] * 8.f), pg8::clamp448(t8[1] * 8.f), w.x, false); w.x = __builtin_amdgcn_cvt_pk_fp8_f32(pg8::clamp448(t8[2] * 8.f), pg8::clamp448(t8[3] * 8.f), w.x, true);
                w.y = __builtin_amdgcn_cvt_pk_fp8_f32(pg8::clamp448(t8[4] * 8.f), pg8::clamp448(t8[5] * 8.f), w.y, false); w.y = __builtin_amdgcn_cvt_pk_fp8_f32(pg8::clamp448(t8[6] * 8.f), pg8::clamp448(t8[7] * 8.f), w.y, true);
                st8_wt((void*)(xg + (size_t)s0 * DM + 512 * q + 8 * lane), w); st8_wt((void*)(xg + (size_t)s1 * DM + 512 * q + 8 * lane), w); }
            if (lane == 0) { slotof[2 * t] = s0; slotof[2 * t + 1] = s1; wslot[s0] = lw[2 * loc]; wslot[s1] = lw[2 * loc + 1];
                const f32x4 sv = {ssq[rr], 0.f, 0.f, 0.f}; *(GAS f32x4*)(ssslot + 4 * (size_t)s0) = sv; *(GAS f32x4*)(ssslot + 4 * (size_t)s1) = sv; }
        }
        __syncthreads();
    }
}
__device__ __forceinline__ void build_tiles(LAS unsigned char* lds, gu32* gcnt) {
    const int tid = opaque_tid(); LAS int* tab = (LAS int*)(lds + TILE_TAB_OFF);
    int seg = 0, ent = -1;
#pragma unroll
    for (int e = 0; e < 8; ++e) { const int nte = ((int)__hip_atomic_load(gcnt + e * 64, RLX_AGENT) + 255) >> 8;
        if (tid >= seg && tid < seg + nte) ent = (e << 16) | (e * (ECAP / 256) + (tid - seg)); seg += nte; }
    if (tid < 255 && ent >= 0) tab[tid] = ent;
    if (tid == 0) tab[255] = seg;
    __syncthreads();
}
__device__ __forceinline__ void combine_phase(int l) {
    const kargs_t A = KARGS(); Frame F = make_frame(A);
    const int lane = F.lane; const int gw = F.vcu * NWAVES + F.wave, NGW = F.G * NWAVES;
    const int* slotof = (const int*)(F.ws + WS_ROUTE + RT_SLOTOF); const bf16* Y = (const bf16*)(F.ws + WS_Y); bf16* xb = (bf16*)(F.ws + WS_XB);
    volatile LAS int* segc = (volatile LAS int*)(F.lds);
    if (F.tid == 0) { gu32* gcnt = F.ctl + CW_GCNT + (l >> 1) * 8 * 64; int s = 0; for (int e = 0; e < 8; ++e) { segc[e] = s; s += (((int)__hip_atomic_load(gcnt + e * 64, RLX_AGENT) + 255) >> 8) << 8; } }
    __syncthreads();
    float* ssn = (float*)(F.ws + WS_SS) + (size_t)(2 * l + 2) * M * 4; const bool fin = (l == DEPTH - 1);
    const float* gf = A->in[18];
    for (int t0 = gw * 4; t0 < M; t0 += NGW * 4) {
        v2u xa[4][4], ya[4][4], yb[4][4];
#pragma unroll
        for (int r = 0; r < 4; ++r) { const int t = t0 + r; const int p0 = slotof[2 * t], p1 = slotof[2 * t + 1];
            const int s0 = segc[p0 >> ECAP_LOG] + (p0 & (ECAP - 1)), s1 = segc[p1 >> ECAP_LOG] + (p1 & (ECAP - 1));
            const GAS v2u* xr = (const GAS v2u*)(xb + (size_t)t * DM) + lane;
            const GAS v2u* y0 = (const GAS v2u*)(Y + (size_t)s0 * DM) + lane; const GAS v2u* y1 = (const GAS v2u*)(Y + (size_t)s1 * DM) + lane;
#pragma unroll
            for (int q = 0; q < 4; ++q) { xa[r][q] = xr[64 * q]; ya[r][q] = y0[64 * q]; yb[r][q] = y1[64 * q]; } }
        asm volatile("" ::: "memory");
#pragma unroll
        for (int r = 0; r < 4; ++r) { const int t = t0 + r; float s = 0.f; f32x4 v[4];
#pragma unroll
            for (int q = 0; q < 4; ++q) { const v2u c = xa[r][q], a = ya[r][q], b = yb[r][q]; f32x4& x = v[q];
                x.x = bflo(c.x) + (bflo(a.x) + bflo(b.x)); x.y = bfhi(c.x) + (bfhi(a.x) + bfhi(b.x)); x.z = bflo(c.y) + (bflo(a.y) + bflo(b.y)); x.w = bfhi(c.y) + (bfhi(a.y) + bfhi(b.y));
                s += (x.x * x.x + x.y * x.y) + (x.z * x.z + x.w * x.w); }
            s = wave_sum(s);
            if (!fin) {
                GAS v2u* o8 = (GAS v2u*)(xb + (size_t)t * DM) + lane;
#pragma unroll
                for (int q = 0; q < 4; ++q) { v2u w; w.x = pk2(v[q].x, v[q].y); w.y = pk2(v[q].z, v[q].w); st8_wt((void*)(o8 + 64 * q), w); }
                if ((INPROJ_F8_MASK & 4) && INPROJ_F8(l + 1)) {
                    GAS unsigned* q8 = (GAS unsigned*)(F.ws + WS_O + (size_t)t * DM) + lane;
#pragma unroll
                    for (int q = 0; q < 4; ++q) { unsigned w = 0u;
                        w = __builtin_amdgcn_cvt_pk_fp8_f32(pg8::clamp448(v[q].x * 8.0f), pg8::clamp448(v[q].y * 8.0f), w, false);
                        w = __builtin_amdgcn_cvt_pk_fp8_f32(pg8::clamp448(v[q].z * 8.0f), pg8::clamp448(v[q].w * 8.0f), w, true); q8[64 * q] = w; } }
                if (lane == 0) *(GAS f32x4*)(ssn + 4 * (size_t)t) = (f32x4){s, 0.f, 0.f, 0.f};
            } else {
                const float rstd = 1.0f / sqrtf(s * (1.0f / 1024.0f) + RMS_EPS);
                GAS f32x4* xo = (GAS f32x4*)(F.X + (size_t)t * DM) + lane;
#pragma unroll
                for (int q = 0; q < 4; ++q) { const f32x4 gg = *((const GAS f32x4*)gf + lane + 64 * q); xo[64 * q] = v[q] * rstd * gg; }
            } }
    }
}

__device__ __forceinline__ XcdBarrier make_bar(unsigned char* ws) {
    extern __shared__ __attribute__((aligned(16))) unsigned char lds[];
    XcdBarrier b; b.bar = (unsigned*)(ws + WS_CTL) + CW_BAR; b.x = xb_xcc_id(); b.st = (volatile LAS unsigned*)((LAS unsigned char*)lds + MISC_OFF) + 8; return b;
}
__global__ void __launch_bounds__(NWAVES * 64, 2) trunk_fwd(Args args_unused) {
    extern __shared__ __attribute__((aligned(16))) unsigned char lds[];
    { const int tid = threadIdx.x;
      for (int u = tid; u < (LDS_BYTES - LDSCTL_OFF) / 4; u += NWAVES * 64) ((LAS unsigned*)((LAS unsigned char*)lds + LDSCTL_OFF))[u] = 0u;
      __syncthreads();
      if (!MK_PER_PHASE) { const kargs_t A = KARGS(); (void)xcd_barrier_post((unsigned*)(A->ws + WS_CTL) + CW_BAR, (volatile LAS unsigned*)((LAS unsigned char*)lds + MISC_OFF) + 8); } }
    int ph = 0;
#define PH_ON ({ const kargs_t Ap_ = KARGS(); ph >= Ap_->ph_lo && ph < Ap_->ph_hi; })
#define PH_END do { if (!MK_PER_PHASE && PH_ON && ph + 1 < KARGS()->ph_hi) { const kargs_t A_ = KARGS(); xcd_barrier(make_bar(A_->ws)); } ++ph; } while (0)

    for (int rep_ = 0; rep_ < (((PROBE_DUP >> 0) & 1) ? 2 : 1); ++rep_) if (((PH_MASK >> 0) & 1) && PH_ON) p0_prologue();
    PH_END;

    for (int l = 0; l < DEPTH; ++l) {
        for (int rep_ = 0; rep_ < (((PROBE_DUP >> 1) & 1) ? 2 : 1); ++rep_) if (((PH_MASK >> 1) & 1) && PH_ON) {
            const kargs_t A = KARGS(); unsigned char* ws = A->ws;
            pg8::StaticOrder S; S.init(M, IN_W, opaque_grid(), opaque_bid());
            if ((INPROJ_F8_MASK != 0) && INPROJ_F8(l)) {
                pg8::Gemm g{(const bf16*)(ws + WS_O), (const bf16*)(ws + WS_WIN + (size_t)l * IN_W * DM * 2), M, IN_W, DM, 0};
                pg8::EpiProj E{(bf16*)(ws + WS_PROJ), (const float*)(ws + WS_SS) + (size_t)(2 * l) * M * 4, (const float*)(ws + WS_ROPEC), (const float*)(ws + WS_ROPES), attn_body::C2, 1.0f / 2048.0f};
                pg8::gemm_phase<pg8::EpiProj, pg8::StaticOrder, PG8_ALIGN, PG8_SP2, true>((LAS unsigned char*)lds + RING_OFF, g, S, E);
            } else {
            pg8::Gemm g{(const bf16*)(ws + WS_XB), (const bf16*)(ws + WS_WIN) + (size_t)l * IN_W * DM, M, IN_W, DM, 0};
            pg8::EpiProj E{(bf16*)(ws + WS_PROJ), (const float*)(ws + WS_SS) + (size_t)(2 * l) * M * 4, (const float*)(ws + WS_ROPEC), (const float*)(ws + WS_ROPES), attn_body::C2};
            pg8::gemm_phase<pg8::EpiProj, pg8::StaticOrder, PG8_ALIGN, PG8_SP2>((LAS unsigned char*)lds + RING_OFF, g, S, E); }
        }
        PH_END;
        for (int rep_ = 0; rep_ < (((PROBE_DUP >> 2) & 1) ? 2 : 1); ++rep_) if (((PH_MASK >> 2) & 1) && PH_ON) {
            const kargs_t A = KARGS(); unsigned char* ws = A->ws;
            const attn_body::bf16* Qb = (const attn_body::bf16*)(ws + WS_PROJ); attn_body::bf16* Ob = (attn_body::bf16*)(ws + WS_O);
            const int G = opaque_grid(), bx = opaque_bid(), vcu = (G % 8 == 0) ? (bx % 8) * (G / 8) + bx / 8 : bx;
            attn_body::AttnCarry cy; cy.primed = false; cy.s0 = 0;
#pragma unroll
            for (int d0 = 0; d0 < 4; ++d0) cy.qr[d0] = (attn_body::bf16x8){0, 0, 0, 0, 0, 0, 0, 0};
            for (int vc = vcu; vc < 256; vc += G) {
                const int bh = vc >> 2, b = bh >> 3, h = bh & 7;
                for (int u = 0; u < 4; ++u) {
                    const int mp = u & 1, qb = (u >> 1) ? (vc & 3) : 7 - (vc & 3);
                    if (((vc >> 2) & 3) == u) {
                        const kargs_t A3 = KARGS(); const int tid3 = opaque_tid(); int grp3 = l + 1; asm volatile("" : "+s"(grp3));
                        convert_group(A3, A3->ws, grp3, vc * NWAVES + (tid3 >> 6), 256 * NWAVES, tid3 & 63);
                    }
                    const attn_body::bf16* Qh = Qb + (size_t)b * SEQ * 1024 + (2 * h + mp) * 64;
                    const attn_body::bf16* Vh = Qb + (size_t)2 * M * 1024 + (size_t)b * SEQ * 1024 + h * 128;
                    attn_body::AttnNext nx; nx.has = (u < 3); nx.qb = ((u + 1) >> 1) ? (vc & 3) : 7 - (vc & 3);
                    nx.Qh = Qb + (size_t)b * SEQ * 1024 + (2 * h + ((u + 1) & 1)) * 64; nx.Kh = nx.Qh + (size_t)M * 1024; nx.Vh = Vh;
                    const MergePost post{mp == 1, l, b, h};
                    attn_body::attn_unit128<8>(qb, Qh, Qh + (size_t)M * 1024, Vh, Ob + (size_t)b * SEQ * 2048 + h * 256 + mp * 128, (char*)lds + RING_OFF, post, nx, cy);
                }
            }
        }
        PH_END;
        for (int rep_ = 0; rep_ < (((PROBE_DUP >> 4) & 1) ? 2 : 1); ++rep_) if (((PH_MASK >> 4) & 1) && PH_ON) {
            const kargs_t A = KARGS(); unsigned char* ws = A->ws;
            pg8::Gemm g{(const bf16*)(ws + WS_MIX), (const bf16*)(ws + WS_WOUT) + (size_t)l * DM * DM, M, DM, DM, 0};
            pg8::StaticOrder S; S.init(M, DM, opaque_grid(), opaque_bid());
            if (l & 1) { pg8::EpiResidLite E{(bf16*)(ws + WS_XB), nullptr};
                pg8::gemm_phase<pg8::EpiResidLite, pg8::StaticOrder, PG8_ALIGN, PG8_SP2>((LAS unsigned char*)lds + RING_OFF, g, S, E); }
            else if (DENSE_F8(l >> 1)) { pg8::EpiResidF8X E{(bf16*)(ws + WS_XB), (float*)(ws + WS_SS) + (size_t)(2 * l + 1) * M * 4, (unsigned char*)(ws + WS_O), 1.0f};
                pg8::gemm_phase<pg8::EpiResidF8X, pg8::StaticOrder, PG8_ALIGN, PG8_SP2>((LAS unsigned char*)lds + RING_OFF, g, S, E); }
            else { pg8::EpiResid E{(bf16*)(ws + WS_XB), (float*)(ws + WS_SS) + (size_t)(2 * l + 1) * M * 4};
                pg8::gemm_phase<pg8::EpiResid, pg8::StaticOrder, PG8_ALIGN, PG8_SP2>((LAS unsigned char*)lds + RING_OFF, g, S, E); }
        }
        PH_END;
        if ((l & 1) == 0) {
            for (int rep_ = 0; rep_ < (((PROBE_DUP >> 5) & 1) ? 2 : 1); ++rep_) if (((PH_MASK >> 5) & 1) && PH_ON) {
                const kargs_t A = KARGS(); unsigned char* ws = A->ws; const int j = l >> 1;
                pg8::StaticOrder S; S.init(M, 2 * DFF, opaque_grid(), opaque_bid());
                if (DENSE_F8(j)) {
                    pg8::Gemm g{(const bf16*)(ws + WS_O), (const bf16*)(ws + WS_WGU + (size_t)j * 2 * DFF * DM * 2), M, 2 * DFF, DM, 0};
                    pg8::EpiSwigluF8 E{(void*)(ws + WS_PROJ), DFF, (const float*)(ws + WS_SS) + (size_t)(2 * l + 1) * M * 4, 1.0f / 2048.0f};
                    pg8::gemm_phase<pg8::EpiSwigluF8, pg8::StaticOrder, PG8_ALIGN, PG8_SP2, true>((LAS unsigned char*)lds + RING_OFF, g, S, E);
                } else {
                pg8::Gemm g{(const bf16*)(ws + WS_XB), (const bf16*)(ws + WS_WGU) + (size_t)j * 2 * DFF * DM, M, 2 * DFF, DM, 0};
                if (((DENSE_DN_F8_MASK & ~DENSE_F8_MASK) != 0) && DENSE_DN_F8(j)) {
                    pg8::EpiSwigluF8 E{(void*)(ws + WS_PROJ), DFF, (const float*)(ws + WS_SS) + (size_t)(2 * l + 1) * M * 4, 1.0f};
                    pg8::gemm_phase<pg8::EpiSwigluF8, pg8::StaticOrder, PG8_ALIGN, PG8_SP2>((LAS unsigned char*)lds + RING_OFF, g, S, E);
                } else {
                pg8::EpiSwiglu E{(void*)(ws + WS_PROJ), DFF, (const float*)(ws + WS_SS) + (size_t)(2 * l + 1) * M * 4, 1.0f};
                pg8::gemm_phase<pg8::EpiSwiglu, pg8::StaticOrder, PG8_ALIGN, PG8_SP2>((LAS unsigned char*)lds + RING_OFF, g, S, E); } }
            }
            PH_END;
            for (int rep_ = 0; rep_ < (((PROBE_DUP >> 6) & 1) ? 2 : 1); ++rep_) if (((PH_MASK >> 6) & 1) && PH_ON) {
                const kargs_t A = KARGS(); unsigned char* ws = A->ws; const int j = l >> 1;
                pg8::StaticOrder S; S.init(M, DM, opaque_grid(), opaque_bid());
                constexpr bool C_F8_X = ((DENSE_DN_F8_MASK & 1) && (INPROJ_F8_MASK & 2)) || ((DENSE_DN_F8_MASK & 2) && (INPROJ_F8_MASK & 8));
                constexpr bool C_F8_N = ((DENSE_DN_F8_MASK & 1) && !(INPROJ_F8_MASK & 2)) || ((DENSE_DN_F8_MASK & 2) && !(INPROJ_F8_MASK & 8));
                constexpr bool C_BF_X = (!(DENSE_DN_F8_MASK & 1) && (INPROJ_F8_MASK & 2)) || (!(DENSE_DN_F8_MASK & 2) && (INPROJ_F8_MASK & 8));
                const bool f8x = INPROJ_F8(l + 1);
                if (C_F8_X && DENSE_DN_F8(j) && f8x) {
                    pg8::Gemm g{(const bf16*)(ws + WS_PROJ), (const bf16*)(ws + WS_WD + (size_t)j * DM * DFF * 2), M, DM, DFF, 0};
                    pg8::EpiResidF8X E{(bf16*)(ws + WS_XB), (float*)(ws + WS_SS) + (size_t)(2 * l + 2) * M * 4, (unsigned char*)(ws + WS_O), 1.0f / 2048.0f};
                    pg8::gemm_phase<pg8::EpiResidF8X, pg8::StaticOrder, PG8_ALIGN, PG8_SP2, true>((LAS unsigned char*)lds + RING_OFF, g, S, E);
                } else if (C_F8_N && DENSE_DN_F8(j)) {
                    pg8::Gemm g{(const bf16*)(ws + WS_PROJ), (const bf16*)(ws + WS_WD + (size_t)j * DM * DFF * 2), M, DM, DFF, 0};
                    pg8::EpiResid E{(bf16*)(ws + WS_XB), (float*)(ws + WS_SS) + (size_t)(2 * l + 2) * M * 4, nullptr, 1.0f / 2048.0f};
                    pg8::gemm_phase<pg8::EpiResid, pg8::StaticOrder, PG8_ALIGN, PG8_SP2, true>((LAS unsigned char*)lds + RING_OFF, g, S, E);
                } else if (C_BF_X && f8x) {
                    pg8::Gemm g{(const bf16*)(ws + WS_PROJ), (const bf16*)(ws + WS_WD) + (size_t)j * DM * DFF, M, DM, DFF, 0};
                    pg8::EpiResidF8X E{(bf16*)(ws + WS_XB), (float*)(ws + WS_SS) + (size_t)(2 * l + 2) * M * 4, (unsigned char*)(ws + WS_O), 1.0f};
                    pg8::gemm_phase<pg8::EpiResidF8X, pg8::StaticOrder, PG8_ALIGN, PG8_SP2>((LAS unsigned char*)lds + RING_OFF, g, S, E);
                } else {
                pg8::Gemm g{(const bf16*)(ws + WS_PROJ), (const bf16*)(ws + WS_WD) + (size_t)j * DM * DFF, M, DM, DFF, 0};
                pg8::EpiResid E{(bf16*)(ws + WS_XB), (float*)(ws + WS_SS) + (size_t)(2 * l + 2) * M * 4};
                pg8::gemm_phase<pg8::EpiResid, pg8::StaticOrder, PG8_ALIGN, PG8_SP2>((LAS unsigned char*)lds + RING_OFF, g, S, E); }
            }
            PH_END;
        } else {
            for (int rep_ = 0; rep_ < (((PROBE_DUP >> 7) & 1) ? 2 : 1); ++rep_) if (((PH_MASK >> 7) & 1) && PH_ON) route_phase(l);
            PH_END;
            for (int rep_ = 0; rep_ < (((PROBE_DUP >> 9) & 1) ? 2 : 1); ++rep_) if (((PH_MASK >> 9) & 1) && PH_ON) {
                const kargs_t A = KARGS(); unsigned char* ws = A->ws; const int j = l >> 1;
                build_tiles((LAS unsigned char*)lds, (gu32*)(ws + WS_CTL) + CW_GCNT + j * 8 * 64);
                const LAS int* tab = (const LAS int*)((LAS unsigned char*)lds + TILE_TAB_OFF);
                const int ntl = __builtin_amdgcn_readfirstlane(tab[255]);
                pg8::Gemm g{(const bf16*)(ws + WS_O), (const bf16*)(ws + WS_WEGU + (size_t)j * 8 * 2 * DFFE * DM), NEXP * ECAP, 2 * DFFE, DM, (size_t)2 * DFFE * DM};
                pg8::GroupedOrder S; S.init(ntl, 2 * DFFE, opaque_grid(), opaque_bid(), tab, true);
                pg8::EpiSwigluF8 E{(void*)(ws + WS_PROJ), DFFE, (const float*)(ws + WS_ROUTE + RT_SSSLOT), 1.0f / 2048.0f};
                pg8::gemm_phase<pg8::EpiSwigluF8, pg8::GroupedOrder, PG8_ALIGN, PG8_SP2, true>((LAS unsigned char*)lds + RING_OFF, g, S, E);
            }
            PH_END;
            for (int rep_ = 0; rep_ < (((PROBE_DUP >> 10) & 1) ? 2 : 1); ++rep_) if (((PH_MASK >> 10) & 1) && PH_ON) {
                const kargs_t A = KARGS(); unsigned char* ws = A->ws; const int j = l >> 1;
                build_tiles((LAS unsigned char*)lds, (gu32*)(ws + WS_CTL) + CW_GCNT + j * 8 * 64);
                const LAS int* tab = (const LAS int*)((LAS unsigned char*)lds + TILE_TAB_OFF);
                const int ntl = __builtin_amdgcn_readfirstlane(tab[255]);
                pg8::Gemm g{(const bf16*)(ws + WS_PROJ), (const bf16*)(ws + WS_WED + (size_t)j * 8 * DM * DFFE), MSLOT, DM, DFFE, (size_t)DM * DFFE};
                pg8::GroupedOrder S; S.init(ntl, DM, opaque_grid(), opaque_bid(), tab, false);
                pg8::EpiSlot E{(bf16*)(ws + WS_Y), (const float*)(ws + WS_ROUTE + RT_WSLOT), 1.0f / 2048.0f};
                pg8::gemm_phase<pg8::EpiSlot, pg8::GroupedOrder, PG8_ALIGN, PG8_SP2, true>((LAS unsigned char*)lds + RING_OFF, g, S, E);
            }
            PH_END;
            for (int rep_ = 0; rep_ < (((PROBE_DUP >> 11) & 1) ? 2 : 1); ++rep_) if (((PH_MASK >> 11) & 1) && PH_ON) combine_phase(l);
            PH_END;
        }
    }
#undef PH_ON
#undef PH_END
}

constexpr int N_PHASES = 1 + 2 * 5 + 2 * 7;

extern "C" void kernel_launch(void* const* d_in, const int* in_sizes, int n_in, void* d_out, int out_size, void* d_ws, size_t ws_size, hipStream_t stream) {
    static int grid = 0;
    if (grid == 0) {
        if (n_in != 19 || in_sizes[0] != M * DM || out_size != M * DM || ws_size < WS_END) { fprintf(stderr, "kernel_launch: unexpected shapes / workspace (n_in %d, in0 %d, out %d, ws %zu < %zu); nothing launched\n", n_in, n_in > 0 ? in_sizes[0] : -1, out_size, ws_size, (size_t)WS_END); grid = -1; return; }
        int dev = 0, cus = 0, per_cu = 0;
        if (hipGetDevice(&dev) != hipSuccess || hipDeviceGetAttribute(&cus, hipDeviceAttributeMultiprocessorCount, dev) != hipSuccess) { grid = -1; return; }
        if (hipFuncSetAttribute((const void*)trunk_fwd, hipFuncAttributeMaxDynamicSharedMemorySize, LDS_BYTES) != hipSuccess) { fprintf(stderr, "kernel_launch: hipFuncSetAttribute failed\n"); grid = -1; return; }
        if (hipOccupancyMaxActiveBlocksPerMultiprocessor(&per_cu, (const void*)trunk_fwd, NWAVES * 64, LDS_BYTES) != hipSuccess || per_cu < 1)
            fprintf(stderr, "kernel_launch: note: occupancy query reports %d workgroups per CU\n", per_cu);
        (void)hipGetLastError();
        grid = cus;
        if (grid > 256) grid = 256;
    }
    if (grid < 0) return;
    if (hipMemsetAsync((char*)d_ws + WS_CTL, 0, CTL_ZERO_BYTES, stream) != hipSuccess) return;
    Args a{};
    for (int i = 0; i < 19; ++i) a.in[i] = (const float*)d_in[i];
    a.out = (float*)d_out; a.ws = (unsigned char*)d_ws;
#if MK_PER_PHASE
    for (int p = 0; p < N_PHASES; ++p) { a.ph_lo = p; a.ph_hi = p + 1; hipLaunchKernelGGL(trunk_fwd, dim3(grid), dim3(NWAVES * 64), LDS_BYTES, stream, a); }
#else
    a.ph_lo = 0; a.ph_hi = N_PHASES;
    hipLaunchKernelGGL(trunk_fwd, dim3(grid), dim3(NWAVES * 64), LDS_BYTES, stream, a);
#endif
}
```

```cpp
#include <hip/hip_runtime.h>
#include <hip/hip_bf16.h>
#include <cstdio>
#include <cstdint>
#include <cmath>

#ifndef PH_MASK
#define PH_MASK 0xFFFF
#endif
#ifndef DENSE_F8_MASK
#define DENSE_F8_MASK 2
#endif
#define DENSE_F8(j) (((DENSE_F8_MASK) >> (j)) & 1)
#ifndef DENSE_DN_F8_MASK
#define DENSE_DN_F8_MASK 3
#endif
#define DENSE_DN_F8(j) (((DENSE_DN_F8_MASK) >> (j)) & 1)
static_assert((DENSE_DN_F8_MASK & DENSE_F8_MASK) == DENSE_F8_MASK, "an fp8 gate|up GEMM writes fp8 hidden activations: its down projection is fp8 too");
#ifndef INPROJ_F8_MASK
#define INPROJ_F8_MASK 12
#endif
#define INPROJ_F8(l) (((INPROJ_F8_MASK) >> (l)) & 1)
static_assert((INPROJ_F8_MASK & 1) == 0, "layer 0's in-projection reads the prologue's bf16 x");
#ifndef PROBE_DUP
#define PROBE_DUP 0
#endif
#ifndef MK_PER_PHASE
#define MK_PER_PHASE 0
#endif

constexpr int BATCH = 8, SEQ = 2048, DM = 1024, DEPTH = 4;
constexpr int M = BATCH * SEQ;
constexpr int NHEADS = 8;
constexpr int IN_W = 8192;
constexpr int DFF = 2816, DFFE = 3584, NEXP = 8;
constexpr int MSLOT = 2 * M + NEXP * 256;
constexpr float RMS_EPS = 1e-5f;

__device__ __forceinline__ int opaque_tid() { int t = threadIdx.x; asm volatile("" : "+v"(t)); return t; }
__device__ __forceinline__ int opaque_bid() { int t = blockIdx.x; asm volatile("" : "+s"(t)); return t; }
__device__ __forceinline__ int opaque_grid() { int t = gridDim.x; asm volatile("" : "+s"(t)); return t; }

typedef unsigned wt_u32x4 __attribute__((ext_vector_type(4))); typedef unsigned wt_u32x2 __attribute__((ext_vector_type(2)));
__device__ __forceinline__ void st16_wt(void* p, wt_u32x4 v) { asm volatile("global_store_dwordx4 %0, %1, off sc1\n\ts_nop 1" :: "v"(p), "v"(v) : "memory"); }
__device__ __forceinline__ void st8_wt(void* p, wt_u32x2 v) { asm volatile("global_store_dwordx2 %0, %1, off sc1" :: "v"(p), "v"(v) : "memory"); }

namespace pg8 {
#define PG8_LAS __attribute__((address_space(3)))
typedef unsigned short bf16_t;
typedef short bf16x8 __attribute__((ext_vector_type(8)));
typedef float f32x4 __attribute__((ext_vector_type(4)));
typedef unsigned u32x4 __attribute__((ext_vector_type(4)));
constexpr int BM = 256, BK = 64, HALF = 128, HTB = HALF * BK * 2, STAGE_BYTES = 8 * HTB, NXCD = 8, WGM = 8;

__host__ __device__ __forceinline__ int lds_byte(int r, int c) { const int st = (r >> 4) * 2 + (c >> 5), rr = r & 15, cc = c & 31, ob = rr * 64 + cc * 2; return st * 1024 + (ob ^ (((ob >> 9) & 1) << 5)); }
__host__ __device__ __forceinline__ void stage_rc(int b, int& R, int& C) { const int st = b / 1024, sb = b % 1024, swz = sb ^ (((sb >> 9) & 1) << 5); R = (st >> 1) * 16 + swz / 64; C = (st & 1) * 32 + (swz % 64) / 2; }
__host__ __device__ __forceinline__ int perm32(int rho) { const int n = rho >> 4, i = rho & 15; return 8 * (i >> 2) + 4 * n + (i & 3); }

struct Unit { int pm, pn, be, pa, ps; };
struct Gemm { const bf16_t* A; const bf16_t* Bt; int M, N, K; size_t bstride; };

struct StaticOrder {
    int nM, nN, nwg, G, c;
    __host__ __device__ void init(int M_, int N_, int G_, int c_) { nM = M_ / BM; nN = N_ / BM; nwg = nM * nN; G = G_; c = c_; }
    __host__ __device__ bool next(int i, Unit& u) const {
        const long L = (long)i * G + c; if (L >= nwg) return false;
        int wgid = (int)L; { const int q = nwg / NXCD, r = nwg % NXCD, xcd = wgid % NXCD, off = wgid / NXCD; wgid = (xcd < r ? xcd * (q + 1) : r * (q + 1) + (xcd - r) * q) + off; }
        const int nig = WGM * nN, gid = wgid / nig, fm = gid * WGM, gsz = (nM - fm) < WGM ? (nM - fm) : WGM;
        u.pm = fm + ((wgid % nig) % gsz); u.pn = (wgid % nig) / gsz; u.be = 0; u.pa = u.pm; u.ps = u.pm; return true;
    }
    __device__ __forceinline__ void a_ready(const Unit&) const {}
    __device__ __forceinline__ void done(const Unit&) const {}
};
struct GroupedOrder {
    int nM, nN, nwg, G, c; const PG8_LAS int* tab; bool sparseA;
    __device__ void init(int nM_, int N_, int G_, int c_, const PG8_LAS int* tab_, bool sparseA_) { nM = nM_; nN = N_ / BM; nwg = nM * nN; G = G_; c = c_; tab = tab_; sparseA = sparseA_; }
    __device__ bool next(int i, Unit& u) const {
        const long L = (long)i * G + c; if (L >= nwg) return false;
        int wgid = (int)L; { const int q = nwg / NXCD, r = nwg % NXCD, xcd = wgid % NXCD, off = wgid / NXCD; wgid = (xcd < r ? xcd * (q + 1) : r * (q + 1) + (xcd - r) * q) + off; }
        const int nig = WGM * nN, gid = wgid / nig, fm = gid * WGM, gsz = (nM - fm) < WGM ? (nM - fm) : WGM;
        u.pm = fm + ((wgid % nig) % gsz); u.pn = (wgid % nig) / gsz;
        const int ent = __builtin_amdgcn_readfirstlane(tab[u.pm]); u.be = ent >> 16; u.ps = ent & 0xffff; u.pa = sparseA ? u.ps : u.pm; return true;
    }
    __device__ __forceinline__ void a_ready(const Unit&) const {}
    __device__ __forceinline__ void done(const Unit&) const {}
};

constexpr int RSC_OFF = 131072 + 8192;
__device__ __forceinline__ unsigned cvt_pk_bf16(float lo, float hi) { unsigned r; asm volatile("v_cvt_pk_bf16_f32 %0, %1, %2" : "=v"(r) : "v"(lo), "v"(hi)); return r; }
__device__ __forceinline__ u32x4 pack8(const f32x4 a, const f32x4 b) { u32x4 w; w.x = cvt_pk_bf16(a[0], a[1]); w.y = cvt_pk_bf16(a[2], a[3]); w.z = cvt_pk_bf16(b[0], b[1]); w.w = cvt_pk_bf16(b[2], b[3]); return w; }
__device__ __forceinline__ void st_pair128(bf16_t* rowp, int pitch, int fr, u32x4 a0, u32x4 a1) {
    u32x4 t;
#pragma unroll
    for (int i = 0; i < 4; ++i) t[i] = (unsigned)__builtin_amdgcn_update_dpp(0, (int)a1[i], 0x128  , 0xf, 0xf, false);
    const bool hi = (fr & 8) != 0;
    u32x4 x, y;
#pragma unroll
    for (int i = 0; i < 4; ++i) { x[i] = hi ? t[i] : a0[i]; y[i] = hi ? a0[i] : t[i]; }
    st16_wt(rowp + (hi ? 32 - 8 * pitch : 0), x);
    st16_wt(rowp + (hi ? 0 : 8 * pitch + 32), y);
}
__device__ __forceinline__ float rstd_of(const float* ss4) { const f32x4 p = *(const f32x4*)ss4; return __builtin_amdgcn_rsqf(((p[0] + p[1]) + (p[2] + p[3])) * (1.0f / 1024.0f) + RMS_EPS); }

struct EpiProj {
    static constexpr bool PERM = true, AFTER_DRAIN = false, NEEDS_ALIGN = false;
    bf16_t* P; const float* ss; const float* ropeC; const float* ropeS; float qscale; float ascale = 1.0f;
    mutable int pmc = -1;
    __device__ __forceinline__ PG8_LAS float* rsc_lds() const { extern __shared__ __attribute__((aligned(16))) unsigned char lds_all[]; return (PG8_LAS float*)((PG8_LAS unsigned char*)lds_all + RSC_OFF) + opaque_tid(); }
    __device__ __forceinline__ void refresh(const Unit& u, int wr, int fr) const {
        if (u.pm != pmc) { pmc = u.pm; const int row0 = u.pm * BM + wr * 64 + fr; f32x4 t_[8]; PG8_LAS float* rc = rsc_lds();
#pragma unroll
            for (int i = 0; i < 8; ++i) t_[i] = *(const f32x4*)(ss + 4 * (size_t)(row0 + (i >> 2) * HALF + (i & 3) * 16));
#pragma unroll
            for (int i = 0; i < 8; ++i) rc[i * 512] = __builtin_amdgcn_rsqf(((t_[i][0] + t_[i][1]) + (t_[i][2] + t_[i][3])) * (1.0f / 1024.0f) + RMS_EPS) * ascale;
            asm volatile("s_waitcnt lgkmcnt(0)" ::: "memory"); }
    }
    __device__ __forceinline__ void half(const f32x4 (&acc)[2][2][4][2], const Unit& u, int ai, int wr, int wc, int fr, int fq) const {
        asm volatile("" : "+v"(fr), "+v"(fq));
        refresh(u, wr, fr);
        float rsc[4]; { const PG8_LAS float* rc = rsc_lds();
#pragma unroll
            for (int m = 0; m < 4; ++m) rsc[m] = rc[(ai * 4 + m) * 512]; }
        const int t = u.pn >> 2, ct = u.pn & 3;
        bf16_t* base = P + (size_t)t * ((size_t)M * 1024);
        const int row0 = u.pm * BM + wr * 64 + fr;
        if (t < 2) {
            const float sc = (t == 0) ? qscale : 1.0f;
            int fqo = fq; asm volatile("" : "+v"(fqo));
            const int hcol = ct * 256 + wc * 64 + 8 * fq;
            f32x4 tc[4][2], ts[4][2];
#pragma unroll
            for (int m = 0; m < 4; ++m) { const int pos = (row0 + ai * HALF + m * 16) & (SEQ - 1);
                tc[m][0] = *(const f32x4*)(ropeC + pos * 32 + 8 * fqo); tc[m][1] = *(const f32x4*)(ropeC + pos * 32 + 8 * fqo + 4);
                ts[m][0] = *(const f32x4*)(ropeS + pos * 32 + 8 * fqo); ts[m][1] = *(const f32x4*)(ropeS + pos * 32 + 8 * fqo + 4); }
            asm volatile("" ::: "memory");
#pragma unroll
            for (int m = 0; m < 4; ++m) {
                const int row = row0 + ai * HALF + m * 16; const float rs = rsc[m] * sc;
                const f32x4 c0 = tc[m][0], c1 = tc[m][1], s0 = ts[m][0], s1 = ts[m][1];
                const f32x4 l0 = acc[ai][0][m][0] * rs, l1 = acc[ai][0][m][1] * rs, h0 = acc[ai][1][m][0] * rs, h1 = acc[ai][1][m][1] * rs;
                const f32x4 ol0 = l0 * c0 - h0 * s0, ol1 = l1 * c1 - h1 * s1, oh0 = h0 * c0 + l0 * s0, oh1 = h1 * c1 + l1 * s1;
                bf16_t* rowp = base + (size_t)row * 1024 + hcol;
                st_pair128(rowp, 1024, fr, pack8(ol0, ol1), pack8(oh0, oh1));
            }
        } else if (u.pn < 12 || u.pn >= 28) {
            bf16_t* b2 = P + (size_t)(u.pn < 12 ? 2 : 5) * ((size_t)M * 1024);
            const int col0 = ct * 256 + wc * 64 + 8 * fq;
#pragma unroll
            for (int m = 0; m < 4; ++m) {
                const int row = row0 + ai * HALF + m * 16; const float rs = rsc[m];
                bf16_t* rowp = b2 + (size_t)row * 1024 + col0;
                st_pair128(rowp, 1024, fr, pack8(acc[ai][0][m][0] * rs, acc[ai][0][m][1] * rs), pack8(acc[ai][1][m][0] * rs, acc[ai][1][m][1] * rs));
            }
        } else {
            const bool conv = u.pn < 20;
            bf16_t* b2 = P + (size_t)(conv ? 3 : 4) * ((size_t)M * 1024);
            const int col0 = (u.pn - (conv ? 12 : 20)) * HALF + wc * 32 + 8 * fq;
#pragma unroll
            for (int m = 0; m < 4; ++m) {
                const int row = row0 + ai * HALF + m * 16; const float rs = rsc[m];
                f32x4 o[2];
#pragma unroll
                for (int n = 0; n < 2; ++n) {
                    const f32x4 x0 = acc[ai][0][m][n] * rs, x1 = acc[ai][1][m][n] * rs;
                    if (conv) o[n] = x0 * x1;
                    else {
#pragma unroll
                        for (int i = 0; i < 4; ++i) o[n][i] = x0[i] * __builtin_amdgcn_rcpf(1.0f + __builtin_amdgcn_exp2f(x1[i] * -1.4426950408889634f)); }
                }
                st16_wt(b2 + (size_t)row * 1024 + col0, pack8(o[0], o[1]));
            }
        }
    }
    __device__ __forceinline__ void operator()(const f32x4 (&acc)[2][2][4][2], const Unit& u, int wr, int wc, int fr, int fq) const { half(acc, u, 0, wr, wc, fr, fq); half(acc, u, 1, wr, wc, fr, fq); }
};
__device__ __forceinline__ float clamp448(float v) { return __builtin_fminf(__builtin_fmaxf(v, -448.0f), 448.0f); }
template <bool F8OUT> struct EpiSwigluT {
    static constexpr bool PERM = true, AFTER_DRAIN = false, NEEDS_ALIGN = false;
    void* H; int ldh; const float* ss; float ascale;
    mutable int pmc = -1;
    __device__ __forceinline__ PG8_LAS float* rsc_lds() const { extern __shared__ __attribute__((aligned(16))) unsigned char lds_all[]; return (PG8_LAS float*)((PG8_LAS unsigned char*)lds_all + RSC_OFF) + opaque_tid(); }
    __device__ __forceinline__ void refresh(const Unit& u, int wr, int fr) const {
        if (u.pm != pmc) { pmc = u.pm; const int srow0 = u.ps * BM + wr * 64 + fr;
            f32x4 t_[8]; PG8_LAS float* rc = rsc_lds();
#pragma unroll
            for (int i = 0; i < 8; ++i) t_[i] = *(const f32x4*)(ss + 4 * (size_t)(srow0 + (i >> 2) * HALF + (i & 3) * 16));
#pragma unroll
            for (int i = 0; i < 8; ++i) rc[i * 512] = __builtin_amdgcn_rsqf(((t_[i][0] + t_[i][1]) + (t_[i][2] + t_[i][3])) * (1.0f / 1024.0f) + RMS_EPS) * ascale;
            asm volatile("s_waitcnt lgkmcnt(0)" ::: "memory"); }
    }
    __device__ __forceinline__ void half(const f32x4 (&acc)[2][2][4][2], const Unit& u, int ai, int wr, int wc, int fr, int fq) const {
        asm volatile("" : "+v"(fr), "+v"(fq));
        refresh(u, wr, fr);
        float rsc[4]; { const PG8_LAS float* rc = rsc_lds();
#pragma unroll
            for (int m = 0; m < 4; ++m) rsc[m] = rc[(ai * 4 + m) * 512]; }
        const int row0 = u.pm * BM + wr * 64 + fr, col0 = u.pn * HALF + wc * 32 + 8 * fq;
#pragma unroll
        for (int m = 0; m < 4; ++m) {
            const int row = row0 + ai * HALF + m * 16; const float rs = rsc[m];
            f32x4 o[2];
            {
                const float rse = rs * -1.4426950408889634f, rs2 = rs * rs * (F8OUT ? 8.0f : 1.0f);
                f32x4 e[2], p[2];
#pragma unroll
                for (int n = 0; n < 2; ++n) { e[n] = acc[ai][0][m][n] * rse; p[n] = (acc[ai][0][m][n] * acc[ai][1][m][n]) * rs2; }
#pragma unroll
                for (int n = 0; n < 2; ++n)
#pragma unroll
                    for (int i = 0; i < 4; ++i) e[n][i] = __builtin_amdgcn_exp2f(e[n][i]);
#pragma unroll
                for (int n = 0; n < 2; ++n) e[n] = e[n] + 1.0f;
#pragma unroll
                for (int n = 0; n < 2; ++n)
#pragma unroll
                    for (int i = 0; i < 4; ++i) e[n][i] = __builtin_amdgcn_rcpf(e[n][i]);
#pragma unroll
                for (int n = 0; n < 2; ++n) o[n] = p[n] * e[n];
            }
            if constexpr (F8OUT) {
                unsigned w0 = 0u, w1 = 0u;
                w0 = __builtin_amdgcn_cvt_pk_fp8_f32(clamp448(o[0][0]), clamp448(o[0][1]), w0, false); w0 = __builtin_amdgcn_cvt_pk_fp8_f32(clamp448(o[0][2]), clamp448(o[0][3]), w0, true);
                w1 = __builtin_amdgcn_cvt_pk_fp8_f32(clamp448(o[1][0]), clamp448(o[1][1]), w1, false); w1 = __builtin_amdgcn_cvt_pk_fp8_f32(clamp448(o[1][2]), clamp448(o[1][3]), w1, true);
                typedef unsigned u32x2 __attribute__((ext_vector_type(2)));
                *(u32x2*)((unsigned char*)H + (size_t)row * ldh + col0) = (u32x2){w0, w1};
            } else {
                st16_wt((bf16_t*)H + (size_t)row * ldh + col0, pack8(o[0], o[1]));
            }
        }
    }
    __device__ __forceinline__ void operator()(const f32x4 (&acc)[2][2][4][2], const Unit& u, int wr, int wc, int fr, int fq) const { half(acc, u, 0, wr, wc, fr, fq); half(acc, u, 1, wr, wc, fr, fq); }
};
typedef EpiSwigluT<false> EpiSwiglu;
typedef EpiSwigluT<true> EpiSwigluF8;
constexpr int EPI_TAB_OFF = 131072 + 1024;
template <bool LITE, bool F8X = false> struct EpiResidT {
    static constexpr bool PERM = true, AFTER_DRAIN = false, NEEDS_ALIGN = !LITE;
    bf16_t* xb; float* ssn; unsigned char* xq = nullptr; float ascale = 1.0f;
    __device__ __forceinline__ void operator()(const f32x4 (&acc)[2][2][4][2], const Unit& u, int wr, int wc, int fr, int fq) const {
        extern __shared__ __attribute__((aligned(16))) unsigned char lds_all[];
        PG8_LAS float* T = (PG8_LAS float*)((PG8_LAS unsigned char*)lds_all + EPI_TAB_OFF);
        const int row0 = u.pm * BM + wr * 64 + fr, col0 = u.pn * BM + wc * 64 + 8 * fq;
#pragma unroll
        for (int ai = 0; ai < 2; ++ai) {
            u32x4 xv[4][2];
#pragma unroll
            for (int m = 0; m < 4; ++m)
#pragma unroll
                for (int bj = 0; bj < 2; ++bj) xv[m][bj] = *(const u32x4*)(xb + (size_t)(row0 + ai * HALF + m * 16) * 1024 + col0 + bj * 32);
            asm volatile("" ::: "memory");
#pragma unroll
            for (int m = 0; m < 4; ++m) {
                const int row = row0 + ai * HALF + m * 16; float sq = 0.f; u32x4 pk[2];
#pragma unroll
                for (int bj = 0; bj < 2; ++bj) {
                    const u32x4 w = xv[m][bj];
                    f32x4 x0 = {__uint_as_float(w.x << 16), __uint_as_float(w.x & 0xffff0000u), __uint_as_float(w.y << 16), __uint_as_float(w.y & 0xffff0000u)};
                    f32x4 x1 = {__uint_as_float(w.z << 16), __uint_as_float(w.z & 0xffff0000u), __uint_as_float(w.w << 16), __uint_as_float(w.w & 0xffff0000u)};
                    x0 += acc[ai][bj][m][0] * ascale; x1 += acc[ai][bj][m][1] * ascale;
                    pk[bj] = pack8(x0, x1);
                    if constexpr (F8X) { unsigned w0 = 0u, w1 = 0u;
                        w0 = __builtin_amdgcn_cvt_pk_fp8_f32(clamp448(x0[0] * 8.0f), clamp448(x0[1] * 8.0f), w0, false); w0 = __builtin_amdgcn_cvt_pk_fp8_f32(clamp448(x0[2] * 8.0f), clamp448(x0[3] * 8.0f), w0, true);
                        w1 = __builtin_amdgcn_cvt_pk_fp8_f32(clamp448(x1[0] * 8.0f), clamp448(x1[1] * 8.0f), w1, false); w1 = __builtin_amdgcn_cvt_pk_fp8_f32(clamp448(x1[2] * 8.0f), clamp448(x1[3] * 8.0f), w1, true);
                        st8_wt(xq + (size_t)row * 1024 + col0 + bj * 32, (wt_u32x2){w0, w1}); }
                    if constexpr (!LITE) sq += (x0[0] * x0[0] + x0[1] * x0[1]) + (x0[2] * x0[2] + x0[3] * x0[3]) + (x1[0] * x1[0] + x1[1] * x1[1]) + (x1[2] * x1[2] + x1[3] * x1[3]);
                }
                st_pair128(xb + (size_t)row * 1024 + col0, 1024, fr, pk[0], pk[1]);
                if constexpr (!LITE) { sq += __shfl_xor(sq, 16); sq += __shfl_xor(sq, 32);
                    if (fq == 0) T[(ai * HALF + wr * 64 + m * 16 + fr) * 4 + wc] = sq; }
            }
        }
        if constexpr (!LITE) {
        asm volatile("s_waitcnt lgkmcnt(0)\n\ts_barrier" ::: "memory");
        if (wc == 0 && fq == 0) {
#pragma unroll
            for (int ai = 0; ai < 2; ++ai)
#pragma unroll
                for (int m = 0; m < 4; ++m) { const int lr = ai * HALF + wr * 64 + m * 16 + fr; const f32x4 p = *(const PG8_LAS f32x4*)(T + lr * 4);
                    ssn[(size_t)(u.pm * BM + lr) * 4 + u.pn] = (p[0] + p[1]) + (p[2] + p[3]); }
        } }
    }
};
typedef EpiResidT<false> EpiResid;
typedef EpiResidT<true> EpiResidLite;
typedef EpiResidT<false, true> EpiResidF8X;
struct EpiSlot {
    static constexpr bool PERM = true, AFTER_DRAIN = false, NEEDS_ALIGN = false;
    bf16_t* Y; const float* wslot; float ascale;
    __device__ __forceinline__ void half(const f32x4 (&acc)[2][2][4][2], const Unit& u, int ai, int wr, int wc, int fr, int fq) const {
        asm volatile("" : "+v"(fr), "+v"(fq));
        const int row0 = u.pm * BM + wr * 64 + fr, col0 = u.pn * BM + wc * 64 + 8 * fq;
        float w[4];
#pragma unroll
        for (int m = 0; m < 4; ++m) w[m] = wslot[u.ps * BM + wr * 64 + fr + ai * HALF + m * 16] * ascale;
#pragma unroll
        for (int m = 0; m < 4; ++m) {
            const int row = row0 + ai * HALF + m * 16;
            st_pair128(Y + (size_t)row * 1024 + col0, 1024, fr, pack8(acc[ai][0][m][0] * w[m], acc[ai][0][m][1] * w[m]), pack8(acc[ai][1][m][0] * w[m], acc[ai][1][m][1] * w[m]));
        }
    }
    __device__ __forceinline__ void operator()(const f32x4 (&acc)[2][2][4][2], const Unit& u, int wr, int wc, int fr, int fq) const { half(acc, u, 0, wr, wc, fr, fq); half(acc, u, 1, wr, wc, fr, fq); }
};

__device__ __forceinline__ void glds16s(unsigned voff, const void* sbase, unsigned lds_dst) { unsigned keep;
    asm volatile("s_mov_b32 %0, m0\n\ts_mov_b32 m0, %3\n\ts_nop 0\n\tglobal_load_lds_dwordx4 %1, %2\n\ts_mov_b32 m0, %0" : "=&s"(keep) : "v"(voff), "s"(sbase), "s"(lds_dst) : "memory"); }
typedef int v8i_t __attribute__((ext_vector_type(8))); typedef int v4i_t __attribute__((ext_vector_type(4)));
__device__ __forceinline__ v8i_t cat16(bf16x8 lo, bf16x8 hi) { const v4i_t a = __builtin_bit_cast(v4i_t, lo), b = __builtin_bit_cast(v4i_t, hi); return __builtin_shufflevector(a, b, 0, 1, 2, 3, 4, 5, 6, 7); }
template <class Epi, class Sched, bool ALIGN_EPI = false, bool SP2 = false, bool FP8 = false>
__device__ __forceinline__ void gemm_phase(PG8_LAS unsigned char* lds, const Gemm g, const Sched& S, const Epi& E) {
    const int tid = opaque_tid(), wid = __builtin_amdgcn_readfirstlane(tid >> 6), lane = tid & 63, wr = wid >> 2, wc = wid & 3, fr = lane & 15, fq = lane >> 4;
    const int K = FP8 ? g.K / 2 : g.K, nt = K / BK;
    unsigned voffA[2], voffB[2];
#pragma unroll
    for (int i = 0; i < 2; ++i) { int R, C; stage_rc(tid * 16 + i * 8192, R, C); const int Rb = Epi::PERM ? (64 * (R >> 5) + perm32(R & 31)) : R;
        voffA[i] = (unsigned)(R * K + C) * 2u; voffB[i] = (unsigned)(Rb * K + C) * 2u; }
    const size_t kstep = (size_t)(BK * 2);
    const size_t hstep = (size_t)HALF * K * 2;
    const size_t tstep = 2 * hstep;
    const size_t hstepB = Epi::PERM ? (size_t)32 * K * 2 : hstep;
    const unsigned ldsw = (unsigned)wid * 1024u; const unsigned ldsb = (unsigned)__builtin_amdgcn_readfirstlane((int)((unsigned)(size_t)lds + ldsw));
    const int aoff = lds_byte(wr * 64 + fr, fq * 8), boff = lds_byte(wc * 32 + fr, fq * 8);
#define PG8_SA(b, h) (((b) * 2 + (h)) * HTB)
#define PG8_SB(b, h) ((4 + (b) * 2 + (h)) * HTB)
#define PG8_STAGE(bufoff, gbase, voff) do { _Pragma("unroll") for (int _i = 0; _i < 2; ++_i) \
        glds16s((voff)[_i], (const void*)(gbase), ldsb + (unsigned)((bufoff) + _i * 8192)); } while (0)
#define PG8_LDA(dst, b, h) do { _Pragma("unroll") for (int m = 0; m < 4; ++m) _Pragma("unroll") for (int k = 0; k < 2; ++k) dst[m][k] = *(const PG8_LAS bf16x8*)(lds + PG8_SA(b, h) + aoff + m * 2048 + k * 1024); } while (0)
#define PG8_LDB(dst, b, h) do { _Pragma("unroll") for (int n = 0; n < 2; ++n) _Pragma("unroll") for (int k = 0; k < 2; ++k) dst[n][k] = *(const PG8_LAS bf16x8*)(lds + PG8_SB(b, h) + boff + n * 2048 + k * 1024); } while (0)
#define PG8_MMA(ai, bj, At, Bt) do { __builtin_amdgcn_s_setprio(1); _Pragma("unroll") for (int m = 0; m < 4; ++m) _Pragma("unroll") for (int n = 0; n < 2; ++n) { \
        if constexpr (FP8) { const v8i_t bo_ = cat16(Bt[n][0], Bt[n][1]), ao_ = cat16(At[m][0], At[m][1]); \
            asm volatile("v_mfma_f32_16x16x128_f8f6f4 %0, %1, %2, %0" : "+v"(acc[ai][bj][m][n]) : "v"(bo_), "v"(ao_)); }     \
        else { _Pragma("unroll") for (int k = 0; k < 2; ++k) acc[ai][bj][m][n] = __builtin_amdgcn_mfma_f32_16x16x32_bf16(Bt[n][k], At[m][k], acc[ai][bj][m][n], 0, 0, 0); } } \
        __builtin_amdgcn_s_setprio(0); } while (0)
#define PG8_WAIT_V(n) asm volatile("s_waitcnt vmcnt(" #n ")" ::: "memory")
#define PG8_WAIT_L(n) asm volatile("s_waitcnt lgkmcnt(" #n ")" ::: "memory")
#define PG8_BAR __builtin_amdgcn_s_barrier()
#define PG8_SCHED __builtin_amdgcn_sched_barrier(0)
    Unit cur, nxt; int ui = 0;
    if (!S.next(0, cur)) return;
    f32x4 acc[2][2][4][2];
#pragma unroll
    for (int a = 0; a < 2; ++a)
#pragma unroll
        for (int b = 0; b < 2; ++b)
#pragma unroll
            for (int m = 0; m < 4; ++m)
#pragma unroll
                for (int n = 0; n < 2; ++n) { acc[a][b][m][n] = (f32x4){0.f, 0.f, 0.f, 0.f}; asm volatile("" : "+v"(acc[a][b][m][n])); }
    bf16x8 At[4][2], B0[2][2], B1[2][2];
    const char* cA = (const char*)g.A + (size_t)cur.pa * tstep; const char* cB = (const char*)g.Bt + (size_t)cur.be * g.bstride + (size_t)cur.pn * tstep;
    S.a_ready(cur);
    if constexpr (SP2) {
        PG8_STAGE(PG8_SB(0, 0), cB, voffB); PG8_STAGE(PG8_SB(0, 1), cB + hstepB, voffB); PG8_STAGE(PG8_SA(0, 0), cA, voffA); PG8_STAGE(PG8_SA(0, 1), cA + hstep, voffA);
        if (wr == 1) PG8_BAR;
        PG8_WAIT_V(2); PG8_BAR;
        PG8_STAGE(PG8_SB(1, 0), cB + kstep, voffB); PG8_STAGE(PG8_SA(1, 0), cA + kstep, voffA); PG8_STAGE(PG8_SB(1, 1), cB + hstepB + kstep, voffB);
        PG8_WAIT_V(6); PG8_BAR;
    } else {
        PG8_STAGE(PG8_SB(0, 0), cB, voffB); PG8_STAGE(PG8_SA(0, 0), cA, voffA); PG8_STAGE(PG8_SB(0, 1), cB + hstepB, voffB); PG8_STAGE(PG8_SA(0, 1), cA + hstep, voffA);
        if (wr == 1) PG8_BAR;
        PG8_WAIT_V(4); PG8_BAR;
        PG8_STAGE(PG8_SB(1, 0), cB + kstep, voffB); PG8_STAGE(PG8_SA(1, 0), cA + kstep, voffA); PG8_STAGE(PG8_SB(1, 1), cB + hstepB + kstep, voffB);
        PG8_WAIT_V(6); PG8_BAR;
    }
    for (;;) {
        const bool has_next = S.next(ui + 1, nxt);
        const char* nA = has_next ? (const char*)g.A + (size_t)nxt.pa * tstep : cA; const char* nB = has_next ? (const char*)g.Bt + (size_t)nxt.be * g.bstride + (size_t)nxt.pn * tstep : cB;
#pragma nounroll
        for (int t = 0; t < nt; t += 2) {
            const bool last = (t == nt - 2);
            const char* a1 = cA + (size_t)(t + 1) * kstep;
            const char* a2 = last ? nA : cA + (size_t)(t + 2) * kstep; const char* b2 = last ? nB : cB + (size_t)(t + 2) * kstep;
            const char* a3 = a2 + kstep; const char* b3 = b2 + kstep;
            if (last && has_next) S.a_ready(nxt);
            if constexpr (SP2) {
            PG8_LDB(B0, 0, 0); PG8_LDB(B1, 0, 1); PG8_SCHED; PG8_LDA(At, 0, 0); PG8_STAGE(PG8_SA(1, 1), a1 + hstep, voffA);
            PG8_WAIT_V(8); PG8_WAIT_L(0); PG8_BAR; PG8_MMA(0, 0, At, B0); PG8_MMA(0, 1, At, B1); PG8_BAR; PG8_SCHED;
            PG8_LDA(At, 0, 1); PG8_STAGE(PG8_SB(0, 0), b2, voffB); PG8_STAGE(PG8_SB(0, 1), b2 + hstepB, voffB); PG8_STAGE(PG8_SA(0, 0), a2, voffA);
            PG8_WAIT_V(8); PG8_WAIT_L(0); PG8_BAR; PG8_MMA(1, 0, At, B0); PG8_MMA(1, 1, At, B1); PG8_BAR; PG8_SCHED;
            PG8_LDB(B0, 1, 0); PG8_LDB(B1, 1, 1); PG8_SCHED; PG8_LDA(At, 1, 0); PG8_STAGE(PG8_SA(0, 1), a2 + hstep, voffA);
            PG8_WAIT_V(8); PG8_WAIT_L(0); PG8_BAR; PG8_MMA(0, 0, At, B0); PG8_MMA(0, 1, At, B1); PG8_BAR; PG8_SCHED;
            PG8_LDA(At, 1, 1); PG8_STAGE(PG8_SB(1, 0), b3, voffB); PG8_STAGE(PG8_SB(1, 1), b3 + hstepB, voffB); PG8_STAGE(PG8_SA(1, 0), a3, voffA);
            PG8_WAIT_V(8); PG8_WAIT_L(0); PG8_BAR; PG8_MMA(1, 0, At, B0); PG8_MMA(1, 1, At, B1); PG8_BAR; PG8_SCHED;
            } else {
            PG8_LDB(B0, 0, 0); PG8_SCHED; PG8_LDA(At, 0, 0); PG8_STAGE(PG8_SA(1, 1), a1 + hstep, voffA);
            PG8_WAIT_L(8); PG8_BAR; PG8_WAIT_L(0); PG8_MMA(0, 0, At, B0); PG8_BAR; PG8_SCHED;
            PG8_LDB(B1, 0, 1); PG8_STAGE(PG8_SB(0, 0), b2, voffB);
            PG8_BAR; PG8_WAIT_L(0); PG8_MMA(0, 1, At, B1); PG8_BAR;
            PG8_LDA(At, 0, 1); PG8_STAGE(PG8_SA(0, 0), a2, voffA);
            PG8_BAR; PG8_WAIT_L(0); PG8_MMA(1, 0, At, B0); PG8_BAR; PG8_SCHED;
            PG8_STAGE(PG8_SB(0, 1), b2 + hstepB, voffB);
            PG8_WAIT_V(6); PG8_BAR; PG8_MMA(1, 1, At, B1); PG8_BAR;
            PG8_LDB(B0, 1, 0); PG8_SCHED; PG8_LDA(At, 1, 0); PG8_STAGE(PG8_SA(0, 1), a2 + hstep, voffA);
            PG8_WAIT_L(8); PG8_BAR; PG8_WAIT_L(0); PG8_MMA(0, 0, At, B0); PG8_BAR; PG8_SCHED;
            PG8_LDB(B1, 1, 1); PG8_STAGE(PG8_SB(1, 0), b3, voffB);
            PG8_BAR; PG8_WAIT_L(0); PG8_MMA(0, 1, At, B1); PG8_BAR;
            PG8_LDA(At, 1, 1); PG8_STAGE(PG8_SA(1, 0), a3, voffA);
            PG8_BAR; PG8_WAIT_L(0); PG8_MMA(1, 0, At, B0); PG8_BAR; PG8_SCHED;
            PG8_STAGE(PG8_SB(1, 1), b3 + hstepB, voffB);
            PG8_WAIT_V(6); PG8_BAR; PG8_MMA(1, 1, At, B1); PG8_BAR;
            }
        }
        if constexpr (ALIGN_EPI) { if (wr == 0) PG8_BAR; }
        static_assert(ALIGN_EPI || !Epi::NEEDS_ALIGN, "this epilogue contains a workgroup barrier: both halves must run it together");
        if constexpr (!Epi::AFTER_DRAIN) { E(acc, cur, wr, wc, fr, fq); S.done(cur); }
        if (!has_next) break;
#pragma unroll
        for (int a = 0; a < 2; ++a)
#pragma unroll
            for (int b = 0; b < 2; ++b)
#pragma unroll
                for (int m = 0; m < 4; ++m)
#pragma unroll
                    for (int n = 0; n < 2; ++n) { acc[a][b][m][n] = (f32x4){0.f, 0.f, 0.f, 0.f}; asm volatile("" : "+v"(acc[a][b][m][n])); }
        cur = nxt; cA = nA; cB = nB; ++ui;
        if constexpr (ALIGN_EPI) { if (wr == 1) PG8_BAR; }
    }
    PG8_WAIT_V(0);
    if constexpr (!ALIGN_EPI) { if (wr == 0) PG8_BAR; }
    PG8_BAR;
#undef PG8_SA
#undef PG8_SB
#undef PG8_STAGE
#undef PG8_LDA
#undef PG8_LDB
#undef PG8_MMA
#undef PG8_WAIT_V
#undef PG8_WAIT_L
#undef PG8_BAR
#undef PG8_SCHED
}

}

#ifndef PG8_SP2
#define PG8_SP2 true
#endif
#ifndef PG8_ALIGN
#define PG8_ALIGN true
#endif

namespace attn_body {
using bf16=__hip_bfloat16;
using bf16x8=__attribute__((ext_vector_type(8)))short;
using s16x4=__attribute__((ext_vector_type(4)))short;
using f32x16=__attribute__((ext_vector_type(16)))float;
using u32x4=__attribute__((ext_vector_type(4)))unsigned;
constexpr int D=64;
constexpr int PQ=1024,PK=1024,PV=1024,PO=2048;
constexpr int NW=8,QBLK=32,QB=QBLK*NW,KVBLK=64;
__device__ __forceinline__ int crow(int r,int hi){return (r&3)+8*(r>>2)+4*hi;}
#define SBAR() __builtin_amdgcn_sched_barrier(0)
__device__ __forceinline__ void cmask(f32x16&p0,f32x16&p1,int jb,int qrel,int hi){
  const float NEG=-INFINITY; int kb=64*jb+4*hi;
  #pragma unroll
  for(int r=0;r<16;++r){int kv=kb+(r&3)+8*(r>>2); if(kv>qrel)p0[r]=NEG; if(kv+32>qrel)p1[r]=NEG;}
}
constexpr int NSLOT=3, SLOTB=8192;
constexpr int LDS_K=0, LDS_V=NSLOT*SLOTB, LDS_WS=2*NSLOT*SLOTB, LDS_OST=LDS_WS+NW*64*4, LDS_BYTES=LDS_OST+NW*4096;
constexpr float C2=0.125f*1.4426950408889634f;
__device__ __forceinline__ void glds16(const void*gsrc,unsigned lds_dst){unsigned keep;
  asm volatile("s_mov_b32 %0, m0\n\ts_mov_b32 m0, %2\n\ts_nop 0\n\tglobal_load_lds_dwordx4 %1, off\n\ts_mov_b32 m0, %0":"=&s"(keep):"v"(gsrc),"s"(lds_dst):"memory");}
__device__ __forceinline__ float max3f(float a,float b,float c){float r;asm("v_max3_f32 %0, %1, %2, %3":"=v"(r):"v"(a),"v"(b),"v"(c));return r;}
__device__ __forceinline__ float max2f(float a,float b){float r;asm("v_max_f32_e32 %0, %1, %2":"=v"(r):"v"(a),"v"(b));return r;}
__device__ __forceinline__ float fadd_s(float a,float b){float r;asm("v_add_f32_e32 %0, %1, %2":"=v"(r):"v"(a),"v"(b));return r;}
__device__ __forceinline__ float fsub_s(float a,float b){float r;asm("v_sub_f32_e32 %0, %1, %2":"=v"(r):"v"(a),"v"(b));return r;}
typedef float f32x2_t __attribute__((ext_vector_type(2))); typedef __bf16 bf16x2_t __attribute__((ext_vector_type(2)));
__device__ __forceinline__ unsigned cvtpk_s(float lo,float hi){f32x2_t v={lo,hi};bf16x2_t b=__builtin_convertvector(v,bf16x2_t);return __builtin_bit_cast(unsigned,b);}
#define WAIT_BAR(N) asm volatile("s_waitcnt vmcnt(" #N ") lgkmcnt(0)\n\ts_barrier":::"memory")

__device__ __forceinline__ void qkt(f32x16&p0,f32x16&p1,const char*Kslot,const bf16x8*qr,const f32x16&negm,int r32,int hi){
  const char*kb=Kslot+hi*1024+r32*16;
  #pragma unroll
  for(int d0=0;d0<4;++d0){
    const bf16x8 b0=*reinterpret_cast<const bf16x8*>(kb+d0*2048);
    const bf16x8 b1=*reinterpret_cast<const bf16x8*>(kb+d0*2048+512);
    if(d0==0){p0=__builtin_amdgcn_mfma_f32_32x32x16_bf16(b0,qr[0],negm,0,0,0);p1=__builtin_amdgcn_mfma_f32_32x32x16_bf16(b1,qr[0],negm,0,0,0);}
    else{p0=__builtin_amdgcn_mfma_f32_32x32x16_bf16(b0,qr[d0],p0,0,0,0);p1=__builtin_amdgcn_mfma_f32_32x32x16_bf16(b1,qr[d0],p1,0,0,0);}}
}
typedef __attribute__((address_space(3))) const char* lds_cptr;
typedef short v4i16_t __attribute__((ext_vector_type(4)));
__device__ __forceinline__ void kload8(bf16x8*kf,lds_cptr kp){
  kf[0]=*(const __attribute__((address_space(3))) bf16x8*)(kp);      kf[1]=*(const __attribute__((address_space(3))) bf16x8*)(kp+512);
  kf[2]=*(const __attribute__((address_space(3))) bf16x8*)(kp+2048); kf[3]=*(const __attribute__((address_space(3))) bf16x8*)(kp+2560);
  kf[4]=*(const __attribute__((address_space(3))) bf16x8*)(kp+4096); kf[5]=*(const __attribute__((address_space(3))) bf16x8*)(kp+4608);
  kf[6]=*(const __attribute__((address_space(3))) bf16x8*)(kp+6144); kf[7]=*(const __attribute__((address_space(3))) bf16x8*)(kp+6656);
}
__device__ __forceinline__ void kload2(bf16x8*kf,lds_cptr kp,int j){ kf[2*j]=*(const __attribute__((address_space(3))) bf16x8*)(kp+j*2048); kf[2*j+1]=*(const __attribute__((address_space(3))) bf16x8*)(kp+j*2048+512); }
__device__ __forceinline__ s16x4 vtr(lds_cptr p){ return __builtin_bit_cast(s16x4,__builtin_amdgcn_ds_read_tr16_b64_v4i16((__attribute__((address_space(3))) v4i16_t*)p)); }
__device__ __forceinline__ float rowmax(const f32x16&p0,const f32x16&p1){
  float a=max3f(p0[0],p0[1],p1[0]),b=max3f(p0[2],p0[3],p1[1]);a=max3f(a,p1[2],p1[3]);
  #pragma unroll
  for(int r=4;r<16;r+=4){a=max3f(a,p0[r],p0[r+1]);b=max3f(b,p0[r+2],p0[r+3]);a=max3f(a,p1[r],p1[r+1]);b=max3f(b,p1[r+2],p1[r+3]);}
  const float m=max2f(a,b);
  auto rr=__builtin_amdgcn_permlane32_swap(__float_as_uint(m),__float_as_uint(m),false,false);
  return max2f(__uint_as_float(rr[0]),__uint_as_float(rr[1]));
}
__device__ __forceinline__ void pv(f32x16*o,int vb,bf16x8 pa0,bf16x8 pa1,bf16x8 pa2,bf16x8 pa3){
  #pragma unroll
  for(int d0=0;d0<2;++d0){s16x4 lo[4],hi[4];
    #pragma unroll
    for(int ks=0;ks<4;++ks){
      asm volatile("ds_read_b64_tr_b16 %0,%1 offset:%c2":"=&v"(lo[ks]):"v"(vb),"i"(d0*4096+ks*1024):"memory");
      asm volatile("ds_read_b64_tr_b16 %0,%1 offset:%c2":"=&v"(hi[ks]):"v"(vb),"i"(d0*4096+ks*1024+512):"memory");}
    asm volatile("s_waitcnt lgkmcnt(0)":::"memory");SBAR();
    #define PK(k) (bf16x8){lo[k][0],lo[k][1],lo[k][2],lo[k][3],hi[k][0],hi[k][1],hi[k][2],hi[k][3]}
    o[d0]=__builtin_amdgcn_mfma_f32_32x32x16_bf16(pa0,PK(0),o[d0],0,0,0);
    o[d0]=__builtin_amdgcn_mfma_f32_32x32x16_bf16(pa1,PK(1),o[d0],0,0,0);
    o[d0]=__builtin_amdgcn_mfma_f32_32x32x16_bf16(pa2,PK(2),o[d0],0,0,0);
    o[d0]=__builtin_amdgcn_mfma_f32_32x32x16_bf16(pa3,PK(3),o[d0],0,0,0);
    #undef PK
  }
}
#ifndef ATTN_STORE16
#define ATTN_STORE16(p,v) st16_wt((void*)(p),(v))
#endif
template<int THRL> __device__ __forceinline__ void attn_unit(int qb,const bf16*Qh,const bf16*__restrict__ Kh,const bf16*__restrict__ Vh,bf16*Oh,char*shm){
  const int tid=opaque_tid(),lane=tid&63,r32=lane&31,hi=lane>>5; const int wid=__builtin_amdgcn_readfirstlane(tid>>6);
  const int q0=qb*QB;
  const bf16*Qw=Qh+(long)(q0+wid*QBLK)*PQ;
  const unsigned lds0=(unsigned)(uintptr_t)shm;
  float*wsf=(float*)(shm+LDS_WS)+wid*64;
  const bf16*ksrc=Kh+(long)lane*PK+wid*8;
  const bf16*vsrc=Vh+(long)(16*(wid&3)+(lane>>2))*PV+(wid>>2)*32+(lane&3)*8;
  const unsigned kdst=lds0+LDS_K+wid*1024, vdst=lds0+LDS_V+wid*1024;
  #define DMA_K(t,slot) glds16(ksrc+(long)(t)*KVBLK*PK,(unsigned)__builtin_amdgcn_readfirstlane(kdst+(slot)))
  #define DMA_V(t,slot) glds16(vsrc+(long)(t)*KVBLK*PV,(unsigned)__builtin_amdgcn_readfirstlane(vdst+(slot)))
  const int vb0=(int)(lds0+LDS_V)+((lane>>4)&1)*32+(lane&3)*8+(4*hi+((lane&15)>>2))*64;
  const char*Kbase=shm+LDS_K; bf16x8 kf[8];
  const lds_cptr shm3=(lds_cptr)shm; const lds_cptr kp0=shm3+LDS_K+hi*1024+r32*16; const lds_cptr vp0=shm3+LDS_V+((lane>>4)&1)*32+(lane&3)*8+(4*hi+((lane&15)>>2))*64;
  const int NT=(q0+QB)/KVBLK;
  DMA_K(0,0);DMA_V(0,0);DMA_K(1,SLOTB);
  bf16x8 qr[4];
  #pragma unroll
  for(int d0=0;d0<4;++d0)qr[d0]=*reinterpret_cast<const bf16x8*>(&Qw[(long)r32*PQ+d0*16+hi*8]);
  float mhat=0.f,l_reg=0.f;f32x16 o[2];o[0]=f32x16{};o[1]=f32x16{};f32x16 negm=f32x16{};asm volatile("":"+v"(negm));
  const int qrel=wid*QBLK+r32;
  #define CMASK(P0,P1,t) do{int jb_=(t)-(NT-4); if(jb_>=0)cmask(P0,P1,jb_,qrel,hi);}while(0)
  bool resc=false;
  #define START(P0,P1) do{ const float rm=rowmax(P0,P1); resc=false; \
    { const float dl=rm; mhat=fadd_s(mhat,dl); \
      _Pragma("unroll") for(int r=0;r<16;++r){P0[r]=fsub_s(P0[r],dl);P1[r]=fsub_s(P1[r],dl);} \
      _Pragma("unroll") for(int r=0;r<16;++r)negm[r]=-mhat; asm volatile("":"+v"(negm)); } \
    _Pragma("unroll") for(int r=0;r<16;++r)P0[r]=__builtin_amdgcn_exp2f(P0[r]); }while(0)
  #define RESC() do{ if(resc){ asm volatile("s_waitcnt lgkmcnt(0)":::"memory"); \
      _Pragma("unroll") for(int d_=0;d_<2;++d_) _Pragma("unroll") for(int r=0;r<16;++r)o[d_][r]*=wsf[crow(r,hi)]; } }while(0)
  f32x16 pA0,pA1,pB0,pB1;
  int sl_prev=0,sl_cur=0,sl_next=SLOTB;
  #define ROT() do{sl_prev=sl_cur;sl_cur=sl_next;sl_next=(sl_next==(NSLOT-1)*SLOTB)?0:sl_next+SLOTB;}while(0)
  DMA_K(2,2*SLOTB);
  WAIT_BAR(3);
  qkt(pA0,pA1,Kbase,qr,negm,r32,hi);asm volatile("s_nop 15\n\ts_nop 7":"+v"(pA0),"+v"(pA1));CMASK(pA0,pA1,0);
  START(pA0,pA1);
  _Pragma("unroll") for(int r=0;r<16;++r)pA1[r]=__builtin_amdgcn_exp2f(pA1[r]);
  WAIT_BAR(0);
  DMA_K(3,0);DMA_V(1,SLOTB);
  ROT();
  kload8(kf,kp0+sl_cur);
  WAIT_BAR(2);
  s16x4 vlo[8],vhi[8]; u32x4 pw0,pw1,pw2,pw3;
  #define PKW(P,B) cvtpk_s(P[B],P[B+1])
  #define PAF(k) __builtin_bit_cast(bf16x8,pw##k)
  #define VFR(i) (bf16x8){vlo[i][0],vlo[i][1],vlo[i][2],vlo[i][3],vhi[i][0],vhi[i][1],vhi[i][2],vhi[i][3]}
  #define PIN(x) asm volatile("":"+v"(x))
  #define MX3(a,b,c) __builtin_fmaxf(__builtin_fmaxf((a),(b)),(c))
  #define GAPA(MF,A0,A1,A2,A3,W0,W1,PW) do{ MF; sacc+=A0; sacc+=A1; sacc+=A2; sacc+=A3; PIN(sacc); W0; W1; PIN(PW); SBAR(); }while(0)
  #define EX(v) __builtin_amdgcn_exp2f(v)
  #define GAPB(MF,X,B) do{ MF; X[B]=EX(X[B]); X[B+1]=EX(X[B+1]); X[B+2]=EX(X[B+2]); X[B+3]=EX(X[B+3]); PIN(X); SBAR(); }while(0)
  #define VRD(i) do{ vlo[i]=vtr(vp_+(((i)>>2)*4096+((i)&3)*1024)); vhi[i]=vtr(vp_+(((i)>>2)*4096+((i)&3)*1024+512)); }while(0)
  #define KRD(G,j) do{ if(G){ kload2(kf,kp0+sl_next,j); SBAR(); } }while(0)
  #define STEP(C0,C1,P0,P1,t,GK,GV,GL) do{ SBAR(); \
    const lds_cptr vp_=vp0+sl_prev; \
    VRD(0); SBAR(); float sacc=(P0[0]+P0[1]); \
    GAPA(C0=__builtin_amdgcn_mfma_f32_32x32x16_bf16(kf[0],qr[0],negm,0,0,0), P0[2],P0[3],P0[4],P0[5],     pw0[0]=PKW(P0,0), pw0[1]=PKW(P0,2), pw0); \
    VRD(4); SBAR(); GAPA(C1=__builtin_amdgcn_mfma_f32_32x32x16_bf16(kf[1],qr[0],negm,0,0,0), P0[6],P0[7],P0[8],P0[9],     pw0[2]=PKW(P0,4), pw0[3]=PKW(P0,6), pw0); \
    VRD(1); SBAR(); GAPA(C0=__builtin_amdgcn_mfma_f32_32x32x16_bf16(kf[2],qr[1],C0,0,0,0),   P0[10],P0[11],P0[12],P0[13], pw1[0]=PKW(P0,8), pw1[1]=PKW(P0,10), pw1); \
    VRD(5); SBAR(); GAPA(C1=__builtin_amdgcn_mfma_f32_32x32x16_bf16(kf[3],qr[1],C1,0,0,0),   P0[14],P0[15],P1[0],P1[1],   pw1[2]=PKW(P0,12),pw1[3]=PKW(P0,14), pw1); \
    VRD(2); SBAR(); GAPA(C0=__builtin_amdgcn_mfma_f32_32x32x16_bf16(kf[4],qr[2],C0,0,0,0),   P1[2],P1[3],P1[4],P1[5],     pw2[0]=PKW(P1,0), pw2[1]=PKW(P1,2), pw2); \
    VRD(6); SBAR(); GAPA(C1=__builtin_amdgcn_mfma_f32_32x32x16_bf16(kf[5],qr[2],C1,0,0,0),   P1[6],P1[7],P1[8],P1[9],     pw2[2]=PKW(P1,4), pw2[3]=PKW(P1,6), pw2); \
    VRD(3); SBAR(); GAPA(C0=__builtin_amdgcn_mfma_f32_32x32x16_bf16(kf[6],qr[3],C0,0,0,0),   P1[10],P1[11],P1[12],P1[13], pw3[0]=PKW(P1,8), pw3[1]=PKW(P1,10), pw3); \
    VRD(7); SBAR(); GAPA(C1=__builtin_amdgcn_mfma_f32_32x32x16_bf16(kf[7],qr[3],C1,0,0,0),   P1[14],P1[15],0.f,0.f,       pw3[2]=PKW(P1,12),pw3[3]=PKW(P1,14), pw3); \
    l_reg+=sacc; \
    if(GK){DMA_K((t)+3,sl_cur);} if(GV){DMA_V((t)+1,sl_next);} \
    CMASK(C0,C1,t); \
    { float a=MX3(C0[0],C0[1],C1[0]),b=MX3(C0[2],C0[3],C1[1]); a=MX3(a,C1[2],C1[3]); \
      _Pragma("unroll") for(int r=4;r<16;r+=4){a=MX3(a,C0[r],C0[r+1]);b=MX3(b,C0[r+2],C0[r+3]);a=MX3(a,C1[r],C1[r+1]);b=MX3(b,C1[r+2],C1[r+3]);} \
      float rm=__builtin_fmaxf(a,b); { auto rr=__builtin_amdgcn_permlane32_swap(__float_as_uint(rm),__float_as_uint(rm),false,false); rm=__builtin_fmaxf(__uint_as_float(rr[0]),__uint_as_float(rr[1])); } \
      resc=false; \
      if(__builtin_expect(__any(rm>(float)THRL),0)){ const float dl=__builtin_fmaxf(rm,0.f); mhat+=dl; \
        _Pragma("unroll") for(int r=0;r<16;++r){C0[r]-=dl;C1[r]-=dl;} \
        _Pragma("unroll") for(int r=0;r<16;++r)negm[r]=-mhat; asm volatile("":"+v"(negm)); \
        const float f=__builtin_amdgcn_exp2f(-dl); l_reg*=f; if(hi==0)wsf[r32]=f; resc=true; } } \
    SBAR(); \
    GAPB(o[0]=__builtin_amdgcn_mfma_f32_32x32x16_bf16(PAF(0),VFR(0),o[0],0,0,0), C0,0); \
    GAPB(o[1]=__builtin_amdgcn_mfma_f32_32x32x16_bf16(PAF(0),VFR(4),o[1],0,0,0), C0,4); \
    KRD(GL,0); GAPB(o[0]=__builtin_amdgcn_mfma_f32_32x32x16_bf16(PAF(1),VFR(1),o[0],0,0,0), C0,8); \
    KRD(GL,1); GAPB(o[1]=__builtin_amdgcn_mfma_f32_32x32x16_bf16(PAF(1),VFR(5),o[1],0,0,0), C0,12); \
    KRD(GL,2); GAPB(o[0]=__builtin_amdgcn_mfma_f32_32x32x16_bf16(PAF(2),VFR(2),o[0],0,0,0), C1,0); \
    KRD(GL,3); GAPB(o[1]=__builtin_amdgcn_mfma_f32_32x32x16_bf16(PAF(2),VFR(6),o[1],0,0,0), C1,4); \
    GAPB(o[0]=__builtin_amdgcn_mfma_f32_32x32x16_bf16(PAF(3),VFR(3),o[0],0,0,0), C1,8); \
    GAPB(o[1]=__builtin_amdgcn_mfma_f32_32x32x16_bf16(PAF(3),VFR(7),o[1],0,0,0), C1,12); \
    }while(0)
  int t=1;
  #undef CMASK
  #define CMASK(P0,P1,t) do{}while(0)
  for(;t+5<NT;t+=2){
    STEP(pB0,pB1,pA0,pA1,t,true,true,true);     WAIT_BAR(2); RESC(); ROT();
    STEP(pA0,pA1,pB0,pB1,t+1,true,true,true);   WAIT_BAR(2); RESC(); ROT();
  }
  #undef CMASK
  #define CMASK(P0,P1,t) do{int jb_=(t)-(NT-4); if(jb_>=0)cmask(P0,P1,jb_,qrel,hi);}while(0)
  #define ENDW(tt) do{ if((tt)+3<NT){WAIT_BAR(2);} else if((tt)+2<NT){WAIT_BAR(1);} else {WAIT_BAR(0);} }while(0)
  for(;t+1<NT;t+=2){
    STEP(pB0,pB1,pA0,pA1,t,(t+3<NT),(t+1<NT),(t+1<NT));       ENDW(t);   RESC(); ROT();
    STEP(pA0,pA1,pB0,pB1,t+1,(t+4<NT),(t+2<NT),(t+2<NT));     ENDW(t+1); RESC(); ROT();
  }
  STEP(pB0,pB1,pA0,pA1,NT-1,false,false,false); RESC();
  { float sacc=pB0[0]+pB0[1]; _Pragma("unroll") for(int r=2;r<16;++r)sacc+=pB0[r]; _Pragma("unroll") for(int r=0;r<16;++r)sacc+=pB1[r]; l_reg+=sacc;
    pw0=(u32x4){PKW(pB0,0),PKW(pB0,2),PKW(pB0,4),PKW(pB0,6)};pw1=(u32x4){PKW(pB0,8),PKW(pB0,10),PKW(pB0,12),PKW(pB0,14)};pw2=(u32x4){PKW(pB1,0),PKW(pB1,2),PKW(pB1,4),PKW(pB1,6)};pw3=(u32x4){PKW(pB1,8),PKW(pB1,10),PKW(pB1,12),PKW(pB1,14)};
    SBAR(); pv(o,vb0+sl_cur,PAF(0),PAF(1),PAF(2),PAF(3)); }
  #undef PKW
  #undef PAF
  #undef VFR
  #undef PIN
  #undef MX3
  #undef GAPA
  #undef GAPB
  #undef EX
  #undef VRD
  #undef KRD
  #undef STEP
  #undef ENDW
  {auto rr=__builtin_amdgcn_permlane32_swap(__float_as_uint(l_reg),__float_as_uint(l_reg),false,false);l_reg=__uint_as_float(rr[0])+__uint_as_float(rr[1]);}
  if(hi==0)wsf[32+r32]=l_reg;asm volatile("s_waitcnt lgkmcnt(0)":::"memory");
  float rli[16];
  #pragma unroll
  for(int r=0;r<16;++r)rli[r]=__builtin_amdgcn_rcpf(wsf[32+crow(r,hi)]);
  bf16*Ow=Oh+(long)(q0+wid*QBLK)*PO;
  { bf16*stg=(bf16*)(shm+LDS_OST)+wid*2048;
    #pragma unroll
    for(int r=0;r<16;++r){const int orow=crow(r,hi);
      #pragma unroll
      for(int d0=0;d0<2;++d0)stg[orow*64+d0*32+r32]=__float2bfloat16(o[d0][r]*rli[r]);}
    asm volatile("s_waitcnt lgkmcnt(0)":::"memory");
    #pragma unroll
    for(int i=0;i<4;++i){const int row=i*8+(lane>>3),ch=lane&7; const u32x4 v=*(const u32x4*)(stg+row*64+ch*8); ATTN_STORE16(Ow+(long)row*PO+ch*8,v);} }
  asm volatile("s_waitcnt lgkmcnt(0)\n\ts_barrier":::"memory");
  #undef DMA_K
  #undef DMA_V
  #undef CMASK
  #undef START
  #undef RESC
  #undef ROT
}

constexpr int VSLOT=2*SLOTB;
constexpr int L2_K=0, L2_V=NSLOT*SLOTB, L2_WS=L2_V+NSLOT*VSLOT, L2_OST=L2_WS+NW*64*4, L2_BYTES=L2_OST+NW*4096;
__device__ __forceinline__ void pv128(f32x16*o,int vb,bf16x8 pa0,bf16x8 pa1,bf16x8 pa2,bf16x8 pa3){
  #pragma unroll
  for(int d0=0;d0<4;++d0){s16x4 lo[4],hi[4];
    #pragma unroll
    for(int ks=0;ks<4;++ks){
      asm volatile("ds_read_b64_tr_b16 %0,%1 offset:%c2":"=&v"(lo[ks]):"v"(vb),"i"(d0*4096+ks*1024):"memory");
      asm volatile("ds_read_b64_tr_b16 %0,%1 offset:%c2":"=&v"(hi[ks]):"v"(vb),"i"(d0*4096+ks*1024+512):"memory");}
    asm volatile("s_waitcnt lgkmcnt(0)":::"memory");SBAR();
    #define PK(k) (bf16x8){lo[k][0],lo[k][1],lo[k][2],lo[k][3],hi[k][0],hi[k][1],hi[k][2],hi[k][3]}
    o[d0]=__builtin_amdgcn_mfma_f32_32x32x16_bf16(pa0,PK(0),o[d0],0,0,0);
    o[d0]=__builtin_amdgcn_mfma_f32_32x32x16_bf16(pa1,PK(1),o[d0],0,0,0);
    o[d0]=__builtin_amdgcn_mfma_f32_32x32x16_bf16(pa2,PK(2),o[d0],0,0,0);
    o[d0]=__builtin_amdgcn_mfma_f32_32x32x16_bf16(pa3,PK(3),o[d0],0,0,0);
    #undef PK
  }
}
struct AttnNext { bool has; int qb; const bf16* Qh; const bf16* Kh; const bf16* Vh; };
struct AttnCarry { bool primed; int s0; bf16x8 qr[4]; };
template<int THRL,class Post> __device__ __forceinline__ void attn_unit128(int qb,const bf16*Qh,const bf16*__restrict__ Kh,const bf16*__restrict__ Vh,bf16*Oh,char*shm,const Post&post,const AttnNext&nx,AttnCarry&cy){
  const int tid=opaque_tid(),lane=tid&63,r32=lane&31,hi=lane>>5; const int wid=__builtin_amdgcn_readfirstlane(tid>>6);
  const int q0=qb*QB;
  const bf16*Qw=Qh+(long)(q0+wid*QBLK)*PQ;
  const unsigned lds0=(unsigned)(uintptr_t)shm;
  float*wsf=(float*)(shm+L2_WS)+wid*64;
  const bf16*ksrc=Kh+(long)lane*PK+wid*8;
  const bf16*vsrc=Vh+(long)(16*(wid&3)+(lane>>2))*PV+(wid>>2)*32+(lane&3)*8;
  const unsigned kdst=lds0+L2_K+wid*1024, vdst=lds0+L2_V+wid*1024;
  #define DMA_K(t,slot) glds16(ksrc+(long)(t)*KVBLK*PK,(unsigned)__builtin_amdgcn_readfirstlane(kdst+(slot)))
  #define DMA_V(t,slot) do{ glds16(vsrc+(long)(t)*KVBLK*PV,(unsigned)__builtin_amdgcn_readfirstlane(vdst+2*(slot))); glds16(vsrc+(long)(t)*KVBLK*PV+64,(unsigned)__builtin_amdgcn_readfirstlane(vdst+2*(slot)+8192)); }while(0)
  const char*Kbase=shm+L2_K; bf16x8 kf[8];
  const lds_cptr shm3=(lds_cptr)shm; const lds_cptr kp0=shm3+L2_K+hi*1024+r32*16; const lds_cptr vp0=shm3+L2_V+((lane>>4)&1)*32+(lane&3)*8+(4*hi+((lane&15)>>2))*64;
  const int NT=(q0+QB)/KVBLK;
  const bool primed=cy.primed; const int s0=primed?cy.s0:0, s1=(s0==(NSLOT-1)*SLOTB)?0:s0+SLOTB, s2=(s1==(NSLOT-1)*SLOTB)?0:s1+SLOTB;
  bf16x8 (&qr)[4]=cy.qr;
  if(!primed){
    DMA_K(0,s0);DMA_V(0,s0);DMA_K(1,s1);
    #pragma unroll
    for(int d0=0;d0<4;++d0)qr[d0]=*reinterpret_cast<const bf16x8*>(&Qw[(long)r32*PQ+d0*16+hi*8]);
  }
  float mhat=0.f,l_reg=0.f;f32x16 o[4];o[0]=f32x16{};o[1]=f32x16{};o[2]=f32x16{};o[3]=f32x16{};f32x16 negm=f32x16{};asm volatile("":"+v"(negm));
  const int qrel=wid*QBLK+r32;
  #define CMASK(P0,P1,t) do{int jb_=(t)-(NT-4); if(jb_>=0)cmask(P0,P1,jb_,qrel,hi);}while(0)
  bool resc=false;
  #define RESC() do{ if(resc){ asm volatile("s_waitcnt lgkmcnt(0)":::"memory"); \
      _Pragma("unroll") for(int d_=0;d_<4;++d_) _Pragma("unroll") for(int r=0;r<16;++r)o[d_][r]*=wsf[crow(r,hi)]; } }while(0)
  f32x16 c0,c1;
  int sl_prev=s0,sl_cur=s0,sl_next=s1;
  #define ROT() do{sl_prev=sl_cur;sl_cur=sl_next;sl_next=(sl_next==(NSLOT-1)*SLOTB)?0:sl_next+SLOTB;}while(0)
  if(!primed){
    DMA_K(2,s2);
    WAIT_BAR(3);
  }
  qkt(c0,c1,Kbase+s0,qr,negm,r32,hi);asm volatile("s_nop 15\n\ts_nop 7":"+v"(c0),"+v"(c1));CMASK(c0,c1,0);
  u32x4 pw0,pw1,pw2,pw3;
  #define PKW(P,B) cvtpk_s(P[B],P[(B)+1])
  { const float rm=rowmax(c0,c1); mhat=fadd_s(mhat,rm);
    _Pragma("unroll") for(int r=0;r<16;++r){c0[r]=fsub_s(c0[r],rm);c1[r]=fsub_s(c1[r],rm);}
    _Pragma("unroll") for(int r=0;r<16;++r)negm[r]=-mhat; asm volatile("":"+v"(negm));
    _Pragma("unroll") for(int r=0;r<16;++r){c0[r]=__builtin_amdgcn_exp2f(c0[r]);c1[r]=__builtin_amdgcn_exp2f(c1[r]);}
    float sacc=c0[0]+c0[1]; _Pragma("unroll") for(int r=2;r<16;++r)sacc+=c0[r]; _Pragma("unroll") for(int r=0;r<8;++r)sacc+=c1[r]; l_reg+=sacc;
    pw0=(u32x4){PKW(c0,0),PKW(c0,2),PKW(c0,4),PKW(c0,6)};pw1=(u32x4){PKW(c0,8),PKW(c0,10),PKW(c0,12),PKW(c0,14)};pw2=(u32x4){PKW(c1,0),PKW(c1,2),PKW(c1,4),PKW(c1,6)}; }
  WAIT_BAR(0);
  DMA_K(3,s0);DMA_V(1,s1);
  ROT();
  kload8(kf,kp0+sl_cur);
  WAIT_BAR(3);
  s16x4 vlo[8],vhi[8];
  #define PAF(k) __builtin_bit_cast(bf16x8,pw##k)
  #define VFR(i) (bf16x8){vlo[i][0],vlo[i][1],vlo[i][2],vlo[i][3],vhi[i][0],vhi[i][1],vhi[i][2],vhi[i][3]}
  #define PIN(x) asm volatile("":"+v"(x))
  #define MX3(a,b,c) __builtin_fmaxf(__builtin_fmaxf((a),(b)),(c))
  #define EX(v) __builtin_amdgcn_exp2f(v)
  #define VRDF(sl,db,ks) do{ vlo[sl]=vtr(vp_+((db)*4096+(ks)*1024)); vhi[sl]=vtr(vp_+((db)*4096+(ks)*1024+512)); }while(0)
  #define KRD(G,j) do{ if(G){ kload2(kf,kp0+sl_next,j); SBAR(); } }while(0)
  #define MFQ(C,KF,Q,CIN) C=__builtin_amdgcn_mfma_f32_32x32x16_bf16(KF,Q,CIN,0,0,0)
  #define MFO(DB,KS,SL) o[DB]=__builtin_amdgcn_mfma_f32_32x32x16_bf16(PAF(KS),VFR(SL),o[DB],0,0,0)
  #define EX2(X,B) do{ X[B]=EX(X[B]); X[(B)+1]=EX(X[(B)+1]); PIN(X); }while(0)
  #define SPK(Y,PB,PW,W) do{ sacc+=Y[PB]; sacc+=Y[(PB)+1]; PIN(sacc); PW[W]=PKW(Y,PB); PIN(PW); }while(0)
  #define STEP(t,GK,GV,GL) do{ SBAR(); \
    const lds_cptr vp_=vp0+2*sl_prev; float sacc; \
    VRDF(0,0,0); SBAR(); MFQ(c0,kf[0],qr[0],negm); sacc=(c1[8]+c1[9]); sacc+=c1[10]; sacc+=c1[11]; sacc+=c1[12]; sacc+=c1[13]; sacc+=c1[14]; sacc+=c1[15]; PIN(sacc); \
                         pw3[0]=PKW(c1,8); pw3[1]=PKW(c1,10); pw3[2]=PKW(c1,12); pw3[3]=PKW(c1,14); PIN(pw3); SBAR(); \
    VRDF(1,1,0); SBAR(); MFQ(c1,kf[1],qr[0],negm); SBAR(); \
    VRDF(2,2,0); SBAR(); MFQ(c0,kf[2],qr[1],c0); SBAR(); \
    VRDF(3,3,0); SBAR(); MFQ(c1,kf[3],qr[1],c1); SBAR(); \
    VRDF(4,0,1); SBAR(); MFQ(c0,kf[4],qr[2],c0); SBAR(); \
    VRDF(5,1,1); SBAR(); MFQ(c1,kf[5],qr[2],c1); SBAR(); \
    VRDF(6,2,1); SBAR(); MFQ(c0,kf[6],qr[3],c0); SBAR(); \
    VRDF(7,3,1); SBAR(); MFQ(c1,kf[7],qr[3],c1); SBAR(); \
    l_reg+=sacc; sacc=0.f; \
    if(GK){DMA_K((t)+3,sl_cur);} if(GV){DMA_V((t)+1,sl_next);} \
    CMASK(c0,c1,t); \
    { float a=MX3(c0[0],c0[1],c1[0]),b=MX3(c0[2],c0[3],c1[1]); a=MX3(a,c1[2],c1[3]); \
      _Pragma("unroll") for(int r=4;r<16;r+=4){a=MX3(a,c0[r],c0[r+1]);b=MX3(b,c0[r+2],c0[r+3]);a=MX3(a,c1[r],c1[r+1]);b=MX3(b,c1[r+2],c1[r+3]);} \
      float rm=__builtin_fmaxf(a,b); { auto rr=__builtin_amdgcn_permlane32_swap(__float_as_uint(rm),__float_as_uint(rm),false,false); rm=__builtin_fmaxf(__uint_as_float(rr[0]),__uint_as_float(rr[1])); } \
      resc=false; \
      if(__builtin_expect(__any(rm>(float)THRL),0)){ const float dl=__builtin_fmaxf(rm,0.f); mhat+=dl; \
        _Pragma("unroll") for(int r=0;r<16;++r){c0[r]-=dl;c1[r]-=dl;} \
        _Pragma("unroll") for(int r=0;r<16;++r)negm[r]=-mhat; asm volatile("":"+v"(negm)); \
        const float f=__builtin_amdgcn_exp2f(-dl); l_reg*=f; if(hi==0)wsf[r32]=f; resc=true; } } \
    SBAR(); \
    MFO(0,0,0); VRDF(0,0,2); EX2(c0,0);  SBAR(); \
    MFO(1,0,1); VRDF(1,1,2); EX2(c0,2);  SBAR(); \
    MFO(2,0,2); VRDF(2,2,2); EX2(c0,4);  SBAR(); \
    MFO(3,0,3); VRDF(3,3,2); EX2(c0,6);  SBAR(); \
    MFO(0,1,4); VRDF(4,0,3); EX2(c0,8);  SPK(c0,0,pw0,0); SBAR(); \
    MFO(1,1,5); VRDF(5,1,3); EX2(c0,10); SPK(c0,2,pw0,1); SBAR(); \
    MFO(2,1,6); VRDF(6,2,3); EX2(c0,12); SPK(c0,4,pw0,2); SBAR(); \
    MFO(3,1,7); VRDF(7,3,3); EX2(c0,14); SPK(c0,6,pw0,3); SBAR(); \
    KRD(GL,0); MFO(0,2,0); EX2(c1,0);  SPK(c0,8,pw1,0);  SBAR(); \
    KRD(GL,1); MFO(1,2,1); EX2(c1,2);  SPK(c0,10,pw1,1); SBAR(); \
    KRD(GL,2); MFO(2,2,2); EX2(c1,4);  SPK(c0,12,pw1,2); SBAR(); \
    KRD(GL,3); MFO(3,2,3); EX2(c1,6);  SPK(c0,14,pw1,3); SBAR(); \
    MFO(0,3,4); EX2(c1,8);  SPK(c1,0,pw2,0); SBAR(); \
    MFO(1,3,5); EX2(c1,10); SPK(c1,2,pw2,1); SBAR(); \
    MFO(2,3,6); EX2(c1,12); SPK(c1,4,pw2,2); SBAR(); \
    MFO(3,3,7); EX2(c1,14); SPK(c1,6,pw2,3); SBAR(); \
    l_reg+=sacc; \
    }while(0)
  int t=1;
  #undef CMASK
  #define CMASK(P0,P1,t) do{}while(0)
  for(;t+4<NT;++t){ STEP(t,true,true,true); WAIT_BAR(3); RESC(); ROT(); }
  #undef CMASK
  #define CMASK(P0,P1,t) do{int jb_=(t)-(NT-4); if(jb_>=0)cmask(P0,P1,jb_,qrel,hi);}while(0)
  const bool hn=nx.has;
  const long kadj=hn?(long)(nx.Kh-Kh)-(long)NT*KVBLK*PK:0L, vadj=hn?(long)(nx.Vh-Vh)-(long)NT*KVBLK*PV:0L;
  #undef DMA_K
  #undef DMA_V
  #define DMA_K(t,slot) glds16(ksrc+(long)(t)*KVBLK*PK+(((t)>=NT)?kadj:0L),(unsigned)__builtin_amdgcn_readfirstlane(kdst+(slot)))
  #define DMA_V(t,slot) do{ const bf16*vs_=vsrc+(long)(t)*KVBLK*PV+(((t)>=NT)?vadj:0L); glds16(vs_,(unsigned)__builtin_amdgcn_readfirstlane(vdst+2*(slot))); glds16(vs_+64,(unsigned)__builtin_amdgcn_readfirstlane(vdst+2*(slot)+8192)); }while(0)
  #define ENDW(tt) do{ if(hn||(tt)+3<NT){WAIT_BAR(3);} else if((tt)+2<NT){WAIT_BAR(2);} else {WAIT_BAR(0);} }while(0)
  for(;t+1<NT;++t){ STEP(t,(hn||t+3<NT),true,true); ENDW(t); RESC(); ROT(); }
  STEP(NT-1,hn,hn,false);
  if(hn){
    const bf16*QwN=nx.Qh+(long)(nx.qb*QB+wid*QBLK)*PQ;
    #pragma unroll
    for(int d0=0;d0<4;++d0)qr[d0]=*reinterpret_cast<const bf16x8*>(&QwN[(long)r32*PQ+d0*16+hi*8]);
    WAIT_BAR(7);
  }
  cy.primed=hn; cy.s0=sl_next;
  RESC();
  { float sacc=(c1[8]+c1[9]); _Pragma("unroll") for(int r=10;r<16;++r)sacc+=c1[r]; l_reg+=sacc;
    pw3=(u32x4){PKW(c1,8),PKW(c1,10),PKW(c1,12),PKW(c1,14)};
    SBAR(); pv128(o,(int)(unsigned)(uintptr_t)vp0+2*sl_cur,PAF(0),PAF(1),PAF(2),PAF(3)); }
  #undef PKW
  #undef PAF
  #undef VFR
  #undef PIN
  #undef MX3
  #undef EX
  #undef VRDF
  #undef KRD
  #undef MFQ
  #undef MFO
  #undef EX2
  #undef SPK
  #undef STEP
  #undef ENDW
  {auto rr=__builtin_amdgcn_permlane32_swap(__float_as_uint(l_reg),__float_as_uint(l_reg),false,false);l_reg=__uint_as_float(rr[0])+__uint_as_float(rr[1]);}
  if(hi==0)wsf[32+r32]=l_reg;asm volatile("s_waitcnt lgkmcnt(0)":::"memory");
  float rli[16];
  #pragma unroll
  for(int r=0;r<16;++r)rli[r]=__builtin_amdgcn_rcpf(wsf[32+crow(r,hi)]);
  if(post.on){
    asm volatile("s_waitcnt lgkmcnt(0)\n\ts_barrier":::"memory");
    const int so=__builtin_amdgcn_readfirstlane((wid<4)?(L2_OST+wid*8192):(L2_V+2*((wid<6)?sl_prev:sl_cur)+(wid&1)*8192));
    bf16*stg=(bf16*)(shm+so);
    #pragma unroll
    for(int r=0;r<16;++r){const int orow=crow(r,hi);
      #pragma unroll
      for(int d0=0;d0<4;++d0)stg[orow*128+d0*32+r32]=__float2bfloat16(o[d0][r]*rli[r]);}
    asm volatile("s_waitcnt lgkmcnt(0)":::"memory");
    post.run((lds_cptr)shm+so,q0+wid*QBLK,lane);
  } else {
  bf16*Ow=Oh+(long)(q0+wid*QBLK)*PO;
  { bf16*stg=(bf16*)(shm+L2_OST)+wid*2048;
    #pragma unroll
    for(int h2=0;h2<2;++h2){
      #pragma unroll
      for(int r=0;r<16;++r){const int orow=crow(r,hi);
        #pragma unroll
        for(int d0=0;d0<2;++d0)stg[orow*64+d0*32+r32]=__float2bfloat16(o[2*h2+d0][r]*rli[r]);}
      asm volatile("s_waitcnt lgkmcnt(0)":::"memory");
      #pragma unroll
      for(int i=0;i<4;++i){const int row=i*8+(lane>>3),ch=lane&7; const u32x4 v=*(const u32x4*)(stg+row*64+ch*8); ATTN_STORE16(Ow+(long)row*PO+h2*64+ch*8,v);}
      asm volatile("s_waitcnt lgkmcnt(0)":::"memory"); } }
  }
  asm volatile("s_waitcnt lgkmcnt(0)\n\ts_barrier":::"memory");
  #undef DMA_K
  #undef DMA_V
  #undef CMASK
  #undef RESC
  #undef ROT
}
constexpr int ATTN_LDS_BYTES=L2_BYTES;
#undef SBAR
#undef WAIT_BAR
}

constexpr int NWAVES = 8;
constexpr size_t MiB = 1u << 20;
constexpr size_t WS_CTL = 0, CTL_ZERO_BYTES = 1 * MiB;
constexpr size_t WS_ROPEC = 1 * MiB, WS_ROPES = WS_ROPEC + 256 * 1024;
constexpr size_t WS_ROUTE = 2 * MiB;
constexpr int ECAP = M, ECAP_LOG = 14;
static_assert((1 << ECAP_LOG) == ECAP, "ECAP");
constexpr size_t RT_SLOTOF = 0, RT_WSLOT = 128 * 1024, RT_SSSLOT = 1024 * 1024;
constexpr size_t WS_SS = 6 * MiB;
constexpr size_t WS_WIN = 10 * MiB;
constexpr size_t WS_WOUT = WS_WIN + 64 * MiB;
constexpr size_t WS_WGU = WS_WOUT + 8 * MiB;
constexpr size_t WS_WD = WS_WGU + 22 * MiB;
constexpr size_t WS_WEGU = WS_WD + 11 * MiB;
constexpr size_t WS_WED = WS_WEGU + 224 * MiB;
constexpr size_t WS_XB = WS_WED + 112 * MiB;
constexpr size_t WS_PROJ = WS_XB + 32 * MiB;
constexpr size_t WS_O = WS_PROJ + 256 * MiB;
constexpr size_t WS_MIX = WS_O + 64 * MiB;
constexpr size_t WS_Y = WS_MIX + 32 * MiB;
constexpr size_t WS_END = WS_Y + 68 * MiB;
static_assert((size_t)MSLOT * DFFE * 2 <= 256 * MiB && (size_t)MSLOT * 1024 * 2 <= 68 * MiB && (size_t)MSLOT * 1024 * 2 <= 96 * MiB, "overlays");
static_assert((size_t)NEXP * ECAP * 4 <= 896 * 1024 && RT_SSSLOT + (size_t)NEXP * ECAP * 16 <= 4 * MiB && (size_t)9 * M * 16 <= 4 * MiB && (size_t)NEXP * ECAP * 1024 <= 164 * MiB, "routing / ss map; sparse expert inputs overlay O | MIX | Y");
constexpr int CW_TMO = 0, CW_CODE = 1;
constexpr int CW_BAR = 4096;
constexpr int CW_GCNT = 16384;

constexpr int RING_OFF = 0, RING_BYTES = 131072;
constexpr int LDSCTL_OFF = RING_BYTES, MISC_OFF = LDSCTL_OFF + 320;
constexpr int LDS_BYTES = 163840;
static_assert(MISC_OFF + 128 <= LDS_BYTES, "LDS map");

#define GAS __attribute__((address_space(1)))
#define LAS __attribute__((address_space(3)))
typedef unsigned short bf16;
typedef unsigned v4u __attribute__((ext_vector_type(4)));
typedef unsigned v2u __attribute__((ext_vector_type(2)));
typedef float f32x4 __attribute__((ext_vector_type(4)));
typedef GAS unsigned gu32;
#define RLX_AGENT __ATOMIC_RELAXED, __HIP_MEMORY_SCOPE_AGENT
#define LDS_WAIT() asm volatile("s_waitcnt lgkmcnt(0)" ::: "memory")
#define VM_WAIT() asm volatile("s_waitcnt vmcnt(0)" ::: "memory")
__device__ __forceinline__ unsigned f2bf(float f) { unsigned u = __builtin_bit_cast(unsigned, f); return (u + 0x7fffu + ((u >> 16) & 1u)) >> 16; }
__device__ __forceinline__ unsigned pk2(float lo, float hi) { return f2bf(lo) | (f2bf(hi) << 16); }
__device__ __forceinline__ float bflo(unsigned w) { return __uint_as_float(w << 16); }
__device__ __forceinline__ float bfhi(unsigned w) { return __uint_as_float(w & 0xffff0000u); }

#define XB_TMO      128
#define XB_XCNT(j)  (256  + 64 * (j))
#define XB_XSUB(j)  (1280 + 64 * (j))
#define XB_XGEN(j)  (2304 + 64 * (j))
#define XB_TOP      3328
#define XB_TOPGEN   3392
#define XCD_BAR_WORDS 3456
#define XB_SPIN_CAP (1u << 18)
__device__ __forceinline__ unsigned xb_ld(unsigned* p)              { return __hip_atomic_load(p, __ATOMIC_RELAXED, __HIP_MEMORY_SCOPE_AGENT); }
__device__ __forceinline__ unsigned xb_add(unsigned* p, unsigned v) { return __hip_atomic_fetch_add(p, v, __ATOMIC_RELAXED, __HIP_MEMORY_SCOPE_AGENT); }
__device__ __forceinline__ unsigned xb_xcc_id() { return (unsigned)__builtin_amdgcn_s_getreg((3 << 11) | 20) & 0xFu; }
#define XB_SPIN(cond, bar) do { unsigned _sp = 0; while (cond) { __builtin_amdgcn_s_sleep(1); \
    if ((++_sp & 255u) == 0u) { if (xb_ld(&(bar)[XB_TMO])) break; if (_sp > XB_SPIN_CAP) { atomicAdd(&(bar)[XB_TMO], 1u); break; } } } } while (0)
struct XcdBarrier { unsigned* bar; unsigned x; volatile LAS unsigned* st; };
__device__ __forceinline__ XcdBarrier xcd_barrier_post(unsigned* bar, volatile LAS unsigned* st) {
    XcdBarrier b; b.bar = bar; b.x = xb_xcc_id(); b.st = st;
    if (threadIdx.x == 0) (void)xb_add(&bar[XB_XCNT(b.x)], 1u);
    return b;
}
__device__ __forceinline__ void xcd_barrier_complete(unsigned* bar, unsigned x, unsigned& nloc, unsigned& nx) {
    const unsigned G = gridDim.x * gridDim.y * gridDim.z;
    unsigned sum, cnt, mine, sp = 0u;
    for (;;) {
        sum = 0u; cnt = 0u; mine = 0u;
#pragma unroll
        for (unsigned j = 0; j < 16; ++j) { const unsigned c = xb_ld(&bar[XB_XCNT(j)]); sum += c; cnt += (c > 0u) ? 1u : 0u; mine = (j == x) ? c : mine; }
        if (sum == G) break;
        __builtin_amdgcn_s_sleep(1);
        if ((++sp & 255u) == 0u) { if (xb_ld(&bar[XB_TMO])) break; if (sp > XB_SPIN_CAP) { atomicAdd(&bar[XB_TMO], 1u); break; } }
    }
    nloc = mine > 0u ? mine : 1u; nx = cnt > 0u ? cnt : 1u;
}
__device__ __forceinline__ void xcd_barrier(const XcdBarrier& b) {
    asm volatile("s_waitcnt vmcnt(0)" ::: "memory");
    __syncthreads();
    if (threadIdx.x == 0) {
        unsigned* bar = b.bar;
        __builtin_amdgcn_s_waitcnt(0);
        unsigned nloc = b.st[0], nx = b.st[1];
        if (nloc == 0u) { xcd_barrier_complete(bar, b.x, nloc, nx); b.st[0] = nloc; b.st[1] = nx; }
        const unsigned old = xb_add(&bar[XB_XSUB(b.x)], 1u);
        const unsigned gen = old / nloc;
        if (old + 1u == (gen + 1u) * nloc) {
            __builtin_amdgcn_fence(__ATOMIC_RELEASE, "agent");
            asm volatile("s_waitcnt vmcnt(0)" ::: "memory");
            const unsigned og = xb_add(&bar[XB_TOP], 1u);
            const unsigned tg = og / nx;
            if (og + 1u == (tg + 1u) * nx) xb_add(&bar[XB_TOPGEN], 1u);
            else XB_SPIN(xb_ld(&bar[XB_TOPGEN]) == tg, bar);
            __builtin_amdgcn_fence(__ATOMIC_ACQUIRE, "agent");
            xb_add(&bar[XB_XGEN(b.x)], 1u);
            asm volatile("s_waitcnt vmcnt(0)" ::: "memory");
        } else {
            XB_SPIN(xb_ld(&bar[XB_XGEN(b.x)]) == gen, bar);
            __builtin_amdgcn_fence(__ATOMIC_ACQUIRE, "agent");
            asm volatile("s_waitcnt vmcnt(0)" ::: "memory");
        }
    }
    __syncthreads();
}

struct Args { const float* in[19]; float* out; unsigned char* ws; int ph_lo, ph_hi; };
static_assert(sizeof(Args) == 19 * 8 + 8 + 8 + 8, "Args has no padding");

typedef const __attribute__((address_space(4))) Args* kargs_t;
#define KARGS() ({ kargs_t p_ = (kargs_t)__builtin_amdgcn_kernarg_segment_ptr(); asm volatile("" : "+s"(p_)); p_; })
struct Frame {
    LAS unsigned char* lds;
    int tid, lane, wave;
    int vcu, G;
    unsigned char* ws;
    gu32* ctl;
    float* X;
};
__device__ __forceinline__ Frame make_frame(kargs_t ap) {
    extern __shared__ __attribute__((aligned(16))) unsigned char lds[];
    Frame F; F.lds = (LAS unsigned char*)lds; F.tid = opaque_tid(); F.lane = F.tid & 63; F.wave = __builtin_amdgcn_readfirstlane(F.tid >> 6);
    F.G = opaque_grid(); { const int bx = opaque_bid(); F.vcu = (F.G % 8 == 0) ? (bx % 8) * (F.G / 8) + bx / 8 : bx; }
    F.ws = ap->ws; F.ctl = (gu32*)(F.ws + WS_CTL); F.X = ap->out; return F;
}

__device__ __forceinline__ float wave_sum(float v) {
#pragma unroll
    for (int o = 1; o < 64; o <<= 1) v += __shfl_xor(v, o);
    return v;
}

template <int KIND>
__device__ __forceinline__ int rowmap(int n) {
    if (KIND == 1) {
        if (n < 3072) return n;
        if (n < 4096) { const int c = n - 3072; return (20 + (c >> 7)) * 256 + ((c & 127) >> 5) * 64 + (c & 31); }
        if (n < 5120) { const int c = n - 4096; return (12 + (c >> 7)) * 256 + ((c & 127) >> 5) * 64 + (c & 31); }
        if (n < 6144) { const int c = n - 5120; return (12 + (c >> 7)) * 256 + ((c & 127) >> 5) * 64 + 32 + (c & 31); }
        if (n < 7168) { return 28 * 256 + (n - 6144); }
        { const int c = n - 7168; return (20 + (c >> 7)) * 256 + ((c & 127) >> 5) * 64 + 32 + (c & 31); }
    }
    if (KIND == 2) return (n >> 7) * 256 + ((n & 127) >> 5) * 64 + (n & 31);
    if (KIND == 3) return (n >> 7) * 256 + ((n & 127) >> 5) * 64 + 32 + (n & 31);
    return n;
}
__device__ __forceinline__ void cvt_ld(const float* __restrict__ W, int N, int item, int lane, f32x4 (&v)[8]) {
    const int nblk = N >> 5, kb = item / nblk, nb = item - kb * nblk;
    const int l8 = lane & 7, kg = lane >> 3;
    const int k0 = kb * 64 + kg * 8, n0 = nb * 32 + l8 * 4;
#pragma unroll
    for (int r = 0; r < 8; ++r) v[r] = *(const GAS f32x4*)(W + (size_t)(k0 + r) * N + n0);
}
template <int KIND>
__device__ __forceinline__ void cvt_st(int K, int N, const float* __restrict__ gain, bf16* __restrict__ WT, int item, int lane, f32x4 (&v)[8]) {
    const int nblk = N >> 5, kb = item / nblk, nb = item - kb * nblk;
    const int l8 = lane & 7, kg = lane >> 3;
    const int k0 = kb * 64 + kg * 8, n0 = nb * 32 + l8 * 4;
    if (gain) {
        const f32x4 g0 = *(const GAS f32x4*)(gain + k0), g1 = *(const GAS f32x4*)(gain + k0 + 4);
#pragma unroll
        for (int r = 0; r < 4; ++r) { v[r] = v[r] * g0[r]; v[r + 4] = v[r + 4] * g1[r]; }
    }
#pragma unroll
    for (int i = 0; i < 4; ++i) {
        v4u o; o.x = pk2(v[0][i], v[1][i]); o.y = pk2(v[2][i], v[3][i]); o.z = pk2(v[4][i], v[5][i]); o.w = pk2(v[6][i], v[7][i]);
        st16_wt((void*)(WT + (size_t)rowmap<KIND>(n0 + i) * K + k0), o);
    }
}

__device__ __forceinline__ void cvt_ld_f8(const float* __restrict__ W, int N, int item, int lane, f32x4 (&v)[16]) {
    const int nblk = N >> 5, kb = item / nblk, nb = item - kb * nblk;
    const int l8 = lane & 7, kg = lane >> 3;
    const int k0 = kb * 128 + kg * 16, n0 = nb * 32 + l8 * 4;
#pragma unroll
    for (int r = 0; r < 16; ++r) v[r] = __builtin_nontemporal_load((const GAS f32x4*)(W + (size_t)(k0 + r) * N + n0));
}
template <int KIND>
__device__ __forceinline__ void cvt_st_f8(int K, int N, const float* __restrict__ gain, unsigned char* __restrict__ WT, int item, int lane, f32x4 (&v)[16]) {
    const int nblk = N >> 5, kb = item / nblk, nb = item - kb * nblk;
    const int l8 = lane & 7, kg = lane >> 3;
    const int k0 = kb * 128 + kg * 16, n0 = nb * 32 + l8 * 4;
#pragma unroll
    for (int q = 0; q < 4; ++q) { f32x4 g = {256.f, 256.f, 256.f, 256.f}; if (gain) g = *(const GAS f32x4*)(gain + k0 + 4 * q) * 256.f;
#pragma unroll
        for (int r = 0; r < 4; ++r) v[4 * q + r] = v[4 * q + r] * g[r]; }
#pragma unroll
    for (int i = 0; i < 4; ++i) {
        v4u o;
#pragma unroll
        for (int q = 0; q < 4; ++q) { unsigned w = 0u;
            w = __builtin_amdgcn_cvt_pk_fp8_f32(pg8::clamp448(v[4 * q][i]), pg8::clamp448(v[4 * q + 1][i]), w, false);
            w = __builtin_amdgcn_cvt_pk_fp8_f32(pg8::clamp448(v[4 * q + 2][i]), pg8::clamp448(v[4 * q + 3][i]), w, true); o[q] = w; }
        st16_wt((void*)(WT + (size_t)rowmap<KIND>(n0 + i) * K + k0), o);
    }
}

template <int KIND>
__device__ __forceinline__ void cvt_st_b16(int K, int N, const float* __restrict__ gain, bf16* __restrict__ WT, int item, int lane, f32x4 (&v)[16]) {
    const int nblk = N >> 5, kb = item / nblk, nb = item - kb * nblk;
    const int l8 = lane & 7, kg = lane >> 3;
    const int k0 = kb * 128 + kg * 16, n0 = nb * 32 + l8 * 4;
    if (gain) {
#pragma unroll
        for (int q = 0; q < 4; ++q) { const f32x4 g = *(const GAS f32x4*)(gain + k0 + 4 * q);
#pragma unroll
            for (int r = 0; r < 4; ++r) v[4 * q + r] = v[4 * q + r] * g[r]; } }
#pragma unroll
    for (int i = 0; i < 4; ++i) {
        v4u o0, o1; o0.x = pk2(v[0][i], v[1][i]); o0.y = pk2(v[2][i], v[3][i]); o0.z = pk2(v[4][i], v[5][i]); o0.w = pk2(v[6][i], v[7][i]);
        o1.x = pk2(v[8][i], v[9][i]); o1.y = pk2(v[10][i], v[11][i]); o1.z = pk2(v[12][i], v[13][i]); o1.w = pk2(v[14][i], v[15][i]);
        bf16* q = WT + (size_t)rowmap<KIND>(n0 + i) * K + k0;
        *(GAS v4u*)q = o0; *(GAS v4u*)(q + 8) = o1;
    }
}

template <int KIND>
__device__ __forceinline__ void cvt_run(const float* __restrict__ W, int K, int N, const float* __restrict__ gain, bf16* __restrict__ WT, int it0, int NI, int nranks, int lane) {
    constexpr int NP = 4;
    for (int it = it0; it < NI; it += NP * nranks) {
        f32x4 v[NP][8];
#pragma unroll
        for (int q = 0; q < NP; ++q) { const int ii = it + q * nranks; if (ii < NI) cvt_ld(W, N, ii, lane, v[q]); }
        asm volatile("" ::: "memory");
#pragma unroll
        for (int q = 0; q < NP; ++q) { const int ii = it + q * nranks; if (ii < NI) cvt_st<KIND>(K, N, gain, WT, ii, lane, v[q]); }
    }
}
template <int KIND>
__device__ __forceinline__ void cvt_run_f8(const float* __restrict__ W, int K, int N, const float* __restrict__ gain, unsigned char* __restrict__ WT, int it0, int NI, int nranks, int lane) {
    constexpr int NP = 2;
    for (int it = it0; it < NI; it += NP * nranks) {
        f32x4 v[NP][16];
#pragma unroll
        for (int q = 0; q < NP; ++q) { const int ii = it + q * nranks; if (ii < NI) cvt_ld_f8(W, N, ii, lane, v[q]); }
        asm volatile("" ::: "memory");
#pragma unroll
        for (int q = 0; q < NP; ++q) { const int ii = it + q * nranks; if (ii < NI) cvt_st_f8<KIND>(K, N, gain, WT, ii, lane, v[q]); }
    }
}

__device__ __forceinline__ void convert_group(kargs_t A, unsigned char* ws, int grp, int rank, int nranks, int lane) {
    constexpr int I_IN = (DM / 128) * (IN_W / 32), I_OUT = (DM / 128) * (DM / 32), I_G = (DM / 128) * (DFF / 32), I_D = (DFF / 128) * (DM / 32), I_EG = (DM / 128) * (DFFE / 32), I_ED = (DFFE / 128) * (DM / 32);
    const int in_n = (grp < 4) ? 1 : 0, d_n = (grp == 1 || grp == 2) ? 1 : 0, e_lo = (grp - 1) * 4, e_n = (grp >= 1) ? 4 : 0;
    const int c0 = in_n * I_IN, c1 = c0 + in_n * I_OUT, c2 = c1 + d_n * I_G, c3 = c2 + d_n * I_G, c4 = c3 + d_n * I_D, c5 = c4 + e_n * I_EG, c6 = c5 + e_n * I_EG, c7 = c6 + e_n * I_ED;
    const int j = grp, jd = grp - 1;
    for (int it = rank; it < c7; it += 2 * nranks) {
        f32x4 v[2][16];
#pragma unroll
        for (int q = 0; q < 2; ++q) { const int ii = it + q * nranks;
            if (ii < c7) { const float* W; int N, r;
                if (ii < c0) { W = A->in[2] + (size_t)j * DM * IN_W; N = IN_W; r = ii; }
                else if (ii < c1) { W = A->in[9] + (size_t)j * DM * DM; N = DM; r = ii - c0; }
                else if (ii < c2) { W = A->in[11] + (size_t)jd * DM * DFF; N = DFF; r = ii - c1; }
                else if (ii < c3) { W = A->in[12] + (size_t)jd * DM * DFF; N = DFF; r = ii - c2; }
                else if (ii < c4) { W = A->in[13] + (size_t)jd * DFF * DM; N = DM; r = ii - c3; }
                else if (ii < c5) { const int rr = ii - c4, jj = rr / I_EG; r = rr - jj * I_EG; W = A->in[15] + (size_t)(e_lo + jj) * DM * DFFE; N = DFFE; }
                else if (ii < c6) { const int rr = ii - c5, jj = rr / I_EG; r = rr - jj * I_EG; W = A->in[16] + (size_t)(e_lo + jj) * DM * DFFE; N = DFFE; }
                else { const int rr = ii - c6, jj = rr / I_ED; r = rr - jj * I_ED; W = A->in[17] + (size_t)(e_lo + jj) * DFFE * DM; N = DM; }
                cvt_ld_f8(W, N, r, lane, v[q]); } }
        asm volatile("" ::: "memory");
#pragma unroll
        for (int q = 0; q < 2; ++q) { const int ii = it + q * nranks;
            if (ii < c7) {
                if (ii < c0) { const int r = ii;
                    if (INPROJ_F8(j)) cvt_st_f8<1>(DM, IN_W, A->in[1] + j * DM, (unsigned char*)(ws + WS_WIN) + (size_t)j * IN_W * DM * 2, r, lane, v[q]);
                    else cvt_st_b16<1>(DM, IN_W, A->in[1] + j * DM, (bf16*)(ws + WS_WIN) + (size_t)j * IN_W * DM, r, lane, v[q]); }
                else if (ii < c1) cvt_st_b16<0>(DM, DM, nullptr, (bf16*)(ws + WS_WOUT) + (size_t)j * DM * DM, ii - c0, lane, v[q]);
                else if (ii < c2) { const int r = ii - c1;
                    if (DENSE_F8(jd)) cvt_st_f8<2>(DM, DFF, A->in[10] + (2 * jd) * DM, (unsigned char*)(ws + WS_WGU) + (size_t)jd * 2 * DFF * DM * 2, r, lane, v[q]);
                    else cvt_st_b16<2>(DM, DFF, A->in[10] + (2 * jd) * DM, (bf16*)(ws + WS_WGU) + (size_t)jd * 2 * DFF * DM, r, lane, v[q]); }
                else if (ii < c3) { const int r = ii - c2;
                    if (DENSE_F8(jd)) cvt_st_f8<3>(DM, DFF, A->in[10] + (2 * jd) * DM, (unsigned char*)(ws + WS_WGU) + (size_t)jd * 2 * DFF * DM * 2, r, lane, v[q]);
                    else cvt_st_b16<3>(DM, DFF, A->in[10] + (2 * jd) * DM, (bf16*)(ws + WS_WGU) + (size_t)jd * 2 * DFF * DM, r, lane, v[q]); }
                else if (ii < c4) { const int r = ii - c3;
                    if (DENSE_DN_F8(jd)) cvt_st_f8<0>(DFF, DM, nullptr, (unsigned char*)(ws + WS_WD) + (size_t)jd * DM * DFF * 2, r, lane, v[q]);
                    else cvt_st_b16<0>(DFF, DM, nullptr, (bf16*)(ws + WS_WD) + (size_t)jd * DM * DFF, r, lane, v[q]); }
                else if (ii < c5) { const int rr = ii - c4, jj = rr / I_EG, r = rr - jj * I_EG, je = e_lo + jj;
                    cvt_st_f8<2>(DM, DFFE, A->in[10] + (2 * (je >> 3) + 1) * DM, (unsigned char*)(ws + WS_WEGU) + (size_t)je * 2 * DFFE * DM, r, lane, v[q]); }
                else if (ii < c6) { const int rr = ii - c5, jj = rr / I_EG, r = rr - jj * I_EG, je = e_lo + jj;
                    cvt_st_f8<3>(DM, DFFE, A->in[10] + (2 * (je >> 3) + 1) * DM, (unsigned char*)(ws + WS_WEGU) + (size_t)je * 2 * DFFE * DM, r, lane, v[q]); }
                else { const int rr = ii - c6, jj = rr / I_ED, r = rr - jj * I_ED, je = e_lo + jj;
                    cvt_st_f8<0>(DFFE, DM, nullptr, (unsigned char*)(ws + WS_WED) + (size_t)je * DM * DFFE, r, lane, v[q]); } } }
    }
}
__device__ __forceinline__ void p0_prologue() {
    const kargs_t A = KARGS(); Frame F = make_frame(A);
    const int gw = F.vcu * NWAVES + F.wave, NGW = F.G * NWAVES, lane = F.lane;
    unsigned char* ws = F.ws;
    convert_group(A, ws, 0, gw, NGW, lane);
    { float* rc = (float*)(ws + WS_ROPEC); float* rs = (float*)(ws + WS_ROPES);
      for (int idx = (F.vcu * NWAVES + F.wave) * 64 + lane; idx < SEQ * 32; idx += NGW * 64) {
          const int pos = idx >> 5, i = idx & 31;
          const float inv = __builtin_amdgcn_exp2f(-(float)i * 0.4152410118609203f);
          const float ang = (float)pos * inv;
          const double rev = (double)ang * 0.15915494309189535; const float fr = (float)(rev - __builtin_rint(rev));
          rc[idx] = __builtin_amdgcn_cosf(fr); rs[idx] = __builtin_amdgcn_sinf(fr); } }
    { const float* x = A->in[0]; float* ss = (float*)(ws + WS_SS); bf16* xb = (bf16*)(ws + WS_XB);
      for (int m0 = gw * 4; m0 < M; m0 += NGW * 4) {
          f32x4 v[4][4];
#pragma unroll
          for (int r = 0; r < 4; ++r) { const GAS f32x4* xr = (const GAS f32x4*)(x + (size_t)(m0 + r) * DM) + lane;
#pragma unroll
              for (int j = 0; j < 4; ++j) v[r][j] = xr[64 * j]; }
#pragma unroll
          for (int r = 0; r < 4; ++r) { const int m = m0 + r; GAS v2u* o8 = (GAS v2u*)(xb + (size_t)m * DM) + lane; float s = 0.f;
#pragma unroll
              for (int j = 0; j < 4; ++j) { const f32x4 q = v[r][j]; s += (q.x * q.x + q.y * q.y) + (q.z * q.z + q.w * q.w); v2u w; w.x = pk2(q.x, q.y); w.y = pk2(q.z, q.w); st8_wt((void*)(o8 + 64 * j), w); }
              s = wave_sum(s); if (lane == 0) *(GAS f32x4*)(ss + 4 * (size_t)m) = (f32x4){s, 0.f, 0.f, 0.f}; } } }
}

__device__ __forceinline__ float sigmoidf_(float x) { return __builtin_amdgcn_rcpf(1.0f + __builtin_amdgcn_exp2f(x * -1.4426950408889634f)); }
__device__ __forceinline__ void unpack8(const v4u w, float (&f)[8]) { f[0] = bflo(w.x); f[1] = bfhi(w.x); f[2] = bflo(w.y); f[3] = bfhi(w.y); f[4] = bflo(w.z); f[5] = bfhi(w.z); f[6] = bflo(w.w); f[7] = bfhi(w.w); }
struct MergeCtx { float lam, one_m_li; float w0[8], w1[8], w2[8], g[8]; };
__device__ __forceinline__ void merge_setup(MergeCtx& C, kargs_t A, int l, int h, int tid) {
    const int lane = tid & 63, chunk = tid & 15;
    const float lam_init = (l == 0) ? 0.2f : (l == 1) ? 0.35550906759096934f : (l == 2) ? 0.4707130183435842f : 0.5560582041556406f;
    const float a1 = A->in[4][l * 64 + lane] * A->in[5][l * 64 + lane], a2 = A->in[6][l * 64 + lane] * A->in[7][l * 64 + lane];
    const float s1 = wave_sum(a1), s2 = wave_sum(a2);
    C.lam = __builtin_amdgcn_exp2f(s1 * 1.4426950408889634f) - __builtin_amdgcn_exp2f(s2 * 1.4426950408889634f) + lam_init; C.one_m_li = 1.0f - lam_init;
    const float* cw = A->in[3] + (size_t)l * 3 * DM + h * 128 + 8 * chunk; const float* sg = A->in[8] + l * 128 + 8 * chunk;
#pragma unroll
    for (int i = 0; i < 8; ++i) { C.w0[i] = cw[i]; C.w1[i] = cw[DM + i]; C.w2[i] = cw[2 * DM + i]; C.g[i] = sg[i] * C.one_m_li; }
}
__device__ __forceinline__ void merge_block(const MergeCtx& C, unsigned char* ws, int b, int h, int qb, int tid) {
    const bf16* P = (const bf16*)(ws + WS_PROJ); const size_t PS = (size_t)M * 1024;
    const bf16* Ob = (const bf16*)(ws + WS_O); bf16* Mx = (bf16*)(ws + WS_MIX);
    const int chunk = tid & 15, c = h * 128 + 8 * chunk, oc = h * 256 + 8 * chunk;
    for (int it0 = 0; it0 < 8; it0 += 2) {
        v4u raw[2][7];
#pragma unroll
        for (int k = 0; k < 2; ++k) {
            const int tl = qb * 256 + (it0 + k) * 32 + (tid >> 4);
            const size_t t = (size_t)b * SEQ + tl;
            const size_t tm1 = (tl >= 1) ? t - 1 : t, tm2 = (tl >= 2) ? t - 2 : t;
            raw[k][0] = *(const GAS v4u*)(Ob + t * 2048 + oc); raw[k][1] = *(const GAS v4u*)(Ob + t * 2048 + oc + 128);
            raw[k][2] = *(const GAS v4u*)(P + 4 * PS + t * 1024 + c); raw[k][3] = *(const GAS v4u*)(P + 5 * PS + t * 1024 + c);
            raw[k][4] = *(const GAS v4u*)(P + 3 * PS + t * 1024 + c); raw[k][5] = *(const GAS v4u*)(P + 3 * PS + tm1 * 1024 + c); raw[k][6] = *(const GAS v4u*)(P + 3 * PS + tm2 * 1024 + c);
        }
        asm volatile("" ::: "memory");
#pragma unroll
        for (int k = 0; k < 2; ++k) {
            const int tl = qb * 256 + (it0 + k) * 32 + (tid >> 4);
            const size_t t = (size_t)b * SEQ + tl;
            float o1[8], o2[8], bgc[8], ga[8], cu0[8], cu1[8], cu2[8];
            unpack8(raw[k][0], o1); unpack8(raw[k][1], o2); unpack8(raw[k][2], bgc); unpack8(raw[k][3], ga); unpack8(raw[k][4], cu0); unpack8(raw[k][5], cu1); unpack8(raw[k][6], cu2);
            const float k1 = (tl >= 1) ? 1.f : 0.f, k2 = (tl >= 2) ? 1.f : 0.f;
            float d[8], sq = 0.f;
#pragma unroll
            for (int i = 0; i < 8; ++i) { d[i] = o1[i] - C.lam * o2[i]; sq += d[i] * d[i]; }
            sq += __shfl_xor(sq, 1); sq += __shfl_xor(sq, 2); sq += __shfl_xor(sq, 4); sq += __shfl_xor(sq, 8);
            const float r = __builtin_amdgcn_rsqf(sq * (1.0f / 128.0f) + RMS_EPS);
            float mo[8];
#pragma unroll
            for (int i = 0; i < 8; ++i) {
                const float yc = bgc[i] * (C.w0[i] * (cu2[i] * k2) + C.w1[i] * (cu1[i] * k1) + C.w2[i] * cu0[i]);
                const float ya = d[i] * r * C.g[i];
                mo[i] = sigmoidf_(ga[i]) * ya + yc; }
            v4u w; w.x = pk2(mo[0], mo[1]); w.y = pk2(mo[2], mo[3]); w.z = pk2(mo[4], mo[5]); w.w = pk2(mo[6], mo[7]);
            st16_wt((void*)(Mx + t * 1024 + c), w);
        }
    }
}

__device__ __forceinline__ void merge_wave(const MergeCtx& C, unsigned char* ws, int b, int h, int tl0, attn_body::lds_cptr stg, int lane) {
    const bf16* P = (const bf16*)(ws + WS_PROJ); const size_t PS = (size_t)M * 1024;
    const bf16* Ob = (const bf16*)(ws + WS_O); bf16* Mx = (bf16*)(ws + WS_MIX);
    const int chunk = lane & 15, c = h * 128 + 8 * chunk, oc = h * 256 + 8 * chunk;
    for (int p0 = 0; p0 < 8; p0 += 2) {
        v4u raw[2][7];
#pragma unroll
        for (int k = 0; k < 2; ++k) {
            const int rw = (p0 + k) * 4 + (lane >> 4), tl = tl0 + rw;
            const size_t t = (size_t)b * SEQ + tl;
            const size_t tm1 = (tl >= 1) ? t - 1 : t, tm2 = (tl >= 2) ? t - 2 : t;
            raw[k][0] = *(const GAS v4u*)(Ob + t * 2048 + oc); raw[k][1] = *(const LAS v4u*)(stg + (rw * 128 + 8 * chunk) * 2);
            raw[k][2] = *(const GAS v4u*)(P + 4 * PS + t * 1024 + c); raw[k][3] = *(const GAS v4u*)(P + 5 * PS + t * 1024 + c);
            raw[k][4] = *(const GAS v4u*)(P + 3 * PS + t * 1024 + c); raw[k][5] = *(const GAS v4u*)(P + 3 * PS + tm1 * 1024 + c); raw[k][6] = *(const GAS v4u*)(P + 3 * PS + tm2 * 1024 + c);
        }
        asm volatile("" ::: "memory");
#pragma unroll
        for (int k = 0; k < 2; ++k) {
            const int rw = (p0 + k) * 4 + (lane >> 4), tl = tl0 + rw;
            const size_t t = (size_t)b * SEQ + tl;
            float o1[8], o2[8], bgc[8], ga[8], cu0[8], cu1[8], cu2[8];
            unpack8(raw[k][0], o1); unpack8(raw[k][1], o2); unpack8(raw[k][2], bgc); unpack8(raw[k][3], ga); unpack8(raw[k][4], cu0); unpack8(raw[k][5], cu1); unpack8(raw[k][6], cu2);
            const float k1 = (tl >= 1) ? 1.f : 0.f, k2 = (tl >= 2) ? 1.f : 0.f;
            float d[8], sq = 0.f;
#pragma unroll
            for (int i = 0; i < 8; ++i) { d[i] = o1[i] - C.lam * o2[i]; sq += d[i] * d[i]; }
            sq += __shfl_xor(sq, 1); sq += __shfl_xor(sq, 2); sq += __shfl_xor(sq, 4); sq += __shfl_xor(sq, 8);
            const float r = __builtin_amdgcn_rsqf(sq * (1.0f / 128.0f) + RMS_EPS);
            float mo[8];
#pragma unroll
            for (int i = 0; i < 8; ++i) {
                const float yc = bgc[i] * (C.w0[i] * (cu2[i] * k2) + C.w1[i] * (cu1[i] * k1) + C.w2[i] * cu0[i]);
                const float ya = d[i] * r * C.g[i];
                mo[i] = sigmoidf_(ga[i]) * ya + yc; }
            v4u w; w.x = pk2(mo[0], mo[1]); w.y = pk2(mo[2], mo[3]); w.z = pk2(mo[4], mo[5]); w.w = pk2(mo[6], mo[7]);
            st16_wt((void*)(Mx + t * 1024 + c), w);
        }
    }
}
struct MergePost { bool on; int l, b, h;
    __device__ __forceinline__ void run(attn_body::lds_cptr stg, int tl0, int lane) const {
        const kargs_t A = KARGS(); asm volatile("s_waitcnt vmcnt(0)" ::: "memory");
        MergeCtx MC; merge_setup(MC, A, l, h, lane); merge_wave(MC, A->ws, b, h, tl0, stg, lane); } };

constexpr int TILE_TAB_OFF = RING_BYTES + 1024 + 4096;
__device__ __forceinline__ void route_phase(int l) {
    const kargs_t A = KARGS(); Frame F = make_frame(A);
    const int lane = F.lane, tid = F.tid, j = l >> 1;
    LAS float* WrT = (LAS float*)(F.lds);
    volatile LAS int* cntl = (volatile LAS int*)(F.lds + 32768);
    volatile LAS int* gbase = cntl + 8;
    volatile LAS int* li = cntl + 16;
    volatile LAS int* lr = cntl + 16 + 128;
    volatile LAS float* lw = (volatile LAS float*)(cntl + 16 + 256);
    const float* Wr = A->in[14] + (size_t)j * DM * NEXP; const float* gn = A->in[10] + (size_t)l * DM;
    for (int idx = tid; idx < DM * NEXP; idx += NWAVES * 64) { const int k = idx >> 3, e = idx & 7; WrT[e * DM + k] = Wr[idx] * gn[k]; }
    gu32* gcnt = F.ctl + CW_GCNT + j * 8 * 64;
    int* slotof = (int*)(F.ws + WS_ROUTE + RT_SLOTOF); float* wslot = (float*)(F.ws + WS_ROUTE + RT_WSLOT); float* ssslot = (float*)(F.ws + WS_ROUTE + RT_SSSLOT);
    unsigned char* xg = (unsigned char*)(F.ws + WS_O);
    for (int blk = F.vcu; blk < M / 64; blk += F.G) {
        if (tid < 8) cntl[tid] = 0;
        __syncthreads();
        float ssq[8];
        const bf16* xbr = (const bf16*)(F.ws + WS_XB) + (size_t)(blk * 64 + F.wave * 8) * DM + 8 * lane;
        v4u cur0 = *(const GAS v4u*)xbr, cur1 = *(const GAS v4u*)(xbr + 512);
#pragma unroll
        for (int rr = 0; rr < 8; ++rr) {
            const int loc = F.wave * 8 + rr;
            v4u nx0 = cur0, nx1 = cur1;
            if (rr < 7) { nx0 = *(const GAS v4u*)(xbr + (size_t)(rr + 1) * DM); nx1 = *(const GAS v4u*)(xbr + (size_t)(rr + 1) * DM + 512); }
            float v[16]; float s = 0.f;
            { float t8[8]; unpack8(cur0, t8);
#pragma unroll
              for (int i = 0; i < 8; ++i) v[i] = t8[i];
              unpack8(cur1, t8);
#pragma unroll
              for (int i = 0; i < 8; ++i) v[8 + i] = t8[i]; }
#pragma unroll
            for (int i = 0; i < 16; ++i) s += v[i] * v[i];
            s = wave_sum(s); ssq[rr] = s; const float rstd = 1.0f / sqrtf(s * (1.0f / 1024.0f) + RMS_EPS);
            float lg[8];
#pragma unroll
            for (int e = 0; e < 8; ++e) { float a = 0.f;
#pragma unroll
                for (int q = 0; q < 2; ++q) { const f32x4 w0 = *(const LAS f32x4*)(WrT + e * DM + 512 * q + 8 * lane), w1 = *(const LAS f32x4*)(WrT + e * DM + 512 * q + 8 * lane + 4);
                    a += (v[8 * q] * w0.x + v[8 * q + 1] * w0.y) + (v[8 * q + 2] * w0.z + v[8 * q + 3] * w0.w) + (v[8 * q + 4] * w1.x + v[8 * q + 5] * w1.y) + (v[8 * q + 6] * w1.z + v[8 * q + 7] * w1.w); }
                lg[e] = wave_sum(a) * rstd; }
            int i0 = 0; float v0 = lg[0];
#pragma unroll
            for (int e = 1; e < 8; ++e) if (lg[e] > v0) { v0 = lg[e]; i0 = e; }
            int i1 = -1; float v1 = -INFINITY;
#pragma unroll
            for (int e = 0; e < 8; ++e) if (e != i0 && lg[e] > v1) { v1 = lg[e]; i1 = e; }
            if (i1 < 0) i1 = (i0 + 1) & 7;
            const float wA = 1.0f / (1.0f + __expf(v1 - v0)), wB = 1.0f - wA;
            if (lane == 0) {
                const int r0 = __hip_atomic_fetch_add((LAS int*)&cntl[i0], 1, __ATOMIC_RELAXED, __HIP_MEMORY_SCOPE_WORKGROUP);
                const int r1 = __hip_atomic_fetch_add((LAS int*)&cntl[i1], 1, __ATOMIC_RELAXED, __HIP_MEMORY_SCOPE_WORKGROUP);
                li[2 * loc] = i0; li[2 * loc + 1] = i1; lr[2 * loc] = r0; lr[2 * loc + 1] = r1; lw[2 * loc] = wA; lw[2 * loc + 1] = wB;
            }
            cur0 = nx0; cur1 = nx1;
            asm volatile("" ::: "memory");
        }
        __syncthreads();
        if (tid < 8) gbase[tid] = (int)__hip_atomic_fetch_add(gcnt + tid * 64, (unsigned)cntl[tid], RLX_AGENT);
        __syncthreads();
        v4u vs[8][2];
#pragma unroll
        for (int rr = 0; rr < 8; ++rr) { vs[rr][0] = *(const GAS v4u*)(xbr + (size_t)rr * DM); vs[rr][1] = *(const GAS v4u*)(xbr + (size_t)rr * DM + 512); }
#pragma unroll
        for (int rr = 0; rr < 8; ++rr) {
            const int loc = F.wave * 8 + rr, t = blk * 64 + loc;
            const int e0 = li[2 * loc], e1 = li[2 * loc + 1];
            const int s0 = e0 * ECAP + gbase[e0] + lr[2 * loc], s1 = e1 * ECAP + gbase[e1] + lr[2 * loc + 1];
            typedef unsigned u32x2_t __attribute__((ext_vector_type(2)));
#pragma unroll
            for (int q = 0; q < 2; ++q) { float t8[8]; unpack8(vs[rr][q], t8); u32x2_t w = {0u, 0u};
                w.x = __builtin_amdgcn_cvt_pk_fp8_f32(pg8::clamp448(t8[0] * 8.f), pg8::clamp448(t8[1] * 8.f), w.x, false); w.x = __builtin_amdgcn_cvt_pk_fp8_f32(pg8::clamp448(t8[2] * 8.f), pg8::clamp448(t8[3] * 8.f), w.x, true);
                w.y = __builtin_amdgcn_cvt_pk_fp8_f32(pg8::clamp448(t8[4] * 8.f), pg8::clamp448(t8[5] * 8.f), w.y, false); w.y = __builtin_amdgcn_cvt_pk_fp8_f32(pg8::clamp448(t8[6] * 8.f), pg8::clamp448(t8[7] * 8.f), w.y, true);
                st8_wt((void*)(xg + (size_t)s0 * DM + 512 * q + 8 * lane), w); st8_wt((void*)(xg + (size_t)s1 * DM + 512 * q + 8 * lane), w); }
            if (lane == 0) { slotof[2 * t] = s0; slotof[2 * t + 1] = s1; wslot[s0] = lw[2 * loc]; wslot[s1] = lw[2 * loc + 1];
                const f32x4 sv = {ssq[rr], 0.f, 0.f, 0.f}; *(GAS f32x4*)(ssslot + 4 * (size_t)s0) = sv; *(GAS f32x4*)(ssslot + 4 * (size_t)s1) = sv; }
        }
        __syncthreads();
    }
}
__device__ __forceinline__ void build_tiles(LAS unsigned char* lds, gu32* gcnt) {
    const int tid = opaque_tid(); LAS int* tab = (LAS int*)(lds + TILE_TAB_OFF);
    int seg = 0, ent = -1;
#pragma unroll
    for (int e = 0; e < 8; ++e) { const int nte = ((int)__hip_atomic_load(gcnt + e * 64, RLX_AGENT) + 255) >> 8;
        if (tid >= seg && tid < seg + nte) ent = (e << 16) | (e * (ECAP / 256) + (tid - seg)); seg += nte; }
    if (tid < 255 && ent >= 0) tab[tid] = ent;
    if (tid == 0) tab[255] = seg;
    __syncthreads();
}
__device__ __forceinline__ void combine_phase(int l) {
    const kargs_t A = KARGS(); Frame F = make_frame(A);
    const int lane = F.lane; const int gw = F.vcu * NWAVES + F.wave, NGW = F.G * NWAVES;
    const int* slotof = (const int*)(F.ws + WS_ROUTE + RT_SLOTOF); const bf16* Y = (const bf16*)(F.ws + WS_Y); bf16* xb = (bf16*)(F.ws + WS_XB);
    volatile LAS int* segc = (volatile LAS int*)(F.lds);
    if (F.tid == 0) { gu32* gcnt = F.ctl + CW_GCNT + (l >> 1) * 8 * 64; int s = 0; for (int e = 0; e < 8; ++e) { segc[e] = s; s += (((int)__hip_atomic_load(gcnt + e * 64, RLX_AGENT) + 255) >> 8) << 8; } }
    __syncthreads();
    float* ssn = (float*)(F.ws + WS_SS) + (size_t)(2 * l + 2) * M * 4; const bool fin = (l == DEPTH - 1);
    const float* gf = A->in[18];
    for (int t0 = gw * 4; t0 < M; t0 += NGW * 4) {
        v2u xa[4][4], ya[4][4], yb[4][4];
#pragma unroll
        for (int r = 0; r < 4; ++r) { const int t = t0 + r; const int p0 = slotof[2 * t], p1 = slotof[2 * t + 1];
            const int s0 = segc[p0 >> ECAP_LOG] + (p0 & (ECAP - 1)), s1 = segc[p1 >> ECAP_LOG] + (p1 & (ECAP - 1));
            const GAS v2u* xr = (const GAS v2u*)(xb + (size_t)t * DM) + lane;
            const GAS v2u* y0 = (const GAS v2u*)(Y + (size_t)s0 * DM) + lane; const GAS v2u* y1 = (const GAS v2u*)(Y + (size_t)s1 * DM) + lane;
#pragma unroll
            for (int q = 0; q < 4; ++q) { xa[r][q] = xr[64 * q]; ya[r][q] = y0[64 * q]; yb[r][q] = y1[64 * q]; } }
        asm volatile("" ::: "memory");
#pragma unroll
        for (int r = 0; r < 4; ++r) { const int t = t0 + r; float s = 0.f; f32x4 v[4];
#pragma unroll
            for (int q = 0; q < 4; ++q) { const v2u c = xa[r][q], a = ya[r][q], b = yb[r][q]; f32x4& x = v[q];
                x.x = bflo(c.x) + (bflo(a.x) + bflo(b.x)); x.y = bfhi(c.x) + (bfhi(a.x) + bfhi(b.x)); x.z = bflo(c.y) + (bflo(a.y) + bflo(b.y)); x.w = bfhi(c.y) + (bfhi(a.y) + bfhi(b.y));
                s += (x.x * x.x + x.y * x.y) + (x.z * x.z + x.w * x.w); }
            s = wave_sum(s);
            if (!fin) {
                GAS v2u* o8 = (GAS v2u*)(xb + (size_t)t * DM) + lane;
#pragma unroll
                for (int q = 0; q < 4; ++q) { v2u w; w.x = pk2(v[q].x, v[q].y); w.y = pk2(v[q].z, v[q].w); st8_wt((void*)(o8 + 64 * q), w); }
                if ((INPROJ_F8_MASK & 4) && INPROJ_F8(l + 1)) {
                    GAS unsigned* q8 = (GAS unsigned*)(F.ws + WS_O + (size_t)t * DM) + lane;
#pragma unroll
                    for (int q = 0; q < 4; ++q) { unsigned w = 0u;
                        w = __builtin_amdgcn_cvt_pk_fp8_f32(pg8::clamp448(v[q].x * 8.0f), pg8::clamp448(v[q].y * 8.0f), w, false);
                        w = __builtin_amdgcn_cvt_pk_fp8_f32(pg8::clamp448(v[q].z * 8.0f), pg8::clamp448(v[q].w * 8.0f), w, true); q8[64 * q] = w; } }
                if (lane == 0) *(GAS f32x4*)(ssn + 4 * (size_t)t) = (f32x4){s, 0.f, 0.f, 0.f};
            } else {
                const float rstd = 1.0f / sqrtf(s * (1.0f / 1024.0f) + RMS_EPS);
                GAS f32x4* xo = (GAS f32x4*)(F.X + (size_t)t * DM) + lane;
#pragma unroll
                for (int q = 0; q < 4; ++q) { const f32x4 gg = *((const GAS f32x4*)gf + lane + 64 * q); xo[64 * q] = v[q] * rstd * gg; }
            } }
    }
}

__device__ __forceinline__ XcdBarrier make_bar(unsigned char* ws) {
    extern __shared__ __attribute__((aligned(16))) unsigned char lds[];
    XcdBarrier b; b.bar = (unsigned*)(ws + WS_CTL) + CW_BAR; b.x = xb_xcc_id(); b.st = (volatile LAS unsigned*)((LAS unsigned char*)lds + MISC_OFF) + 8; return b;
}
__global__ void __launch_bounds__(NWAVES * 64, 2) trunk_fwd(Args args_unused) {
    extern __shared__ __attribute__((aligned(16))) unsigned char lds[];
    { const int tid = threadIdx.x;
      for (int u = tid; u < (LDS_BYTES - LDSCTL_OFF) / 4; u += NWAVES * 64) ((LAS unsigned*)((LAS unsigned char*)lds + LDSCTL_OFF))[u] = 0u;
      __syncthreads();
      if (!MK_PER_PHASE) { const kargs_t A = KARGS(); (void)xcd_barrier_post((unsigned*)(A->ws + WS_CTL) + CW_BAR, (volatile LAS unsigned*)((LAS unsigned char*)lds + MISC_OFF) + 8); } }
    int ph = 0;
#define PH_ON ({ const kargs_t Ap_ = KARGS(); ph >= Ap_->ph_lo && ph < Ap_->ph_hi; })
#define PH_END do { if (!MK_PER_PHASE && PH_ON && ph + 1 < KARGS()->ph_hi) { const kargs_t A_ = KARGS(); xcd_barrier(make_bar(A_->ws)); } ++ph; } while (0)

    for (int rep_ = 0; rep_ < (((PROBE_DUP >> 0) & 1) ? 2 : 1); ++rep_) if (((PH_MASK >> 0) & 1) && PH_ON) p0_prologue();
    PH_END;

    for (int l = 0; l < DEPTH; ++l) {
        for (int rep_ = 0; rep_ < (((PROBE_DUP >> 1) & 1) ? 2 : 1); ++rep_) if (((PH_MASK >> 1) & 1) && PH_ON) {
            const kargs_t A = KARGS(); unsigned char* ws = A->ws;
            pg8::StaticOrder S; S.init(M, IN_W, opaque_grid(), opaque_bid());
            if ((INPROJ_F8_MASK != 0) && INPROJ_F8(l)) {
                pg8::Gemm g{(const bf16*)(ws + WS_O), (const bf16*)(ws + WS_WIN + (size_t)l * IN_W * DM * 2), M, IN_W, DM, 0};
                pg8::EpiProj E{(bf16*)(ws + WS_PROJ), (const float*)(ws + WS_SS) + (size_t)(2 * l) * M * 4, (const float*)(ws + WS_ROPEC), (const float*)(ws + WS_ROPES), attn_body::C2, 1.0f / 2048.0f};
                pg8::gemm_phase<pg8::EpiProj, pg8::StaticOrder, PG8_ALIGN, PG8_SP2, true>((LAS unsigned char*)lds + RING_OFF, g, S, E);
            } else {
            pg8::Gemm g{(const bf16*)(ws + WS_XB), (const bf16*)(ws + WS_WIN) + (size_t)l * IN_W * DM, M, IN_W, DM, 0};
            pg8::EpiProj E{(bf16*)(ws + WS_PROJ), (const float*)(ws + WS_SS) + (size_t)(2 * l) * M * 4, (const float*)(ws + WS_ROPEC), (const float*)(ws + WS_ROPES), attn_body::C2};
            pg8::gemm_phase<pg8::EpiProj, pg8::StaticOrder, PG8_ALIGN, PG8_SP2>((LAS unsigned char*)lds + RING_OFF, g, S, E); }
        }
        PH_END;
        for (int rep_ = 0; rep_ < (((PROBE_DUP >> 2) & 1) ? 2 : 1); ++rep_) if (((PH_MASK >> 2) & 1) && PH_ON) {
            const kargs_t A = KARGS(); unsigned char* ws = A->ws;
            const attn_body::bf16* Qb = (const attn_body::bf16*)(ws + WS_PROJ); attn_body::bf16* Ob = (attn_body::bf16*)(ws + WS_O);
            const int G = opaque_grid(), bx = opaque_bid(), vcu = (G % 8 == 0) ? (bx % 8) * (G / 8) + bx / 8 : bx;
            attn_body::AttnCarry cy; cy.primed = false; cy.s0 = 0;
#pragma unroll
            for (int d0 = 0; d0 < 4; ++d0) cy.qr[d0] = (attn_body::bf16x8){0, 0, 0, 0, 0, 0, 0, 0};
            for (int vc = vcu; vc < 256; vc += G) {
                const int bh = vc >> 2, b = bh >> 3, h = bh & 7;
                for (int u = 0; u < 4; ++u) {
                    const int mp = u & 1, qb = (u >> 1) ? (vc & 3) : 7 - (vc & 3);
                    if (((vc >> 2) & 3) == u) {
                        const kargs_t A3 = KARGS(); const int tid3 = opaque_tid(); int grp3 = l + 1; asm volatile("" : "+s"(grp3));
                        convert_group(A3, A3->ws, grp3, vc * NWAVES + (tid3 >> 6), 256 * NWAVES, tid3 & 63);
                    }
                    const attn_body::bf16* Qh = Qb + (size_t)b * SEQ * 1024 + (2 * h + mp) * 64;
                    const attn_body::bf16* Vh = Qb + (size_t)2 * M * 1024 + (size_t)b * SEQ * 1024 + h * 128;
                    attn_body::AttnNext nx; nx.has = (u < 3); nx.qb = ((u + 1) >> 1) ? (vc & 3) : 7 - (vc & 3);
                    nx.Qh = Qb + (size_t)b * SEQ * 1024 + (2 * h + ((u + 1) & 1)) * 64; nx.Kh = nx.Qh + (size_t)M * 1024; nx.Vh = Vh;
                    const MergePost post{mp == 1, l, b, h};
                    attn_body::attn_unit128<8>(qb, Qh, Qh + (size_t)M * 1024, Vh, Ob + (size_t)b * SEQ * 2048 + h * 256 + mp * 128, (char*)lds + RING_OFF, post, nx, cy);
                }
            }
        }
        PH_END;
        for (int rep_ = 0; rep_ < (((PROBE_DUP >> 4) & 1) ? 2 : 1); ++rep_) if (((PH_MASK >> 4) & 1) && PH_ON) {
            const kargs_t A = KARGS(); unsigned char* ws = A->ws;
            pg8::Gemm g{(const bf16*)(ws + WS_MIX), (const bf16*)(ws + WS_WOUT) + (size_t)l * DM * DM, M, DM, DM, 0};
            pg8::StaticOrder S; S.init(M, DM, opaque_grid(), opaque_bid());
            if (l & 1) { pg8::EpiResidLite E{(bf16*)(ws + WS_XB), nullptr};
                pg8::gemm_phase<pg8::EpiResidLite, pg8::StaticOrder, PG8_ALIGN, PG8_SP2>((LAS unsigned char*)lds + RING_OFF, g, S, E); }
            else if (DENSE_F8(l >> 1)) { pg8::EpiResidF8X E{(bf16*)(ws + WS_XB), (float*)(ws + WS_SS) + (size_t)(2 * l + 1) * M * 4, (unsigned char*)(ws + WS_O), 1.0f};
                pg8::gemm_phase<pg8::EpiResidF8X, pg8::StaticOrder, PG8_ALIGN, PG8_SP2>((LAS unsigned char*)lds + RING_OFF, g, S, E); }
            else { pg8::EpiResid E{(bf16*)(ws + WS_XB), (float*)(ws + WS_SS) + (size_t)(2 * l + 1) * M * 4};
                pg8::gemm_phase<pg8::EpiResid, pg8::StaticOrder, PG8_ALIGN, PG8_SP2>((LAS unsigned char*)lds + RING_OFF, g, S, E); }
        }
        PH_END;
        if ((l & 1) == 0) {
            for (int rep_ = 0; rep_ < (((PROBE_DUP >> 5) & 1) ? 2 : 1); ++rep_) if (((PH_MASK >> 5) & 1) && PH_ON) {
                const kargs_t A = KARGS(); unsigned char* ws = A->ws; const int j = l >> 1;
                pg8::StaticOrder S; S.init(M, 2 * DFF, opaque_grid(), opaque_bid());
                if (DENSE_F8(j)) {
                    pg8::Gemm g{(const bf16*)(ws + WS_O), (const bf16*)(ws + WS_WGU + (size_t)j * 2 * DFF * DM * 2), M, 2 * DFF, DM, 0};
                    pg8::EpiSwigluF8 E{(void*)(ws + WS_PROJ), DFF, (const float*)(ws + WS_SS) + (size_t)(2 * l + 1) * M * 4, 1.0f / 2048.0f};
                    pg8::gemm_phase<pg8::EpiSwigluF8, pg8::StaticOrder, PG8_ALIGN, PG8_SP2, true>((LAS unsigned char*)lds + RING_OFF, g, S, E);
                } else {
                pg8::Gemm g{(const bf16*)(ws + WS_XB), (const bf16*)(ws + WS_WGU) + (size_t)j * 2 * DFF * DM, M, 2 * DFF, DM, 0};
                if (((DENSE_DN_F8_MASK & ~DENSE_F8_MASK) != 0) && DENSE_DN_F8(j)) {
                    pg8::EpiSwigluF8 E{(void*)(ws + WS_PROJ), DFF, (const float*)(ws + WS_SS) + (size_t)(2 * l + 1) * M * 4, 1.0f};
                    pg8::gemm_phase<pg8::EpiSwigluF8, pg8::StaticOrder, PG8_ALIGN, PG8_SP2>((LAS unsigned char*)lds + RING_OFF, g, S, E);
                } else {
                pg8::EpiSwiglu E{(void*)(ws + WS_PROJ), DFF, (const float*)(ws + WS_SS) + (size_t)(2 * l + 1) * M * 4, 1.0f};
                pg8::gemm_phase<pg8::EpiSwiglu, pg8::StaticOrder, PG8_ALIGN, PG8_SP2>((LAS unsigned char*)lds + RING_OFF, g, S, E); } }
            }
            PH_END;
            for (int rep_ = 0; rep_ < (((PROBE_DUP >> 6) & 1) ? 2 : 1); ++rep_) if (((PH_MASK >> 6) & 1) && PH_ON) {
                const kargs_t A = KARGS(); unsigned char* ws = A->ws; const int j = l >> 1;
                pg8::StaticOrder S; S.init(M, DM, opaque_grid(), opaque_bid());
                constexpr bool C_F8_X = ((DENSE_DN_F8_MASK & 1) && (INPROJ_F8_MASK & 2)) || ((DENSE_DN_F8_MASK & 2) && (INPROJ_F8_MASK & 8));
                constexpr bool C_F8_N = ((DENSE_DN_F8_MASK & 1) && !(INPROJ_F8_MASK & 2)) || ((DENSE_DN_F8_MASK & 2) && !(INPROJ_F8_MASK & 8));
                constexpr bool C_BF_X = (!(DENSE_DN_F8_MASK & 1) && (INPROJ_F8_MASK & 2)) || (!(DENSE_DN_F8_MASK & 2) && (INPROJ_F8_MASK & 8));
                const bool f8x = INPROJ_F8(l + 1);
                if (C_F8_X && DENSE_DN_F8(j) && f8x) {
                    pg8::Gemm g{(const bf16*)(ws + WS_PROJ), (const bf16*)(ws + WS_WD + (size_t)j * DM * DFF * 2), M, DM, DFF, 0};
                    pg8::EpiResidF8X E{(bf16*)(ws + WS_XB), (float*)(ws + WS_SS) + (size_t)(2 * l + 2) * M * 4, (unsigned char*)(ws + WS_O), 1.0f / 2048.0f};
                    pg8::gemm_phase<pg8::EpiResidF8X, pg8::StaticOrder, PG8_ALIGN, PG8_SP2, true>((LAS unsigned char*)lds + RING_OFF, g, S, E);
                } else if (C_F8_N && DENSE_DN_F8(j)) {
                    pg8::Gemm g{(const bf16*)(ws + WS_PROJ), (const bf16*)(ws + WS_WD + (size_t)j * DM * DFF * 2), M, DM, DFF, 0};
                    pg8::EpiResid E{(bf16*)(ws + WS_XB), (float*)(ws + WS_SS) + (size_t)(2 * l + 2) * M * 4, nullptr, 1.0f / 2048.0f};
                    pg8::gemm_phase<pg8::EpiResid, pg8::StaticOrder, PG8_ALIGN, PG8_SP2, true>((LAS unsigned char*)lds + RING_OFF, g, S, E);
                } else if (C_BF_X && f8x) {
                    pg8::Gemm g{(const bf16*)(ws + WS_PROJ), (const bf16*)(ws + WS_WD) + (size_t)j * DM * DFF, M, DM, DFF, 0};
                    pg8::EpiResidF8X E{(bf16*)(ws + WS_XB), (float*)(ws + WS_SS) + (size_t)(2 * l + 2) * M * 4, (unsigned char*)(ws + WS_O), 1.0f};
                    pg8::gemm_phase<pg8::EpiResidF8X, pg8::StaticOrder, PG8_ALIGN, PG8_SP2>((LAS unsigned char*)lds + RING_OFF, g, S, E);
                } else {
                pg8::Gemm g{(const bf16*)(ws + WS_PROJ), (const bf16*)(ws + WS_WD) + (size_t)j * DM * DFF, M, DM, DFF, 0};
                pg8::EpiResid E{(bf16*)(ws + WS_XB), (float*)(ws + WS_SS) + (size_t)(2 * l + 2) * M * 4};
                pg8::gemm_phase<pg8::EpiResid, pg8::StaticOrder, PG8_ALIGN, PG8_SP2>((LAS unsigned char*)lds + RING_OFF, g, S, E); }
            }
            PH_END;
        } else {
            for (int rep_ = 0; rep_ < (((PROBE_DUP >> 7) & 1) ? 2 : 1); ++rep_) if (((PH_MASK >> 7) & 1) && PH_ON) route_phase(l);
            PH_END;
            for (int rep_ = 0; rep_ < (((PROBE_DUP >> 9) & 1) ? 2 : 1); ++rep_) if (((PH_MASK >> 9) & 1) && PH_ON) {
                const kargs_t A = KARGS(); unsigned char* ws = A->ws; const int j = l >> 1;
                build_tiles((LAS unsigned char*)lds, (gu32*)(ws + WS_CTL) + CW_GCNT + j * 8 * 64);
                const LAS int* tab = (const LAS int*)((LAS unsigned char*)lds + TILE_TAB_OFF);
                const int ntl = __builtin_amdgcn_readfirstlane(tab[255]);
                pg8::Gemm g{(const bf16*)(ws + WS_O), (const bf16*)(ws + WS_WEGU + (size_t)j * 8 * 2 * DFFE * DM), NEXP * ECAP, 2 * DFFE, DM, (size_t)2 * DFFE * DM};
                pg8::GroupedOrder S; S.init(ntl, 2 * DFFE, opaque_grid(), opaque_bid(), tab, true);
                pg8::EpiSwigluF8 E{(void*)(ws + WS_PROJ), DFFE, (const float*)(ws + WS_ROUTE + RT_SSSLOT), 1.0f / 2048.0f};
                pg8::gemm_phase<pg8::EpiSwigluF8, pg8::GroupedOrder, PG8_ALIGN, PG8_SP2, true>((LAS unsigned char*)lds + RING_OFF, g, S, E);
            }
            PH_END;
            for (int rep_ = 0; rep_ < (((PROBE_DUP >> 10) & 1) ? 2 : 1); ++rep_) if (((PH_MASK >> 10) & 1) && PH_ON) {
                const kargs_t A = KARGS(); unsigned char* ws = A->ws; const int j = l >> 1;
                build_tiles((LAS unsigned char*)lds, (gu32*)(ws + WS_CTL) + CW_GCNT + j * 8 * 64);
                const LAS int* tab = (const LAS int*)((LAS unsigned char*)lds + TILE_TAB_OFF);
                const int ntl = __builtin_amdgcn_readfirstlane(tab[255]);
                pg8::Gemm g{(const bf16*)(ws + WS_PROJ), (const bf16*)(ws + WS_WED + (size_t)j * 8 * DM * DFFE), MSLOT, DM, DFFE, (size_t)DM * DFFE};
                pg8::GroupedOrder S; S.init(ntl, DM, opaque_grid(), opaque_bid(), tab, false);
                pg8::EpiSlot E{(bf16*)(ws + WS_Y), (const float*)(ws + WS_ROUTE + RT_WSLOT), 1.0f / 2048.0f};
                pg8::gemm_phase<pg8::EpiSlot, pg8::GroupedOrder, PG8_ALIGN, PG8_SP2, true>((LAS unsigned char*)lds + RING_OFF, g, S, E);
            }
            PH_END;
            for (int rep_ = 0; rep_ < (((PROBE_DUP >> 11) & 1) ? 2 : 1); ++rep_) if (((PH_MASK >> 11) & 1) && PH_ON) combine_phase(l);
            PH_END;
        }
    }
#undef PH_ON
#undef PH_END
}

constexpr int N_PHASES = 1 + 2 * 5 + 2 * 7;

extern "C" void kernel_launch(void* const* d_in, const int* in_sizes, int n_in, void* d_out, int out_size, void* d_ws, size_t ws_size, hipStream_t stream) {
    static int grid = 0;
    if (grid == 0) {
        if (n_in != 19 || in_sizes[0] != M * DM || out_size != M * DM || ws_size < WS_END) { fprintf(stderr, "kernel_launch: unexpected shapes / workspace (n_in %d, in0 %d, out %d, ws %zu < %zu); nothing launched\n", n_in, n_in > 0 ? in_sizes[0] : -1, out_size, ws_size, (size_t)WS_END); grid = -1; return; }
        int dev = 0, cus = 0, per_cu = 0;
        if (hipGetDevice(&dev) != hipSuccess || hipDeviceGetAttribute(&cus, hipDeviceAttributeMultiprocessorCount, dev) != hipSuccess) { grid = -1; return; }
        if (hipFuncSetAttribute((const void*)trunk_fwd, hipFuncAttributeMaxDynamicSharedMemorySize, LDS_BYTES) != hipSuccess) { fprintf(stderr, "kernel_launch: hipFuncSetAttribute failed\n"); grid = -1; return; }
        if (hipOccupancyMaxActiveBlocksPerMultiprocessor(&per_cu, (const void*)trunk_fwd, NWAVES * 64, LDS_BYTES) != hipSuccess || per_cu < 1)
            fprintf(stderr, "kernel_launch: note: occupancy query reports %d workgroups per CU\n", per_cu);
        (void)hipGetLastError();
        grid = cus;
        if (grid > 256) grid = 256;
    }
    if (grid < 0) return;
    if (hipMemsetAsync((char*)d_ws + WS_CTL, 0, CTL_ZERO_BYTES, stream) != hipSuccess) return;
    Args a{};
    for (int i = 0; i < 19; ++i) a.in[i] = (const float*)d_in[i];
    a.out = (float*)d_out; a.ws = (unsigned char*)d_ws;
#if MK_PER_PHASE
    for (int p = 0; p < N_PHASES; ++p) { a.ph_lo = p; a.ph_hi = p + 1; hipLaunchKernelGGL(trunk_fwd, dim3(grid), dim3(NWAVES * 64), LDS_BYTES, stream, a); }
#else
    a.ph_lo = 0; a.ph_hi = N_PHASES;
    hipLaunchKernelGGL(trunk_fwd, dim3(grid), dim3(NWAVES * 64), LDS_BYTES, stream, a);
#endif
}
```
